# Optimizing an MI355X kernel written in HIP

```python
import jax, jax.numpy as jnp
from jax import lax
import numpy as np

D_MODEL = 2048
BATCH = 16
SEQ = 2048
DEPTH = 2

CHUNK = 64
LEFT_CHUNKS = 8
BAND_CHUNKS = LEFT_CHUNKS + 1
D_MIX = D_MODEL
D_LRU = D_MIX // 2
LRU_HEADS = 16
LRU_BLOCK = D_LRU // LRU_HEADS
CONV_WIDTH = 4
LRU_C = 8.0
D_ATT = D_MIX - D_LRU
ATT_HEADS = 8
HEAD_DIM = D_ATT // ATT_HEADS
MAX_REL = 128
N_REL = 2 * MAX_REL + 1
D_FF = 5632
D_IN = 2 * D_LRU + 3 * D_ATT
EPS = 1e-6
NEG_INF = -1e30

kernel_name = "macaron_hybrid_rglru_chunkattn"


def rmsnorm(x, g):
    xf = x.astype(jnp.float32)
    y = xf * lax.rsqrt(jnp.mean(xf * xf, axis=-1, keepdims=True) + EPS)
    return (y * g.astype(jnp.float32)).astype(x.dtype)


def swiglu(h, w_gate, w_up, w_down):
    return (jax.nn.silu(h @ w_gate) * (h @ w_up)) @ w_down


def causal_dwconv(x, w, b):
    s = x.shape[1]
    xp = jnp.pad(x, ((0, 0), (CONV_WIDTH - 1, 0), (0, 0)))
    y = b
    for k in range(CONV_WIDTH):
        y = y + xp[:, k:k + s] * w[k]
    return y


def block_diag_linear(x, w, b):
    bsz, s, _ = x.shape
    xh = x.reshape(bsz, s, LRU_HEADS, LRU_BLOCK)
    return jnp.einsum('bshi,hij->bshj', xh, w).reshape(bsz, s, D_LRU) + b


def _lin_rec_combine(e1, e2):
    a1, b1 = e1
    a2, b2 = e2
    return a1 * a2, a2 * b1 + b2


def rg_lru(x, w_a, b_a, w_x, b_x, lam):
    r = jax.nn.sigmoid(block_diag_linear(x, w_a, b_a)).astype(jnp.float32)
    i = jax.nn.sigmoid(block_diag_linear(x, w_x, b_x)).astype(jnp.float32)
    log_a = -LRU_C * r * jax.nn.softplus(-lam.astype(jnp.float32))
    a = jnp.exp(log_a)
    mult = jnp.sqrt(-jnp.expm1(2.0 * log_a))
    u = mult * i * x.astype(jnp.float32)
    _, h = lax.associative_scan(_lin_rec_combine, (a, u), axis=1)
    return h.astype(x.dtype)


def chunk_attention(q, k, v, rel_table):
    bsz, s, _ = q.shape
    nc = s // CHUNK
    q = q.reshape(bsz, nc, CHUNK, ATT_HEADS, HEAD_DIM)
    k = k.reshape(bsz, nc, CHUNK, ATT_HEADS, HEAD_DIM)
    v = v.reshape(bsz, nc, CHUNK, ATT_HEADS, HEAD_DIM)
    pad = ((0, 0), (LEFT_CHUNKS, 0), (0, 0), (0, 0), (0, 0))
    kp = jnp.pad(k, pad)
    vp = jnp.pad(v, pad)
    band_idx = np.arange(nc)[:, None] + np.arange(BAND_CHUNKS)[None, :]
    nk = BAND_CHUNKS * CHUNK
    kb = kp[:, band_idx].reshape(bsz, nc, nk, ATT_HEADS, HEAD_DIM)
    vb = vp[:, band_idx].reshape(bsz, nc, nk, ATT_HEADS, HEAD_DIM)
    scores = jnp.einsum('bcqhd,bckhd->bhcqk', q, kb).astype(jnp.float32) * (HEAD_DIM ** -0.5)
    key_off = (np.arange(BAND_CHUNKS)[:, None] * CHUNK - LEFT_CHUNKS * CHUNK
               + np.arange(CHUNK)[None, :]).reshape(-1)
    rel = key_off[None, :] - np.arange(CHUNK)[:, None]
    rel_idx = np.clip(rel, -MAX_REL, MAX_REL) + MAX_REL
    bias = rel_table[:, rel_idx].astype(jnp.float32)
    valid = (np.arange(nc)[:, None] - LEFT_CHUNKS + np.arange(BAND_CHUNKS)[None, :]) >= 0
    valid = np.repeat(valid, CHUNK, axis=1)
    scores = scores + bias[None, :, None]
    scores = jnp.where(valid[None, None, :, None, :], scores, NEG_INF)
    p = jax.nn.softmax(scores, axis=-1).astype(v.dtype)
    o = jnp.einsum('bhcqk,bckhd->bcqhd', p, vb)
    return o.reshape(bsz, s, D_ATT)


def setup_inputs(seed: int = 0) -> dict:
    key = jax.random.key(seed)
    ks = jax.random.split(key, 24)
    f32 = jnp.float32

    def nrm(k, shape, fan_in):
        return jax.random.normal(k, shape, f32) * (fan_in ** -0.5)

    def gain(k, shape):
        return 1.0 + 0.02 * jax.random.normal(k, shape, f32)

    u = jax.random.uniform(ks[13], (DEPTH, D_LRU), f32, 0.9, 0.999)
    sig = u ** (1.0 / LRU_C)
    lam = jnp.log(sig) - jnp.log1p(-sig)
    return {
        "x": jax.random.normal(ks[0], (BATCH, SEQ, D_MODEL), f32),
        "ffn1_norm": gain(ks[1], (DEPTH, D_MODEL)),
        "ffn1_w_gate": nrm(ks[2], (DEPTH, D_MODEL, D_FF), D_MODEL),
        "ffn1_w_up": nrm(ks[3], (DEPTH, D_MODEL, D_FF), D_MODEL),
        "ffn1_w_down": nrm(ks[4], (DEPTH, D_FF, D_MODEL), D_FF),
        "mix_norm": gain(ks[5], (DEPTH, D_MODEL)),
        "w_in": nrm(ks[6], (DEPTH, D_MODEL, D_IN), D_MODEL),
        "conv_w": nrm(ks[7], (DEPTH, CONV_WIDTH, D_LRU), CONV_WIDTH),
        "conv_b": 0.01 * jax.random.normal(ks[8], (DEPTH, D_LRU), f32),
        "lru_gate_a_w": nrm(ks[9], (DEPTH, LRU_HEADS, LRU_BLOCK, LRU_BLOCK), LRU_BLOCK),
        "lru_gate_a_b": 0.01 * jax.random.normal(ks[10], (DEPTH, D_LRU), f32),
        "lru_gate_x_w": nrm(ks[11], (DEPTH, LRU_HEADS, LRU_BLOCK, LRU_BLOCK), LRU_BLOCK),
        "lru_gate_x_b": 0.01 * jax.random.normal(ks[12], (DEPTH, D_LRU), f32),
        "lru_lambda": lam,
        "rel_bias": 0.1 * jax.random.normal(ks[14], (DEPTH, ATT_HEADS, N_REL), f32),
        "lru_out_norm": gain(ks[15], (DEPTH, D_LRU)),
        "att_out_norm": gain(ks[16], (DEPTH, D_ATT)),
        "w_out": nrm(ks[17], (DEPTH, D_MIX, D_MODEL), D_MIX),
        "ffn2_norm": gain(ks[18], (DEPTH, D_MODEL)),
        "ffn2_w_gate": nrm(ks[19], (DEPTH, D_MODEL, D_FF), D_MODEL),
        "ffn2_w_up": nrm(ks[20], (DEPTH, D_MODEL, D_FF), D_MODEL),
        "ffn2_w_down": nrm(ks[21], (DEPTH, D_FF, D_MODEL), D_FF),
        "final_norm": gain(ks[22], (D_MODEL,)),
    }


def reference(x, ffn1_norm, ffn1_w_gate, ffn1_w_up, ffn1_w_down, mix_norm, w_in,
              conv_w, conv_b, lru_gate_a_w, lru_gate_a_b, lru_gate_x_w, lru_gate_x_b,
              lru_lambda, rel_bias, lru_out_norm, att_out_norm, w_out,
              ffn2_norm, ffn2_w_gate, ffn2_w_up, ffn2_w_down, final_norm):
    splits = [D_LRU, 2 * D_LRU, 2 * D_LRU + D_ATT, 2 * D_LRU + 2 * D_ATT]
    for l in range(DEPTH):
        h = rmsnorm(x, ffn1_norm[l])
        x = x + 0.5 * swiglu(h, ffn1_w_gate[l], ffn1_w_up[l], ffn1_w_down[l])
        h = rmsnorm(x, mix_norm[l])
        z = h @ w_in[l]
        xl, gl, q, k, v = jnp.split(z, splits, axis=-1)
        xl = causal_dwconv(xl, conv_w[l], conv_b[l])
        y_lru = rg_lru(xl, lru_gate_a_w[l], lru_gate_a_b[l], lru_gate_x_w[l],
                       lru_gate_x_b[l], lru_lambda[l]) * jax.nn.gelu(gl)
        y_att = chunk_attention(q, k, v, rel_bias[l])
        y = jnp.concatenate([rmsnorm(y_lru, lru_out_norm[l]),
                             rmsnorm(y_att, att_out_norm[l])], axis=-1)
        x = x + y @ w_out[l]
        h = rmsnorm(x, ffn2_norm[l])
        x = x + 0.5 * swiglu(h, ffn2_w_gate[l], ffn2_w_up[l], ffn2_w_down[l])
    return rmsnorm(x, final_norm)
```

```cpp
#include <hip/hip_runtime.h>
#include <hip/hip_cooperative_groups.h>
#include <cstdio>
#include <cstdint>
namespace cg = cooperative_groups;

#define LAS __attribute__((address_space(3)))
#define LAUNDER(v) asm volatile("" : "+v"(v))
typedef unsigned short bf16_t;
typedef short bf16x8 __attribute__((ext_vector_type(8)));
typedef float f32x4 __attribute__((ext_vector_type(4)));
typedef float f32x2 __attribute__((ext_vector_type(2)));
typedef unsigned u32x4 __attribute__((ext_vector_type(4)));
typedef unsigned u32x2 __attribute__((ext_vector_type(2)));

constexpr int NB = 16, SEQ = 2048, M = NB * SEQ, D = 2048, FF = 5632, DIN = 5120, DL = 1024, NH = 8, HD = 128, NREL = 257, DEPTH = 2;
constexpr int ZLD = 3072;
constexpr float EPS = 1e-6f;
constexpr float LOG2E = 1.4426950408889634f;

constexpr size_t MiB = 1u << 20;
constexpr size_t SZ_WGU = (size_t)2 * FF * D * 2, SZ_WD = (size_t)D * FF * 2, SZ_WIN = (size_t)DIN * D * 2, SZ_WOUT = (size_t)D * D * 2;
constexpr size_t OFF_WGU1 = 0, OFF_WD1 = OFF_WGU1 + SZ_WGU, OFF_WIN = OFF_WD1 + SZ_WD, OFF_WOUT = OFF_WIN + SZ_WIN, OFF_WGU2 = OFF_WOUT + SZ_WOUT, OFF_WD2 = OFF_WGU2 + SZ_WGU;
constexpr size_t LAYER_W = OFF_WD2 + SZ_WD;
static_assert(LAYER_W == 160 * MiB, "weights per layer");
constexpr size_t WS_BIG = 2 * LAYER_W;
constexpr size_t WS_VT = WS_BIG + (size_t)M * ZLD * 2;
constexpr size_t WS_KH = WS_VT + (size_t)M * 1024 * 2;
constexpr size_t WS_H = WS_BIG + 352 * MiB;
constexpr size_t WS_H2 = WS_H + 128 * MiB;
constexpr size_t WS_SSQ = WS_H2 + 128 * MiB;
constexpr size_t WS_CTL = WS_SSQ + 8 * MiB;
constexpr size_t CTL_BYTES = 16384;
constexpr size_t WS_END = WS_CTL + 1 * MiB;
static_assert((size_t)M * FF * 2 == 352 * MiB, "hidden size");

constexpr int NWAVES = 8, NTHREADS = 512;
constexpr int LDS_BYTES = 147456;

__device__ __forceinline__ unsigned cvt_pk_bf16(float lo, float hi) { unsigned r; asm volatile("v_cvt_pk_bf16_f32 %0, %1, %2" : "=v"(r) : "v"(lo), "v"(hi)); return r; }
__device__ __forceinline__ float bf_lo(unsigned u) { return __uint_as_float(u << 16); }
__device__ __forceinline__ float bf_hi(unsigned u) { return __uint_as_float(u & 0xffff0000u); }
__device__ __forceinline__ float fast_exp2(float x) { return __builtin_amdgcn_exp2f(x); }
__device__ __forceinline__ float fast_rcp(float x) { return __builtin_amdgcn_rcpf(x); }
__device__ __forceinline__ float sigmoidf_(float x) { return fast_rcp(1.0f + fast_exp2(-LOG2E * x)); }

namespace pg8 {
constexpr int BM = 256, BK = 64, HALF = 128, HTB = HALF * BK * 2, STAGE_BYTES = 8 * HTB, NXCD = 8, WGM = 8;
__host__ __device__ __forceinline__ int lds_byte(int r, int c) { const int st = (r >> 4) * 2 + (c >> 5), rr = r & 15, cc = c & 31, ob = rr * 64 + cc * 2; return st * 1024 + (ob ^ (((ob >> 9) & 1) << 5)); }
__host__ __device__ __forceinline__ void stage_rc(int b, int& R, int& C) { const int st = b / 1024, sb = b % 1024, swz = sb ^ (((sb >> 9) & 1) << 5); R = (st >> 1) * 16 + swz / 64; C = (st & 1) * 32 + (swz % 64) / 2; }
__host__ __device__ __forceinline__ int perm32(int rho) { const int n = rho >> 4, i = rho & 15; return 8 * (i >> 2) + 4 * n + (i & 3); }

struct Unit { int pm, pn; };
struct Gemm { const bf16_t* A; const bf16_t* Bt; int M, N, K; };

struct StaticOrder {
    int nM, nN, nwg, G, c;
    __host__ __device__ void init(int M_, int N_, int G_, int c_) { nM = M_ / BM; nN = N_ / BM; nwg = nM * nN; G = G_; c = c_; }
    __host__ __device__ bool next(int i, Unit& u) const {
        const long L = (long)i * G + c; if (L >= nwg) return false;
        int wgid = (int)L; { const int q = nwg / NXCD, r = nwg % NXCD, xcd = wgid % NXCD, off = wgid / NXCD; wgid = (xcd < r ? xcd * (q + 1) : r * (q + 1) + (xcd - r) * q) + off; }
        const int nig = WGM * nN, gid = wgid / nig, fm = gid * WGM, gsz = (nM - fm) < WGM ? (nM - fm) : WGM;
        u.pm = fm + ((wgid % nig) % gsz); u.pn = (wgid % nig) / gsz; return true;
    }
    __device__ __forceinline__ void a_ready(const Unit&) const {}
    __device__ __forceinline__ void done(const Unit&) const {}
};


constexpr int LDS_RS = 131072 + 1024, LDS_RSPM = 131072 + 2048 + 64, LDS_SSP = 131072 + 4096;
__device__ __forceinline__ void rs_panel(LAS unsigned char* lds, const float* ssq, int pm) {
    volatile LAS int* pmL = (volatile LAS int*)(lds + LDS_RSPM); LAS float* rsL = (LAS float*)(lds + LDS_RS);
    if (pmL[0] != pm) {
        asm volatile("s_waitcnt lgkmcnt(0)" ::: "memory"); __builtin_amdgcn_s_barrier();
        const int t = threadIdx.x;
        if (t < 256) { const f32x4* pp = (const f32x4*)(ssq + (size_t)(pm * 256 + t) * 8); const f32x4 pa = pp[0], pb = pp[1];
            rsL[t] = __builtin_amdgcn_rsqf((((pa.x + pa.y) + (pa.z + pa.w)) + ((pb.x + pb.y) + (pb.z + pb.w))) * (1.0f / D) + EPS); }
        if (t == 0) pmL[0] = pm;
        asm volatile("s_waitcnt vmcnt(0) lgkmcnt(0)" ::: "memory"); __builtin_amdgcn_s_barrier();
    }
}
struct EpiSwiGLU {
    static constexpr bool PERM = true, AFTER_DRAIN = false;
    bf16_t* O; int ldc; const float* ssq; LAS unsigned char* lds;
    __device__ __forceinline__ void operator()(const f32x4 (&acc)[2][2][4][2], const Unit& u, int wr, int wc, int fr, int fq) const {
        rs_panel(lds, ssq, u.pm);
        const LAS float* rsL = (const LAS float*)(lds + LDS_RS) + wr * 64 + fr;
        const int row0 = u.pm * BM + wr * 64 + fr; const int col0 = u.pn * HALF + wc * 32 + 8 * fq;
#pragma unroll
        for (int ai = 0; ai < 2; ++ai)
#pragma unroll
            for (int m = 0; m < 4; ++m) {
                bf16_t* rowp = O + (size_t)(row0 + ai * HALF + m * 16) * ldc + col0;
                const float rs = rsL[ai * HALF + m * 16];
                float v[8];
#pragma unroll
                for (int n = 0; n < 2; ++n)
#pragma unroll
                    for (int i = 0; i < 4; ++i) { const float g = acc[ai][0][m][n][i] * rs, up = acc[ai][1][m][n][i] * rs; v[n * 4 + i] = g * sigmoidf_(g) * up; }
                u32x4 w; w.x = cvt_pk_bf16(v[0], v[1]); w.y = cvt_pk_bf16(v[2], v[3]); w.z = cvt_pk_bf16(v[4], v[5]); w.w = cvt_pk_bf16(v[6], v[7]);
                *(u32x4*)rowp = w;
            }
    }
};
template <bool HALFSC> struct EpiResid {
    static constexpr bool PERM = false, AFTER_DRAIN = false;
    const float* res; float* out; bf16_t* xb; float* ssq_part; LAS unsigned char* lds;
    __device__ __forceinline__ void operator()(const f32x4 (&acc)[2][2][4][2], const Unit& u, int wr, int wc, int fr, int fq) const {
        const float* const res_ = res; float* const out_ = out; const float scale_ = HALFSC ? 0.5f : 1.0f; bf16_t* const xb_ = xb; float* const ssq_ = ssq_part;
        LAS float* pl = (LAS float*)(lds + LDS_SSP);
        const int col0 = u.pn * BM + wc * 32 + 4 * fq;
        const size_t base = (size_t)(u.pm * BM + wr * 64 + fr) * D + col0;
        f32x4 r[2][2][2][2];
#define ER_LOAD(buf, bb) do { _Pragma("unroll") for (int mm = 0; mm < 2; ++mm) _Pragma("unroll") for (int bj = 0; bj < 2; ++bj) _Pragma("unroll") for (int n = 0; n < 2; ++n) \
            r[buf][mm][bj][n] = *(const f32x4*)(res_ + base + (size_t)(((bb) >> 1) * HALF + (((bb) & 1) * 2 + mm) * 16) * D + bj * HALF + n * 16); } while (0)
        ER_LOAD(0, 0);
#pragma unroll
        for (int bb = 0; bb < 4; ++bb) {
            if (bb < 3) ER_LOAD((bb + 1) & 1, bb + 1);
            const int ai = bb >> 1;
#pragma unroll
            for (int mm = 0; mm < 2; ++mm) { const int m = (bb & 1) * 2 + mm; const int rowl = ai * HALF + m * 16; const size_t off = base + (size_t)rowl * D; float ssum = 0.f;
#pragma unroll
                for (int bj = 0; bj < 2; ++bj)
#pragma unroll
                    for (int n = 0; n < 2; ++n) { const f32x4 o = r[bb & 1][mm][bj][n] + acc[ai][bj][m][n] * scale_; *(f32x4*)(out_ + off + bj * HALF + n * 16) = o;
                        u32x2 w; w.x = cvt_pk_bf16(o.x, o.y); w.y = cvt_pk_bf16(o.z, o.w); *(u32x2*)(xb_ + off + bj * HALF + n * 16) = w;
                        ssum += (o.x * o.x + o.y * o.y) + (o.z * o.z + o.w * o.w); }
                ssum += __shfl_xor(ssum, 16); ssum += __shfl_xor(ssum, 32);
                if (fq == 0) pl[(rowl + wr * 64 + fr) * 4 + wc] = ssum;
            }
        }
#undef ER_LOAD
        asm volatile("s_waitcnt lgkmcnt(0)" ::: "memory"); __builtin_amdgcn_s_barrier();
        const int t = threadIdx.x;
        if (t < 256) { const f32x4 p = *(const LAS f32x4*)(pl + t * 4); ssq_[(size_t)(u.pm * BM + t) * 8 + u.pn] = (p.x + p.y) + (p.z + p.w); }
    }
};
struct EpiZ {
    static constexpr bool PERM = true, AFTER_DRAIN = false;
    bf16_t* Z; bf16_t* Vt; bf16_t* Kh; const float* ssq; LAS unsigned char* lds;
    __device__ __forceinline__ void operator()(const f32x4 (&acc)[2][2][4][2], const Unit& u, int wr, int wc, int fr, int fq) const {
        rs_panel(lds, ssq, u.pm);
        float rs[2][4];
        { const LAS float* rsL = (const LAS float*)(lds + LDS_RS) + wr * 64 + fr;
#pragma unroll
          for (int ai = 0; ai < 2; ++ai)
#pragma unroll
            for (int m = 0; m < 4; ++m) rs[ai][m] = rsL[ai * HALF + m * 16]; }
        if (u.pn >= 12 && u.pn < 16) {
            const int b = (u.pm * BM) / SEQ; const int s0 = (u.pm * BM) % SEQ + wr * 64 + fr;
#pragma unroll
            for (int bj = 0; bj < 2; ++bj) {
                const int head = (u.pn - 12) * 2 + bj;
                bf16_t* hb = Kh + ((size_t)(b * NH + head) * SEQ + s0) * HD + wc * 32 + 8 * fq;
#pragma unroll
                for (int ai = 0; ai < 2; ++ai)
#pragma unroll
                    for (int m = 0; m < 4; ++m) { const f32x4 v0 = acc[ai][bj][m][0] * rs[ai][m], v1 = acc[ai][bj][m][1] * rs[ai][m];
                        u32x4 w; w.x = cvt_pk_bf16(v0[0], v0[1]); w.y = cvt_pk_bf16(v0[2], v0[3]); w.z = cvt_pk_bf16(v1[0], v1[1]); w.w = cvt_pk_bf16(v1[2], v1[3]);
                        *(u32x4*)(hb + (size_t)(ai * HALF + m * 16) * HD) = w; }
            }
        } else if (u.pn < 12) {
            const int row0 = u.pm * BM + wr * 64 + fr; const int col0 = u.pn * BM + wc * 32 + 8 * fq;
#pragma unroll
            for (int ai = 0; ai < 2; ++ai)
#pragma unroll
                for (int m = 0; m < 4; ++m) {
                    bf16_t* rowp = Z + (size_t)(row0 + ai * HALF + m * 16) * ZLD + col0;
#pragma unroll
                    for (int bj = 0; bj < 2; ++bj) { const f32x4 v0 = acc[ai][bj][m][0] * rs[ai][m], v1 = acc[ai][bj][m][1] * rs[ai][m];
                        u32x4 w; w.x = cvt_pk_bf16(v0[0], v0[1]); w.y = cvt_pk_bf16(v0[2], v0[3]); w.z = cvt_pk_bf16(v1[0], v1[1]); w.w = cvt_pk_bf16(v1[2], v1[3]);
                        *(u32x4*)(rowp + bj * HALF) = w; }
                }
        } else {
            const int b = (u.pm * BM) / SEQ; const int s0 = (u.pm * BM) % SEQ + wr * 64 + fr;
#pragma unroll
            for (int bj = 0; bj < 2; ++bj) {
                const int head = (u.pn - 16) * 2 + bj;
                bf16_t* hb = Vt + ((size_t)(b * NH + head) * HD + wc * 32 + 8 * fq) * SEQ + s0;
#pragma unroll
                for (int ai = 0; ai < 2; ++ai)
#pragma unroll
                    for (int m = 0; m < 4; ++m)
#pragma unroll
                        for (int n = 0; n < 2; ++n)
#pragma unroll
                            for (int i = 0; i < 4; ++i) {
                                const unsigned w = cvt_pk_bf16(acc[ai][bj][m][n][i] * rs[ai][m], 0.f);
                                hb[(size_t)(4 * n + i) * SEQ + ai * HALF + m * 16] = (bf16_t)(w & 0xffffu);
                            }
            }
        }
    }
};

template <class Epi, class Sched, bool ALIGN_EPI = false, bool SP2 = false>
__device__ __forceinline__ void gemm_phase(LAS unsigned char* lds, const Gemm g, const Sched& S, const Epi& E) {
    int tid_l = threadIdx.x; LAUNDER(tid_l);
    const int tid = tid_l, wid = __builtin_amdgcn_readfirstlane(tid >> 6), lane = tid & 63, wr = wid >> 2, wc = wid & 3, fr = lane & 15, fq = lane >> 4;
    const int K = g.K, nt = K / BK;
    unsigned voffA[2], voffB[2];
#pragma unroll
    for (int i = 0; i < 2; ++i) { int R, C; stage_rc(tid * 16 + i * 8192, R, C); const int Rb = Epi::PERM ? ((R & ~31) + perm32(R & 31)) : R;
        voffA[i] = (unsigned)(R * K + C) * 2u; voffB[i] = (unsigned)(Rb * K + C) * 2u; }
    const size_t kstep = (size_t)(BK * 2);
    const size_t hstep = (size_t)HALF * K * 2;
    const size_t tstep = 2 * hstep;
    const unsigned ldsw = (unsigned)wid * 1024u;
    const int aoff = lds_byte(wr * 64 + fr, fq * 8), boff = lds_byte(wc * 32 + fr, fq * 8);
#define PG8_SA(b, h) (((b) * 2 + (h)) * HTB)
#define PG8_SB(b, h) ((4 + (b) * 2 + (h)) * HTB)
#define PG8_STAGE(bufoff, gbase, voff) do { _Pragma("unroll") for (int _i = 0; _i < 2; ++_i) \
        __builtin_amdgcn_global_load_lds((const unsigned*)((const char*)(gbase) + (voff)[_i]), (LAS unsigned*)(lds + (bufoff) + ldsw + _i * 8192), 16, 0, 0); } while (0)
#define PG8_LDA(dst, b, h) do { _Pragma("unroll") for (int m = 0; m < 4; ++m) _Pragma("unroll") for (int k = 0; k < 2; ++k) dst[m][k] = *(const LAS bf16x8*)(lds + PG8_SA(b, h) + aoff + m * 2048 + k * 1024); } while (0)
#define PG8_LDB(dst, b, h) do { _Pragma("unroll") for (int n = 0; n < 2; ++n) _Pragma("unroll") for (int k = 0; k < 2; ++k) dst[n][k] = *(const LAS bf16x8*)(lds + PG8_SB(b, h) + boff + n * 2048 + k * 1024); } while (0)
#define PG8_MMA(ai, bj, At, Bt) do { __builtin_amdgcn_s_setprio(1); _Pragma("unroll") for (int m = 0; m < 4; ++m) _Pragma("unroll") for (int n = 0; n < 2; ++n) _Pragma("unroll") for (int k = 0; k < 2; ++k) \
        acc[ai][bj][m][n] = __builtin_amdgcn_mfma_f32_16x16x32_bf16(Bt[n][k], At[m][k], acc[ai][bj][m][n], 0, 0, 0); __builtin_amdgcn_s_setprio(0); } while (0)
#define PG8_WAIT_V(n) asm volatile("s_waitcnt vmcnt(" #n ")" ::: "memory")
#define PG8_WAIT_L(n) asm volatile("s_waitcnt lgkmcnt(" #n ")" ::: "memory")
#define PG8_BAR __builtin_amdgcn_s_barrier()
#define PG8_SCHED __builtin_amdgcn_sched_barrier(0)
    Unit cur, nxt; int ui = 0;
    if (!S.next(0, cur)) return;
    f32x4 acc[2][2][4][2];
#pragma unroll
    for (int a = 0; a < 2; ++a)
#pragma unroll
        for (int b = 0; b < 2; ++b)
#pragma unroll
            for (int m = 0; m < 4; ++m)
#pragma unroll
                for (int n = 0; n < 2; ++n) acc[a][b][m][n] = (f32x4){0.f, 0.f, 0.f, 0.f};
    bf16x8 At[4][2], B0[2][2], B1[2][2];
    const char* cA = (const char*)g.A + (size_t)cur.pm * tstep; const char* cB = (const char*)g.Bt + (size_t)cur.pn * tstep;
    S.a_ready(cur);
    if constexpr (SP2) {
        PG8_STAGE(PG8_SB(0, 0), cB, voffB); PG8_STAGE(PG8_SB(0, 1), cB + hstep, voffB); PG8_STAGE(PG8_SA(0, 0), cA, voffA); PG8_STAGE(PG8_SA(0, 1), cA + hstep, voffA);
        if (wr == 1) PG8_BAR;
        PG8_WAIT_V(2); PG8_BAR;
        PG8_STAGE(PG8_SB(1, 0), cB + kstep, voffB); PG8_STAGE(PG8_SA(1, 0), cA + kstep, voffA); PG8_STAGE(PG8_SB(1, 1), cB + hstep + kstep, voffB);
        PG8_WAIT_V(6); PG8_BAR;
    } else {
        PG8_STAGE(PG8_SB(0, 0), cB, voffB); PG8_STAGE(PG8_SA(0, 0), cA, voffA); PG8_STAGE(PG8_SB(0, 1), cB + hstep, voffB); PG8_STAGE(PG8_SA(0, 1), cA + hstep, voffA);
        if (wr == 1) PG8_BAR;
        PG8_WAIT_V(4); PG8_BAR;
        PG8_STAGE(PG8_SB(1, 0), cB + kstep, voffB); PG8_STAGE(PG8_SA(1, 0), cA + kstep, voffA); PG8_STAGE(PG8_SB(1, 1), cB + hstep + kstep, voffB);
        PG8_WAIT_V(6); PG8_BAR;
    }
    for (;;) {
        const bool has_next = S.next(ui + 1, nxt);
        const char* nA = has_next ? (const char*)g.A + (size_t)nxt.pm * tstep : cA; const char* nB = has_next ? (const char*)g.Bt + (size_t)nxt.pn * tstep : cB;
        for (int t = 0; t < nt; t += 2) {
            const bool last = (t == nt - 2);
            const char* a1 = cA + (size_t)(t + 1) * kstep;
            const char* a2 = last ? nA : cA + (size_t)(t + 2) * kstep; const char* b2 = last ? nB : cB + (size_t)(t + 2) * kstep;
            const char* a3 = a2 + kstep; const char* b3 = b2 + kstep;
            if (last && has_next) S.a_ready(nxt);
            if constexpr (SP2) {
            PG8_LDB(B0, 0, 0); PG8_LDB(B1, 0, 1); PG8_SCHED; PG8_LDA(At, 0, 0); PG8_STAGE(PG8_SA(1, 1), a1 + hstep, voffA);
            PG8_WAIT_V(8); PG8_WAIT_L(0); PG8_BAR; PG8_MMA(0, 0, At, B0); PG8_MMA(0, 1, At, B1); PG8_BAR; PG8_SCHED;
            PG8_LDA(At, 0, 1); PG8_STAGE(PG8_SB(0, 0), b2, voffB); PG8_STAGE(PG8_SB(0, 1), b2 + hstep, voffB); PG8_STAGE(PG8_SA(0, 0), a2, voffA);
            PG8_WAIT_V(8); PG8_WAIT_L(0); PG8_BAR; PG8_MMA(1, 0, At, B0); PG8_MMA(1, 1, At, B1); PG8_BAR; PG8_SCHED;
            PG8_LDB(B0, 1, 0); PG8_LDB(B1, 1, 1); PG8_SCHED; PG8_LDA(At, 1, 0); PG8_STAGE(PG8_SA(0, 1), a2 + hstep, voffA);
            PG8_WAIT_V(8); PG8_WAIT_L(0); PG8_BAR; PG8_MMA(0, 0, At, B0); PG8_MMA(0, 1, At, B1); PG8_BAR; PG8_SCHED;
            PG8_LDA(At, 1, 1); PG8_STAGE(PG8_SB(1, 0), b3, voffB); PG8_STAGE(PG8_SB(1, 1), b3 + hstep, voffB); PG8_STAGE(PG8_SA(1, 0), a3, voffA);
            PG8_WAIT_V(8); PG8_WAIT_L(0); PG8_BAR; PG8_MMA(1, 0, At, B0); PG8_MMA(1, 1, At, B1); PG8_BAR; PG8_SCHED;
            } else {
            PG8_LDB(B0, 0, 0); PG8_SCHED; PG8_LDA(At, 0, 0); PG8_STAGE(PG8_SA(1, 1), a1 + hstep, voffA);
            PG8_WAIT_L(8); PG8_BAR; PG8_WAIT_L(0); PG8_MMA(0, 0, At, B0); PG8_BAR; PG8_SCHED;
            PG8_LDB(B1, 0, 1); PG8_STAGE(PG8_SB(0, 0), b2, voffB);
            PG8_BAR; PG8_WAIT_L(0); PG8_MMA(0, 1, At, B1); PG8_BAR;
            PG8_LDA(At, 0, 1); PG8_STAGE(PG8_SA(0, 0), a2, voffA);
            PG8_BAR; PG8_WAIT_L(0); PG8_MMA(1, 0, At, B0); PG8_BAR; PG8_SCHED;
            PG8_STAGE(PG8_SB(0, 1), b2 + hstep, voffB);
            PG8_WAIT_V(6); PG8_BAR; PG8_MMA(1, 1, At, B1); PG8_BAR;
            PG8_LDB(B0, 1, 0); PG8_SCHED; PG8_LDA(At, 1, 0); PG8_STAGE(PG8_SA(0, 1), a2 + hstep, voffA);
            PG8_WAIT_L(8); PG8_BAR; PG8_WAIT_L(0); PG8_MMA(0, 0, At, B0); PG8_BAR; PG8_SCHED;
            PG8_LDB(B1, 1, 1); PG8_STAGE(PG8_SB(1, 0), b3, voffB);
            PG8_BAR; PG8_WAIT_L(0); PG8_MMA(0, 1, At, B1); PG8_BAR;
            PG8_LDA(At, 1, 1); PG8_STAGE(PG8_SA(1, 0), a3, voffA);
            PG8_BAR; PG8_WAIT_L(0); PG8_MMA(1, 0, At, B0); PG8_BAR; PG8_SCHED;
            PG8_STAGE(PG8_SB(1, 1), b3 + hstep, voffB);
            PG8_WAIT_V(6); PG8_BAR; PG8_MMA(1, 1, At, B1); PG8_BAR;
            }
        }
        if constexpr (ALIGN_EPI) { if (wr == 0) PG8_BAR; }
        if constexpr (!Epi::AFTER_DRAIN) { E(acc, cur, wr, wc, fr, fq); S.done(cur); }
        if (!has_next) break;
#pragma unroll
        for (int a = 0; a < 2; ++a)
#pragma unroll
            for (int b = 0; b < 2; ++b)
#pragma unroll
                for (int m = 0; m < 4; ++m)
#pragma unroll
                    for (int n = 0; n < 2; ++n) acc[a][b][m][n] = (f32x4){0.f, 0.f, 0.f, 0.f};
        cur = nxt; cA = nA; cB = nB; ++ui;
        if constexpr (ALIGN_EPI) { if (wr == 1) PG8_BAR; }
    }
    PG8_WAIT_V(0);
    if constexpr (!ALIGN_EPI) { if (wr == 0) PG8_BAR; }
    PG8_BAR;
#undef PG8_SA
#undef PG8_SB
#undef PG8_STAGE
#undef PG8_LDA
#undef PG8_LDB
#undef PG8_MMA
#undef PG8_WAIT_V
#undef PG8_WAIT_L
#undef PG8_BAR
#undef PG8_SCHED
}
}

#define LDS_WAIT() asm volatile("s_waitcnt lgkmcnt(0)" ::: "memory")

__device__ __forceinline__ float wave_sum(float v) {
#pragma unroll
    for (int o = 1; o < 64; o <<= 1) v += __shfl_xor(v, o);
    return v;
}

__device__ __forceinline__ void p0_transpose_item(const float* W, const float* gain, int K, int N, bf16_t* WT, int ilv, LAS float* scr, int item, int lane) {
    const int nblk = N / 32, kb = item / nblk, nb = item % nblk, k0 = 64 * kb, n0 = 32 * nb;
#pragma unroll 8
    for (int i = 0; i < 32; ++i) { const int kk = 2 * i + (lane >> 5); scr[kk * 33 + (lane & 31)] = W[(size_t)(k0 + kk) * N + n0 + (lane & 31)]; }
    LDS_WAIT(); asm volatile("" ::: "memory");
    const int c = lane & 7;
    f32x4 g0 = (f32x4){1.f, 1.f, 1.f, 1.f}, g1 = g0;
    if (gain) { g0 = *(const f32x4*)(gain + k0 + 8 * c); g1 = *(const f32x4*)(gain + k0 + 8 * c + 4); }
#pragma unroll
    for (int j = 0; j < 4; ++j) { const int n = (lane >> 3) + 8 * j; const LAS float* s = scr + (8 * c) * 33 + n;
        u32x4 o; o.x = cvt_pk_bf16(s[0 * 33] * g0.x, s[1 * 33] * g0.y); o.y = cvt_pk_bf16(s[2 * 33] * g0.z, s[3 * 33] * g0.w); o.z = cvt_pk_bf16(s[4 * 33] * g1.x, s[5 * 33] * g1.y); o.w = cvt_pk_bf16(s[6 * 33] * g1.z, s[7 * 33] * g1.w);
        const int nn = n0 + n; const int row = ilv < 0 ? nn : ((nn >> 7) * 256 + (nn & 127) + ilv);
        *(u32x4*)(WT + (size_t)row * K + k0 + 8 * c) = o; }
    LDS_WAIT(); asm volatile("" ::: "memory");
}

__device__ __forceinline__ void rms_rows_bf16(const float* x, const float* g, bf16_t* out, int gw, int NGW, int lane) {
    LAUNDER(lane);
    f32x4 gv[8];
#pragma unroll
    for (int j = 0; j < 8; ++j) gv[j] = *(const f32x4*)(g + 4 * lane + 256 * j);
    for (int m = gw; m < M; m += NGW) {
        const f32x4* xr = (const f32x4*)(x + (size_t)m * D) + lane; f32x4 v[8]; float s = 0.f;
#pragma unroll
        for (int j = 0; j < 8; ++j) { v[j] = xr[64 * j]; s += (v[j].x * v[j].x + v[j].y * v[j].y) + (v[j].z * v[j].z + v[j].w * v[j].w); }
        const float rstd = 1.0f / sqrtf(wave_sum(s) * (1.0f / D) + EPS);
        u32x2* o8 = (u32x2*)(out + (size_t)m * D) + lane;
#pragma unroll
        for (int j = 0; j < 8; ++j) { const f32x4 o = v[j] * rstd * gv[j]; u32x2 w; w.x = cvt_pk_bf16(o.x, o.y); w.y = cvt_pk_bf16(o.z, o.w); o8[64 * j] = w; }
    }
}
__device__ __forceinline__ void cast_rows_bf16(const float* x, bf16_t* out, float* ssq, int gw, int NGW, int lane) {
    LAUNDER(lane);
    for (int m = gw; m < M; m += NGW) {
        const f32x4* xr = (const f32x4*)(x + (size_t)m * D) + lane; f32x4 v[8]; float s = 0.f;
#pragma unroll
        for (int j = 0; j < 8; ++j) { v[j] = xr[64 * j]; s += (v[j].x * v[j].x + v[j].y * v[j].y) + (v[j].z * v[j].z + v[j].w * v[j].w); }
        s = wave_sum(s);
        if (lane == 0) { f32x4* pp = (f32x4*)(ssq + (size_t)m * 8); pp[0] = (f32x4){s, 0.f, 0.f, 0.f}; pp[1] = (f32x4){0.f, 0.f, 0.f, 0.f}; }
        u32x2* o8 = (u32x2*)(out + (size_t)m * D) + lane;
#pragma unroll
        for (int j = 0; j < 8; ++j) { u32x2 w; w.x = cvt_pk_bf16(v[j].x, v[j].y); w.y = cvt_pk_bf16(v[j].z, v[j].w); o8[64 * j] = w; }
    }
}
__device__ __forceinline__ void rms_rows_f32_inplace(float* x, const float* g, int gw, int NGW, int lane) {
    LAUNDER(lane);
    f32x4 gv[8];
#pragma unroll
    for (int j = 0; j < 8; ++j) gv[j] = *(const f32x4*)(g + 4 * lane + 256 * j);
    for (int m = gw; m < M; m += NGW) {
        f32x4* xr = (f32x4*)(x + (size_t)m * D) + lane; f32x4 v[8]; float s = 0.f;
#pragma unroll
        for (int j = 0; j < 8; ++j) { v[j] = xr[64 * j]; s += (v[j].x * v[j].x + v[j].y * v[j].y) + (v[j].z * v[j].z + v[j].w * v[j].w); }
        const float rstd = 1.0f / sqrtf(wave_sum(s) * (1.0f / D) + EPS);
#pragma unroll
        for (int j = 0; j < 8; ++j) xr[64 * j] = v[j] * rstd * gv[j];
    }
}
__device__ __forceinline__ void ynorm_rows(bf16_t* y, const float* g_lru, const float* g_att, int gw, int NGW, int lane) {
    LAUNDER(lane);
    f32x4 gv[4][2];
#pragma unroll
    for (int j = 0; j < 4; ++j) { const float* gp = (j < 2 ? g_lru + 512 * j : g_att + 512 * (j - 2)) + 8 * lane; gv[j][0] = *(const f32x4*)gp; gv[j][1] = *(const f32x4*)(gp + 4); }
    for (int m = gw; m < M; m += NGW) {
        u32x4* yr = (u32x4*)(y + (size_t)m * D) + lane; u32x4 raw[4]; float s0 = 0.f, s1 = 0.f;
#pragma unroll
        for (int j = 0; j < 4; ++j) raw[j] = yr[64 * j];
        float v[4][8];
#pragma unroll
        for (int j = 0; j < 4; ++j) {
            v[j][0] = bf_lo(raw[j].x); v[j][1] = bf_hi(raw[j].x); v[j][2] = bf_lo(raw[j].y); v[j][3] = bf_hi(raw[j].y);
            v[j][4] = bf_lo(raw[j].z); v[j][5] = bf_hi(raw[j].z); v[j][6] = bf_lo(raw[j].w); v[j][7] = bf_hi(raw[j].w);
            float s = 0.f;
#pragma unroll
            for (int e = 0; e < 8; ++e) s += v[j][e] * v[j][e];
            if (j < 2) s0 += s; else s1 += s;
        }
        const float r0 = 1.0f / sqrtf(wave_sum(s0) * (1.0f / 1024.f) + EPS), r1 = 1.0f / sqrtf(wave_sum(s1) * (1.0f / 1024.f) + EPS);
#pragma unroll
        for (int j = 0; j < 4; ++j) { const float r = j < 2 ? r0 : r1; u32x4 w;
            w.x = cvt_pk_bf16(v[j][0] * r * gv[j][0].x, v[j][1] * r * gv[j][0].y); w.y = cvt_pk_bf16(v[j][2] * r * gv[j][0].z, v[j][3] * r * gv[j][0].w);
            w.z = cvt_pk_bf16(v[j][4] * r * gv[j][1].x, v[j][5] * r * gv[j][1].y); w.w = cvt_pk_bf16(v[j][6] * r * gv[j][1].z, v[j][7] * r * gv[j][1].w);
            yr[64 * j] = w; }
    }
}

constexpr int LM_BIAS = 0;
constexpr int LM_CW = 8448;
constexpr int LM_CB = 9472;
constexpr int LM_P = 10240;
constexpr int LM_H = 18432;
__device__ __forceinline__ void lru_unit(LAS unsigned char* lds, const bf16_t* zm, bf16_t* yraw, const float* conv_w, const float* conv_b, const float* wa, const float* ba,
                                         const float* wx, const float* bx, const float* lam, int b, int hb, int tid) {
    LAUNDER(tid);
    const int lane = tid & 63, w = tid >> 6, fr = lane & 15, fq = lane >> 4;
    LAS float* cwL = (LAS float*)(lds + LM_CW); LAS float* cbL = (LAS float*)(lds + LM_CB); LAS float* PL = (LAS float*)(lds + LM_P); LAS float* HL = (LAS float*)(lds + LM_H);
    if (tid < 256) cwL[tid] = conv_w[(tid >> 6) * DL + hb * 64 + (tid & 63)];
    else if (tid < 320) cbL[tid - 256] = conv_b[hb * 64 + tid - 256];
    bf16x8 WA[4][2], WX[4][2];
#pragma unroll
    for (int nt = 0; nt < 4; ++nt)
#pragma unroll
        for (int ks = 0; ks < 2; ++ks) {
            const float* pa = wa + ((size_t)hb * 64 + ks * 32 + 8 * fq) * 64 + nt * 16 + fr; const float* px = wx + ((size_t)hb * 64 + ks * 32 + 8 * fq) * 64 + nt * 16 + fr;
            u32x4 ua, ux;
            ua.x = cvt_pk_bf16(pa[0 * 64], pa[1 * 64]); ua.y = cvt_pk_bf16(pa[2 * 64], pa[3 * 64]); ua.z = cvt_pk_bf16(pa[4 * 64], pa[5 * 64]); ua.w = cvt_pk_bf16(pa[6 * 64], pa[7 * 64]);
            ux.x = cvt_pk_bf16(px[0 * 64], px[1 * 64]); ux.y = cvt_pk_bf16(px[2 * 64], px[3 * 64]); ux.z = cvt_pk_bf16(px[4 * 64], px[5 * 64]); ux.w = cvt_pk_bf16(px[6 * 64], px[7 * 64]);
            WA[nt][ks] = __builtin_bit_cast(bf16x8, ua); WX[nt][ks] = __builtin_bit_cast(bf16x8, ux);
        }
    bf16x8 ID[2];
#pragma unroll
    for (int p = 0; p < 2; ++p)
#pragma unroll
        for (int e = 0; e < 8; ++e) ID[p][e] = (8 * fq + e == 16 * p + fr) ? (short)0x3F80 : (short)0;
    float pba[4], pbx[4], pcl[4];
#pragma unroll
    for (int nt = 0; nt < 4; ++nt) { const int c = hb * 64 + nt * 16 + fr; pba[nt] = ba[c]; pbx[nt] = bx[c]; pcl[nt] = -8.0f * log1pf(expf(-lam[c])); }
    __syncthreads();
    float hst[4], pst[4];
    const bf16_t* zb = zm + (size_t)b * SEQ * ZLD + hb * 64;
    const int tbaseA = 256 * w + (fr >> 2) * 64 + (fr & 3);
    const int tbaseD = 256 * w + fq * 64;
#pragma unroll 1
    for (int pass = 0; pass < 2; ++pass) {
        if (pass == 0) {
#pragma unroll
            for (int nt = 0; nt < 4; ++nt) { hst[nt] = 0.f; pst[nt] = 1.f; }
        }
        u32x4 XR[2][4], GR[2];
        {
            const int tA = tbaseA;
#pragma unroll
            for (int ks = 0; ks < 2; ++ks) {
                const int ch0 = ks * 32 + 8 * fq;
#pragma unroll
                for (int tap = 0; tap < 4; ++tap) { const int t = tA - 3 + tap; const int tt = t >= 0 ? t : 0; XR[ks][tap] = *(const u32x4*)(zb + (size_t)tt * ZLD + ch0); }
                GR[ks] = *(const u32x4*)(zb + (size_t)tA * ZLD + 1024 + ch0);
            }
        }
#pragma unroll 1
        for (int i = 0; i < 16; ++i) {
            const int tA = tbaseA + i * 4;
            const int tN = tbaseA + (i < 15 ? i + 1 : i) * 4;
            u32x4 XN[2][4], GN[2];
#pragma unroll
            for (int ks = 0; ks < 2; ++ks) {
                const int ch0 = ks * 32 + 8 * fq;
#pragma unroll
                for (int tap = 0; tap < 4; ++tap) { const int t = tN - 3 + tap; const int tt = t >= 0 ? t : 0; XN[ks][tap] = *(const u32x4*)(zb + (size_t)tt * ZLD + ch0); }
                GN[ks] = *(const u32x4*)(zb + (size_t)tN * ZLD + 1024 + ch0);
            }
            bf16x8 XC[2], GL[2];
#pragma unroll
            for (int ks = 0; ks < 2; ++ks) {
                const int ch0 = ks * 32 + 8 * fq;
                const f32x4 c0 = *(const LAS f32x4*)(cbL + ch0), c1 = *(const LAS f32x4*)(cbL + ch0 + 4);
                float a8[8] = {c0.x, c0.y, c0.z, c0.w, c1.x, c1.y, c1.z, c1.w};
#pragma unroll
                for (int tap = 0; tap < 4; ++tap) {
                    const bool ok = (tA - 3 + tap) >= 0;
                    u32x4 xr = XR[ks][tap];
                    if (!ok) xr = (u32x4){0u, 0u, 0u, 0u};
                    const f32x4 w0 = *(const LAS f32x4*)(cwL + tap * 64 + ch0), w1 = *(const LAS f32x4*)(cwL + tap * 64 + ch0 + 4);
                    a8[0] += w0.x * bf_lo(xr.x); a8[1] += w0.y * bf_hi(xr.x); a8[2] += w0.z * bf_lo(xr.y); a8[3] += w0.w * bf_hi(xr.y);
                    a8[4] += w1.x * bf_lo(xr.z); a8[5] += w1.y * bf_hi(xr.z); a8[6] += w1.z * bf_lo(xr.w); a8[7] += w1.w * bf_hi(xr.w);
                }
                u32x4 pk; pk.x = cvt_pk_bf16(a8[0], a8[1]); pk.y = cvt_pk_bf16(a8[2], a8[3]); pk.z = cvt_pk_bf16(a8[4], a8[5]); pk.w = cvt_pk_bf16(a8[6], a8[7]);
                XC[ks] = __builtin_bit_cast(bf16x8, pk);
                GL[ks] = __builtin_bit_cast(bf16x8, GR[ks]);
            }
#pragma unroll
            for (int nt = 0; nt < 4; ++nt) {
                f32x4 ga = (f32x4){0.f, 0.f, 0.f, 0.f}, gx = ga, xo = ga, go = ga;
#pragma unroll
                for (int ks = 0; ks < 2; ++ks) { ga = __builtin_amdgcn_mfma_f32_16x16x32_bf16(XC[ks], WA[nt][ks], ga, 0, 0, 0); gx = __builtin_amdgcn_mfma_f32_16x16x32_bf16(XC[ks], WX[nt][ks], gx, 0, 0, 0); }
                xo = __builtin_amdgcn_mfma_f32_16x16x32_bf16(XC[nt >> 1], ID[nt & 1], xo, 0, 0, 0);
                if (pass) go = __builtin_amdgcn_mfma_f32_16x16x32_bf16(GL[nt >> 1], ID[nt & 1], go, 0, 0, 0);
#pragma unroll
                for (int j = 0; j < 4; ++j) {
                    const float r = sigmoidf_(ga[j] + pba[nt]), ig = sigmoidf_(gx[j] + pbx[nt]);
                    const float la = pcl[nt] * r;
                    const float a = fast_exp2(la * LOG2E);
                    const float x2 = 2.0f * la;
                    float ome = -x2 * (1.0f + x2 * 0.5f * (1.0f + x2 * (1.0f / 3.0f)));
                    if (x2 < -0.03f) ome = 1.0f - a * a;
                    const float u = sqrtf(ome) * ig * xo[j];
                    hst[nt] = a * hst[nt] + u;
                    if (pass == 0) pst[nt] *= a;
                    else {
                        const float gv = go[j];
                        const float gel = gv * sigmoidf_(1.5957691216057308f * (gv + 0.044715f * gv * gv * gv));
                        const unsigned o = cvt_pk_bf16(hst[nt] * gel, 0.f);
                        yraw[(size_t)(b * SEQ + tbaseD + i * 4 + j) * D + hb * 64 + nt * 16 + fr] = (bf16_t)(o & 0xffffu);
                    }
                }
            }
#pragma unroll
            for (int ks = 0; ks < 2; ++ks) {
#pragma unroll
                for (int tap = 0; tap < 4; ++tap) XR[ks][tap] = XN[ks][tap];
                GR[ks] = GN[ks];
            }
        }
        if (pass == 0) {
            const int seg = 4 * w + fq;
#pragma unroll
            for (int nt = 0; nt < 4; ++nt) { PL[seg * 64 + nt * 16 + fr] = pst[nt]; HL[seg * 64 + nt * 16 + fr] = hst[nt]; }
            __syncthreads();
#pragma unroll
            for (int nt = 0; nt < 4; ++nt) hst[nt] = 0.f;
            for (int s2 = 0; s2 < seg; ++s2) {
#pragma unroll
                for (int nt = 0; nt < 4; ++nt) hst[nt] = PL[s2 * 64 + nt * 16 + fr] * hst[nt] + HL[s2 * 64 + nt * 16 + fr];
            }
        }
    }
    __syncthreads();
}

constexpr int LM_ATT = 32768;
#define ATT_COMPUTE(FAR) do { \
        bf16x8 Kf[2][4], Vf[8]; \
        _Pragma("unroll") for (int t = 0; t < 2; ++t) _Pragma("unroll") for (int ks = 0; ks < 4; ++ks) Kf[t][ks] = *(const LAS bf16x8*)(sb + (t * 4 + ks) * 1024 + foff); \
        _Pragma("unroll") for (int dt = 0; dt < 8; ++dt) Vf[dt] = *(const LAS bf16x8*)(sb + 8192 + dt * 1024 + foff); \
        f32x4 St[2][2]; \
        _Pragma("unroll") for (int t = 0; t < 2; ++t) _Pragma("unroll") for (int qt = 0; qt < 2; ++qt) { f32x4 s_ = (f32x4){0.f, 0.f, 0.f, 0.f}; \
            _Pragma("unroll") for (int ks = 0; ks < 4; ++ks) s_ = __builtin_amdgcn_mfma_f32_16x16x32_bf16(Kf[t][ks], Q[qt][ks], s_, 0, 0, 0); \
            St[t][qt] = s_; } \
        bf16x8 Pf[2]; \
        _Pragma("unroll") for (int qt = 0; qt < 2; ++qt) { \
            const int qpos = c * 64 + qh * 32 + qt * 16 + fr; \
            float sv[8]; float bm = -1e30f; \
            _Pragma("unroll") for (int t = 0; t < 2; ++t) _Pragma("unroll") for (int j = 0; j < 4; ++j) { float bv_; \
                if (FAR) bv_ = bias0; else { int rel = k0 + 8 * fq + 4 * t + j - qpos; rel = rel < -128 ? -128 : (rel > 128 ? 128 : rel); bv_ = bias[rel + 128]; } \
                const float s_ = St[t][qt][j] * SC + bv_; sv[t * 4 + j] = s_; bm = fmaxf(bm, s_); } \
            bm = fmaxf(bm, __shfl_xor(bm, 16)); bm = fmaxf(bm, __shfl_xor(bm, 32)); \
            const float mn = fmaxf(mrun[qt], bm); const float alpha = fast_exp2(mrun[qt] - mn); mrun[qt] = mn; \
            float ps = 0.f; \
            _Pragma("unroll") for (int e = 0; e < 8; ++e) { sv[e] = fast_exp2(sv[e] - mn); ps += sv[e]; } \
            lrun[qt] = lrun[qt] * alpha + ps; \
            _Pragma("unroll") for (int dt = 0; dt < 8; ++dt) O[dt][qt] = O[dt][qt] * alpha; \
            u32x4 pk; pk.x = cvt_pk_bf16(sv[0], sv[1]); pk.y = cvt_pk_bf16(sv[2], sv[3]); pk.z = cvt_pk_bf16(sv[4], sv[5]); pk.w = cvt_pk_bf16(sv[6], sv[7]); \
            Pf[qt] = __builtin_bit_cast(bf16x8, pk); } \
        _Pragma("unroll") for (int dt = 0; dt < 8; ++dt) _Pragma("unroll") for (int qt = 0; qt < 2; ++qt) O[dt][qt] = __builtin_amdgcn_mfma_f32_16x16x32_bf16(Vf[dt], Pf[qt], O[dt][qt], 0, 0, 0); \
    } while (0)
__device__ __forceinline__ void attn_block(LAS unsigned char* lds, const bf16_t* zm, const bf16_t* Kh, const bf16_t* Vt, bf16_t* yraw, const LAS float* biasAll, int b, int h, int g, int tid) {
    LAUNDER(tid);
    const int lane = tid & 63, wave = tid >> 6, fr = lane & 15, fq = lane >> 4;
    const int c = 4 * g + (wave >> 1), qh = wave & 1;
    const LAS float* bias = biasAll + h * NREL;
    const float bias0 = bias[0];
    const float SC = 0.08838834764831845f * LOG2E;
    bf16x8 Q[2][4];
#pragma unroll
    for (int qt = 0; qt < 2; ++qt) { const size_t tok = (size_t)b * SEQ + c * 64 + qh * 32 + qt * 16 + fr;
#pragma unroll
        for (int ks = 0; ks < 4; ++ks) Q[qt][ks] = *(const bf16x8*)(zm + tok * ZLD + 2048 + h * HD + ks * 32 + 8 * fq); }
    f32x4 O[8][2];
#pragma unroll
    for (int dt = 0; dt < 8; ++dt)
#pragma unroll
        for (int qt = 0; qt < 2; ++qt) O[dt][qt] = (f32x4){0.f, 0.f, 0.f, 0.f};
    float mrun[2] = {-1e30f, -1e30f}, lrun[2] = {0.f, 0.f};
    const int lo = g >= 2 ? 4 * g - 8 : 0, nsteps = (4 * g + 4 - lo) * 2;
    const int kr = tid >> 4, c16 = tid & 15;
    const int krho = ((kr >> 3) << 2) | (kr & 3);
    const int kst = ((((kr >> 2) & 1) * 4 + (c16 >> 2)) * 1024) + ((krho * 64 + (c16 & 3) * 16) ^ (krho >= 8 ? 32 : 0));
    const bf16_t* kg = Kh + ((size_t)(b * NH + h) * SEQ + kr) * HD + 8 * c16;
    const int vd = tid >> 2, vq = tid & 3;
    const int vst = 8192 + (vd >> 4) * 1024 + (((vd & 15) * 64 + vq * 16) ^ ((vd & 15) >= 8 ? 32 : 0));
    const bf16_t* vg = Vt + ((size_t)(b * NH + h) * HD + vd) * SEQ + 8 * vq;
    const int foff = (fr * 64 + fq * 16) ^ (fr >= 8 ? 32 : 0);
    LAS unsigned char* st = lds + LM_ATT;
    { const int k0 = lo * 64; const u32x4 kv = *(const u32x4*)(kg + (size_t)k0 * HD); const u32x4 vv = *(const u32x4*)(vg + k0);
      *(LAS u32x4*)(st + kst) = kv; *(LAS u32x4*)(st + vst) = vv; }
    __syncthreads();
#pragma unroll 1
    for (int s = 0; s < nsteps; ++s) {
        const int kc = lo + (s >> 1), k0 = kc * 64 + (s & 1) * 32;
        const int sn = s + 1 < nsteps ? s + 1 : s;
        const int k0n = (lo + (sn >> 1)) * 64 + (sn & 1) * 32;
        const u32x4 kv = *(const u32x4*)(kg + (size_t)k0n * HD); const u32x4 vv = *(const u32x4*)(vg + k0n);
        const LAS unsigned char* sb = st + (s & 1) * 16384;
        if (kc >= c - 8 && kc <= c) {
            if (kc <= c - 3) ATT_COMPUTE(true); else ATT_COMPUTE(false);
        }
        LAS unsigned char* nb = st + ((s + 1) & 1) * 16384;
        *(LAS u32x4*)(nb + kst) = kv; *(LAS u32x4*)(nb + vst) = vv;
        __syncthreads();
    }
#pragma unroll
    for (int qt = 0; qt < 2; ++qt) {
        float l = lrun[qt]; l += __shfl_xor(l, 16); l += __shfl_xor(l, 32);
        const float inv = 1.0f / l;
        bf16_t* op = yraw + ((size_t)b * SEQ + c * 64 + qh * 32 + qt * 16 + fr) * D + 1024 + h * HD + 4 * fq;
#pragma unroll
        for (int dt = 0; dt < 8; ++dt) { const f32x4 o = O[dt][qt] * inv; u32x2 w; w.x = cvt_pk_bf16(o.x, o.y); w.y = cvt_pk_bf16(o.z, o.w); *(u32x2*)(op + dt * 16) = w; }
    }
}
#undef ATT_COMPUTE

#define XB_TMO      128
#define XB_XCNT(j)  (256  + 64 * (j))
#define XB_XSUB(j)  (1280 + 64 * (j))
#define XB_XGEN(j)  (2304 + 64 * (j))
#define XB_TOP      3328
#define XB_TOPGEN   3392
#define XCD_BAR_WORDS 3456
#define XB_SPIN_CAP (1u << 18)
__device__ __forceinline__ unsigned xb_ld(unsigned* p)              { return __hip_atomic_load(p, __ATOMIC_RELAXED, __HIP_MEMORY_SCOPE_AGENT); }
__device__ __forceinline__ unsigned xb_add(unsigned* p, unsigned v) { return __hip_atomic_fetch_add(p, v, __ATOMIC_RELAXED, __HIP_MEMORY_SCOPE_AGENT); }
__device__ __forceinline__ unsigned xb_xcc_id() { return (unsigned)__builtin_amdgcn_s_getreg((3 << 11) | 20) & 0xFu; }
#define XB_SPIN(cond, bar) do { unsigned _sp = 0; while (cond) { __builtin_amdgcn_s_sleep(1); \
    if ((++_sp & 255u) == 0u) { if (xb_ld(&(bar)[XB_TMO])) break; if (_sp > XB_SPIN_CAP) { atomicAdd(&(bar)[XB_TMO], 1u); break; } } } } while (0)
struct XcdBarrier { unsigned* bar; unsigned x; volatile LAS unsigned* st; };
__device__ __forceinline__ XcdBarrier xcd_barrier_post(unsigned* bar, volatile LAS unsigned* st) {
    XcdBarrier b; b.bar = bar; b.x = xb_xcc_id(); b.st = st;
    if (threadIdx.x == 0) (void)xb_add(&bar[XB_XCNT(b.x)], 1u);
    return b;
}
__device__ __forceinline__ void xcd_barrier_complete(unsigned* bar, unsigned x, unsigned& nloc, unsigned& nx) {
    const unsigned G = gridDim.x * gridDim.y * gridDim.z;
    unsigned sum, cnt, mine, sp = 0u;
    for (;;) {
        sum = 0u; cnt = 0u; mine = 0u;
#pragma unroll
        for (unsigned j = 0; j < 16; ++j) { const unsigned c = xb_ld(&bar[XB_XCNT(j)]); sum += c; cnt += (c > 0u) ? 1u : 0u; mine = (j == x) ? c : mine; }
        if (sum == G) break;
        __builtin_amdgcn_s_sleep(1);
        if ((++sp & 255u) == 0u) { if (xb_ld(&bar[XB_TMO])) break; if (sp > XB_SPIN_CAP) { atomicAdd(&bar[XB_TMO], 1u); break; } }
    }
    nloc = mine > 0u ? mine : 1u; nx = cnt > 0u ? cnt : 1u;
}
__device__ __forceinline__ void xcd_barrier(const XcdBarrier& b) {
    asm volatile("s_waitcnt vmcnt(0)" ::: "memory");
    __syncthreads();
    if (threadIdx.x == 0) {
        unsigned* bar = b.bar;
        __builtin_amdgcn_s_waitcnt(0);
        unsigned nloc = b.st[0], nx = b.st[1];
        if (nloc == 0u) { xcd_barrier_complete(bar, b.x, nloc, nx); b.st[0] = nloc; b.st[1] = nx; }
        const unsigned old = xb_add(&bar[XB_XSUB(b.x)], 1u);
        const unsigned gen = old / nloc;
        if (old + 1u == (gen + 1u) * nloc) {
            __builtin_amdgcn_fence(__ATOMIC_RELEASE, "agent");
            asm volatile("s_waitcnt vmcnt(0)" ::: "memory");
            const unsigned og = xb_add(&bar[XB_TOP], 1u);
            const unsigned tg = og / nx;
            if (og + 1u == (tg + 1u) * nx) xb_add(&bar[XB_TOPGEN], 1u);
            else XB_SPIN(xb_ld(&bar[XB_TOPGEN]) == tg, bar);
            __builtin_amdgcn_fence(__ATOMIC_ACQUIRE, "agent");
            xb_add(&bar[XB_XGEN(b.x)], 1u);
            asm volatile("s_waitcnt vmcnt(0)" ::: "memory");
        } else {
            XB_SPIN(xb_ld(&bar[XB_XGEN(b.x)]) == gen, bar);
            __builtin_amdgcn_fence(__ATOMIC_ACQUIRE, "agent");
            asm volatile("s_waitcnt vmcnt(0)" ::: "memory");
        }
    }
    __syncthreads();
}

struct Args { const float* in[23]; float* out; unsigned char* ws; int pad0, pad1; };

__global__ void __launch_bounds__(NTHREADS, 2) mk_fwd(Args args) {
    extern __shared__ __attribute__((aligned(16))) unsigned char lds_raw[];
    LAS unsigned char* lds = (LAS unsigned char*)lds_raw;
    cg::grid_group grid = cg::this_grid();
    const int tid = threadIdx.x, lane = tid & 63, wave = __builtin_amdgcn_readfirstlane(tid >> 6);
    const int G = gridDim.x, bx = blockIdx.x;
    const int gw = bx * NWAVES + wave, NGW = G * NWAVES;
    typedef const float* cfp;
    const __attribute__((address_space(4))) cfp* inp = (const __attribute__((address_space(4))) cfp*)__builtin_amdgcn_kernarg_segment_ptr();
#define INP(k) (inp[k])
#define LAUNDER_S(v) asm volatile("" : "+s"(v))
    unsigned char* ws = args.ws;
    float* out = args.out;
    volatile LAS unsigned* bst = (volatile LAS unsigned*)(lds + 131072 + 64);
    if (tid < 2) bst[tid] = 0u;
    __syncthreads();
    (void)xcd_barrier_post((unsigned*)(ws + WS_CTL), bst);
#define GRID_BAR() do { XcdBarrier xb_; xb_.bar = (unsigned*)(args.ws + WS_CTL); xb_.x = xb_xcc_id(); xb_.st = (volatile LAS unsigned*)(lds + 131072 + 64); xcd_barrier(xb_); } while (0)
    bf16_t* HID = (bf16_t*)(ws + WS_BIG); bf16_t* ZM = (bf16_t*)(ws + WS_BIG); bf16_t* VT = (bf16_t*)(ws + WS_VT); bf16_t* KH = (bf16_t*)(ws + WS_KH); bf16_t* HB = (bf16_t*)(ws + WS_H); bf16_t* HB2 = (bf16_t*)(ws + WS_H2); float* SSQ = (float*)(ws + WS_SSQ);

    {
        LAS float* scr = (LAS float*)(lds + wave * 16384);
        constexpr int I_G = (D / 64) * (FF / 32), I_D = (FF / 64) * (D / 32), I_IN = (D / 64) * (DIN / 32), I_O = (D / 64) * (D / 32);
        constexpr int PER_LAYER = 4 * I_G + 2 * I_D + I_IN + I_O;
        for (int it = gw; it < DEPTH * PER_LAYER; it += NGW) {
            const int l = it / PER_LAYER; int r = it % PER_LAYER;
            unsigned char* wl = ws + (size_t)l * LAYER_W;
            if (r < I_G) { p0_transpose_item(INP(2) + (size_t)l * D * FF, INP(1) + (size_t)l * D, D, FF, (bf16_t*)(wl + OFF_WGU1), 0, scr, r, lane); continue; } r -= I_G;
            if (r < I_G) { p0_transpose_item(INP(3) + (size_t)l * D * FF, INP(1) + (size_t)l * D, D, FF, (bf16_t*)(wl + OFF_WGU1), 128, scr, r, lane); continue; } r -= I_G;
            if (r < I_D) { p0_transpose_item(INP(4) + (size_t)l * FF * D, nullptr, FF, D, (bf16_t*)(wl + OFF_WD1), -1, scr, r, lane); continue; } r -= I_D;
            if (r < I_IN) { p0_transpose_item(INP(6) + (size_t)l * D * DIN, INP(5) + (size_t)l * D, D, DIN, (bf16_t*)(wl + OFF_WIN), -1, scr, r, lane); continue; } r -= I_IN;
            if (r < I_O) { p0_transpose_item(INP(17) + (size_t)l * D * D, nullptr, D, D, (bf16_t*)(wl + OFF_WOUT), -1, scr, r, lane); continue; } r -= I_O;
            if (r < I_G) { p0_transpose_item(INP(19) + (size_t)l * D * FF, INP(18) + (size_t)l * D, D, FF, (bf16_t*)(wl + OFF_WGU2), 0, scr, r, lane); continue; } r -= I_G;
            if (r < I_G) { p0_transpose_item(INP(20) + (size_t)l * D * FF, INP(18) + (size_t)l * D, D, FF, (bf16_t*)(wl + OFF_WGU2), 128, scr, r, lane); continue; } r -= I_G;
            p0_transpose_item(INP(21) + (size_t)l * FF * D, nullptr, FF, D, (bf16_t*)(wl + OFF_WD2), -1, scr, r, lane);
        }
        cast_rows_bf16(INP(0), HB, SSQ, gw, NGW, lane);
    }
    grid.sync();

#pragma unroll 1
    for (int l = 0; l < DEPTH; ++l) {
        unsigned char* wl = ws + (size_t)l * LAYER_W;
#pragma unroll 1
        for (int f = 0; f < 2; ++f) {
            LAUNDER_S(inp);
            {
                pg8::Gemm g{HB, (const bf16_t*)(wl + (f ? OFF_WGU2 : OFF_WGU1)), M, 2 * FF, D}; pg8::StaticOrder S; S.init(M, 2 * FF, G, bx);
                { if (tid == 0) *(volatile LAS int*)(lds + pg8::LDS_RSPM) = -1; __syncthreads(); }
                pg8::EpiSwiGLU E{HID, FF, SSQ + (size_t)(3 * l + (f ? 2 : 0)) * M * 8, lds};
                pg8::gemm_phase<pg8::EpiSwiGLU, pg8::StaticOrder, true, true>(lds, g, S, E);
            }
            GRID_BAR();
            {
                pg8::Gemm g{HID, (const bf16_t*)(wl + (f ? OFF_WD2 : OFF_WD1)), M, D, FF}; pg8::StaticOrder S; S.init(M, D, G, bx);
                const float* resp = out; if (l == 0 && f == 0) resp = INP(0);
                pg8::EpiResid<true> E{resp, out, HB, SSQ + (size_t)(3 * l + (f ? 3 : 1)) * M * 8, lds};
                pg8::gemm_phase<pg8::EpiResid<true>, pg8::StaticOrder, true, true>(lds, g, S, E);
            }
            GRID_BAR();
            if (f == 0) {
                {
                    pg8::Gemm g{HB, (const bf16_t*)(wl + OFF_WIN), M, DIN, D}; pg8::StaticOrder S; S.init(M, DIN, G, bx);
                    { if (tid == 0) *(volatile LAS int*)(lds + pg8::LDS_RSPM) = -1; __syncthreads(); }
                    pg8::EpiZ E{ZM, VT, KH, SSQ + (size_t)(3 * l + 1) * M * 8, lds};
                    pg8::gemm_phase<pg8::EpiZ, pg8::StaticOrder, true, true>(lds, g, S, E);
                }
                GRID_BAR();
                {
                    LAS float* biasL = (LAS float*)(lds + LM_BIAS);
                    const float* rb = INP(14) + (size_t)l * NH * NREL;
                    int tid_m = tid; LAUNDER(tid_m);
                    for (int i = tid_m; i < NH * NREL; i += NTHREADS) biasL[i] = rb[i] * LOG2E;
                    __syncthreads();
                    for (int u = bx; u < NB * 16; u += G)
                        lru_unit(lds, ZM, HB2, INP(7) + (size_t)l * 4 * DL, INP(8) + (size_t)l * DL, INP(9) + (size_t)l * 16 * 64 * 64, INP(10) + (size_t)l * DL,
                                 INP(11) + (size_t)l * 16 * 64 * 64, INP(12) + (size_t)l * DL, INP(13) + (size_t)l * DL, u >> 4, u & 15, tid);
                    for (int bu = bx; bu < 1024; bu += G) {
                        const int kk = bu >> 8, bxv = bu & 255;
                        const int ag = ((bxv & 7) + 2 * kk) & 7, ap = (bxv >> 3) + 32 * kk;
                        attn_block(lds, ZM, KH, VT, HB2, biasL, ap >> 3, ap & 7, ag, tid);
                    }
                }
                GRID_BAR();
                ynorm_rows(HB2, INP(15) + (size_t)l * DL, INP(16) + (size_t)l * DL, gw, NGW, lane);
                GRID_BAR();
                {
                    pg8::Gemm g{HB2, (const bf16_t*)(wl + OFF_WOUT), M, D, D}; pg8::StaticOrder S; S.init(M, D, G, bx);
                    pg8::EpiResid<false> E{out, out, HB, SSQ + (size_t)(3 * l + 2) * M * 8, lds};
                    pg8::gemm_phase<pg8::EpiResid<false>, pg8::StaticOrder, true, true>(lds, g, S, E);
                }
                GRID_BAR();
            } else {
                if (l + 1 == DEPTH) rms_rows_f32_inplace(out, INP(22), gw, NGW, lane);
            }
        }
    }
}

extern "C" void kernel_launch(void* const* d_in, const int* in_sizes, int n_in, void* d_out, int out_size, void* d_ws, size_t ws_size, hipStream_t stream) {
    static int grid = 0;
    if (grid == 0) {
        if (n_in != 23 || in_sizes[0] != M * D || out_size != M * D || ws_size < WS_END) {
            fprintf(stderr, "kernel_launch: unexpected shapes: n_in %d in0 %d out %d ws %zu (need %zu)\n", n_in, n_in > 0 ? in_sizes[0] : -1, out_size, ws_size, (size_t)WS_END); grid = -1; return; }
        int dev = 0, cus = 0, per_cu = 0;
        hipGetDevice(&dev); hipDeviceGetAttribute(&cus, hipDeviceAttributeMultiprocessorCount, dev);
        if (hipFuncSetAttribute((const void*)mk_fwd, hipFuncAttributeMaxDynamicSharedMemorySize, LDS_BYTES) != hipSuccess) fprintf(stderr, "kernel_launch: hipFuncSetAttribute failed\n");
        if (hipOccupancyMaxActiveBlocksPerMultiprocessor(&per_cu, (const void*)mk_fwd, NTHREADS, LDS_BYTES) != hipSuccess || per_cu < 1) { fprintf(stderr, "kernel_launch: occupancy query gave %d\n", per_cu); per_cu = 1; }
        (void)hipGetLastError();
        grid = cus * per_cu;
        if (grid > 256) grid = 256;
    }
    if (grid < 0) return;
    (void)hipMemsetAsync((char*)d_ws + WS_CTL, 0, CTL_BYTES, stream);
    Args a{};
    for (int i = 0; i < 23; ++i) a.in[i] = (const float*)d_in[i];
    a.out = (float*)d_out; a.ws = (unsigned char*)d_ws;
    void* kargs[] = {&a};
    hipError_t e = hipLaunchCooperativeKernel((const void*)mk_fwd, dim3(grid), dim3(NTHREADS), kargs, LDS_BYTES, stream);
    if (e != hipSuccess) fprintf(stderr, "kernel_launch: cooperative launch failed: %s (grid %d)\n", hipGetErrorString(e), grid);
}
```

```cpp
#include <hip/hip_runtime.h>
#include <hip/hip_cooperative_groups.h>
#include <cstdio>
#include <cstdint>
namespace cg = cooperative_groups;

#define LAS __attribute__((address_space(3)))
#define LAUNDER(v) asm volatile("" : "+v"(v))
typedef unsigned short bf16_t;
typedef short bf16x8 __attribute__((ext_vector_type(8)));
typedef float f32x4 __attribute__((ext_vector_type(4)));
typedef float f32x2 __attribute__((ext_vector_type(2)));
typedef unsigned u32x4 __attribute__((ext_vector_type(4)));
typedef unsigned u32x2 __attribute__((ext_vector_type(2)));

constexpr int NB = 16, SEQ = 2048, M = NB * SEQ, D = 2048, FF = 5632, DIN = 5120, DL = 1024, NH = 8, HD = 128, NREL = 257, DEPTH = 2;
constexpr int ZLD = 3072;
constexpr float EPS = 1e-6f;
constexpr float LOG2E = 1.4426950408889634f;

constexpr size_t MiB = 1u << 20;
constexpr size_t SZ_WGU = (size_t)2 * FF * D * 2, SZ_WD = (size_t)D * FF * 2, SZ_WIN = (size_t)DIN * D * 2, SZ_WOUT = (size_t)D * D * 2;
constexpr size_t OFF_WGU1 = 0, OFF_WD1 = OFF_WGU1 + SZ_WGU, OFF_WIN = OFF_WD1 + SZ_WD, OFF_WOUT = OFF_WIN + SZ_WIN, OFF_WGU2 = OFF_WOUT + SZ_WOUT, OFF_WD2 = OFF_WGU2 + SZ_WGU;
constexpr size_t LAYER_W = OFF_WD2 + SZ_WD;
static_assert(LAYER_W == 160 * MiB, "weights per layer");
constexpr size_t WS_BIG = 2 * LAYER_W;
constexpr size_t WS_VT = WS_BIG + (size_t)M * ZLD * 2;
constexpr size_t WS_KH = WS_VT + (size_t)M * 1024 * 2;
constexpr size_t WS_H = WS_BIG + 352 * MiB;
constexpr size_t WS_H2 = WS_H + 128 * MiB;
constexpr size_t WS_SSQ = WS_H2 + 128 * MiB;
constexpr size_t WS_CTL = WS_SSQ + 8 * MiB;
constexpr size_t CTL_BYTES = 16384;
constexpr size_t WS_END = WS_CTL + 1 * MiB;
static_assert((size_t)M * FF * 2 == 352 * MiB, "hidden size");

constexpr int NWAVES = 8, NTHREADS = 512;
constexpr int LDS_BYTES = 147456;

__device__ __forceinline__ unsigned cvt_pk_bf16(float lo, float hi) { unsigned r; asm volatile("v_cvt_pk_bf16_f32 %0, %1, %2" : "=v"(r) : "v"(lo), "v"(hi)); return r; }
__device__ __forceinline__ float bf_lo(unsigned u) { return __uint_as_float(u << 16); }
__device__ __forceinline__ float bf_hi(unsigned u) { return __uint_as_float(u & 0xffff0000u); }
__device__ __forceinline__ float fast_exp2(float x) { return __builtin_amdgcn_exp2f(x); }
__device__ __forceinline__ float fast_rcp(float x) { return __builtin_amdgcn_rcpf(x); }
__device__ __forceinline__ float sigmoidf_(float x) { return fast_rcp(1.0f + fast_exp2(-LOG2E * x)); }

namespace pg8 {
constexpr int BM = 256, BK = 64, HALF = 128, HTB = HALF * BK * 2, STAGE_BYTES = 8 * HTB, NXCD = 8, WGM = 8;
__host__ __device__ __forceinline__ int lds_byte(int r, int c) { const int st = (r >> 4) * 2 + (c >> 5), rr = r & 15, cc = c & 31, ob = rr * 64 + cc * 2; return st * 1024 + (ob ^ (((ob >> 9) & 1) << 5)); }
__host__ __device__ __forceinline__ void stage_rc(int b, int& R, int& C) { const int st = b / 1024, sb = b % 1024, swz = sb ^ (((sb >> 9) & 1) << 5); R = (st >> 1) * 16 + swz / 64; C = (st & 1) * 32 + (swz % 64) / 2; }
__host__ __device__ __forceinline__ int perm32(int rho) { const int n = rho >> 4, i = rho & 15; return 8 * (i >> 2) + 4 * n + (i & 3); }

struct Unit { int pm, pn; };
struct Gemm { const bf16_t* A; const bf16_t* Bt; int M, N, K; };

struct StaticOrder {
    int nM, nN, nwg, G, c;
    __host__ __device__ void init(int M_, int N_, int G_, int c_) { nM = M_ / BM; nN = N_ / BM; nwg = nM * nN; G = G_; c = c_; }
    __host__ __device__ bool next(int i, Unit& u) const {
        const long L = (long)i * G + c; if (L >= nwg) return false;
        int wgid = (int)L; { const int q = nwg / NXCD, r = nwg % NXCD, xcd = wgid % NXCD, off = wgid / NXCD; wgid = (xcd < r ? xcd * (q + 1) : r * (q + 1) + (xcd - r) * q) + off; }
        const int nig = WGM * nN, gid = wgid / nig, fm = gid * WGM, gsz = (nM - fm) < WGM ? (nM - fm) : WGM;
        u.pm = fm + ((wgid % nig) % gsz); u.pn = (wgid % nig) / gsz; return true;
    }
    __device__ __forceinline__ void a_ready(const Unit&) const {}
    __device__ __forceinline__ void done(const Unit&) const {}
};


constexpr int LDS_RS = 131072 + 1024, LDS_RSPM = 131072 + 2048 + 64, LDS_SSP = 131072 + 4096;
__device__ __forceinline__ void rs_panel(LAS unsigned char* lds, const float* ssq, int pm) {
    volatile LAS int* pmL = (volatile LAS int*)(lds + LDS_RSPM); LAS float* rsL = (LAS float*)(lds + LDS_RS);
    if (pmL[0] != pm) {
        asm volatile("s_waitcnt lgkmcnt(0)" ::: "memory"); __builtin_amdgcn_s_barrier();
        const int t = threadIdx.x;
        if (t < 256) { const f32x4* pp = (const f32x4*)(ssq + (size_t)(pm * 256 + t) * 8); const f32x4 pa = pp[0], pb = pp[1];
            rsL[t] = __builtin_amdgcn_rsqf((((pa.x + pa.y) + (pa.z + pa.w)) + ((pb.x + pb.y) + (pb.z + pb.w))) * (1.0f / D) + EPS); }
        if (t == 0) pmL[0] = pm;
        asm volatile("s_waitcnt vmcnt(0) lgkmcnt(0)" ::: "memory"); __builtin_amdgcn_s_barrier();
    }
}
struct EpiSwiGLU {
    static constexpr bool PERM = true, AFTER_DRAIN = false;
    bf16_t* O; int ldc; const float* ssq; LAS unsigned char* lds;
    __device__ __forceinline__ void operator()(const f32x4 (&acc)[2][2][4][2], const Unit& u, int wr, int wc, int fr, int fq) const {
        rs_panel(lds, ssq, u.pm);
        const LAS float* rsL = (const LAS float*)(lds + LDS_RS) + wr * 64 + fr;
        const int row0 = u.pm * BM + wr * 64 + fr; const int col0 = u.pn * HALF + wc * 32 + 8 * fq;
#pragma unroll
        for (int ai = 0; ai < 2; ++ai)
#pragma unroll
            for (int m = 0; m < 4; ++m) {
                bf16_t* rowp = O + (size_t)(row0 + ai * HALF + m * 16) * ldc + col0;
                const float rs = rsL[ai * HALF + m * 16];
                float v[8];
#pragma unroll
                for (int n = 0; n < 2; ++n)
#pragma unroll
                    for (int i = 0; i < 4; ++i) { const float g = acc[ai][0][m][n][i] * rs, up = acc[ai][1][m][n][i] * rs; v[n * 4 + i] = g * sigmoidf_(g) * up; }
                u32x4 w; w.x = cvt_pk_bf16(v[0], v[1]); w.y = cvt_pk_bf16(v[2], v[3]); w.z = cvt_pk_bf16(v[4], v[5]); w.w = cvt_pk_bf16(v[6], v[7]);
                *(u32x4*)rowp = w;
            }
    }
};
template <bool HALFSC> struct EpiResid {
    static constexpr bool PERM = false, AFTER_DRAIN = false;
    bf16_t* xb; float* ssq_part; LAS unsigned char* lds;
    __device__ __forceinline__ void operator()(const f32x4 (&acc)[2][2][4][2], const Unit& u, int wr, int wc, int fr, int fq) const {
        const float scale_ = HALFSC ? 0.5f : 1.0f; bf16_t* const xb_ = xb; float* const ssq_ = ssq_part;
        LAS float* pl = (LAS float*)(lds + LDS_SSP);
        const int col0 = u.pn * BM + wc * 32 + 4 * fq;
        const size_t base = (size_t)(u.pm * BM + wr * 64 + fr) * D + col0;
        u32x2 r[2][2][2][2];
#define ER_LOAD(buf, bb) do { _Pragma("unroll") for (int mm = 0; mm < 2; ++mm) _Pragma("unroll") for (int bj = 0; bj < 2; ++bj) _Pragma("unroll") for (int n = 0; n < 2; ++n) \
            r[buf][mm][bj][n] = *(const u32x2*)(xb_ + base + (size_t)(((bb) >> 1) * HALF + (((bb) & 1) * 2 + mm) * 16) * D + bj * HALF + n * 16); } while (0)
        ER_LOAD(0, 0);
#pragma unroll
        for (int bb = 0; bb < 4; ++bb) {
            if (bb < 3) ER_LOAD((bb + 1) & 1, bb + 1);
            const int ai = bb >> 1;
#pragma unroll
            for (int mm = 0; mm < 2; ++mm) { const int m = (bb & 1) * 2 + mm; const int rowl = ai * HALF + m * 16; const size_t off = base + (size_t)rowl * D; float ssum = 0.f;
#pragma unroll
                for (int bj = 0; bj < 2; ++bj)
#pragma unroll
                    for (int n = 0; n < 2; ++n) { const u32x2 rr = r[bb & 1][mm][bj][n]; const f32x4 a = acc[ai][bj][m][n];
                        const float o0 = bf_lo(rr.x) + a.x * scale_, o1 = bf_hi(rr.x) + a.y * scale_, o2 = bf_lo(rr.y) + a.z * scale_, o3 = bf_hi(rr.y) + a.w * scale_;
                        u32x2 w; w.x = cvt_pk_bf16(o0, o1); w.y = cvt_pk_bf16(o2, o3); *(u32x2*)(xb_ + off + bj * HALF + n * 16) = w;
                        ssum += (o0 * o0 + o1 * o1) + (o2 * o2 + o3 * o3); }
                ssum += __shfl_xor(ssum, 16); ssum += __shfl_xor(ssum, 32);
                if (fq == 0) pl[(rowl + wr * 64 + fr) * 4 + wc] = ssum;
            }
        }
#undef ER_LOAD
        asm volatile("s_waitcnt lgkmcnt(0)" ::: "memory"); __builtin_amdgcn_s_barrier();
        const int t = threadIdx.x;
        if (t < 256) { const f32x4 p = *(const LAS f32x4*)(pl + t * 4); ssq_[(size_t)(u.pm * BM + t) * 8 + u.pn] = (p.x + p.y) + (p.z + p.w); }
    }
};
struct EpiZ {
    static constexpr bool PERM = true, AFTER_DRAIN = false;
    bf16_t* Z; bf16_t* Vt; bf16_t* Kh; const float* ssq; LAS unsigned char* lds;
    __device__ __forceinline__ void operator()(const f32x4 (&acc)[2][2][4][2], const Unit& u, int wr, int wc, int fr, int fq) const {
        rs_panel(lds, ssq, u.pm);
        float rs[2][4];
        { const LAS float* rsL = (const LAS float*)(lds + LDS_RS) + wr * 64 + fr;
#pragma unroll
          for (int ai = 0; ai < 2; ++ai)
#pragma unroll
            for (int m = 0; m < 4; ++m) rs[ai][m] = rsL[ai * HALF + m * 16]; }
        if (u.pn >= 12 && u.pn < 16) {
            const int b = (u.pm * BM) / SEQ; const int s0 = (u.pm * BM) % SEQ + wr * 64 + fr;
#pragma unroll
            for (int bj = 0; bj < 2; ++bj) {
                const int head = (u.pn - 12) * 2 + bj;
                bf16_t* hb = Kh + ((size_t)(b * NH + head) * SEQ + s0) * HD + wc * 32 + 8 * fq;
#pragma unroll
                for (int ai = 0; ai < 2; ++ai)
#pragma unroll
                    for (int m = 0; m < 4; ++m) { const f32x4 v0 = acc[ai][bj][m][0] * rs[ai][m], v1 = acc[ai][bj][m][1] * rs[ai][m];
                        u32x4 w; w.x = cvt_pk_bf16(v0[0], v0[1]); w.y = cvt_pk_bf16(v0[2], v0[3]); w.z = cvt_pk_bf16(v1[0], v1[1]); w.w = cvt_pk_bf16(v1[2], v1[3]);
                        *(u32x4*)(hb + (size_t)(ai * HALF + m * 16) * HD) = w; }
            }
        } else if (u.pn < 12) {
            const int row0 = u.pm * BM + wr * 64 + fr; const int col0 = u.pn * BM + wc * 32 + 8 * fq;
#pragma unroll
            for (int ai = 0; ai < 2; ++ai)
#pragma unroll
                for (int m = 0; m < 4; ++m) {
                    bf16_t* rowp = Z + (size_t)(row0 + ai * HALF + m * 16) * ZLD + col0;
#pragma unroll
                    for (int bj = 0; bj < 2; ++bj) { const f32x4 v0 = acc[ai][bj][m][0] * rs[ai][m], v1 = acc[ai][bj][m][1] * rs[ai][m];
                        u32x4 w; w.x = cvt_pk_bf16(v0[0], v0[1]); w.y = cvt_pk_bf16(v0[2], v0[3]); w.z = cvt_pk_bf16(v1[0], v1[1]); w.w = cvt_pk_bf16(v1[2], v1[3]);
                        *(u32x4*)(rowp + bj * HALF) = w; }
                }
        } else {
            const int b = (u.pm * BM) / SEQ; const int s0 = (u.pm * BM) % SEQ + wr * 64 + fr;
#pragma unroll
            for (int bj = 0; bj < 2; ++bj) {
                const int head = (u.pn - 16) * 2 + bj;
                bf16_t* hb = Vt + ((size_t)(b * NH + head) * HD + wc * 32 + 8 * fq) * SEQ + s0;
#pragma unroll
                for (int ai = 0; ai < 2; ++ai)
#pragma unroll
                    for (int m = 0; m < 4; ++m)
#pragma unroll
                        for (int n = 0; n < 2; ++n)
#pragma unroll
                            for (int i = 0; i < 4; ++i) {
                                const unsigned w = cvt_pk_bf16(acc[ai][bj][m][n][i] * rs[ai][m], 0.f);
                                hb[(size_t)(4 * n + i) * SEQ + ai * HALF + m * 16] = (bf16_t)(w & 0xffffu);
                            }
            }
        }
    }
};

template <class Epi, class Sched, bool ALIGN_EPI = false, bool SP2 = false>
__device__ __forceinline__ void gemm_phase(LAS unsigned char* lds, const Gemm g, const Sched& S, const Epi& E) {
    int tid_l = threadIdx.x; LAUNDER(tid_l);
    const int tid = tid_l, wid = __builtin_amdgcn_readfirstlane(tid >> 6), lane = tid & 63, wr = wid >> 2, wc = wid & 3, fr = lane & 15, fq = lane >> 4;
    const int K = g.K, nt = K / BK;
    unsigned voffA[2], voffB[2];
#pragma unroll
    for (int i = 0; i < 2; ++i) { int R, C; stage_rc(tid * 16 + i * 8192, R, C); const int Rb = Epi::PERM ? ((R & ~31) + perm32(R & 31)) : R;
        voffA[i] = (unsigned)(R * K + C) * 2u; voffB[i] = (unsigned)(Rb * K + C) * 2u; }
    const size_t kstep = (size_t)(BK * 2);
    const size_t hstep = (size_t)HALF * K * 2;
    const size_t tstep = 2 * hstep;
    const unsigned ldsw = (unsigned)wid * 1024u;
    const int aoff = lds_byte(wr * 64 + fr, fq * 8), boff = lds_byte(wc * 32 + fr, fq * 8);
#define PG8_SA(b, h) (((b) * 2 + (h)) * HTB)
#define PG8_SB(b, h) ((4 + (b) * 2 + (h)) * HTB)
#define PG8_STAGE(bufoff, gbase, voff) do { _Pragma("unroll") for (int _i = 0; _i < 2; ++_i) \
        __builtin_amdgcn_global_load_lds((const unsigned*)((const char*)(gbase) + (voff)[_i]), (LAS unsigned*)(lds + (bufoff) + ldsw + _i * 8192), 16, 0, 0); } while (0)
#define PG8_LDA(dst, b, h) do { _Pragma("unroll") for (int m = 0; m < 4; ++m) _Pragma("unroll") for (int k = 0; k < 2; ++k) dst[m][k] = *(const LAS bf16x8*)(lds + PG8_SA(b, h) + aoff + m * 2048 + k * 1024); } while (0)
#define PG8_LDB(dst, b, h) do { _Pragma("unroll") for (int n = 0; n < 2; ++n) _Pragma("unroll") for (int k = 0; k < 2; ++k) dst[n][k] = *(const LAS bf16x8*)(lds + PG8_SB(b, h) + boff + n * 2048 + k * 1024); } while (0)
#define PG8_MMA(ai, bj, At, Bt) do { __builtin_amdgcn_s_setprio(1); _Pragma("unroll") for (int m = 0; m < 4; ++m) _Pragma("unroll") for (int n = 0; n < 2; ++n) _Pragma("unroll") for (int k = 0; k < 2; ++k) \
        acc[ai][bj][m][n] = __builtin_amdgcn_mfma_f32_16x16x32_bf16(Bt[n][k], At[m][k], acc[ai][bj][m][n], 0, 0, 0); __builtin_amdgcn_s_setprio(0); } while (0)
#define PG8_WAIT_V(n) asm volatile("s_waitcnt vmcnt(" #n ")" ::: "memory")
#define PG8_WAIT_L(n) asm volatile("s_waitcnt lgkmcnt(" #n ")" ::: "memory")
#define PG8_BAR __builtin_amdgcn_s_barrier()
#define PG8_SCHED __builtin_amdgcn_sched_barrier(0)
    Unit cur, nxt; int ui = 0;
    if (!S.next(0, cur)) return;
    f32x4 acc[2][2][4][2];
#pragma unroll
    for (int a = 0; a < 2; ++a)
#pragma unroll
        for (int b = 0; b < 2; ++b)
#pragma unroll
            for (int m = 0; m < 4; ++m)
#pragma unroll
                for (int n = 0; n < 2; ++n) acc[a][b][m][n] = (f32x4){0.f, 0.f, 0.f, 0.f};
    bf16x8 At[4][2], B0[2][2], B1[2][2];
    const char* cA = (const char*)g.A + (size_t)cur.pm * tstep; const char* cB = (const char*)g.Bt + (size_t)cur.pn * tstep;
    S.a_ready(cur);
    if constexpr (SP2) {
        PG8_STAGE(PG8_SB(0, 0), cB, voffB); PG8_STAGE(PG8_SB(0, 1), cB + hstep, voffB); PG8_STAGE(PG8_SA(0, 0), cA, voffA); PG8_STAGE(PG8_SA(0, 1), cA + hstep, voffA);
        if (wr == 1) PG8_BAR;
        PG8_WAIT_V(2); PG8_BAR;
        PG8_STAGE(PG8_SB(1, 0), cB + kstep, voffB); PG8_STAGE(PG8_SA(1, 0), cA + kstep, voffA); PG8_STAGE(PG8_SB(1, 1), cB + hstep + kstep, voffB);
        PG8_WAIT_V(6); PG8_BAR;
    } else {
        PG8_STAGE(PG8_SB(0, 0), cB, voffB); PG8_STAGE(PG8_SA(0, 0), cA, voffA); PG8_STAGE(PG8_SB(0, 1), cB + hstep, voffB); PG8_STAGE(PG8_SA(0, 1), cA + hstep, voffA);
        if (wr == 1) PG8_BAR;
        PG8_WAIT_V(4); PG8_BAR;
        PG8_STAGE(PG8_SB(1, 0), cB + kstep, voffB); PG8_STAGE(PG8_SA(1, 0), cA + kstep, voffA); PG8_STAGE(PG8_SB(1, 1), cB + hstep + kstep, voffB);
        PG8_WAIT_V(6); PG8_BAR;
    }
    for (;;) {
        const bool has_next = S.next(ui + 1, nxt);
        const char* nA = has_next ? (const char*)g.A + (size_t)nxt.pm * tstep : cA; const char* nB = has_next ? (const char*)g.Bt + (size_t)nxt.pn * tstep : cB;
        for (int t = 0; t < nt; t += 2) {
            const bool last = (t == nt - 2);
            const char* a1 = cA + (size_t)(t + 1) * kstep;
            const char* a2 = last ? nA : cA + (size_t)(t + 2) * kstep; const char* b2 = last ? nB : cB + (size_t)(t + 2) * kstep;
            const char* a3 = a2 + kstep; const char* b3 = b2 + kstep;
            if (last && has_next) S.a_ready(nxt);
            if constexpr (SP2) {
            PG8_LDB(B0, 0, 0); PG8_LDB(B1, 0, 1); PG8_SCHED; PG8_LDA(At, 0, 0); PG8_STAGE(PG8_SA(1, 1), a1 + hstep, voffA);
            PG8_WAIT_V(8); PG8_WAIT_L(0); PG8_BAR; PG8_MMA(0, 0, At, B0); PG8_MMA(0, 1, At, B1); PG8_BAR; PG8_SCHED;
            PG8_LDA(At, 0, 1); PG8_STAGE(PG8_SB(0, 0), b2, voffB); PG8_STAGE(PG8_SB(0, 1), b2 + hstep, voffB); PG8_STAGE(PG8_SA(0, 0), a2, voffA);
            PG8_WAIT_V(8); PG8_WAIT_L(0); PG8_BAR; PG8_MMA(1, 0, At, B0); PG8_MMA(1, 1, At, B1); PG8_BAR; PG8_SCHED;
            PG8_LDB(B0, 1, 0); PG8_LDB(B1, 1, 1); PG8_SCHED; PG8_LDA(At, 1, 0); PG8_STAGE(PG8_SA(0, 1), a2 + hstep, voffA);
            PG8_WAIT_V(8); PG8_WAIT_L(0); PG8_BAR; PG8_MMA(0, 0, At, B0); PG8_MMA(0, 1, At, B1); PG8_BAR; PG8_SCHED;
            PG8_LDA(At, 1, 1); PG8_STAGE(PG8_SB(1, 0), b3, voffB); PG8_STAGE(PG8_SB(1, 1), b3 + hstep, voffB); PG8_STAGE(PG8_SA(1, 0), a3, voffA);
            PG8_WAIT_V(8); PG8_WAIT_L(0); PG8_BAR; PG8_MMA(1, 0, At, B0); PG8_MMA(1, 1, At, B1); PG8_BAR; PG8_SCHED;
            } else {
            PG8_LDB(B0, 0, 0); PG8_SCHED; PG8_LDA(At, 0, 0); PG8_STAGE(PG8_SA(1, 1), a1 + hstep, voffA);
            PG8_WAIT_L(8); PG8_BAR; PG8_WAIT_L(0); PG8_MMA(0, 0, At, B0); PG8_BAR; PG8_SCHED;
            PG8_LDB(B1, 0, 1); PG8_STAGE(PG8_SB(0, 0), b2, voffB);
            PG8_BAR; PG8_WAIT_L(0); PG8_MMA(0, 1, At, B1); PG8_BAR;
            PG8_LDA(At, 0, 1); PG8_STAGE(PG8_SA(0, 0), a2, voffA);
            PG8_BAR; PG8_WAIT_L(0); PG8_MMA(1, 0, At, B0); PG8_BAR; PG8_SCHED;
            PG8_STAGE(PG8_SB(0, 1), b2 + hstep, voffB);
            PG8_WAIT_V(6); PG8_BAR; PG8_MMA(1, 1, At, B1); PG8_BAR;
            PG8_LDB(B0, 1, 0); PG8_SCHED; PG8_LDA(At, 1, 0); PG8_STAGE(PG8_SA(0, 1), a2 + hstep, voffA);
            PG8_WAIT_L(8); PG8_BAR; PG8_WAIT_L(0); PG8_MMA(0, 0, At, B0); PG8_BAR; PG8_SCHED;
            PG8_LDB(B1, 1, 1); PG8_STAGE(PG8_SB(1, 0), b3, voffB);
            PG8_BAR; PG8_WAIT_L(0); PG8_MMA(0, 1, At, B1); PG8_BAR;
            PG8_LDA(At, 1, 1); PG8_STAGE(PG8_SA(1, 0), a3, voffA);
            PG8_BAR; PG8_WAIT_L(0); PG8_MMA(1, 0, At, B0); PG8_BAR; PG8_SCHED;
            PG8_STAGE(PG8_SB(1, 1), b3 + hstep, voffB);
            PG8_WAIT_V(6); PG8_BAR; PG8_MMA(1, 1, At, B1); PG8_BAR;
            }
        }
        if constexpr (ALIGN_EPI) { if (wr == 0) PG8_BAR; }
        if constexpr (!Epi::AFTER_DRAIN) { E(acc, cur, wr, wc, fr, fq); S.done(cur); }
        if (!has_next) break;
#pragma unroll
        for (int a = 0; a < 2; ++a)
#pragma unroll
            for (int b = 0; b < 2; ++b)
#pragma unroll
                for (int m = 0; m < 4; ++m)
#pragma unroll
                    for (int n = 0; n < 2; ++n) acc[a][b][m][n] = (f32x4){0.f, 0.f, 0.f, 0.f};
        cur = nxt; cA = nA; cB = nB; ++ui;
        if constexpr (ALIGN_EPI) { if (wr == 1) PG8_BAR; }
    }
    PG8_WAIT_V(0);
    if constexpr (!ALIGN_EPI) { if (wr == 0) PG8_BAR; }
    PG8_BAR;
#undef PG8_SA
#undef PG8_SB
#undef PG8_STAGE
#undef PG8_LDA
#undef PG8_LDB
#undef PG8_MMA
#undef PG8_WAIT_V
#undef PG8_WAIT_L
#undef PG8_BAR
#undef PG8_SCHED
}
}

#define LDS_WAIT() asm volatile("s_waitcnt lgkmcnt(0)" ::: "memory")

__device__ __forceinline__ float wave_sum(float v) {
#pragma unroll
    for (int o = 1; o < 64; o <<= 1) v += __shfl_xor(v, o);
    return v;
}

__device__ __forceinline__ void p0_transpose_item(const float* W, const float* gain, int K, int N, bf16_t* WT, int ilv, LAS float* scr, int item, int lane) {
    const int nblk = N / 32, kb = item / nblk, nb = item % nblk, k0 = 64 * kb, n0 = 32 * nb;
#pragma unroll 8
    for (int i = 0; i < 32; ++i) { const int kk = 2 * i + (lane >> 5); scr[kk * 33 + (lane & 31)] = W[(size_t)(k0 + kk) * N + n0 + (lane & 31)]; }
    LDS_WAIT(); asm volatile("" ::: "memory");
    const int c = lane & 7;
    f32x4 g0 = (f32x4){1.f, 1.f, 1.f, 1.f}, g1 = g0;
    if (gain) { g0 = *(const f32x4*)(gain + k0 + 8 * c); g1 = *(const f32x4*)(gain + k0 + 8 * c + 4); }
#pragma unroll
    for (int j = 0; j < 4; ++j) { const int n = (lane >> 3) + 8 * j; const LAS float* s = scr + (8 * c) * 33 + n;
        u32x4 o; o.x = cvt_pk_bf16(s[0 * 33] * g0.x, s[1 * 33] * g0.y); o.y = cvt_pk_bf16(s[2 * 33] * g0.z, s[3 * 33] * g0.w); o.z = cvt_pk_bf16(s[4 * 33] * g1.x, s[5 * 33] * g1.y); o.w = cvt_pk_bf16(s[6 * 33] * g1.z, s[7 * 33] * g1.w);
        const int nn = n0 + n; const int row = ilv < 0 ? nn : ((nn >> 7) * 256 + (nn & 127) + ilv);
        *(u32x4*)(WT + (size_t)row * K + k0 + 8 * c) = o; }
    LDS_WAIT(); asm volatile("" ::: "memory");
}

__device__ __forceinline__ void rms_rows_bf16(const float* x, const float* g, bf16_t* out, int gw, int NGW, int lane) {
    LAUNDER(lane);
    f32x4 gv[8];
#pragma unroll
    for (int j = 0; j < 8; ++j) gv[j] = *(const f32x4*)(g + 4 * lane + 256 * j);
    for (int m = gw; m < M; m += NGW) {
        const f32x4* xr = (const f32x4*)(x + (size_t)m * D) + lane; f32x4 v[8]; float s = 0.f;
#pragma unroll
        for (int j = 0; j < 8; ++j) { v[j] = xr[64 * j]; s += (v[j].x * v[j].x + v[j].y * v[j].y) + (v[j].z * v[j].z + v[j].w * v[j].w); }
        const float rstd = 1.0f / sqrtf(wave_sum(s) * (1.0f / D) + EPS);
        u32x2* o8 = (u32x2*)(out + (size_t)m * D) + lane;
#pragma unroll
        for (int j = 0; j < 8; ++j) { const f32x4 o = v[j] * rstd * gv[j]; u32x2 w; w.x = cvt_pk_bf16(o.x, o.y); w.y = cvt_pk_bf16(o.z, o.w); o8[64 * j] = w; }
    }
}
__device__ __forceinline__ void cast_rows_bf16(const float* x, bf16_t* out, float* ssq, int gw, int NGW, int lane) {
    LAUNDER(lane);
    for (int m = gw; m < M; m += NGW) {
        const f32x4* xr = (const f32x4*)(x + (size_t)m * D) + lane; f32x4 v[8]; float s = 0.f;
#pragma unroll
        for (int j = 0; j < 8; ++j) { v[j] = xr[64 * j]; s += (v[j].x * v[j].x + v[j].y * v[j].y) + (v[j].z * v[j].z + v[j].w * v[j].w); }
        s = wave_sum(s);
        if (lane == 0) { f32x4* pp = (f32x4*)(ssq + (size_t)m * 8); pp[0] = (f32x4){s, 0.f, 0.f, 0.f}; pp[1] = (f32x4){0.f, 0.f, 0.f, 0.f}; }
        u32x2* o8 = (u32x2*)(out + (size_t)m * D) + lane;
#pragma unroll
        for (int j = 0; j < 8; ++j) { u32x2 w; w.x = cvt_pk_bf16(v[j].x, v[j].y); w.y = cvt_pk_bf16(v[j].z, v[j].w); o8[64 * j] = w; }
    }
}
__device__ __forceinline__ void rms_rows_f32_inplace(float* x, const float* g, int gw, int NGW, int lane) {
    LAUNDER(lane);
    f32x4 gv[8];
#pragma unroll
    for (int j = 0; j < 8; ++j) gv[j] = *(const f32x4*)(g + 4 * lane + 256 * j);
    for (int m = gw; m < M; m += NGW) {
        f32x4* xr = (f32x4*)(x + (size_t)m * D) + lane; f32x4 v[8]; float s = 0.f;
#pragma unroll
        for (int j = 0; j < 8; ++j) { v[j] = xr[64 * j]; s += (v[j].x * v[j].x + v[j].y * v[j].y) + (v[j].z * v[j].z + v[j].w * v[j].w); }
        const float rstd = 1.0f / sqrtf(wave_sum(s) * (1.0f / D) + EPS);
#pragma unroll
        for (int j = 0; j < 8; ++j) xr[64 * j] = v[j] * rstd * gv[j];
    }
}
__device__ __forceinline__ void rms_rows_bf16_to_f32(const bf16_t* x, const float* g, float* out, int gw, int NGW, int lane) {
    LAUNDER(lane);
    f32x4 gv[4][2];
#pragma unroll
    for (int j = 0; j < 4; ++j) { const float* gp = g + 512 * j + 8 * lane; gv[j][0] = *(const f32x4*)gp; gv[j][1] = *(const f32x4*)(gp + 4); }
    for (int m = gw; m < M; m += NGW) {
        const u32x4* xr = (const u32x4*)(x + (size_t)m * D) + lane; u32x4 raw[4]; float s = 0.f;
#pragma unroll
        for (int j = 0; j < 4; ++j) raw[j] = xr[64 * j];
        float v[4][8];
#pragma unroll
        for (int j = 0; j < 4; ++j) {
            v[j][0] = bf_lo(raw[j].x); v[j][1] = bf_hi(raw[j].x); v[j][2] = bf_lo(raw[j].y); v[j][3] = bf_hi(raw[j].y);
            v[j][4] = bf_lo(raw[j].z); v[j][5] = bf_hi(raw[j].z); v[j][6] = bf_lo(raw[j].w); v[j][7] = bf_hi(raw[j].w);
#pragma unroll
            for (int e = 0; e < 8; ++e) s += v[j][e] * v[j][e];
        }
        const float rstd = 1.0f / sqrtf(wave_sum(s) * (1.0f / D) + EPS);
        f32x4* orow = (f32x4*)(out + (size_t)m * D + 8 * lane);
#pragma unroll
        for (int j = 0; j < 4; ++j) {
            orow[128 * j] = (f32x4){v[j][0] * rstd * gv[j][0].x, v[j][1] * rstd * gv[j][0].y, v[j][2] * rstd * gv[j][0].z, v[j][3] * rstd * gv[j][0].w};
            orow[128 * j + 1] = (f32x4){v[j][4] * rstd * gv[j][1].x, v[j][5] * rstd * gv[j][1].y, v[j][6] * rstd * gv[j][1].z, v[j][7] * rstd * gv[j][1].w};
        }
    }
}
__device__ __forceinline__ void ynorm_rows(bf16_t* y, const float* g_lru, const float* g_att, int gw, int NGW, int lane) {
    LAUNDER(lane);
    f32x4 gv[4][2];
#pragma unroll
    for (int j = 0; j < 4; ++j) { const float* gp = (j < 2 ? g_lru + 512 * j : g_att + 512 * (j - 2)) + 8 * lane; gv[j][0] = *(const f32x4*)gp; gv[j][1] = *(const f32x4*)(gp + 4); }
    for (int m = gw; m < M; m += NGW) {
        u32x4* yr = (u32x4*)(y + (size_t)m * D) + lane; u32x4 raw[4]; float s0 = 0.f, s1 = 0.f;
#pragma unroll
        for (int j = 0; j < 4; ++j) raw[j] = yr[64 * j];
        float v[4][8];
#pragma unroll
        for (int j = 0; j < 4; ++j) {
            v[j][0] = bf_lo(raw[j].x); v[j][1] = bf_hi(raw[j].x); v[j][2] = bf_lo(raw[j].y); v[j][3] = bf_hi(raw[j].y);
            v[j][4] = bf_lo(raw[j].z); v[j][5] = bf_hi(raw[j].z); v[j][6] = bf_lo(raw[j].w); v[j][7] = bf_hi(raw[j].w);
            float s = 0.f;
#pragma unroll
            for (int e = 0; e < 8; ++e) s += v[j][e] * v[j][e];
            if (j < 2) s0 += s; else s1 += s;
        }
        const float r0 = 1.0f / sqrtf(wave_sum(s0) * (1.0f / 1024.f) + EPS), r1 = 1.0f / sqrtf(wave_sum(s1) * (1.0f / 1024.f) + EPS);
#pragma unroll
        for (int j = 0; j < 4; ++j) { const float r = j < 2 ? r0 : r1; u32x4 w;
            w.x = cvt_pk_bf16(v[j][0] * r * gv[j][0].x, v[j][1] * r * gv[j][0].y); w.y = cvt_pk_bf16(v[j][2] * r * gv[j][0].z, v[j][3] * r * gv[j][0].w);
            w.z = cvt_pk_bf16(v[j][4] * r * gv[j][1].x, v[j][5] * r * gv[j][1].y); w.w = cvt_pk_bf16(v[j][6] * r * gv[j][1].z, v[j][7] * r * gv[j][1].w);
            yr[64 * j] = w; }
    }
}

constexpr int LM_BIAS = 0;
constexpr int LM_CW = 8448;
constexpr int LM_CB = 9472;
constexpr int LM_P = 10240;
constexpr int LM_H = 18432;
__device__ __forceinline__ void lru_unit(LAS unsigned char* lds, const bf16_t* zm, bf16_t* yraw, const float* conv_w, const float* conv_b, const float* wa, const float* ba,
                                         const float* wx, const float* bx, const float* lam, int b, int hb, int tid) {
    LAUNDER(tid);
    const int lane = tid & 63, w = tid >> 6, fr = lane & 15, fq = lane >> 4;
    LAS float* cwL = (LAS float*)(lds + LM_CW); LAS float* cbL = (LAS float*)(lds + LM_CB); LAS float* PL = (LAS float*)(lds + LM_P); LAS float* HL = (LAS float*)(lds + LM_H);
    if (tid < 256) cwL[tid] = conv_w[(tid >> 6) * DL + hb * 64 + (tid & 63)];
    else if (tid < 320) cbL[tid - 256] = conv_b[hb * 64 + tid - 256];
    bf16x8 WA[4][2], WX[4][2];
#pragma unroll
    for (int nt = 0; nt < 4; ++nt)
#pragma unroll
        for (int ks = 0; ks < 2; ++ks) {
            const float* pa = wa + ((size_t)hb * 64 + ks * 32 + 8 * fq) * 64 + nt * 16 + fr; const float* px = wx + ((size_t)hb * 64 + ks * 32 + 8 * fq) * 64 + nt * 16 + fr;
            u32x4 ua, ux;
            ua.x = cvt_pk_bf16(pa[0 * 64], pa[1 * 64]); ua.y = cvt_pk_bf16(pa[2 * 64], pa[3 * 64]); ua.z = cvt_pk_bf16(pa[4 * 64], pa[5 * 64]); ua.w = cvt_pk_bf16(pa[6 * 64], pa[7 * 64]);
            ux.x = cvt_pk_bf16(px[0 * 64], px[1 * 64]); ux.y = cvt_pk_bf16(px[2 * 64], px[3 * 64]); ux.z = cvt_pk_bf16(px[4 * 64], px[5 * 64]); ux.w = cvt_pk_bf16(px[6 * 64], px[7 * 64]);
            WA[nt][ks] = __builtin_bit_cast(bf16x8, ua); WX[nt][ks] = __builtin_bit_cast(bf16x8, ux);
        }
    bf16x8 ID[2];
#pragma unroll
    for (int p = 0; p < 2; ++p)
#pragma unroll
        for (int e = 0; e < 8; ++e) ID[p][e] = (8 * fq + e == 16 * p + fr) ? (short)0x3F80 : (short)0;
    float pba[4], pbx[4], pcl[4];
#pragma unroll
    for (int nt = 0; nt < 4; ++nt) { const int c = hb * 64 + nt * 16 + fr; pba[nt] = ba[c]; pbx[nt] = bx[c]; pcl[nt] = -8.0f * log1pf(expf(-lam[c])); }
    __syncthreads();
    float hst[4], pst[4];
    const bf16_t* zb = zm + (size_t)b * SEQ * ZLD + hb * 64;
    const int tbaseA = 256 * w + (fr >> 2) * 64 + (fr & 3);
    const int tbaseD = 256 * w + fq * 64;
#pragma unroll 1
    for (int pass = 0; pass < 2; ++pass) {
        if (pass == 0) {
#pragma unroll
            for (int nt = 0; nt < 4; ++nt) { hst[nt] = 0.f; pst[nt] = 1.f; }
        }
        u32x4 XR[2][4], GR[2];
        {
            const int tA = tbaseA;
#pragma unroll
            for (int ks = 0; ks < 2; ++ks) {
                const int ch0 = ks * 32 + 8 * fq;
#pragma unroll
                for (int tap = 0; tap < 4; ++tap) { const int t = tA - 3 + tap; const int tt = t >= 0 ? t : 0; XR[ks][tap] = *(const u32x4*)(zb + (size_t)tt * ZLD + ch0); }
                GR[ks] = *(const u32x4*)(zb + (size_t)tA * ZLD + 1024 + ch0);
            }
        }
#pragma unroll 1
        for (int i = 0; i < 16; ++i) {
            const int tA = tbaseA + i * 4;
            const int tN = tbaseA + (i < 15 ? i + 1 : i) * 4;
            u32x4 XN[2][4], GN[2];
#pragma unroll
            for (int ks = 0; ks < 2; ++ks) {
                const int ch0 = ks * 32 + 8 * fq;
#pragma unroll
                for (int tap = 0; tap < 4; ++tap) { const int t = tN - 3 + tap; const int tt = t >= 0 ? t : 0; XN[ks][tap] = *(const u32x4*)(zb + (size_t)tt * ZLD + ch0); }
                GN[ks] = *(const u32x4*)(zb + (size_t)tN * ZLD + 1024 + ch0);
            }
            bf16x8 XC[2], GL[2];
#pragma unroll
            for (int ks = 0; ks < 2; ++ks) {
                const int ch0 = ks * 32 + 8 * fq;
                const f32x4 c0 = *(const LAS f32x4*)(cbL + ch0), c1 = *(const LAS f32x4*)(cbL + ch0 + 4);
                float a8[8] = {c0.x, c0.y, c0.z, c0.w, c1.x, c1.y, c1.z, c1.w};
#pragma unroll
                for (int tap = 0; tap < 4; ++tap) {
                    const bool ok = (tA - 3 + tap) >= 0;
                    u32x4 xr = XR[ks][tap];
                    if (!ok) xr = (u32x4){0u, 0u, 0u, 0u};
                    const f32x4 w0 = *(const LAS f32x4*)(cwL + tap * 64 + ch0), w1 = *(const LAS f32x4*)(cwL + tap * 64 + ch0 + 4);
                    a8[0] += w0.x * bf_lo(xr.x); a8[1] += w0.y * bf_hi(xr.x); a8[2] += w0.z * bf_lo(xr.y); a8[3] += w0.w * bf_hi(xr.y);
                    a8[4] += w1.x * bf_lo(xr.z); a8[5] += w1.y * bf_hi(xr.z); a8[6] += w1.z * bf_lo(xr.w); a8[7] += w1.w * bf_hi(xr.w);
                }
                u32x4 pk; pk.x = cvt_pk_bf16(a8[0], a8[1]); pk.y = cvt_pk_bf16(a8[2], a8[3]); pk.z = cvt_pk_bf16(a8[4], a8[5]); pk.w = cvt_pk_bf16(a8[6], a8[7]);
                XC[ks] = __builtin_bit_cast(bf16x8, pk);
                GL[ks] = __builtin_bit_cast(bf16x8, GR[ks]);
            }
#pragma unroll
            for (int nt = 0; nt < 4; ++nt) {
                f32x4 ga = (f32x4){0.f, 0.f, 0.f, 0.f}, gx = ga, xo = ga, go = ga;
#pragma unroll
                for (int ks = 0; ks < 2; ++ks) { ga = __builtin_amdgcn_mfma_f32_16x16x32_bf16(XC[ks], WA[nt][ks], ga, 0, 0, 0); gx = __builtin_amdgcn_mfma_f32_16x16x32_bf16(XC[ks], WX[nt][ks], gx, 0, 0, 0); }
                xo = __builtin_amdgcn_mfma_f32_16x16x32_bf16(XC[nt >> 1], ID[nt & 1], xo, 0, 0, 0);
                if (pass) go = __builtin_amdgcn_mfma_f32_16x16x32_bf16(GL[nt >> 1], ID[nt & 1], go, 0, 0, 0);
#pragma unroll
                for (int j = 0; j < 4; ++j) {
                    const float r = sigmoidf_(ga[j] + pba[nt]), ig = sigmoidf_(gx[j] + pbx[nt]);
                    const float la = pcl[nt] * r;
                    const float a = fast_exp2(la * LOG2E);
                    const float x2 = 2.0f * la;
                    float ome = -x2 * (1.0f + x2 * 0.5f * (1.0f + x2 * (1.0f / 3.0f)));
                    if (x2 < -0.03f) ome = 1.0f - a * a;
                    const float u = sqrtf(ome) * ig * xo[j];
                    hst[nt] = a * hst[nt] + u;
                    if (pass == 0) pst[nt] *= a;
                    else {
                        const float gv = go[j];
                        const float gel = gv * sigmoidf_(1.5957691216057308f * (gv + 0.044715f * gv * gv * gv));
                        const unsigned o = cvt_pk_bf16(hst[nt] * gel, 0.f);
                        yraw[(size_t)(b * SEQ + tbaseD + i * 4 + j) * D + hb * 64 + nt * 16 + fr] = (bf16_t)(o & 0xffffu);
                    }
                }
            }
#pragma unroll
            for (int ks = 0; ks < 2; ++ks) {
#pragma unroll
                for (int tap = 0; tap < 4; ++tap) XR[ks][tap] = XN[ks][tap];
                GR[ks] = GN[ks];
            }
        }
        if (pass == 0) {
            const int seg = 4 * w + fq;
#pragma unroll
            for (int nt = 0; nt < 4; ++nt) { PL[seg * 64 + nt * 16 + fr] = pst[nt]; HL[seg * 64 + nt * 16 + fr] = hst[nt]; }
            __syncthreads();
#pragma unroll
            for (int nt = 0; nt < 4; ++nt) hst[nt] = 0.f;
            for (int s2 = 0; s2 < seg; ++s2) {
#pragma unroll
                for (int nt = 0; nt < 4; ++nt) hst[nt] = PL[s2 * 64 + nt * 16 + fr] * hst[nt] + HL[s2 * 64 + nt * 16 + fr];
            }
        }
    }
    __syncthreads();
}

constexpr int LM_ATT = 32768;
#define ATT_COMPUTE(FAR) do { \
        bf16x8 Kf[2][4], Vf[8]; \
        _Pragma("unroll") for (int t = 0; t < 2; ++t) _Pragma("unroll") for (int ks = 0; ks < 4; ++ks) Kf[t][ks] = *(const LAS bf16x8*)(sb + (t * 4 + ks) * 1024 + foff); \
        _Pragma("unroll") for (int dt = 0; dt < 8; ++dt) Vf[dt] = *(const LAS bf16x8*)(sb + 8192 + dt * 1024 + foff); \
        f32x4 St[2][2]; \
        _Pragma("unroll") for (int t = 0; t < 2; ++t) _Pragma("unroll") for (int qt = 0; qt < 2; ++qt) { f32x4 s_ = (f32x4){0.f, 0.f, 0.f, 0.f}; \
            _Pragma("unroll") for (int ks = 0; ks < 4; ++ks) s_ = __builtin_amdgcn_mfma_f32_16x16x32_bf16(Kf[t][ks], Q[qt][ks], s_, 0, 0, 0); \
            St[t][qt] = s_; } \
        bf16x8 Pf[2]; \
        _Pragma("unroll") for (int qt = 0; qt < 2; ++qt) { \
            const int qpos = c * 64 + qh * 32 + qt * 16 + fr; \
            float sv[8]; float bm = -1e30f; \
            _Pragma("unroll") for (int t = 0; t < 2; ++t) _Pragma("unroll") for (int j = 0; j < 4; ++j) { float bv_; \
                if (FAR) bv_ = bias0; else { int rel = k0 + 8 * fq + 4 * t + j - qpos; rel = rel < -128 ? -128 : (rel > 128 ? 128 : rel); bv_ = bias[rel + 128]; } \
                const float s_ = St[t][qt][j] * SC + bv_; sv[t * 4 + j] = s_; bm = fmaxf(bm, s_); } \
            bm = fmaxf(bm, __shfl_xor(bm, 16)); bm = fmaxf(bm, __shfl_xor(bm, 32)); \
            const float mn = fmaxf(mrun[qt], bm); const float alpha = fast_exp2(mrun[qt] - mn); mrun[qt] = mn; \
            float ps = 0.f; \
            _Pragma("unroll") for (int e = 0; e < 8; ++e) { sv[e] = fast_exp2(sv[e] - mn); ps += sv[e]; } \
            lrun[qt] = lrun[qt] * alpha + ps; \
            _Pragma("unroll") for (int dt = 0; dt < 8; ++dt) O[dt][qt] = O[dt][qt] * alpha; \
            u32x4 pk; pk.x = cvt_pk_bf16(sv[0], sv[1]); pk.y = cvt_pk_bf16(sv[2], sv[3]); pk.z = cvt_pk_bf16(sv[4], sv[5]); pk.w = cvt_pk_bf16(sv[6], sv[7]); \
            Pf[qt] = __builtin_bit_cast(bf16x8, pk); } \
        _Pragma("unroll") for (int dt = 0; dt < 8; ++dt) _Pragma("unroll") for (int qt = 0; qt < 2; ++qt) O[dt][qt] = __builtin_amdgcn_mfma_f32_16x16x32_bf16(Vf[dt], Pf[qt], O[dt][qt], 0, 0, 0); \
    } while (0)
__device__ __forceinline__ void attn_block(LAS unsigned char* lds, const bf16_t* zm, const bf16_t* Kh, const bf16_t* Vt, bf16_t* yraw, const LAS float* biasAll, int b, int h, int g, int tid) {
    LAUNDER(tid);
    const int lane = tid & 63, wave = tid >> 6, fr = lane & 15, fq = lane >> 4;
    const int c = 4 * g + (wave >> 1), qh = wave & 1;
    const LAS float* bias = biasAll + h * NREL;
    const float bias0 = bias[0];
    const float SC = 0.08838834764831845f * LOG2E;
    bf16x8 Q[2][4];
#pragma unroll
    for (int qt = 0; qt < 2; ++qt) { const size_t tok = (size_t)b * SEQ + c * 64 + qh * 32 + qt * 16 + fr;
#pragma unroll
        for (int ks = 0; ks < 4; ++ks) Q[qt][ks] = *(const bf16x8*)(zm + tok * ZLD + 2048 + h * HD + ks * 32 + 8 * fq); }
    f32x4 O[8][2];
#pragma unroll
    for (int dt = 0; dt < 8; ++dt)
#pragma unroll
        for (int qt = 0; qt < 2; ++qt) O[dt][qt] = (f32x4){0.f, 0.f, 0.f, 0.f};
    float mrun[2] = {-1e30f, -1e30f}, lrun[2] = {0.f, 0.f};
    const int lo = g >= 2 ? 4 * g - 8 : 0, nsteps = (4 * g + 4 - lo) * 2;
    const int kr = tid >> 4, c16 = tid & 15;
    const int krho = ((kr >> 3) << 2) | (kr & 3);
    const int kst = ((((kr >> 2) & 1) * 4 + (c16 >> 2)) * 1024) + ((krho * 64 + (c16 & 3) * 16) ^ (krho >= 8 ? 32 : 0));
    const bf16_t* kg = Kh + ((size_t)(b * NH + h) * SEQ + kr) * HD + 8 * c16;
    const int vd = tid >> 2, vq = tid & 3;
    const int vst = 8192 + (vd >> 4) * 1024 + (((vd & 15) * 64 + vq * 16) ^ ((vd & 15) >= 8 ? 32 : 0));
    const bf16_t* vg = Vt + ((size_t)(b * NH + h) * HD + vd) * SEQ + 8 * vq;
    const int foff = (fr * 64 + fq * 16) ^ (fr >= 8 ? 32 : 0);
    LAS unsigned char* st = lds + LM_ATT;
    { const int k0 = lo * 64; const u32x4 kv = *(const u32x4*)(kg + (size_t)k0 * HD); const u32x4 vv = *(const u32x4*)(vg + k0);
      *(LAS u32x4*)(st + kst) = kv; *(LAS u32x4*)(st + vst) = vv; }
    __syncthreads();
#pragma unroll 1
    for (int s = 0; s < nsteps; ++s) {
        const int kc = lo + (s >> 1), k0 = kc * 64 + (s & 1) * 32;
        const int sn = s + 1 < nsteps ? s + 1 : s;
        const int k0n = (lo + (sn >> 1)) * 64 + (sn & 1) * 32;
        const u32x4 kv = *(const u32x4*)(kg + (size_t)k0n * HD); const u32x4 vv = *(const u32x4*)(vg + k0n);
        const LAS unsigned char* sb = st + (s & 1) * 16384;
        if (kc >= c - 8 && kc <= c) {
            if (kc <= c - 3) ATT_COMPUTE(true); else ATT_COMPUTE(false);
        }
        LAS unsigned char* nb = st + ((s + 1) & 1) * 16384;
        *(LAS u32x4*)(nb + kst) = kv; *(LAS u32x4*)(nb + vst) = vv;
        __syncthreads();
    }
#pragma unroll
    for (int qt = 0; qt < 2; ++qt) {
        float l = lrun[qt]; l += __shfl_xor(l, 16); l += __shfl_xor(l, 32);
        const float inv = 1.0f / l;
        bf16_t* op = yraw + ((size_t)b * SEQ + c * 64 + qh * 32 + qt * 16 + fr) * D + 1024 + h * HD + 4 * fq;
#pragma unroll
        for (int dt = 0; dt < 8; ++dt) { const f32x4 o = O[dt][qt] * inv; u32x2 w; w.x = cvt_pk_bf16(o.x, o.y); w.y = cvt_pk_bf16(o.z, o.w); *(u32x2*)(op + dt * 16) = w; }
    }
}
#undef ATT_COMPUTE

#define XB_TMO      128
#define XB_XCNT(j)  (256  + 64 * (j))
#define XB_XSUB(j)  (1280 + 64 * (j))
#define XB_XGEN(j)  (2304 + 64 * (j))
#define XB_TOP      3328
#define XB_TOPGEN   3392
#define XCD_BAR_WORDS 3456
#define XB_SPIN_CAP (1u << 18)
__device__ __forceinline__ unsigned xb_ld(unsigned* p)              { return __hip_atomic_load(p, __ATOMIC_RELAXED, __HIP_MEMORY_SCOPE_AGENT); }
__device__ __forceinline__ unsigned xb_add(unsigned* p, unsigned v) { return __hip_atomic_fetch_add(p, v, __ATOMIC_RELAXED, __HIP_MEMORY_SCOPE_AGENT); }
__device__ __forceinline__ unsigned xb_xcc_id() { return (unsigned)__builtin_amdgcn_s_getreg((3 << 11) | 20) & 0xFu; }
#define XB_SPIN(cond, bar) do { unsigned _sp = 0; while (cond) { __builtin_amdgcn_s_sleep(1); \
    if ((++_sp & 255u) == 0u) { if (xb_ld(&(bar)[XB_TMO])) break; if (_sp > XB_SPIN_CAP) { atomicAdd(&(bar)[XB_TMO], 1u); break; } } } } while (0)
struct XcdBarrier { unsigned* bar; unsigned x; volatile LAS unsigned* st; };
__device__ __forceinline__ XcdBarrier xcd_barrier_post(unsigned* bar, volatile LAS unsigned* st) {
    XcdBarrier b; b.bar = bar; b.x = xb_xcc_id(); b.st = st;
    if (threadIdx.x == 0) (void)xb_add(&bar[XB_XCNT(b.x)], 1u);
    return b;
}
__device__ __forceinline__ void xcd_barrier_complete(unsigned* bar, unsigned x, unsigned& nloc, unsigned& nx) {
    const unsigned G = gridDim.x * gridDim.y * gridDim.z;
    unsigned sum, cnt, mine, sp = 0u;
    for (;;) {
        sum = 0u; cnt = 0u; mine = 0u;
#pragma unroll
        for (unsigned j = 0; j < 16; ++j) { const unsigned c = xb_ld(&bar[XB_XCNT(j)]); sum += c; cnt += (c > 0u) ? 1u : 0u; mine = (j == x) ? c : mine; }
        if (sum == G) break;
        __builtin_amdgcn_s_sleep(1);
        if ((++sp & 255u) == 0u) { if (xb_ld(&bar[XB_TMO])) break; if (sp > XB_SPIN_CAP) { atomicAdd(&bar[XB_TMO], 1u); break; } }
    }
    nloc = mine > 0u ? mine : 1u; nx = cnt > 0u ? cnt : 1u;
}
__device__ __forceinline__ void xcd_barrier(const XcdBarrier& b) {
    asm volatile("s_waitcnt vmcnt(0)" ::: "memory");
    __syncthreads();
    if (threadIdx.x == 0) {
        unsigned* bar = b.bar;
        __builtin_amdgcn_s_waitcnt(0);
        unsigned nloc = b.st[0], nx = b.st[1];
        if (nloc == 0u) { xcd_barrier_complete(bar, b.x, nloc, nx); b.st[0] = nloc; b.st[1] = nx; }
        const unsigned old = xb_add(&bar[XB_XSUB(b.x)], 1u);
        const unsigned gen = old / nloc;
        if (old + 1u == (gen + 1u) * nloc) {
            __builtin_amdgcn_fence(__ATOMIC_RELEASE, "agent");
            asm volatile("s_waitcnt vmcnt(0)" ::: "memory");
            const unsigned og = xb_add(&bar[XB_TOP], 1u);
            const unsigned tg = og / nx;
            if (og + 1u == (tg + 1u) * nx) xb_add(&bar[XB_TOPGEN], 1u);
            else XB_SPIN(xb_ld(&bar[XB_TOPGEN]) == tg, bar);
            __builtin_amdgcn_fence(__ATOMIC_ACQUIRE, "agent");
            xb_add(&bar[XB_XGEN(b.x)], 1u);
            asm volatile("s_waitcnt vmcnt(0)" ::: "memory");
        } else {
            XB_SPIN(xb_ld(&bar[XB_XGEN(b.x)]) == gen, bar);
            __builtin_amdgcn_fence(__ATOMIC_ACQUIRE, "agent");
            asm volatile("s_waitcnt vmcnt(0)" ::: "memory");
        }
    }
    __syncthreads();
}

struct Args { const float* in[23]; float* out; unsigned char* ws; int pad0, pad1; };

__global__ void __launch_bounds__(NTHREADS, 2) mk_fwd(Args args) {
    extern __shared__ __attribute__((aligned(16))) unsigned char lds_raw[];
    LAS unsigned char* lds = (LAS unsigned char*)lds_raw;
    cg::grid_group grid = cg::this_grid();
    const int tid = threadIdx.x, lane = tid & 63, wave = __builtin_amdgcn_readfirstlane(tid >> 6);
    const int G = gridDim.x, bx = blockIdx.x;
    const int gw = bx * NWAVES + wave, NGW = G * NWAVES;
    typedef const float* cfp;
    const __attribute__((address_space(4))) cfp* inp = (const __attribute__((address_space(4))) cfp*)__builtin_amdgcn_kernarg_segment_ptr();
#define INP(k) (inp[k])
#define LAUNDER_S(v) asm volatile("" : "+s"(v))
    unsigned char* ws = args.ws;
    float* out = args.out;
    volatile LAS unsigned* bst = (volatile LAS unsigned*)(lds + 131072 + 64);
    if (tid < 2) bst[tid] = 0u;
    __syncthreads();
    (void)xcd_barrier_post((unsigned*)(ws + WS_CTL), bst);
#define GRID_BAR() do { XcdBarrier xb_; xb_.bar = (unsigned*)(args.ws + WS_CTL); xb_.x = xb_xcc_id(); xb_.st = (volatile LAS unsigned*)(lds + 131072 + 64); xcd_barrier(xb_); } while (0)
    bf16_t* HID = (bf16_t*)(ws + WS_BIG); bf16_t* ZM = (bf16_t*)(ws + WS_BIG); bf16_t* VT = (bf16_t*)(ws + WS_VT); bf16_t* KH = (bf16_t*)(ws + WS_KH); bf16_t* HB = (bf16_t*)(ws + WS_H); bf16_t* HB2 = (bf16_t*)(ws + WS_H2); float* SSQ = (float*)(ws + WS_SSQ);

    {
        LAS float* scr = (LAS float*)(lds + wave * 16384);
        constexpr int I_G = (D / 64) * (FF / 32), I_D = (FF / 64) * (D / 32), I_IN = (D / 64) * (DIN / 32), I_O = (D / 64) * (D / 32);
        constexpr int PER_LAYER = 4 * I_G + 2 * I_D + I_IN + I_O;
        for (int it = gw; it < DEPTH * PER_LAYER; it += NGW) {
            const int l = it / PER_LAYER; int r = it % PER_LAYER;
            unsigned char* wl = ws + (size_t)l * LAYER_W;
            if (r < I_G) { p0_transpose_item(INP(2) + (size_t)l * D * FF, INP(1) + (size_t)l * D, D, FF, (bf16_t*)(wl + OFF_WGU1), 0, scr, r, lane); continue; } r -= I_G;
            if (r < I_G) { p0_transpose_item(INP(3) + (size_t)l * D * FF, INP(1) + (size_t)l * D, D, FF, (bf16_t*)(wl + OFF_WGU1), 128, scr, r, lane); continue; } r -= I_G;
            if (r < I_D) { p0_transpose_item(INP(4) + (size_t)l * FF * D, nullptr, FF, D, (bf16_t*)(wl + OFF_WD1), -1, scr, r, lane); continue; } r -= I_D;
            if (r < I_IN) { p0_transpose_item(INP(6) + (size_t)l * D * DIN, INP(5) + (size_t)l * D, D, DIN, (bf16_t*)(wl + OFF_WIN), -1, scr, r, lane); continue; } r -= I_IN;
            if (r < I_O) { p0_transpose_item(INP(17) + (size_t)l * D * D, nullptr, D, D, (bf16_t*)(wl + OFF_WOUT), -1, scr, r, lane); continue; } r -= I_O;
            if (r < I_G) { p0_transpose_item(INP(19) + (size_t)l * D * FF, INP(18) + (size_t)l * D, D, FF, (bf16_t*)(wl + OFF_WGU2), 0, scr, r, lane); continue; } r -= I_G;
            if (r < I_G) { p0_transpose_item(INP(20) + (size_t)l * D * FF, INP(18) + (size_t)l * D, D, FF, (bf16_t*)(wl + OFF_WGU2), 128, scr, r, lane); continue; } r -= I_G;
            p0_transpose_item(INP(21) + (size_t)l * FF * D, nullptr, FF, D, (bf16_t*)(wl + OFF_WD2), -1, scr, r, lane);
        }
        cast_rows_bf16(INP(0), HB, SSQ, gw, NGW, lane);
    }
    grid.sync();

#pragma unroll 1
    for (int l = 0; l < DEPTH; ++l) {
        unsigned char* wl = ws + (size_t)l * LAYER_W;
#pragma unroll 1
        for (int f = 0; f < 2; ++f) {
            LAUNDER_S(inp);
            {
                pg8::Gemm g{HB, (const bf16_t*)(wl + (f ? OFF_WGU2 : OFF_WGU1)), M, 2 * FF, D}; pg8::StaticOrder S; S.init(M, 2 * FF, G, bx);
                { if (tid == 0) *(volatile LAS int*)(lds + pg8::LDS_RSPM) = -1; __syncthreads(); }
                pg8::EpiSwiGLU E{HID, FF, SSQ + (size_t)(3 * l + (f ? 2 : 0)) * M * 8, lds};
                pg8::gemm_phase<pg8::EpiSwiGLU, pg8::StaticOrder, true, true>(lds, g, S, E);
            }
            GRID_BAR();
            {
                pg8::Gemm g{HID, (const bf16_t*)(wl + (f ? OFF_WD2 : OFF_WD1)), M, D, FF}; pg8::StaticOrder S; S.init(M, D, G, bx);
                pg8::EpiResid<true> E{HB, SSQ + (size_t)(3 * l + (f ? 3 : 1)) * M * 8, lds};
                pg8::gemm_phase<pg8::EpiResid<true>, pg8::StaticOrder, true, true>(lds, g, S, E);
            }
            GRID_BAR();
            if (f == 0) {
                {
                    pg8::Gemm g{HB, (const bf16_t*)(wl + OFF_WIN), M, DIN, D}; pg8::StaticOrder S; S.init(M, DIN, G, bx);
                    { if (tid == 0) *(volatile LAS int*)(lds + pg8::LDS_RSPM) = -1; __syncthreads(); }
                    pg8::EpiZ E{ZM, VT, KH, SSQ + (size_t)(3 * l + 1) * M * 8, lds};
                    pg8::gemm_phase<pg8::EpiZ, pg8::StaticOrder, true, true>(lds, g, S, E);
                }
                GRID_BAR();
                {
                    LAS float* biasL = (LAS float*)(lds + LM_BIAS);
                    const float* rb = INP(14) + (size_t)l * NH * NREL;
                    int tid_m = tid; LAUNDER(tid_m);
                    for (int i = tid_m; i < NH * NREL; i += NTHREADS) biasL[i] = rb[i] * LOG2E;
                    __syncthreads();
                    for (int u = bx; u < NB * 16; u += G)
                        lru_unit(lds, ZM, HB2, INP(7) + (size_t)l * 4 * DL, INP(8) + (size_t)l * DL, INP(9) + (size_t)l * 16 * 64 * 64, INP(10) + (size_t)l * DL,
                                 INP(11) + (size_t)l * 16 * 64 * 64, INP(12) + (size_t)l * DL, INP(13) + (size_t)l * DL, u >> 4, u & 15, tid);
                    for (int bu = bx; bu < 1024; bu += G) {
                        const int kk = bu >> 8, bxv = bu & 255;
                        const int ag = ((bxv & 7) + 2 * kk) & 7, ap = (bxv >> 3) + 32 * kk;
                        attn_block(lds, ZM, KH, VT, HB2, biasL, ap >> 3, ap & 7, ag, tid);
                    }
                }
                GRID_BAR();
                ynorm_rows(HB2, INP(15) + (size_t)l * DL, INP(16) + (size_t)l * DL, gw, NGW, lane);
                GRID_BAR();
                {
                    pg8::Gemm g{HB2, (const bf16_t*)(wl + OFF_WOUT), M, D, D}; pg8::StaticOrder S; S.init(M, D, G, bx);
                    pg8::EpiResid<false> E{HB, SSQ + (size_t)(3 * l + 2) * M * 8, lds};
                    pg8::gemm_phase<pg8::EpiResid<false>, pg8::StaticOrder, true, true>(lds, g, S, E);
                }
                GRID_BAR();
            } else {
                if (l + 1 == DEPTH) rms_rows_bf16_to_f32(HB, INP(22), out, gw, NGW, lane);
            }
        }
    }
}

extern "C" void kernel_launch(void* const* d_in, const int* in_sizes, int n_in, void* d_out, int out_size, void* d_ws, size_t ws_size, hipStream_t stream) {
    static int grid = 0;
    if (grid == 0) {
        if (n_in != 23 || in_sizes[0] != M * D || out_size != M * D || ws_size < WS_END) {
            fprintf(stderr, "kernel_launch: unexpected shapes: n_in %d in0 %d out %d ws %zu (need %zu)\n", n_in, n_in > 0 ? in_sizes[0] : -1, out_size, ws_size, (size_t)WS_END); grid = -1; return; }
        int dev = 0, cus = 0, per_cu = 0;
        hipGetDevice(&dev); hipDeviceGetAttribute(&cus, hipDeviceAttributeMultiprocessorCount, dev);
        if (hipFuncSetAttribute((const void*)mk_fwd, hipFuncAttributeMaxDynamicSharedMemorySize, LDS_BYTES) != hipSuccess) fprintf(stderr, "kernel_launch: hipFuncSetAttribute failed\n");
        if (hipOccupancyMaxActiveBlocksPerMultiprocessor(&per_cu, (const void*)mk_fwd, NTHREADS, LDS_BYTES) != hipSuccess || per_cu < 1) { fprintf(stderr, "kernel_launch: occupancy query gave %d\n", per_cu); per_cu = 1; }
        (void)hipGetLastError();
        grid = cus * per_cu;
        if (grid > 256) grid = 256;
    }
    if (grid < 0) return;
    (void)hipMemsetAsync((char*)d_ws + WS_CTL, 0, CTL_BYTES, stream);
    Args a{};
    for (int i = 0; i < 23; ++i) a.in[i] = (const float*)d_in[i];
    a.out = (float*)d_out; a.ws = (unsigned char*)d_ws;
    void* kargs[] = {&a};
    hipError_t e = hipLaunchCooperativeKernel((const void*)mk_fwd, dim3(grid), dim3(NTHREADS), kargs, LDS_BYTES, stream);
    if (e != hipSuccess) fprintf(stderr, "kernel_launch: cooperative launch failed: %s (grid %d)\n", hipGetErrorString(e), grid);
}
```

```cpp
#include <hip/hip_runtime.h>
#include <hip/hip_cooperative_groups.h>
#include <cstdio>
#include <cstdint>
namespace cg = cooperative_groups;

#define LAS __attribute__((address_space(3)))
#define LAUNDER(v) asm volatile("" : "+v"(v))
typedef unsigned short bf16_t;
typedef short bf16x8 __attribute__((ext_vector_type(8)));
typedef float f32x4 __attribute__((ext_vector_type(4)));
typedef float f32x2 __attribute__((ext_vector_type(2)));
typedef unsigned u32x4 __attribute__((ext_vector_type(4)));
typedef unsigned u32x2 __attribute__((ext_vector_type(2)));

constexpr int NB = 16, SEQ = 2048, M = NB * SEQ, D = 2048, FF = 5632, DIN = 5120, DL = 1024, NH = 8, HD = 128, NREL = 257, DEPTH = 2;
constexpr int ZLD = 3072;
constexpr float EPS = 1e-6f;
constexpr float LOG2E = 1.4426950408889634f;

constexpr size_t MiB = 1u << 20;
constexpr size_t SZ_WGU = (size_t)2 * FF * D * 2, SZ_WD = (size_t)D * FF * 2, SZ_WIN = (size_t)DIN * D * 2, SZ_WOUT = (size_t)D * D * 2;
constexpr size_t OFF_WGU1 = 0, OFF_WD1 = OFF_WGU1 + SZ_WGU, OFF_WIN = OFF_WD1 + SZ_WD, OFF_WOUT = OFF_WIN + SZ_WIN, OFF_WGU2 = OFF_WOUT + SZ_WOUT, OFF_WD2 = OFF_WGU2 + SZ_WGU;
constexpr size_t LAYER_W = OFF_WD2 + SZ_WD;
static_assert(LAYER_W == 160 * MiB, "weights per layer");
constexpr size_t WS_BIG = 2 * LAYER_W;
constexpr size_t WS_VT = WS_BIG + (size_t)M * ZLD * 2;
constexpr size_t WS_KH = WS_VT + (size_t)M * 1024 * 2;
constexpr size_t WS_H = WS_BIG + 352 * MiB;
constexpr size_t WS_H2 = WS_H + 128 * MiB;
constexpr size_t WS_SSQ = WS_H2 + 128 * MiB;
constexpr size_t WS_YP = WS_SSQ + 8 * MiB;
constexpr size_t WS_CTL = WS_YP + 4 * MiB;
constexpr size_t CTL_BYTES = 16384;
constexpr size_t WS_END = WS_CTL + 1 * MiB;
static_assert((size_t)M * FF * 2 == 352 * MiB, "hidden size");

constexpr int NWAVES = 8, NTHREADS = 512;
constexpr int LDS_BYTES = 147456;

__device__ __forceinline__ unsigned cvt_pk_bf16(float lo, float hi) { unsigned r; asm volatile("v_cvt_pk_bf16_f32 %0, %1, %2" : "=v"(r) : "v"(lo), "v"(hi)); return r; }
__device__ __forceinline__ float bf_lo(unsigned u) { return __uint_as_float(u << 16); }
__device__ __forceinline__ float bf_hi(unsigned u) { return __uint_as_float(u & 0xffff0000u); }
__device__ __forceinline__ float fast_exp2(float x) { return __builtin_amdgcn_exp2f(x); }
__device__ __forceinline__ float fast_rcp(float x) { return __builtin_amdgcn_rcpf(x); }
__device__ __forceinline__ float sigmoidf_(float x) { return fast_rcp(1.0f + fast_exp2(-LOG2E * x)); }

namespace pg8 {
constexpr int BM = 256, BK = 64, HALF = 128, HTB = HALF * BK * 2, STAGE_BYTES = 8 * HTB, NXCD = 8, WGM = 8;
__host__ __device__ __forceinline__ int lds_byte(int r, int c) { const int st = (r >> 4) * 2 + (c >> 5), rr = r & 15, cc = c & 31, ob = rr * 64 + cc * 2; return st * 1024 + (ob ^ (((ob >> 9) & 1) << 5)); }
__host__ __device__ __forceinline__ void stage_rc(int b, int& R, int& C) { const int st = b / 1024, sb = b % 1024, swz = sb ^ (((sb >> 9) & 1) << 5); R = (st >> 1) * 16 + swz / 64; C = (st & 1) * 32 + (swz % 64) / 2; }
__host__ __device__ __forceinline__ int perm32(int rho) { const int n = rho >> 4, i = rho & 15; return 8 * (i >> 2) + 4 * n + (i & 3); }

struct Unit { int pm, pn; };
struct Gemm { const bf16_t* A; const bf16_t* Bt; int M, N, K; };

struct StaticOrder {
    int nM, nN, nwg, G, c;
    __host__ __device__ void init(int M_, int N_, int G_, int c_) { nM = M_ / BM; nN = N_ / BM; nwg = nM * nN; G = G_; c = c_; }
    __host__ __device__ bool next(int i, Unit& u) const {
        const long L = (long)i * G + c; if (L >= nwg) return false;
        int wgid = (int)L; { const int q = nwg / NXCD, r = nwg % NXCD, xcd = wgid % NXCD, off = wgid / NXCD; wgid = (xcd < r ? xcd * (q + 1) : r * (q + 1) + (xcd - r) * q) + off; }
        const int nig = WGM * nN, gid = wgid / nig, fm = gid * WGM, gsz = (nM - fm) < WGM ? (nM - fm) : WGM;
        u.pm = fm + ((wgid % nig) % gsz); u.pn = (wgid % nig) / gsz; return true;
    }
    __device__ __forceinline__ void a_ready(const Unit&) const {}
    __device__ __forceinline__ void done(const Unit&) const {}
};


constexpr int LDS_RS = 131072 + 1024, LDS_RSPM = 131072 + 2048 + 64, LDS_SSP = 131072 + 4096;
__device__ __forceinline__ void rs_panel(LAS unsigned char* lds, const float* ssq, int pm) {
    volatile LAS int* pmL = (volatile LAS int*)(lds + LDS_RSPM); LAS float* rsL = (LAS float*)(lds + LDS_RS);
    if (pmL[0] != pm) {
        asm volatile("s_waitcnt lgkmcnt(0)" ::: "memory"); __builtin_amdgcn_s_barrier();
        const int t = threadIdx.x;
        if (t < 256) { const f32x4* pp = (const f32x4*)(ssq + (size_t)(pm * 256 + t) * 8); const f32x4 pa = pp[0], pb = pp[1];
            rsL[t] = __builtin_amdgcn_rsqf((((pa.x + pa.y) + (pa.z + pa.w)) + ((pb.x + pb.y) + (pb.z + pb.w))) * (1.0f / D) + EPS); }
        if (t == 0) pmL[0] = pm;
        asm volatile("s_waitcnt vmcnt(0) lgkmcnt(0)" ::: "memory"); __builtin_amdgcn_s_barrier();
    }
}
struct EpiSwiGLU {
    static constexpr bool PERM = true, AFTER_DRAIN = false, MIDK = false;
    bf16_t* O; int ldc; const float* ssq; LAS unsigned char* lds;
    __device__ __forceinline__ void operator()(const f32x4 (&acc)[2][2][4][2], const Unit& u, int wr, int wc, int fr, int fq) const {
        rs_panel(lds, ssq, u.pm);
        const LAS float* rsL = (const LAS float*)(lds + LDS_RS) + wr * 64 + fr;
        const int row0 = u.pm * BM + wr * 64 + fr; const int col0 = u.pn * HALF + wc * 32 + 8 * fq;
#pragma unroll
        for (int ai = 0; ai < 2; ++ai)
#pragma unroll
            for (int m = 0; m < 4; ++m) {
                bf16_t* rowp = O + (size_t)(row0 + ai * HALF + m * 16) * ldc + col0;
                const float rs = rsL[ai * HALF + m * 16];
                float v[8];
#pragma unroll
                for (int n = 0; n < 2; ++n)
#pragma unroll
                    for (int i = 0; i < 4; ++i) { const float g = acc[ai][0][m][n][i] * rs, up = acc[ai][1][m][n][i] * rs; v[n * 4 + i] = g * sigmoidf_(g) * up; }
                u32x4 w; w.x = cvt_pk_bf16(v[0], v[1]); w.y = cvt_pk_bf16(v[2], v[3]); w.z = cvt_pk_bf16(v[4], v[5]); w.w = cvt_pk_bf16(v[6], v[7]);
                *(u32x4*)rowp = w;
            }
    }
};
template <bool HALFSC> struct EpiResid {
    static constexpr bool PERM = false, AFTER_DRAIN = false, MIDK = false;
    bf16_t* xb; float* ssq_part; LAS unsigned char* lds;
    __device__ __forceinline__ void operator()(const f32x4 (&acc)[2][2][4][2], const Unit& u, int wr, int wc, int fr, int fq) const {
        const float scale_ = HALFSC ? 0.5f : 1.0f; bf16_t* const xb_ = xb; float* const ssq_ = ssq_part;
        LAS float* pl = (LAS float*)(lds + LDS_SSP);
        const int col0 = u.pn * BM + wc * 32 + 4 * fq;
        const size_t base = (size_t)(u.pm * BM + wr * 64 + fr) * D + col0;
        u32x2 r[2][2][2][2];
#define ER_LOAD(buf, bb) do { _Pragma("unroll") for (int mm = 0; mm < 2; ++mm) _Pragma("unroll") for (int bj = 0; bj < 2; ++bj) _Pragma("unroll") for (int n = 0; n < 2; ++n) \
            r[buf][mm][bj][n] = *(const u32x2*)(xb_ + base + (size_t)(((bb) >> 1) * HALF + (((bb) & 1) * 2 + mm) * 16) * D + bj * HALF + n * 16); } while (0)
        ER_LOAD(0, 0);
#pragma unroll
        for (int bb = 0; bb < 4; ++bb) {
            if (bb < 3) ER_LOAD((bb + 1) & 1, bb + 1);
            const int ai = bb >> 1;
#pragma unroll
            for (int mm = 0; mm < 2; ++mm) { const int m = (bb & 1) * 2 + mm; const int rowl = ai * HALF + m * 16; const size_t off = base + (size_t)rowl * D; float ssum = 0.f;
#pragma unroll
                for (int bj = 0; bj < 2; ++bj)
#pragma unroll
                    for (int n = 0; n < 2; ++n) { const u32x2 rr = r[bb & 1][mm][bj][n]; const f32x4 a = acc[ai][bj][m][n];
                        const float o0 = bf_lo(rr.x) + a.x * scale_, o1 = bf_hi(rr.x) + a.y * scale_, o2 = bf_lo(rr.y) + a.z * scale_, o3 = bf_hi(rr.y) + a.w * scale_;
                        u32x2 w; w.x = cvt_pk_bf16(o0, o1); w.y = cvt_pk_bf16(o2, o3); *(u32x2*)(xb_ + off + bj * HALF + n * 16) = w;
                        ssum += (o0 * o0 + o1 * o1) + (o2 * o2 + o3 * o3); }
                ssum += __shfl_xor(ssum, 16); ssum += __shfl_xor(ssum, 32);
                if (fq == 0) pl[(rowl + wr * 64 + fr) * 4 + wc] = ssum;
            }
        }
#undef ER_LOAD
        asm volatile("s_waitcnt lgkmcnt(0)" ::: "memory"); __builtin_amdgcn_s_barrier();
        const int t = threadIdx.x;
        if (t < 256) { const f32x4 p = *(const LAS f32x4*)(pl + t * 4); ssq_[(size_t)(u.pm * BM + t) * 8 + u.pn] = (p.x + p.y) + (p.z + p.w); }
    }
};
constexpr int LDS_RS2 = 131072 + 8192, LDS_RS2PM = 131072 + 8192 + 2048 + 64;
__device__ __forceinline__ void rs2_panel(LAS unsigned char* lds, const float* yp, int pm) {
    volatile LAS int* pmL = (volatile LAS int*)(lds + LDS_RS2PM); LAS f32x2* rsL = (LAS f32x2*)(lds + LDS_RS2);
    if (pmL[0] != pm) {
        asm volatile("s_waitcnt lgkmcnt(0)" ::: "memory"); __builtin_amdgcn_s_barrier();
        const int t = threadIdx.x;
        if (t < 256) { const f32x4* pp = (const f32x4*)(yp + (size_t)(pm * 256 + t) * 24);
            const f32x4 a0 = pp[0], a1 = pp[1], a2 = pp[2], a3 = pp[3], b0 = pp[4], b1 = pp[5];
            const float sl = (((a0.x + a0.y) + (a0.z + a0.w)) + ((a1.x + a1.y) + (a1.z + a1.w))) + (((a2.x + a2.y) + (a2.z + a2.w)) + ((a3.x + a3.y) + (a3.z + a3.w)));
            const float sa = ((b0.x + b0.y) + (b0.z + b0.w)) + ((b1.x + b1.y) + (b1.z + b1.w));
            const float va = sa * (1.0f / 1024.f) + EPS, vl = sl * (1.0f / 1024.f) + EPS;
            rsL[t] = (f32x2){__builtin_amdgcn_rsqf(va), __builtin_amdgcn_rsqf(vl) * sqrtf(va)}; }
        if (t == 0) pmL[0] = pm;
        asm volatile("s_waitcnt vmcnt(0) lgkmcnt(0)" ::: "memory"); __builtin_amdgcn_s_barrier();
    }
}
struct EpiResidY {
    static constexpr bool PERM = false, AFTER_DRAIN = false, MIDK = true;
    bf16_t* xb; float* ssq_part; const float* yp; LAS unsigned char* lds;
    __device__ __forceinline__ void prep(const Unit& u) const { rs2_panel(lds, yp, u.pm); }
    __device__ __forceinline__ void mid(f32x4 (&acc)[2][2][4][2], const Unit& u, int wr, int wc, int fr, int fq) const {
        const LAS f32x2* rsL = (const LAS f32x2*)(lds + LDS_RS2) + wr * 64 + fr;
#pragma unroll
        for (int ai = 0; ai < 2; ++ai)
#pragma unroll
            for (int m = 0; m < 4; ++m) { const float q = rsL[ai * HALF + m * 16].y;
#pragma unroll
                for (int bj = 0; bj < 2; ++bj)
#pragma unroll
                    for (int n = 0; n < 2; ++n) acc[ai][bj][m][n] = acc[ai][bj][m][n] * q; }
    }
    __device__ __forceinline__ void operator()(const f32x4 (&acc)[2][2][4][2], const Unit& u, int wr, int wc, int fr, int fq) const {
        bf16_t* const xb_ = xb; float* const ssq_ = ssq_part;
        LAS float* pl = (LAS float*)(lds + LDS_SSP);
        const LAS f32x2* rsL = (const LAS f32x2*)(lds + LDS_RS2) + wr * 64 + fr;
        const int col0 = u.pn * BM + wc * 32 + 4 * fq;
        const size_t base = (size_t)(u.pm * BM + wr * 64 + fr) * D + col0;
        u32x2 r[2][2][2][2];
#define ER_LOAD(buf, bb) do { _Pragma("unroll") for (int mm = 0; mm < 2; ++mm) _Pragma("unroll") for (int bj = 0; bj < 2; ++bj) _Pragma("unroll") for (int n = 0; n < 2; ++n) \
            r[buf][mm][bj][n] = *(const u32x2*)(xb_ + base + (size_t)(((bb) >> 1) * HALF + (((bb) & 1) * 2 + mm) * 16) * D + bj * HALF + n * 16); } while (0)
        ER_LOAD(0, 0);
#pragma unroll
        for (int bb = 0; bb < 4; ++bb) {
            if (bb < 3) ER_LOAD((bb + 1) & 1, bb + 1);
            const int ai = bb >> 1;
#pragma unroll
            for (int mm = 0; mm < 2; ++mm) { const int m = (bb & 1) * 2 + mm; const int rowl = ai * HALF + m * 16; const size_t off = base + (size_t)rowl * D; float ssum = 0.f;
                const float scale_ = rsL[rowl].x;
#pragma unroll
                for (int bj = 0; bj < 2; ++bj)
#pragma unroll
                    for (int n = 0; n < 2; ++n) { const u32x2 rr = r[bb & 1][mm][bj][n]; const f32x4 a = acc[ai][bj][m][n];
                        const float o0 = bf_lo(rr.x) + a.x * scale_, o1 = bf_hi(rr.x) + a.y * scale_, o2 = bf_lo(rr.y) + a.z * scale_, o3 = bf_hi(rr.y) + a.w * scale_;
                        u32x2 w; w.x = cvt_pk_bf16(o0, o1); w.y = cvt_pk_bf16(o2, o3); *(u32x2*)(xb_ + off + bj * HALF + n * 16) = w;
                        ssum += (o0 * o0 + o1 * o1) + (o2 * o2 + o3 * o3); }
                ssum += __shfl_xor(ssum, 16); ssum += __shfl_xor(ssum, 32);
                if (fq == 0) pl[(rowl + wr * 64 + fr) * 4 + wc] = ssum;
            }
        }
#undef ER_LOAD
        asm volatile("s_waitcnt lgkmcnt(0)" ::: "memory"); __builtin_amdgcn_s_barrier();
        const int t = threadIdx.x;
        if (t < 256) { const f32x4 p = *(const LAS f32x4*)(pl + t * 4); ssq_[(size_t)(u.pm * BM + t) * 8 + u.pn] = (p.x + p.y) + (p.z + p.w); }
    }
};
struct EpiZ {
    static constexpr bool PERM = true, AFTER_DRAIN = false, MIDK = false;
    bf16_t* Z; bf16_t* Vt; bf16_t* Kh; const float* ssq; LAS unsigned char* lds;
    __device__ __forceinline__ void operator()(const f32x4 (&acc)[2][2][4][2], const Unit& u, int wr, int wc, int fr, int fq) const {
        rs_panel(lds, ssq, u.pm);
        float rs[2][4];
        { const LAS float* rsL = (const LAS float*)(lds + LDS_RS) + wr * 64 + fr;
#pragma unroll
          for (int ai = 0; ai < 2; ++ai)
#pragma unroll
            for (int m = 0; m < 4; ++m) rs[ai][m] = rsL[ai * HALF + m * 16]; }
        if (u.pn >= 12 && u.pn < 16) {
            const int b = (u.pm * BM) / SEQ; const int s0 = (u.pm * BM) % SEQ + wr * 64 + fr;
#pragma unroll
            for (int bj = 0; bj < 2; ++bj) {
                const int head = (u.pn - 12) * 2 + bj;
                bf16_t* hb = Kh + ((size_t)(b * NH + head) * SEQ + s0) * HD + wc * 32 + 8 * fq;
#pragma unroll
                for (int ai = 0; ai < 2; ++ai)
#pragma unroll
                    for (int m = 0; m < 4; ++m) { const f32x4 v0 = acc[ai][bj][m][0] * rs[ai][m], v1 = acc[ai][bj][m][1] * rs[ai][m];
                        u32x4 w; w.x = cvt_pk_bf16(v0[0], v0[1]); w.y = cvt_pk_bf16(v0[2], v0[3]); w.z = cvt_pk_bf16(v1[0], v1[1]); w.w = cvt_pk_bf16(v1[2], v1[3]);
                        *(u32x4*)(hb + (size_t)(ai * HALF + m * 16) * HD) = w; }
            }
        } else if (u.pn < 12) {
            const int row0 = u.pm * BM + wr * 64 + fr; const int col0 = u.pn * BM + wc * 32 + 8 * fq;
#pragma unroll
            for (int ai = 0; ai < 2; ++ai)
#pragma unroll
                for (int m = 0; m < 4; ++m) {
                    bf16_t* rowp = Z + (size_t)(row0 + ai * HALF + m * 16) * ZLD + col0;
#pragma unroll
                    for (int bj = 0; bj < 2; ++bj) { const f32x4 v0 = acc[ai][bj][m][0] * rs[ai][m], v1 = acc[ai][bj][m][1] * rs[ai][m];
                        u32x4 w; w.x = cvt_pk_bf16(v0[0], v0[1]); w.y = cvt_pk_bf16(v0[2], v0[3]); w.z = cvt_pk_bf16(v1[0], v1[1]); w.w = cvt_pk_bf16(v1[2], v1[3]);
                        *(u32x4*)(rowp + bj * HALF) = w; }
                }
        } else {
            const int b = (u.pm * BM) / SEQ; const int s0 = (u.pm * BM) % SEQ + wr * 64 + fr;
#pragma unroll
            for (int bj = 0; bj < 2; ++bj) {
                const int head = (u.pn - 16) * 2 + bj;
                bf16_t* hb = Vt + ((size_t)(b * NH + head) * HD + wc * 32 + 8 * fq) * SEQ + s0;
#pragma unroll
                for (int ai = 0; ai < 2; ++ai)
#pragma unroll
                    for (int m = 0; m < 4; ++m)
#pragma unroll
                        for (int n = 0; n < 2; ++n)
#pragma unroll
                            for (int i = 0; i < 4; ++i) {
                                const unsigned w = cvt_pk_bf16(acc[ai][bj][m][n][i] * rs[ai][m], 0.f);
                                hb[(size_t)(4 * n + i) * SEQ + ai * HALF + m * 16] = (bf16_t)(w & 0xffffu);
                            }
            }
        }
    }
};

template <class Epi, class Sched, bool ALIGN_EPI = false, bool SP2 = false>
__device__ __forceinline__ void gemm_phase(LAS unsigned char* lds, const Gemm g, const Sched& S, const Epi& E) {
    int tid_l = threadIdx.x; LAUNDER(tid_l);
    const int tid = tid_l, wid = __builtin_amdgcn_readfirstlane(tid >> 6), lane = tid & 63, wr = wid >> 2, wc = wid & 3, fr = lane & 15, fq = lane >> 4;
    const int K = g.K, nt = K / BK;
    unsigned voffA[2], voffB[2];
#pragma unroll
    for (int i = 0; i < 2; ++i) { int R, C; stage_rc(tid * 16 + i * 8192, R, C); const int Rb = Epi::PERM ? ((R & ~31) + perm32(R & 31)) : R;
        voffA[i] = (unsigned)(R * K + C) * 2u; voffB[i] = (unsigned)(Rb * K + C) * 2u; }
    const size_t kstep = (size_t)(BK * 2);
    const size_t hstep = (size_t)HALF * K * 2;
    const size_t tstep = 2 * hstep;
    const unsigned ldsw = (unsigned)wid * 1024u;
    const int aoff = lds_byte(wr * 64 + fr, fq * 8), boff = lds_byte(wc * 32 + fr, fq * 8);
#define PG8_SA(b, h) (((b) * 2 + (h)) * HTB)
#define PG8_SB(b, h) ((4 + (b) * 2 + (h)) * HTB)
#define PG8_STAGE(bufoff, gbase, voff) do { _Pragma("unroll") for (int _i = 0; _i < 2; ++_i) \
        __builtin_amdgcn_global_load_lds((const unsigned*)((const char*)(gbase) + (voff)[_i]), (LAS unsigned*)(lds + (bufoff) + ldsw + _i * 8192), 16, 0, 0); } while (0)
#define PG8_LDA(dst, b, h) do { _Pragma("unroll") for (int m = 0; m < 4; ++m) _Pragma("unroll") for (int k = 0; k < 2; ++k) dst[m][k] = *(const LAS bf16x8*)(lds + PG8_SA(b, h) + aoff + m * 2048 + k * 1024); } while (0)
#define PG8_LDB(dst, b, h) do { _Pragma("unroll") for (int n = 0; n < 2; ++n) _Pragma("unroll") for (int k = 0; k < 2; ++k) dst[n][k] = *(const LAS bf16x8*)(lds + PG8_SB(b, h) + boff + n * 2048 + k * 1024); } while (0)
#define PG8_MMA(ai, bj, At, Bt) do { __builtin_amdgcn_s_setprio(1); _Pragma("unroll") for (int m = 0; m < 4; ++m) _Pragma("unroll") for (int n = 0; n < 2; ++n) _Pragma("unroll") for (int k = 0; k < 2; ++k) \
        acc[ai][bj][m][n] = __builtin_amdgcn_mfma_f32_16x16x32_bf16(Bt[n][k], At[m][k], acc[ai][bj][m][n], 0, 0, 0); __builtin_amdgcn_s_setprio(0); } while (0)
#define PG8_WAIT_V(n) asm volatile("s_waitcnt vmcnt(" #n ")" ::: "memory")
#define PG8_WAIT_L(n) asm volatile("s_waitcnt lgkmcnt(" #n ")" ::: "memory")
#define PG8_BAR __builtin_amdgcn_s_barrier()
#define PG8_SCHED __builtin_amdgcn_sched_barrier(0)
    Unit cur, nxt; int ui = 0;
    if (!S.next(0, cur)) return;
    f32x4 acc[2][2][4][2];
#pragma unroll
    for (int a = 0; a < 2; ++a)
#pragma unroll
        for (int b = 0; b < 2; ++b)
#pragma unroll
            for (int m = 0; m < 4; ++m)
#pragma unroll
                for (int n = 0; n < 2; ++n) acc[a][b][m][n] = (f32x4){0.f, 0.f, 0.f, 0.f};
    bf16x8 At[4][2], B0[2][2], B1[2][2];
    const char* cA = (const char*)g.A + (size_t)cur.pm * tstep; const char* cB = (const char*)g.Bt + (size_t)cur.pn * tstep;
    S.a_ready(cur);
    if constexpr (SP2) {
        PG8_STAGE(PG8_SB(0, 0), cB, voffB); PG8_STAGE(PG8_SB(0, 1), cB + hstep, voffB); PG8_STAGE(PG8_SA(0, 0), cA, voffA); PG8_STAGE(PG8_SA(0, 1), cA + hstep, voffA);
        if (wr == 1) PG8_BAR;
        PG8_WAIT_V(2); PG8_BAR;
        PG8_STAGE(PG8_SB(1, 0), cB + kstep, voffB); PG8_STAGE(PG8_SA(1, 0), cA + kstep, voffA); PG8_STAGE(PG8_SB(1, 1), cB + hstep + kstep, voffB);
        PG8_WAIT_V(6); PG8_BAR;
    } else {
        PG8_STAGE(PG8_SB(0, 0), cB, voffB); PG8_STAGE(PG8_SA(0, 0), cA, voffA); PG8_STAGE(PG8_SB(0, 1), cB + hstep, voffB); PG8_STAGE(PG8_SA(0, 1), cA + hstep, voffA);
        if (wr == 1) PG8_BAR;
        PG8_WAIT_V(4); PG8_BAR;
        PG8_STAGE(PG8_SB(1, 0), cB + kstep, voffB); PG8_STAGE(PG8_SA(1, 0), cA + kstep, voffA); PG8_STAGE(PG8_SB(1, 1), cB + hstep + kstep, voffB);
        PG8_WAIT_V(6); PG8_BAR;
    }
    for (;;) {
        const bool has_next = S.next(ui + 1, nxt);
        const char* nA = has_next ? (const char*)g.A + (size_t)nxt.pm * tstep : cA; const char* nB = has_next ? (const char*)g.Bt + (size_t)nxt.pn * tstep : cB;
        for (int t = 0; t < nt; t += 2) {
            if constexpr (Epi::MIDK) { if (t == (nt >> 1)) E.mid(acc, cur, wr, wc, fr, fq); }
            const bool last = (t == nt - 2);
            const char* a1 = cA + (size_t)(t + 1) * kstep;
            const char* a2 = last ? nA : cA + (size_t)(t + 2) * kstep; const char* b2 = last ? nB : cB + (size_t)(t + 2) * kstep;
            const char* a3 = a2 + kstep; const char* b3 = b2 + kstep;
            if (last && has_next) S.a_ready(nxt);
            if constexpr (SP2) {
            PG8_LDB(B0, 0, 0); PG8_LDB(B1, 0, 1); PG8_SCHED; PG8_LDA(At, 0, 0); PG8_STAGE(PG8_SA(1, 1), a1 + hstep, voffA);
            PG8_WAIT_V(8); PG8_WAIT_L(0); PG8_BAR; PG8_MMA(0, 0, At, B0); PG8_MMA(0, 1, At, B1); PG8_BAR; PG8_SCHED;
            PG8_LDA(At, 0, 1); PG8_STAGE(PG8_SB(0, 0), b2, voffB); PG8_STAGE(PG8_SB(0, 1), b2 + hstep, voffB); PG8_STAGE(PG8_SA(0, 0), a2, voffA);
            PG8_WAIT_V(8); PG8_WAIT_L(0); PG8_BAR; PG8_MMA(1, 0, At, B0); PG8_MMA(1, 1, At, B1); PG8_BAR; PG8_SCHED;
            PG8_LDB(B0, 1, 0); PG8_LDB(B1, 1, 1); PG8_SCHED; PG8_LDA(At, 1, 0); PG8_STAGE(PG8_SA(0, 1), a2 + hstep, voffA);
            PG8_WAIT_V(8); PG8_WAIT_L(0); PG8_BAR; PG8_MMA(0, 0, At, B0); PG8_MMA(0, 1, At, B1); PG8_BAR; PG8_SCHED;
            PG8_LDA(At, 1, 1); PG8_STAGE(PG8_SB(1, 0), b3, voffB); PG8_STAGE(PG8_SB(1, 1), b3 + hstep, voffB); PG8_STAGE(PG8_SA(1, 0), a3, voffA);
            PG8_WAIT_V(8); PG8_WAIT_L(0); PG8_BAR; PG8_MMA(1, 0, At, B0); PG8_MMA(1, 1, At, B1); PG8_BAR; PG8_SCHED;
            } else {
            PG8_LDB(B0, 0, 0); PG8_SCHED; PG8_LDA(At, 0, 0); PG8_STAGE(PG8_SA(1, 1), a1 + hstep, voffA);
            PG8_WAIT_L(8); PG8_BAR; PG8_WAIT_L(0); PG8_MMA(0, 0, At, B0); PG8_BAR; PG8_SCHED;
            PG8_LDB(B1, 0, 1); PG8_STAGE(PG8_SB(0, 0), b2, voffB);
            PG8_BAR; PG8_WAIT_L(0); PG8_MMA(0, 1, At, B1); PG8_BAR;
            PG8_LDA(At, 0, 1); PG8_STAGE(PG8_SA(0, 0), a2, voffA);
            PG8_BAR; PG8_WAIT_L(0); PG8_MMA(1, 0, At, B0); PG8_BAR; PG8_SCHED;
            PG8_STAGE(PG8_SB(0, 1), b2 + hstep, voffB);
            PG8_WAIT_V(6); PG8_BAR; PG8_MMA(1, 1, At, B1); PG8_BAR;
            PG8_LDB(B0, 1, 0); PG8_SCHED; PG8_LDA(At, 1, 0); PG8_STAGE(PG8_SA(0, 1), a2 + hstep, voffA);
            PG8_WAIT_L(8); PG8_BAR; PG8_WAIT_L(0); PG8_MMA(0, 0, At, B0); PG8_BAR; PG8_SCHED;
            PG8_LDB(B1, 1, 1); PG8_STAGE(PG8_SB(1, 0), b3, voffB);
            PG8_BAR; PG8_WAIT_L(0); PG8_MMA(0, 1, At, B1); PG8_BAR;
            PG8_LDA(At, 1, 1); PG8_STAGE(PG8_SA(1, 0), a3, voffA);
            PG8_BAR; PG8_WAIT_L(0); PG8_MMA(1, 0, At, B0); PG8_BAR; PG8_SCHED;
            PG8_STAGE(PG8_SB(1, 1), b3 + hstep, voffB);
            PG8_WAIT_V(6); PG8_BAR; PG8_MMA(1, 1, At, B1); PG8_BAR;
            }
        }
        if constexpr (ALIGN_EPI) { if (wr == 0) PG8_BAR; }
        if constexpr (!Epi::AFTER_DRAIN) { E(acc, cur, wr, wc, fr, fq); S.done(cur); }
        if constexpr (Epi::MIDK) { if (has_next) E.prep(nxt); }
        if (!has_next) break;
#pragma unroll
        for (int a = 0; a < 2; ++a)
#pragma unroll
            for (int b = 0; b < 2; ++b)
#pragma unroll
                for (int m = 0; m < 4; ++m)
#pragma unroll
                    for (int n = 0; n < 2; ++n) acc[a][b][m][n] = (f32x4){0.f, 0.f, 0.f, 0.f};
        cur = nxt; cA = nA; cB = nB; ++ui;
        if constexpr (ALIGN_EPI) { if (wr == 1) PG8_BAR; }
    }
    PG8_WAIT_V(0);
    if constexpr (!ALIGN_EPI) { if (wr == 0) PG8_BAR; }
    PG8_BAR;
#undef PG8_SA
#undef PG8_SB
#undef PG8_STAGE
#undef PG8_LDA
#undef PG8_LDB
#undef PG8_MMA
#undef PG8_WAIT_V
#undef PG8_WAIT_L
#undef PG8_BAR
#undef PG8_SCHED
}
}

#define LDS_WAIT() asm volatile("s_waitcnt lgkmcnt(0)" ::: "memory")

__device__ __forceinline__ float wave_sum(float v) {
#pragma unroll
    for (int o = 1; o < 64; o <<= 1) v += __shfl_xor(v, o);
    return v;
}

__device__ __forceinline__ void p0_transpose_item(const float* W, const float* gain, int K, int N, bf16_t* WT, int ilv, LAS float* scr, int item, int lane, const float* gain2 = nullptr) {
    const int nblk = N / 32, kb = item / nblk, nb = item % nblk, k0 = 64 * kb, n0 = 32 * nb;
#pragma unroll 8
    for (int i = 0; i < 32; ++i) { const int kk = 2 * i + (lane >> 5); scr[kk * 33 + (lane & 31)] = W[(size_t)(k0 + kk) * N + n0 + (lane & 31)]; }
    LDS_WAIT(); asm volatile("" ::: "memory");
    const int c = lane & 7;
    f32x4 g0 = (f32x4){1.f, 1.f, 1.f, 1.f}, g1 = g0;
    if (gain) { const float* gp = (gain2 && k0 >= 1024) ? gain2 + (k0 - 1024) : gain + k0; g0 = *(const f32x4*)(gp + 8 * c); g1 = *(const f32x4*)(gp + 8 * c + 4); }
#pragma unroll
    for (int j = 0; j < 4; ++j) { const int n = (lane >> 3) + 8 * j; const LAS float* s = scr + (8 * c) * 33 + n;
        u32x4 o; o.x = cvt_pk_bf16(s[0 * 33] * g0.x, s[1 * 33] * g0.y); o.y = cvt_pk_bf16(s[2 * 33] * g0.z, s[3 * 33] * g0.w); o.z = cvt_pk_bf16(s[4 * 33] * g1.x, s[5 * 33] * g1.y); o.w = cvt_pk_bf16(s[6 * 33] * g1.z, s[7 * 33] * g1.w);
        const int nn = n0 + n; const int row = ilv < 0 ? nn : ((nn >> 7) * 256 + (nn & 127) + ilv);
        *(u32x4*)(WT + (size_t)row * K + k0 + 8 * c) = o; }
    LDS_WAIT(); asm volatile("" ::: "memory");
}

__device__ __forceinline__ void rms_rows_bf16(const float* x, const float* g, bf16_t* out, int gw, int NGW, int lane) {
    LAUNDER(lane);
    f32x4 gv[8];
#pragma unroll
    for (int j = 0; j < 8; ++j) gv[j] = *(const f32x4*)(g + 4 * lane + 256 * j);
    for (int m = gw; m < M; m += NGW) {
        const f32x4* xr = (const f32x4*)(x + (size_t)m * D) + lane; f32x4 v[8]; float s = 0.f;
#pragma unroll
        for (int j = 0; j < 8; ++j) { v[j] = xr[64 * j]; s += (v[j].x * v[j].x + v[j].y * v[j].y) + (v[j].z * v[j].z + v[j].w * v[j].w); }
        const float rstd = 1.0f / sqrtf(wave_sum(s) * (1.0f / D) + EPS);
        u32x2* o8 = (u32x2*)(out + (size_t)m * D) + lane;
#pragma unroll
        for (int j = 0; j < 8; ++j) { const f32x4 o = v[j] * rstd * gv[j]; u32x2 w; w.x = cvt_pk_bf16(o.x, o.y); w.y = cvt_pk_bf16(o.z, o.w); o8[64 * j] = w; }
    }
}
__device__ __forceinline__ void cast_rows_bf16(const float* x, bf16_t* out, float* ssq, int gw, int NGW, int lane) {
    LAUNDER(lane);
    for (int m = gw; m < M; m += NGW) {
        const f32x4* xr = (const f32x4*)(x + (size_t)m * D) + lane; f32x4 v[8]; float s = 0.f;
#pragma unroll
        for (int j = 0; j < 8; ++j) { v[j] = xr[64 * j]; s += (v[j].x * v[j].x + v[j].y * v[j].y) + (v[j].z * v[j].z + v[j].w * v[j].w); }
        s = wave_sum(s);
        if (lane == 0) { f32x4* pp = (f32x4*)(ssq + (size_t)m * 8); pp[0] = (f32x4){s, 0.f, 0.f, 0.f}; pp[1] = (f32x4){0.f, 0.f, 0.f, 0.f}; }
        u32x2* o8 = (u32x2*)(out + (size_t)m * D) + lane;
#pragma unroll
        for (int j = 0; j < 8; ++j) { u32x2 w; w.x = cvt_pk_bf16(v[j].x, v[j].y); w.y = cvt_pk_bf16(v[j].z, v[j].w); o8[64 * j] = w; }
    }
}
__device__ __forceinline__ void rms_rows_f32_inplace(float* x, const float* g, int gw, int NGW, int lane) {
    LAUNDER(lane);
    f32x4 gv[8];
#pragma unroll
    for (int j = 0; j < 8; ++j) gv[j] = *(const f32x4*)(g + 4 * lane + 256 * j);
    for (int m = gw; m < M; m += NGW) {
        f32x4* xr = (f32x4*)(x + (size_t)m * D) + lane; f32x4 v[8]; float s = 0.f;
#pragma unroll
        for (int j = 0; j < 8; ++j) { v[j] = xr[64 * j]; s += (v[j].x * v[j].x + v[j].y * v[j].y) + (v[j].z * v[j].z + v[j].w * v[j].w); }
        const float rstd = 1.0f / sqrtf(wave_sum(s) * (1.0f / D) + EPS);
#pragma unroll
        for (int j = 0; j < 8; ++j) xr[64 * j] = v[j] * rstd * gv[j];
    }
}
__device__ __forceinline__ void rms_rows_bf16_to_f32(const bf16_t* x, const float* g, float* out, int gw, int NGW, int lane) {
    LAUNDER(lane);
    f32x4 gv[4][2];
#pragma unroll
    for (int j = 0; j < 4; ++j) { const float* gp = g + 512 * j + 8 * lane; gv[j][0] = *(const f32x4*)gp; gv[j][1] = *(const f32x4*)(gp + 4); }
    for (int m = gw; m < M; m += NGW) {
        const u32x4* xr = (const u32x4*)(x + (size_t)m * D) + lane; u32x4 raw[4]; float s = 0.f;
#pragma unroll
        for (int j = 0; j < 4; ++j) raw[j] = xr[64 * j];
        float v[4][8];
#pragma unroll
        for (int j = 0; j < 4; ++j) {
            v[j][0] = bf_lo(raw[j].x); v[j][1] = bf_hi(raw[j].x); v[j][2] = bf_lo(raw[j].y); v[j][3] = bf_hi(raw[j].y);
            v[j][4] = bf_lo(raw[j].z); v[j][5] = bf_hi(raw[j].z); v[j][6] = bf_lo(raw[j].w); v[j][7] = bf_hi(raw[j].w);
#pragma unroll
            for (int e = 0; e < 8; ++e) s += v[j][e] * v[j][e];
        }
        const float rstd = 1.0f / sqrtf(wave_sum(s) * (1.0f / D) + EPS);
        f32x4* orow = (f32x4*)(out + (size_t)m * D + 8 * lane);
#pragma unroll
        for (int j = 0; j < 4; ++j) {
            orow[128 * j] = (f32x4){v[j][0] * rstd * gv[j][0].x, v[j][1] * rstd * gv[j][0].y, v[j][2] * rstd * gv[j][0].z, v[j][3] * rstd * gv[j][0].w};
            orow[128 * j + 1] = (f32x4){v[j][4] * rstd * gv[j][1].x, v[j][5] * rstd * gv[j][1].y, v[j][6] * rstd * gv[j][1].z, v[j][7] * rstd * gv[j][1].w};
        }
    }
}
__device__ __forceinline__ void ynorm_rows(bf16_t* y, const float* g_lru, const float* g_att, int gw, int NGW, int lane) {
    LAUNDER(lane);
    f32x4 gv[4][2];
#pragma unroll
    for (int j = 0; j < 4; ++j) { const float* gp = (j < 2 ? g_lru + 512 * j : g_att + 512 * (j - 2)) + 8 * lane; gv[j][0] = *(const f32x4*)gp; gv[j][1] = *(const f32x4*)(gp + 4); }
    for (int m = gw; m < M; m += NGW) {
        u32x4* yr = (u32x4*)(y + (size_t)m * D) + lane; u32x4 raw[4]; float s0 = 0.f, s1 = 0.f;
#pragma unroll
        for (int j = 0; j < 4; ++j) raw[j] = yr[64 * j];
        float v[4][8];
#pragma unroll
        for (int j = 0; j < 4; ++j) {
            v[j][0] = bf_lo(raw[j].x); v[j][1] = bf_hi(raw[j].x); v[j][2] = bf_lo(raw[j].y); v[j][3] = bf_hi(raw[j].y);
            v[j][4] = bf_lo(raw[j].z); v[j][5] = bf_hi(raw[j].z); v[j][6] = bf_lo(raw[j].w); v[j][7] = bf_hi(raw[j].w);
            float s = 0.f;
#pragma unroll
            for (int e = 0; e < 8; ++e) s += v[j][e] * v[j][e];
            if (j < 2) s0 += s; else s1 += s;
        }
        const float r0 = 1.0f / sqrtf(wave_sum(s0) * (1.0f / 1024.f) + EPS), r1 = 1.0f / sqrtf(wave_sum(s1) * (1.0f / 1024.f) + EPS);
#pragma unroll
        for (int j = 0; j < 4; ++j) { const float r = j < 2 ? r0 : r1; u32x4 w;
            w.x = cvt_pk_bf16(v[j][0] * r * gv[j][0].x, v[j][1] * r * gv[j][0].y); w.y = cvt_pk_bf16(v[j][2] * r * gv[j][0].z, v[j][3] * r * gv[j][0].w);
            w.z = cvt_pk_bf16(v[j][4] * r * gv[j][1].x, v[j][5] * r * gv[j][1].y); w.w = cvt_pk_bf16(v[j][6] * r * gv[j][1].z, v[j][7] * r * gv[j][1].w);
            yr[64 * j] = w; }
    }
}

constexpr int LM_BIAS = 0;
constexpr int LM_CW = 8448;
constexpr int LM_CB = 9472;
constexpr int LM_P = 10240;
constexpr int LM_H = 18432;
__device__ __forceinline__ void lru_unit(LAS unsigned char* lds, const bf16_t* zm, bf16_t* yraw, float* yp, const float* conv_w, const float* conv_b, const float* wa, const float* ba,
                                         const float* wx, const float* bx, const float* lam, int b, int hb, int tid) {
    LAUNDER(tid);
    const int lane = tid & 63, w = tid >> 6, fr = lane & 15, fq = lane >> 4;
    LAS float* cwL = (LAS float*)(lds + LM_CW); LAS float* cbL = (LAS float*)(lds + LM_CB); LAS float* PL = (LAS float*)(lds + LM_P); LAS float* HL = (LAS float*)(lds + LM_H);
    if (tid < 256) cwL[tid] = conv_w[(tid >> 6) * DL + hb * 64 + (tid & 63)];
    else if (tid < 320) cbL[tid - 256] = conv_b[hb * 64 + tid - 256];
    bf16x8 WA[4][2], WX[4][2];
#pragma unroll
    for (int nt = 0; nt < 4; ++nt)
#pragma unroll
        for (int ks = 0; ks < 2; ++ks) {
            const float* pa = wa + ((size_t)hb * 64 + ks * 32 + 8 * fq) * 64 + nt * 16 + fr; const float* px = wx + ((size_t)hb * 64 + ks * 32 + 8 * fq) * 64 + nt * 16 + fr;
            u32x4 ua, ux;
            ua.x = cvt_pk_bf16(pa[0 * 64], pa[1 * 64]); ua.y = cvt_pk_bf16(pa[2 * 64], pa[3 * 64]); ua.z = cvt_pk_bf16(pa[4 * 64], pa[5 * 64]); ua.w = cvt_pk_bf16(pa[6 * 64], pa[7 * 64]);
            ux.x = cvt_pk_bf16(px[0 * 64], px[1 * 64]); ux.y = cvt_pk_bf16(px[2 * 64], px[3 * 64]); ux.z = cvt_pk_bf16(px[4 * 64], px[5 * 64]); ux.w = cvt_pk_bf16(px[6 * 64], px[7 * 64]);
            WA[nt][ks] = __builtin_bit_cast(bf16x8, ua); WX[nt][ks] = __builtin_bit_cast(bf16x8, ux);
        }
    bf16x8 ID[2];
#pragma unroll
    for (int p = 0; p < 2; ++p)
#pragma unroll
        for (int e = 0; e < 8; ++e) ID[p][e] = (8 * fq + e == 16 * p + fr) ? (short)0x3F80 : (short)0;
    float pba[4], pbx[4], pcl[4];
#pragma unroll
    for (int nt = 0; nt < 4; ++nt) { const int c = hb * 64 + nt * 16 + fr; pba[nt] = ba[c]; pbx[nt] = bx[c]; pcl[nt] = -8.0f * log1pf(expf(-lam[c])); }
    __syncthreads();
    float hst[4], pst[4];
    const bf16_t* zb = zm + (size_t)b * SEQ * ZLD + hb * 64;
    const int tbaseA = 256 * w + (fr >> 2) * 64 + (fr & 3);
    const int tbaseD = 256 * w + fq * 64;
#pragma unroll 1
    for (int pass = 0; pass < 2; ++pass) {
        if (pass == 0) {
#pragma unroll
            for (int nt = 0; nt < 4; ++nt) { hst[nt] = 0.f; pst[nt] = 1.f; }
        }
        u32x4 XR[2][4], GR[2];
        {
            const int tA = tbaseA;
#pragma unroll
            for (int ks = 0; ks < 2; ++ks) {
                const int ch0 = ks * 32 + 8 * fq;
#pragma unroll
                for (int tap = 0; tap < 4; ++tap) { const int t = tA - 3 + tap; const int tt = t >= 0 ? t : 0; XR[ks][tap] = *(const u32x4*)(zb + (size_t)tt * ZLD + ch0); }
                GR[ks] = *(const u32x4*)(zb + (size_t)tA * ZLD + 1024 + ch0);
            }
        }
#pragma unroll 1
        for (int i = 0; i < 16; ++i) {
            const int tA = tbaseA + i * 4;
            const int tN = tbaseA + (i < 15 ? i + 1 : i) * 4;
            u32x4 XN[2][4], GN[2];
#pragma unroll
            for (int ks = 0; ks < 2; ++ks) {
                const int ch0 = ks * 32 + 8 * fq;
#pragma unroll
                for (int tap = 0; tap < 4; ++tap) { const int t = tN - 3 + tap; const int tt = t >= 0 ? t : 0; XN[ks][tap] = *(const u32x4*)(zb + (size_t)tt * ZLD + ch0); }
                GN[ks] = *(const u32x4*)(zb + (size_t)tN * ZLD + 1024 + ch0);
            }
            bf16x8 XC[2], GL[2];
#pragma unroll
            for (int ks = 0; ks < 2; ++ks) {
                const int ch0 = ks * 32 + 8 * fq;
                const f32x4 c0 = *(const LAS f32x4*)(cbL + ch0), c1 = *(const LAS f32x4*)(cbL + ch0 + 4);
                float a8[8] = {c0.x, c0.y, c0.z, c0.w, c1.x, c1.y, c1.z, c1.w};
#pragma unroll
                for (int tap = 0; tap < 4; ++tap) {
                    const bool ok = (tA - 3 + tap) >= 0;
                    u32x4 xr = XR[ks][tap];
                    if (!ok) xr = (u32x4){0u, 0u, 0u, 0u};
                    const f32x4 w0 = *(const LAS f32x4*)(cwL + tap * 64 + ch0), w1 = *(const LAS f32x4*)(cwL + tap * 64 + ch0 + 4);
                    a8[0] += w0.x * bf_lo(xr.x); a8[1] += w0.y * bf_hi(xr.x); a8[2] += w0.z * bf_lo(xr.y); a8[3] += w0.w * bf_hi(xr.y);
                    a8[4] += w1.x * bf_lo(xr.z); a8[5] += w1.y * bf_hi(xr.z); a8[6] += w1.z * bf_lo(xr.w); a8[7] += w1.w * bf_hi(xr.w);
                }
                u32x4 pk; pk.x = cvt_pk_bf16(a8[0], a8[1]); pk.y = cvt_pk_bf16(a8[2], a8[3]); pk.z = cvt_pk_bf16(a8[4], a8[5]); pk.w = cvt_pk_bf16(a8[6], a8[7]);
                XC[ks] = __builtin_bit_cast(bf16x8, pk);
                GL[ks] = __builtin_bit_cast(bf16x8, GR[ks]);
            }
            float psq[4] = {0.f, 0.f, 0.f, 0.f};
#pragma unroll
            for (int nt = 0; nt < 4; ++nt) {
                f32x4 ga = (f32x4){0.f, 0.f, 0.f, 0.f}, gx = ga, xo = ga, go = ga;
#pragma unroll
                for (int ks = 0; ks < 2; ++ks) { ga = __builtin_amdgcn_mfma_f32_16x16x32_bf16(XC[ks], WA[nt][ks], ga, 0, 0, 0); gx = __builtin_amdgcn_mfma_f32_16x16x32_bf16(XC[ks], WX[nt][ks], gx, 0, 0, 0); }
                xo = __builtin_amdgcn_mfma_f32_16x16x32_bf16(XC[nt >> 1], ID[nt & 1], xo, 0, 0, 0);
                if (pass) go = __builtin_amdgcn_mfma_f32_16x16x32_bf16(GL[nt >> 1], ID[nt & 1], go, 0, 0, 0);
#pragma unroll
                for (int j = 0; j < 4; ++j) {
                    const float r = sigmoidf_(ga[j] + pba[nt]), ig = sigmoidf_(gx[j] + pbx[nt]);
                    const float la = pcl[nt] * r;
                    const float a = fast_exp2(la * LOG2E);
                    const float x2 = 2.0f * la;
                    float ome = -x2 * (1.0f + x2 * 0.5f * (1.0f + x2 * (1.0f / 3.0f)));
                    if (x2 < -0.03f) ome = 1.0f - a * a;
                    const float u = sqrtf(ome) * ig * xo[j];
                    hst[nt] = a * hst[nt] + u;
                    if (pass == 0) pst[nt] *= a;
                    else {
                        const float gv = go[j];
                        const float gel = gv * sigmoidf_(1.5957691216057308f * (gv + 0.044715f * gv * gv * gv));
                        const float ov = hst[nt] * gel; psq[j] += ov * ov;
                        const unsigned o = cvt_pk_bf16(ov, 0.f);
                        yraw[(size_t)(b * SEQ + tbaseD + i * 4 + j) * D + hb * 64 + nt * 16 + fr] = (bf16_t)(o & 0xffffu);
                    }
                }
            }
            if (pass) {
#pragma unroll
                for (int j = 0; j < 4; ++j) { float q = psq[j]; q += __shfl_xor(q, 1); q += __shfl_xor(q, 2); q += __shfl_xor(q, 4); q += __shfl_xor(q, 8);
                    if (fr == 0) yp[(size_t)(b * SEQ + tbaseD + i * 4 + j) * 24 + hb] = q; }
            }
#pragma unroll
            for (int ks = 0; ks < 2; ++ks) {
#pragma unroll
                for (int tap = 0; tap < 4; ++tap) XR[ks][tap] = XN[ks][tap];
                GR[ks] = GN[ks];
            }
        }
        if (pass == 0) {
            const int seg = 4 * w + fq;
#pragma unroll
            for (int nt = 0; nt < 4; ++nt) { PL[seg * 64 + nt * 16 + fr] = pst[nt]; HL[seg * 64 + nt * 16 + fr] = hst[nt]; }
            __syncthreads();
#pragma unroll
            for (int nt = 0; nt < 4; ++nt) hst[nt] = 0.f;
            for (int s2 = 0; s2 < seg; ++s2) {
#pragma unroll
                for (int nt = 0; nt < 4; ++nt) hst[nt] = PL[s2 * 64 + nt * 16 + fr] * hst[nt] + HL[s2 * 64 + nt * 16 + fr];
            }
        }
    }
    __syncthreads();
}

constexpr int LM_ATT = 32768;
#define ATT_COMPUTE(FAR) do { \
        bf16x8 Kf[2][4], Vf[8]; \
        _Pragma("unroll") for (int t = 0; t < 2; ++t) _Pragma("unroll") for (int ks = 0; ks < 4; ++ks) Kf[t][ks] = *(const LAS bf16x8*)(sb + (t * 4 + ks) * 1024 + foff); \
        _Pragma("unroll") for (int dt = 0; dt < 8; ++dt) Vf[dt] = *(const LAS bf16x8*)(sb + 8192 + dt * 1024 + foff); \
        f32x4 St[2][2]; \
        _Pragma("unroll") for (int t = 0; t < 2; ++t) _Pragma("unroll") for (int qt = 0; qt < 2; ++qt) { f32x4 s_ = (f32x4){0.f, 0.f, 0.f, 0.f}; \
            _Pragma("unroll") for (int ks = 0; ks < 4; ++ks) s_ = __builtin_amdgcn_mfma_f32_16x16x32_bf16(Kf[t][ks], Q[qt][ks], s_, 0, 0, 0); \
            St[t][qt] = s_; } \
        bf16x8 Pf[2]; \
        _Pragma("unroll") for (int qt = 0; qt < 2; ++qt) { \
            const int qpos = c * 64 + qh * 32 + qt * 16 + fr; \
            float sv[8]; float bm = -1e30f; \
            _Pragma("unroll") for (int t = 0; t < 2; ++t) _Pragma("unroll") for (int j = 0; j < 4; ++j) { float bv_; \
                if (FAR) bv_ = bias0; else { int rel = k0 + 8 * fq + 4 * t + j - qpos; rel = rel < -128 ? -128 : (rel > 128 ? 128 : rel); bv_ = bias[rel + 128]; } \
                const float s_ = St[t][qt][j] * SC + bv_; sv[t * 4 + j] = s_; bm = fmaxf(bm, s_); } \
            bm = fmaxf(bm, __shfl_xor(bm, 16)); bm = fmaxf(bm, __shfl_xor(bm, 32)); \
            const float mn = fmaxf(mrun[qt], bm); const float alpha = fast_exp2(mrun[qt] - mn); mrun[qt] = mn; \
            float ps = 0.f; \
            _Pragma("unroll") for (int e = 0; e < 8; ++e) { sv[e] = fast_exp2(sv[e] - mn); ps += sv[e]; } \
            lrun[qt] = lrun[qt] * alpha + ps; \
            _Pragma("unroll") for (int dt = 0; dt < 8; ++dt) O[dt][qt] = O[dt][qt] * alpha; \
            u32x4 pk; pk.x = cvt_pk_bf16(sv[0], sv[1]); pk.y = cvt_pk_bf16(sv[2], sv[3]); pk.z = cvt_pk_bf16(sv[4], sv[5]); pk.w = cvt_pk_bf16(sv[6], sv[7]); \
            Pf[qt] = __builtin_bit_cast(bf16x8, pk); } \
        _Pragma("unroll") for (int dt = 0; dt < 8; ++dt) _Pragma("unroll") for (int qt = 0; qt < 2; ++qt) O[dt][qt] = __builtin_amdgcn_mfma_f32_16x16x32_bf16(Vf[dt], Pf[qt], O[dt][qt], 0, 0, 0); \
    } while (0)
__device__ __forceinline__ void attn_block(LAS unsigned char* lds, const bf16_t* zm, const bf16_t* Kh, const bf16_t* Vt, bf16_t* yraw, float* yp, const LAS float* biasAll, int b, int h, int g, int tid) {
    LAUNDER(tid);
    const int lane = tid & 63, wave = tid >> 6, fr = lane & 15, fq = lane >> 4;
    const int c = 4 * g + (wave >> 1), qh = wave & 1;
    const LAS float* bias = biasAll + h * NREL;
    const float bias0 = bias[0];
    const float SC = 0.08838834764831845f * LOG2E;
    bf16x8 Q[2][4];
#pragma unroll
    for (int qt = 0; qt < 2; ++qt) { const size_t tok = (size_t)b * SEQ + c * 64 + qh * 32 + qt * 16 + fr;
#pragma unroll
        for (int ks = 0; ks < 4; ++ks) Q[qt][ks] = *(const bf16x8*)(zm + tok * ZLD + 2048 + h * HD + ks * 32 + 8 * fq); }
    f32x4 O[8][2];
#pragma unroll
    for (int dt = 0; dt < 8; ++dt)
#pragma unroll
        for (int qt = 0; qt < 2; ++qt) O[dt][qt] = (f32x4){0.f, 0.f, 0.f, 0.f};
    float mrun[2] = {-1e30f, -1e30f}, lrun[2] = {0.f, 0.f};
    const int lo = g >= 2 ? 4 * g - 8 : 0, nsteps = (4 * g + 4 - lo) * 2;
    const int kr = tid >> 4, c16 = tid & 15;
    const int krho = ((kr >> 3) << 2) | (kr & 3);
    const int kst = ((((kr >> 2) & 1) * 4 + (c16 >> 2)) * 1024) + ((krho * 64 + (c16 & 3) * 16) ^ (krho >= 8 ? 32 : 0));
    const bf16_t* kg = Kh + ((size_t)(b * NH + h) * SEQ + kr) * HD + 8 * c16;
    const int vd = tid >> 2, vq = tid & 3;
    const int vst = 8192 + (vd >> 4) * 1024 + (((vd & 15) * 64 + vq * 16) ^ ((vd & 15) >= 8 ? 32 : 0));
    const bf16_t* vg = Vt + ((size_t)(b * NH + h) * HD + vd) * SEQ + 8 * vq;
    const int foff = (fr * 64 + fq * 16) ^ (fr >= 8 ? 32 : 0);
    LAS unsigned char* st = lds + LM_ATT;
    { const int k0 = lo * 64; const u32x4 kv = *(const u32x4*)(kg + (size_t)k0 * HD); const u32x4 vv = *(const u32x4*)(vg + k0);
      *(LAS u32x4*)(st + kst) = kv; *(LAS u32x4*)(st + vst) = vv; }
    __syncthreads();
#pragma unroll 1
    for (int s = 0; s < nsteps; ++s) {
        const int kc = lo + (s >> 1), k0 = kc * 64 + (s & 1) * 32;
        const int sn = s + 1 < nsteps ? s + 1 : s;
        const int k0n = (lo + (sn >> 1)) * 64 + (sn & 1) * 32;
        const u32x4 kv = *(const u32x4*)(kg + (size_t)k0n * HD); const u32x4 vv = *(const u32x4*)(vg + k0n);
        const LAS unsigned char* sb = st + (s & 1) * 16384;
        if (kc >= c - 8 && kc <= c) {
            if (kc <= c - 3) ATT_COMPUTE(true); else ATT_COMPUTE(false);
        }
        LAS unsigned char* nb = st + ((s + 1) & 1) * 16384;
        *(LAS u32x4*)(nb + kst) = kv; *(LAS u32x4*)(nb + vst) = vv;
        __syncthreads();
    }
#pragma unroll
    for (int qt = 0; qt < 2; ++qt) {
        float l = lrun[qt]; l += __shfl_xor(l, 16); l += __shfl_xor(l, 32);
        const float inv = 1.0f / l;
        bf16_t* op = yraw + ((size_t)b * SEQ + c * 64 + qh * 32 + qt * 16 + fr) * D + 1024 + h * HD + 4 * fq;
        float q = 0.f;
#pragma unroll
        for (int dt = 0; dt < 8; ++dt) { const f32x4 o = O[dt][qt] * inv; u32x2 w; w.x = cvt_pk_bf16(o.x, o.y); w.y = cvt_pk_bf16(o.z, o.w); *(u32x2*)(op + dt * 16) = w; q += (o.x * o.x + o.y * o.y) + (o.z * o.z + o.w * o.w); }
        q += __shfl_xor(q, 16); q += __shfl_xor(q, 32);
        if (fq == 0) yp[((size_t)b * SEQ + c * 64 + qh * 32 + qt * 16 + fr) * 24 + 16 + h] = q;
    }
}
#undef ATT_COMPUTE

#define XB_TMO      128
#define XB_XCNT(j)  (256  + 64 * (j))
#define XB_XSUB(j)  (1280 + 64 * (j))
#define XB_XGEN(j)  (2304 + 64 * (j))
#define XB_TOP      3328
#define XB_TOPGEN   3392
#define XCD_BAR_WORDS 3456
#define XB_SPIN_CAP (1u << 18)
__device__ __forceinline__ unsigned xb_ld(unsigned* p)              { return __hip_atomic_load(p, __ATOMIC_RELAXED, __HIP_MEMORY_SCOPE_AGENT); }
__device__ __forceinline__ unsigned xb_add(unsigned* p, unsigned v) { return __hip_atomic_fetch_add(p, v, __ATOMIC_RELAXED, __HIP_MEMORY_SCOPE_AGENT); }
__device__ __forceinline__ unsigned xb_xcc_id() { return (unsigned)__builtin_amdgcn_s_getreg((3 << 11) | 20) & 0xFu; }
#define XB_SPIN(cond, bar) do { unsigned _sp = 0; while (cond) { __builtin_amdgcn_s_sleep(1); \
    if ((++_sp & 255u) == 0u) { if (xb_ld(&(bar)[XB_TMO])) break; if (_sp > XB_SPIN_CAP) { atomicAdd(&(bar)[XB_TMO], 1u); break; } } } } while (0)
struct XcdBarrier { unsigned* bar; unsigned x; volatile LAS unsigned* st; };
__device__ __forceinline__ XcdBarrier xcd_barrier_post(unsigned* bar, volatile LAS unsigned* st) {
    XcdBarrier b; b.bar = bar; b.x = xb_xcc_id(); b.st = st;
    if (threadIdx.x == 0) (void)xb_add(&bar[XB_XCNT(b.x)], 1u);
    return b;
}
__device__ __forceinline__ void xcd_barrier_complete(unsigned* bar, unsigned x, unsigned& nloc, unsigned& nx) {
    const unsigned G = gridDim.x * gridDim.y * gridDim.z;
    unsigned sum, cnt, mine, sp = 0u;
    for (;;) {
        sum = 0u; cnt = 0u; mine = 0u;
#pragma unroll
        for (unsigned j = 0; j < 16; ++j) { const unsigned c = xb_ld(&bar[XB_XCNT(j)]); sum += c; cnt += (c > 0u) ? 1u : 0u; mine = (j == x) ? c : mine; }
        if (sum == G) break;
        __builtin_amdgcn_s_sleep(1);
        if ((++sp & 255u) == 0u) { if (xb_ld(&bar[XB_TMO])) break; if (sp > XB_SPIN_CAP) { atomicAdd(&bar[XB_TMO], 1u); break; } }
    }
    nloc = mine > 0u ? mine : 1u; nx = cnt > 0u ? cnt : 1u;
}
__device__ __forceinline__ void xcd_barrier(const XcdBarrier& b) {
    asm volatile("s_waitcnt vmcnt(0)" ::: "memory");
    __syncthreads();
    if (threadIdx.x == 0) {
        unsigned* bar = b.bar;
        __builtin_amdgcn_s_waitcnt(0);
        unsigned nloc = b.st[0], nx = b.st[1];
        if (nloc == 0u) { xcd_barrier_complete(bar, b.x, nloc, nx); b.st[0] = nloc; b.st[1] = nx; }
        const unsigned old = xb_add(&bar[XB_XSUB(b.x)], 1u);
        const unsigned gen = old / nloc;
        if (old + 1u == (gen + 1u) * nloc) {
            __builtin_amdgcn_fence(__ATOMIC_RELEASE, "agent");
            asm volatile("s_waitcnt vmcnt(0)" ::: "memory");
            const unsigned og = xb_add(&bar[XB_TOP], 1u);
            const unsigned tg = og / nx;
            if (og + 1u == (tg + 1u) * nx) xb_add(&bar[XB_TOPGEN], 1u);
            else XB_SPIN(xb_ld(&bar[XB_TOPGEN]) == tg, bar);
            __builtin_amdgcn_fence(__ATOMIC_ACQUIRE, "agent");
            xb_add(&bar[XB_XGEN(b.x)], 1u);
            asm volatile("s_waitcnt vmcnt(0)" ::: "memory");
        } else {
            XB_SPIN(xb_ld(&bar[XB_XGEN(b.x)]) == gen, bar);
            __builtin_amdgcn_fence(__ATOMIC_ACQUIRE, "agent");
            asm volatile("s_waitcnt vmcnt(0)" ::: "memory");
        }
    }
    __syncthreads();
}

struct Args { const float* in[23]; float* out; unsigned char* ws; int pad0, pad1; };

__global__ void __launch_bounds__(NTHREADS, 2) mk_fwd(Args args) {
    extern __shared__ __attribute__((aligned(16))) unsigned char lds_raw[];
    LAS unsigned char* lds = (LAS unsigned char*)lds_raw;
    cg::grid_group grid = cg::this_grid();
    const int tid = threadIdx.x, lane = tid & 63, wave = __builtin_amdgcn_readfirstlane(tid >> 6);
    const int G = gridDim.x, bx = blockIdx.x;
    const int gw = bx * NWAVES + wave, NGW = G * NWAVES;
    typedef const float* cfp;
    const __attribute__((address_space(4))) cfp* inp = (const __attribute__((address_space(4))) cfp*)__builtin_amdgcn_kernarg_segment_ptr();
#define INP(k) (inp[k])
#define LAUNDER_S(v) asm volatile("" : "+s"(v))
    unsigned char* ws = args.ws;
    float* out = args.out;
    volatile LAS unsigned* bst = (volatile LAS unsigned*)(lds + 131072 + 64);
    if (tid < 2) bst[tid] = 0u;
    __syncthreads();
    (void)xcd_barrier_post((unsigned*)(ws + WS_CTL), bst);
#define GRID_BAR() do { XcdBarrier xb_; xb_.bar = (unsigned*)(args.ws + WS_CTL); xb_.x = xb_xcc_id(); xb_.st = (volatile LAS unsigned*)(lds + 131072 + 64); xcd_barrier(xb_); } while (0)
    bf16_t* HID = (bf16_t*)(ws + WS_BIG); bf16_t* ZM = (bf16_t*)(ws + WS_BIG); bf16_t* VT = (bf16_t*)(ws + WS_VT); bf16_t* KH = (bf16_t*)(ws + WS_KH); bf16_t* HB = (bf16_t*)(ws + WS_H); bf16_t* HB2 = (bf16_t*)(ws + WS_H2); float* SSQ = (float*)(ws + WS_SSQ); float* YP = (float*)(ws + WS_YP);

    {
        LAS float* scr = (LAS float*)(lds + wave * 16384);
        constexpr int I_G = (D / 64) * (FF / 32), I_D = (FF / 64) * (D / 32), I_IN = (D / 64) * (DIN / 32), I_O = (D / 64) * (D / 32);
        constexpr int PER_LAYER = 4 * I_G + 2 * I_D + I_IN + I_O;
        for (int it = gw; it < DEPTH * PER_LAYER; it += NGW) {
            const int l = it / PER_LAYER; int r = it % PER_LAYER;
            unsigned char* wl = ws + (size_t)l * LAYER_W;
            if (r < I_G) { p0_transpose_item(INP(2) + (size_t)l * D * FF, INP(1) + (size_t)l * D, D, FF, (bf16_t*)(wl + OFF_WGU1), 0, scr, r, lane); continue; } r -= I_G;
            if (r < I_G) { p0_transpose_item(INP(3) + (size_t)l * D * FF, INP(1) + (size_t)l * D, D, FF, (bf16_t*)(wl + OFF_WGU1), 128, scr, r, lane); continue; } r -= I_G;
            if (r < I_D) { p0_transpose_item(INP(4) + (size_t)l * FF * D, nullptr, FF, D, (bf16_t*)(wl + OFF_WD1), -1, scr, r, lane); continue; } r -= I_D;
            if (r < I_IN) { p0_transpose_item(INP(6) + (size_t)l * D * DIN, INP(5) + (size_t)l * D, D, DIN, (bf16_t*)(wl + OFF_WIN), -1, scr, r, lane); continue; } r -= I_IN;
            if (r < I_O) { p0_transpose_item(INP(17) + (size_t)l * D * D, INP(15) + (size_t)l * DL, D, D, (bf16_t*)(wl + OFF_WOUT), -1, scr, r, lane, INP(16) + (size_t)l * DL); continue; } r -= I_O;
            if (r < I_G) { p0_transpose_item(INP(19) + (size_t)l * D * FF, INP(18) + (size_t)l * D, D, FF, (bf16_t*)(wl + OFF_WGU2), 0, scr, r, lane); continue; } r -= I_G;
            if (r < I_G) { p0_transpose_item(INP(20) + (size_t)l * D * FF, INP(18) + (size_t)l * D, D, FF, (bf16_t*)(wl + OFF_WGU2), 128, scr, r, lane); continue; } r -= I_G;
            p0_transpose_item(INP(21) + (size_t)l * FF * D, nullptr, FF, D, (bf16_t*)(wl + OFF_WD2), -1, scr, r, lane);
        }
        cast_rows_bf16(INP(0), HB, SSQ, gw, NGW, lane);
    }
    grid.sync();

#pragma unroll 1
    for (int l = 0; l < DEPTH; ++l) {
        unsigned char* wl = ws + (size_t)l * LAYER_W;
#pragma unroll 1
        for (int f = 0; f < 2; ++f) {
            LAUNDER_S(inp);
            {
                pg8::Gemm g{HB, (const bf16_t*)(wl + (f ? OFF_WGU2 : OFF_WGU1)), M, 2 * FF, D}; pg8::StaticOrder S; S.init(M, 2 * FF, G, bx);
                { if (tid == 0) *(volatile LAS int*)(lds + pg8::LDS_RSPM) = -1; __syncthreads(); }
                pg8::EpiSwiGLU E{HID, FF, SSQ + (size_t)(3 * l + (f ? 2 : 0)) * M * 8, lds};
                pg8::gemm_phase<pg8::EpiSwiGLU, pg8::StaticOrder, true, true>(lds, g, S, E);
            }
            GRID_BAR();
            {
                pg8::Gemm g{HID, (const bf16_t*)(wl + (f ? OFF_WD2 : OFF_WD1)), M, D, FF}; pg8::StaticOrder S; S.init(M, D, G, bx);
                pg8::EpiResid<true> E{HB, SSQ + (size_t)(3 * l + (f ? 3 : 1)) * M * 8, lds};
                pg8::gemm_phase<pg8::EpiResid<true>, pg8::StaticOrder, true, true>(lds, g, S, E);
            }
            GRID_BAR();
            if (f == 0) {
                {
                    pg8::Gemm g{HB, (const bf16_t*)(wl + OFF_WIN), M, DIN, D}; pg8::StaticOrder S; S.init(M, DIN, G, bx);
                    { if (tid == 0) *(volatile LAS int*)(lds + pg8::LDS_RSPM) = -1; __syncthreads(); }
                    pg8::EpiZ E{ZM, VT, KH, SSQ + (size_t)(3 * l + 1) * M * 8, lds};
                    pg8::gemm_phase<pg8::EpiZ, pg8::StaticOrder, true, true>(lds, g, S, E);
                }
                GRID_BAR();
                {
                    LAS float* biasL = (LAS float*)(lds + LM_BIAS);
                    const float* rb = INP(14) + (size_t)l * NH * NREL;
                    int tid_m = tid; LAUNDER(tid_m);
                    for (int i = tid_m; i < NH * NREL; i += NTHREADS) biasL[i] = rb[i] * LOG2E;
                    __syncthreads();
                    for (int u = bx; u < NB * 16; u += G)
                        lru_unit(lds, ZM, HB2, YP, INP(7) + (size_t)l * 4 * DL, INP(8) + (size_t)l * DL, INP(9) + (size_t)l * 16 * 64 * 64, INP(10) + (size_t)l * DL,
                                 INP(11) + (size_t)l * 16 * 64 * 64, INP(12) + (size_t)l * DL, INP(13) + (size_t)l * DL, u >> 4, u & 15, tid);
                    for (int bu = bx; bu < 1024; bu += G) {
                        const int kk = bu >> 8, bxv = bu & 255;
                        const int ag = ((bxv & 7) + 2 * kk) & 7, ap = (bxv >> 3) + 32 * kk;
                        attn_block(lds, ZM, KH, VT, HB2, YP, biasL, ap >> 3, ap & 7, ag, tid);
                    }
                }
                GRID_BAR();
                {
                    pg8::Gemm g{HB2, (const bf16_t*)(wl + OFF_WOUT), M, D, D}; pg8::StaticOrder S; S.init(M, D, G, bx);
                    { if (tid == 0) *(volatile LAS int*)(lds + pg8::LDS_RS2PM) = -1; __syncthreads(); }
                    pg8::EpiResidY E{HB, SSQ + (size_t)(3 * l + 2) * M * 8, YP, lds};
                    { pg8::Unit u0; if (S.next(0, u0)) E.prep(u0); }
                    pg8::gemm_phase<pg8::EpiResidY, pg8::StaticOrder, true, true>(lds, g, S, E);
                }
                GRID_BAR();
            } else {
                if (l + 1 == DEPTH) rms_rows_bf16_to_f32(HB, INP(22), out, gw, NGW, lane);
            }
        }
    }
}

extern "C" void kernel_launch(void* const* d_in, const int* in_sizes, int n_in, void* d_out, int out_size, void* d_ws, size_t ws_size, hipStream_t stream) {
    static int grid = 0;
    if (grid == 0) {
        if (n_in != 23 || in_sizes[0] != M * D || out_size != M * D || ws_size < WS_END) {
            fprintf(stderr, "kernel_launch: unexpected shapes: n_in %d in0 %d out %d ws %zu (need %zu)\n", n_in, n_in > 0 ? in_sizes[0] : -1, out_size, ws_size, (size_t)WS_END); grid = -1; return; }
        int dev = 0, cus = 0, per_cu = 0;
        hipGetDevice(&dev); hipDeviceGetAttribute(&cus, hipDeviceAttributeMultiprocessorCount, dev);
        if (hipFuncSetAttribute((const void*)mk_fwd, hipFuncAttributeMaxDynamicSharedMemorySize, LDS_BYTES) != hipSuccess) fprintf(stderr, "kernel_launch: hipFuncSetAttribute failed\n");
        if (hipOccupancyMaxActiveBlocksPerMultiprocessor(&per_cu, (const void*)mk_fwd, NTHREADS, LDS_BYTES) != hipSuccess || per_cu < 1) { fprintf(stderr, "kernel_launch: occupancy query gave %d\n", per_cu); per_cu = 1; }
        (void)hipGetLastError();
        grid = cus * per_cu;
        if (grid > 256) grid = 256;
    }
    if (grid < 0) return;
    (void)hipMemsetAsync((char*)d_ws + WS_CTL, 0, CTL_BYTES, stream);
    Args a{};
    for (int i = 0; i < 23; ++i) a.in[i] = (const float*)d_in[i];
    a.out = (float*)d_out; a.ws = (unsigned char*)d_ws;
    void* kargs[] = {&a};
    hipError_t e = hipLaunchCooperativeKernel((const void*)mk_fwd, dim3(grid), dim3(NTHREADS), kargs, LDS_BYTES, stream);
    if (e != hipSuccess) fprintf(stderr, "kernel_launch: cooperative launch failed: %s (grid %d)\n", hipGetErrorString(e), grid);
}
```

```cpp
#include <hip/hip_runtime.h>
#include <hip/hip_cooperative_groups.h>
#include <cstdio>
#include <cstdint>
namespace cg = cooperative_groups;

#define LAS __attribute__((address_space(3)))
#define LAUNDER(v) asm volatile("" : "+v"(v))
typedef unsigned short bf16_t;
typedef short bf16x8 __attribute__((ext_vector_type(8)));
typedef float f32x4 __attribute__((ext_vector_type(4)));
typedef float f32x2 __attribute__((ext_vector_type(2)));
typedef unsigned u32x4 __attribute__((ext_vector_type(4)));
typedef unsigned u32x2 __attribute__((ext_vector_type(2)));

constexpr int NB = 16, SEQ = 2048, M = NB * SEQ, D = 2048, FF = 5632, DIN = 5120, DL = 1024, NH = 8, HD = 128, NREL = 257, DEPTH = 2;
constexpr int ZLD = 3072;
constexpr float EPS = 1e-6f;
constexpr float LOG2E = 1.4426950408889634f;

constexpr size_t MiB = 1u << 20;
constexpr size_t SZ_WGU = (size_t)2 * FF * D * 2, SZ_WD = (size_t)D * FF * 2, SZ_WIN = (size_t)DIN * D * 2, SZ_WOUT = (size_t)D * D * 2;
constexpr size_t OFF_WGU1 = 0, OFF_WD1 = OFF_WGU1 + SZ_WGU, OFF_WIN = OFF_WD1 + SZ_WD, OFF_WOUT = OFF_WIN + SZ_WIN, OFF_WGU2 = OFF_WOUT + SZ_WOUT, OFF_WD2 = OFF_WGU2 + SZ_WGU;
constexpr size_t LAYER_W = OFF_WD2 + SZ_WD;
static_assert(LAYER_W == 160 * MiB, "weights per layer");
constexpr size_t WS_BIG = 2 * LAYER_W;
constexpr size_t WS_VT = WS_BIG + (size_t)M * ZLD * 2;
constexpr size_t WS_KH = WS_VT + (size_t)M * 1024 * 2;
constexpr size_t WS_H = WS_BIG + 352 * MiB;
constexpr size_t WS_H2 = WS_H + 128 * MiB;
constexpr size_t WS_SSQ = WS_H2 + 128 * MiB;
constexpr size_t WS_YP = WS_SSQ + 8 * MiB;
constexpr size_t WS_CTL = WS_YP + 4 * MiB;
constexpr size_t CTL_BYTES = 16384;
constexpr size_t WS_END = WS_CTL + 1 * MiB;
static_assert((size_t)M * FF * 2 == 352 * MiB, "hidden size");

constexpr int NWAVES = 8, NTHREADS = 512;
constexpr int LDS_BYTES = 147456;

__device__ __forceinline__ unsigned cvt_pk_bf16(float lo, float hi) { unsigned r; asm volatile("v_cvt_pk_bf16_f32 %0, %1, %2" : "=v"(r) : "v"(lo), "v"(hi)); return r; }
__device__ __forceinline__ float bf_lo(unsigned u) { return __uint_as_float(u << 16); }
__device__ __forceinline__ float bf_hi(unsigned u) { return __uint_as_float(u & 0xffff0000u); }
__device__ __forceinline__ float fast_exp2(float x) { return __builtin_amdgcn_exp2f(x); }
__device__ __forceinline__ float fast_rcp(float x) { return __builtin_amdgcn_rcpf(x); }
__device__ __forceinline__ float sigmoidf_(float x) { return fast_rcp(1.0f + fast_exp2(-LOG2E * x)); }

namespace pg8 {
constexpr int BM = 256, BK = 64, HALF = 128, HTB = HALF * BK * 2, STAGE_BYTES = 8 * HTB, NXCD = 8, WGM = 8;
__host__ __device__ __forceinline__ int lds_byte(int r, int c) { const int st = (r >> 4) * 2 + (c >> 5), rr = r & 15, cc = c & 31, ob = rr * 64 + cc * 2; return st * 1024 + (ob ^ (((ob >> 9) & 1) << 5)); }
__host__ __device__ __forceinline__ void stage_rc(int b, int& R, int& C) { const int st = b / 1024, sb = b % 1024, swz = sb ^ (((sb >> 9) & 1) << 5); R = (st >> 1) * 16 + swz / 64; C = (st & 1) * 32 + (swz % 64) / 2; }
__host__ __device__ __forceinline__ int perm32(int rho) { const int n = rho >> 4, i = rho & 15; return 8 * (i >> 2) + 4 * n + (i & 3); }

struct Unit { int pm, pn; };
struct Gemm { const bf16_t* A; const bf16_t* Bt; int M, N, K; };

struct StaticOrder {
    int nM, nN, nwg, G, c;
    __host__ __device__ void init(int M_, int N_, int G_, int c_) { nM = M_ / BM; nN = N_ / BM; nwg = nM * nN; G = G_; c = c_; }
    __host__ __device__ bool next(int i, Unit& u) const {
        const long L = (long)i * G + c; if (L >= nwg) return false;
        int wgid = (int)L; { const int q = nwg / NXCD, r = nwg % NXCD, xcd = wgid % NXCD, off = wgid / NXCD; wgid = (xcd < r ? xcd * (q + 1) : r * (q + 1) + (xcd - r) * q) + off; }
        const int nig = WGM * nN, gid = wgid / nig, fm = gid * WGM, gsz = (nM - fm) < WGM ? (nM - fm) : WGM;
        u.pm = fm + ((wgid % nig) % gsz); u.pn = (wgid % nig) / gsz; return true;
    }
    __device__ __forceinline__ void a_ready(const Unit&) const {}
    __device__ __forceinline__ void done(const Unit&) const {}
};


constexpr int LDS_RS = 131072 + 1024, LDS_RSPM = 131072 + 2048 + 64, LDS_SSP = 131072 + 4096;
__device__ __forceinline__ void rs_panel(LAS unsigned char* lds, const float* ssq, int pm) {
    volatile LAS int* pmL = (volatile LAS int*)(lds + LDS_RSPM); LAS float* rsL = (LAS float*)(lds + LDS_RS);
    if (pmL[0] != pm) {
        asm volatile("s_waitcnt lgkmcnt(0)" ::: "memory"); __builtin_amdgcn_s_barrier();
        const int t = threadIdx.x;
        if (t < 256) { const f32x4* pp = (const f32x4*)(ssq + (size_t)(pm * 256 + t) * 8); const f32x4 pa = pp[0], pb = pp[1];
            rsL[t] = __builtin_amdgcn_rsqf((((pa.x + pa.y) + (pa.z + pa.w)) + ((pb.x + pb.y) + (pb.z + pb.w))) * (1.0f / D) + EPS); }
        if (t == 0) pmL[0] = pm;
        asm volatile("s_waitcnt vmcnt(0) lgkmcnt(0)" ::: "memory"); __builtin_amdgcn_s_barrier();
    }
}
struct EpiSwiGLU {
    static constexpr bool PERM = true, AFTER_DRAIN = false, MIDK = false;
    bf16_t* O; int ldc; const float* ssq; LAS unsigned char* lds;
    __device__ __forceinline__ void operator()(const f32x4 (&acc)[2][2][4][2], const Unit& u, int wr, int wc, int fr, int fq) const {
        rs_panel(lds, ssq, u.pm);
        const LAS float* rsL = (const LAS float*)(lds + LDS_RS) + wr * 64 + fr;
        const int row0 = u.pm * BM + wr * 64 + fr; const int col0 = u.pn * HALF + wc * 32 + 8 * fq;
#pragma unroll
        for (int ai = 0; ai < 2; ++ai)
#pragma unroll
            for (int m = 0; m < 4; ++m) {
                bf16_t* rowp = O + (size_t)(row0 + ai * HALF + m * 16) * ldc + col0;
                const float rs = rsL[ai * HALF + m * 16];
                float v[8];
#pragma unroll
                for (int n = 0; n < 2; ++n)
#pragma unroll
                    for (int i = 0; i < 4; ++i) { const float g = acc[ai][0][m][n][i] * rs, up = acc[ai][1][m][n][i] * rs; v[n * 4 + i] = g * sigmoidf_(g) * up; }
                u32x4 w; w.x = cvt_pk_bf16(v[0], v[1]); w.y = cvt_pk_bf16(v[2], v[3]); w.z = cvt_pk_bf16(v[4], v[5]); w.w = cvt_pk_bf16(v[6], v[7]);
                *(u32x4*)rowp = w;
            }
    }
};
template <bool HALFSC> struct EpiResid {
    static constexpr bool PERM = false, AFTER_DRAIN = false, MIDK = false;
    bf16_t* xb; float* ssq_part; LAS unsigned char* lds;
    __device__ __forceinline__ void operator()(const f32x4 (&acc)[2][2][4][2], const Unit& u, int wr, int wc, int fr, int fq) const {
        const float scale_ = HALFSC ? 0.5f : 1.0f; bf16_t* const xb_ = xb; float* const ssq_ = ssq_part;
        LAS float* pl = (LAS float*)(lds + LDS_SSP);
        const int col0 = u.pn * BM + wc * 32 + 4 * fq;
        const size_t base = (size_t)(u.pm * BM + wr * 64 + fr) * D + col0;
        u32x2 r[2][2][2][2];
#define ER_LOAD(buf, bb) do { _Pragma("unroll") for (int mm = 0; mm < 2; ++mm) _Pragma("unroll") for (int bj = 0; bj < 2; ++bj) _Pragma("unroll") for (int n = 0; n < 2; ++n) \
            r[buf][mm][bj][n] = *(const u32x2*)(xb_ + base + (size_t)(((bb) >> 1) * HALF + (((bb) & 1) * 2 + mm) * 16) * D + bj * HALF + n * 16); } while (0)
        ER_LOAD(0, 0);
#pragma unroll
        for (int bb = 0; bb < 4; ++bb) {
            if (bb < 3) ER_LOAD((bb + 1) & 1, bb + 1);
            const int ai = bb >> 1;
#pragma unroll
            for (int mm = 0; mm < 2; ++mm) { const int m = (bb & 1) * 2 + mm; const int rowl = ai * HALF + m * 16; const size_t off = base + (size_t)rowl * D; float ssum = 0.f;
#pragma unroll
                for (int bj = 0; bj < 2; ++bj)
#pragma unroll
                    for (int n = 0; n < 2; ++n) { const u32x2 rr = r[bb & 1][mm][bj][n]; const f32x4 a = acc[ai][bj][m][n];
                        const float o0 = bf_lo(rr.x) + a.x * scale_, o1 = bf_hi(rr.x) + a.y * scale_, o2 = bf_lo(rr.y) + a.z * scale_, o3 = bf_hi(rr.y) + a.w * scale_;
                        u32x2 w; w.x = cvt_pk_bf16(o0, o1); w.y = cvt_pk_bf16(o2, o3); *(u32x2*)(xb_ + off + bj * HALF + n * 16) = w;
                        ssum += (o0 * o0 + o1 * o1) + (o2 * o2 + o3 * o3); }
                ssum += __shfl_xor(ssum, 16); ssum += __shfl_xor(ssum, 32);
                if (fq == 0) pl[(rowl + wr * 64 + fr) * 4 + wc] = ssum;
            }
        }
#undef ER_LOAD
        asm volatile("s_waitcnt lgkmcnt(0)" ::: "memory"); __builtin_amdgcn_s_barrier();
        const int t = threadIdx.x;
        if (t < 256) { const f32x4 p = *(const LAS f32x4*)(pl + t * 4); ssq_[(size_t)(u.pm * BM + t) * 8 + u.pn] = (p.x + p.y) + (p.z + p.w); }
    }
};
constexpr int LDS_RS2 = 131072 + 8192, LDS_RS2PM = 131072 + 8192 + 2048 + 64;
__device__ __forceinline__ void rs2_panel(LAS unsigned char* lds, const float* yp, int pm) {
    volatile LAS int* pmL = (volatile LAS int*)(lds + LDS_RS2PM); LAS f32x2* rsL = (LAS f32x2*)(lds + LDS_RS2);
    if (pmL[0] != pm) {
        asm volatile("s_waitcnt lgkmcnt(0)" ::: "memory"); __builtin_amdgcn_s_barrier();
        const int t = threadIdx.x;
        if (t < 256) { const f32x4* pp = (const f32x4*)(yp + (size_t)(pm * 256 + t) * 24);
            const f32x4 a0 = pp[0], a1 = pp[1], a2 = pp[2], a3 = pp[3], b0 = pp[4], b1 = pp[5];
            const float sl = (((a0.x + a0.y) + (a0.z + a0.w)) + ((a1.x + a1.y) + (a1.z + a1.w))) + (((a2.x + a2.y) + (a2.z + a2.w)) + ((a3.x + a3.y) + (a3.z + a3.w)));
            const float sa = ((b0.x + b0.y) + (b0.z + b0.w)) + ((b1.x + b1.y) + (b1.z + b1.w));
            const float va = sa * (1.0f / 1024.f) + EPS, vl = sl * (1.0f / 1024.f) + EPS;
            rsL[t] = (f32x2){__builtin_amdgcn_rsqf(va), __builtin_amdgcn_rsqf(vl) * sqrtf(va)}; }
        if (t == 0) pmL[0] = pm;
        asm volatile("s_waitcnt vmcnt(0) lgkmcnt(0)" ::: "memory"); __builtin_amdgcn_s_barrier();
    }
}
struct EpiResidY {
    static constexpr bool PERM = false, AFTER_DRAIN = false, MIDK = true;
    bf16_t* xb; float* ssq_part; const float* yp; LAS unsigned char* lds;
    __device__ __forceinline__ void prep(const Unit& u) const { rs2_panel(lds, yp, u.pm); }
    __device__ __forceinline__ void mid(f32x4 (&acc)[2][2][4][2], const Unit& u, int wr, int wc, int fr, int fq) const {
        const LAS f32x2* rsL = (const LAS f32x2*)(lds + LDS_RS2) + wr * 64 + fr;
#pragma unroll
        for (int ai = 0; ai < 2; ++ai)
#pragma unroll
            for (int m = 0; m < 4; ++m) { const float q = rsL[ai * HALF + m * 16].y;
#pragma unroll
                for (int bj = 0; bj < 2; ++bj)
#pragma unroll
                    for (int n = 0; n < 2; ++n) acc[ai][bj][m][n] = acc[ai][bj][m][n] * q; }
    }
    __device__ __forceinline__ void operator()(const f32x4 (&acc)[2][2][4][2], const Unit& u, int wr, int wc, int fr, int fq) const {
        bf16_t* const xb_ = xb; float* const ssq_ = ssq_part;
        LAS float* pl = (LAS float*)(lds + LDS_SSP);
        const LAS f32x2* rsL = (const LAS f32x2*)(lds + LDS_RS2) + wr * 64 + fr;
        const int col0 = u.pn * BM + wc * 32 + 4 * fq;
        const size_t base = (size_t)(u.pm * BM + wr * 64 + fr) * D + col0;
        u32x2 r[2][2][2][2];
#define ER_LOAD(buf, bb) do { _Pragma("unroll") for (int mm = 0; mm < 2; ++mm) _Pragma("unroll") for (int bj = 0; bj < 2; ++bj) _Pragma("unroll") for (int n = 0; n < 2; ++n) \
            r[buf][mm][bj][n] = *(const u32x2*)(xb_ + base + (size_t)(((bb) >> 1) * HALF + (((bb) & 1) * 2 + mm) * 16) * D + bj * HALF + n * 16); } while (0)
        ER_LOAD(0, 0);
#pragma unroll
        for (int bb = 0; bb < 4; ++bb) {
            if (bb < 3) ER_LOAD((bb + 1) & 1, bb + 1);
            const int ai = bb >> 1;
#pragma unroll
            for (int mm = 0; mm < 2; ++mm) { const int m = (bb & 1) * 2 + mm; const int rowl = ai * HALF + m * 16; const size_t off = base + (size_t)rowl * D; float ssum = 0.f;
                const float scale_ = rsL[rowl].x;
#pragma unroll
                for (int bj = 0; bj < 2; ++bj)
#pragma unroll
                    for (int n = 0; n < 2; ++n) { const u32x2 rr = r[bb & 1][mm][bj][n]; const f32x4 a = acc[ai][bj][m][n];
                        const float o0 = bf_lo(rr.x) + a.x * scale_, o1 = bf_hi(rr.x) + a.y * scale_, o2 = bf_lo(rr.y) + a.z * scale_, o3 = bf_hi(rr.y) + a.w * scale_;
                        u32x2 w; w.x = cvt_pk_bf16(o0, o1); w.y = cvt_pk_bf16(o2, o3); *(u32x2*)(xb_ + off + bj * HALF + n * 16) = w;
                        ssum += (o0 * o0 + o1 * o1) + (o2 * o2 + o3 * o3); }
                ssum += __shfl_xor(ssum, 16); ssum += __shfl_xor(ssum, 32);
                if (fq == 0) pl[(rowl + wr * 64 + fr) * 4 + wc] = ssum;
            }
        }
#undef ER_LOAD
        asm volatile("s_waitcnt lgkmcnt(0)" ::: "memory"); __builtin_amdgcn_s_barrier();
        const int t = threadIdx.x;
        if (t < 256) { const f32x4 p = *(const LAS f32x4*)(pl + t * 4); ssq_[(size_t)(u.pm * BM + t) * 8 + u.pn] = (p.x + p.y) + (p.z + p.w); }
    }
};
struct EpiZ {
    static constexpr bool PERM = true, AFTER_DRAIN = false, MIDK = false;
    bf16_t* Z; bf16_t* Vt; bf16_t* Kh; const float* ssq; LAS unsigned char* lds;
    __device__ __forceinline__ void operator()(const f32x4 (&acc)[2][2][4][2], const Unit& u, int wr, int wc, int fr, int fq) const {
        rs_panel(lds, ssq, u.pm);
        float rs[2][4];
        { const LAS float* rsL = (const LAS float*)(lds + LDS_RS) + wr * 64 + fr;
#pragma unroll
          for (int ai = 0; ai < 2; ++ai)
#pragma unroll
            for (int m = 0; m < 4; ++m) rs[ai][m] = rsL[ai * HALF + m * 16]; }
        if (u.pn >= 12 && u.pn < 16) {
            const int b = (u.pm * BM) / SEQ; const int s0 = (u.pm * BM) % SEQ + wr * 64 + fr;
#pragma unroll
            for (int bj = 0; bj < 2; ++bj) {
                const int head = (u.pn - 12) * 2 + bj;
                bf16_t* hb = Kh + ((size_t)(b * NH + head) * SEQ + s0) * HD + wc * 32 + 8 * fq;
#pragma unroll
                for (int ai = 0; ai < 2; ++ai)
#pragma unroll
                    for (int m = 0; m < 4; ++m) { const f32x4 v0 = acc[ai][bj][m][0] * rs[ai][m], v1 = acc[ai][bj][m][1] * rs[ai][m];
                        u32x4 w; w.x = cvt_pk_bf16(v0[0], v0[1]); w.y = cvt_pk_bf16(v0[2], v0[3]); w.z = cvt_pk_bf16(v1[0], v1[1]); w.w = cvt_pk_bf16(v1[2], v1[3]);
                        *(u32x4*)(hb + (size_t)(ai * HALF + m * 16) * HD) = w; }
            }
        } else if (u.pn < 12) {
            const int row0 = u.pm * BM + wr * 64 + fr; const int col0 = u.pn * BM + wc * 32 + 8 * fq;
#pragma unroll
            for (int ai = 0; ai < 2; ++ai)
#pragma unroll
                for (int m = 0; m < 4; ++m) {
                    bf16_t* rowp = Z + (size_t)(row0 + ai * HALF + m * 16) * ZLD + col0;
#pragma unroll
                    for (int bj = 0; bj < 2; ++bj) { const f32x4 v0 = acc[ai][bj][m][0] * rs[ai][m], v1 = acc[ai][bj][m][1] * rs[ai][m];
                        u32x4 w; w.x = cvt_pk_bf16(v0[0], v0[1]); w.y = cvt_pk_bf16(v0[2], v0[3]); w.z = cvt_pk_bf16(v1[0], v1[1]); w.w = cvt_pk_bf16(v1[2], v1[3]);
                        *(u32x4*)(rowp + bj * HALF) = w; }
                }
        } else {
            const int b = (u.pm * BM) / SEQ; const int s0 = (u.pm * BM) % SEQ + wr * 64 + fr;
#pragma unroll
            for (int bj = 0; bj < 2; ++bj) {
                const int head = (u.pn - 16) * 2 + bj;
                bf16_t* hb = Vt + ((size_t)(b * NH + head) * HD + wc * 32 + 8 * fq) * SEQ + s0;
#pragma unroll
                for (int ai = 0; ai < 2; ++ai)
#pragma unroll
                    for (int m = 0; m < 4; ++m)
#pragma unroll
                        for (int n = 0; n < 2; ++n)
#pragma unroll
                            for (int i = 0; i < 4; ++i) {
                                const unsigned w = cvt_pk_bf16(acc[ai][bj][m][n][i] * rs[ai][m], 0.f);
                                hb[(size_t)(4 * n + i) * SEQ + ai * HALF + m * 16] = (bf16_t)(w & 0xffffu);
                            }
            }
        }
    }
};

template <class Epi, class Sched, bool ALIGN_EPI = false, bool SP2 = false>
__device__ __forceinline__ void gemm_phase(LAS unsigned char* lds, const Gemm g, const Sched& S, const Epi& E) {
    int tid_l = threadIdx.x; LAUNDER(tid_l);
    const int tid = tid_l, wid = __builtin_amdgcn_readfirstlane(tid >> 6), lane = tid & 63, wr = wid >> 2, wc = wid & 3, fr = lane & 15, fq = lane >> 4;
    const int K = g.K, nt = K / BK;
    unsigned voffA[2], voffB[2];
#pragma unroll
    for (int i = 0; i < 2; ++i) { int R, C; stage_rc(tid * 16 + i * 8192, R, C); const int Rb = Epi::PERM ? ((R & ~31) + perm32(R & 31)) : R;
        voffA[i] = (unsigned)(R * K + C) * 2u; voffB[i] = (unsigned)(Rb * K + C) * 2u; }
    const size_t kstep = (size_t)(BK * 2);
    const size_t hstep = (size_t)HALF * K * 2;
    const size_t tstep = 2 * hstep;
    const unsigned ldsw = (unsigned)wid * 1024u;
    const int aoff = lds_byte(wr * 64 + fr, fq * 8), boff = lds_byte(wc * 32 + fr, fq * 8);
#define PG8_SA(b, h) (((b) * 2 + (h)) * HTB)
#define PG8_SB(b, h) ((4 + (b) * 2 + (h)) * HTB)
#define PG8_STAGE(bufoff, gbase, voff) do { _Pragma("unroll") for (int _i = 0; _i < 2; ++_i) \
        __builtin_amdgcn_global_load_lds((const unsigned*)((const char*)(gbase) + (voff)[_i]), (LAS unsigned*)(lds + (bufoff) + ldsw + _i * 8192), 16, 0, 0); } while (0)
#define PG8_LDA(dst, b, h) do { _Pragma("unroll") for (int m = 0; m < 4; ++m) _Pragma("unroll") for (int k = 0; k < 2; ++k) dst[m][k] = *(const LAS bf16x8*)(lds + PG8_SA(b, h) + aoff + m * 2048 + k * 1024); } while (0)
#define PG8_LDB(dst, b, h) do { _Pragma("unroll") for (int n = 0; n < 2; ++n) _Pragma("unroll") for (int k = 0; k < 2; ++k) dst[n][k] = *(const LAS bf16x8*)(lds + PG8_SB(b, h) + boff + n * 2048 + k * 1024); } while (0)
#define PG8_MMA(ai, bj, At, Bt) do { __builtin_amdgcn_s_setprio(1); _Pragma("unroll") for (int m = 0; m < 4; ++m) _Pragma("unroll") for (int n = 0; n < 2; ++n) _Pragma("unroll") for (int k = 0; k < 2; ++k) \
        acc[ai][bj][m][n] = __builtin_amdgcn_mfma_f32_16x16x32_bf16(Bt[n][k], At[m][k], acc[ai][bj][m][n], 0, 0, 0); __builtin_amdgcn_s_setprio(0); } while (0)
#define PG8_WAIT_V(n) asm volatile("s_waitcnt vmcnt(" #n ")" ::: "memory")
#define PG8_WAIT_L(n) asm volatile("s_waitcnt lgkmcnt(" #n ")" ::: "memory")
#define PG8_BAR __builtin_amdgcn_s_barrier()
#define PG8_SCHED __builtin_amdgcn_sched_barrier(0)
    Unit cur, nxt; int ui = 0;
    if (!S.next(0, cur)) return;
    f32x4 acc[2][2][4][2];
#pragma unroll
    for (int a = 0; a < 2; ++a)
#pragma unroll
        for (int b = 0; b < 2; ++b)
#pragma unroll
            for (int m = 0; m < 4; ++m)
#pragma unroll
                for (int n = 0; n < 2; ++n) acc[a][b][m][n] = (f32x4){0.f, 0.f, 0.f, 0.f};
    bf16x8 At[4][2], B0[2][2], B1[2][2];
    const char* cA = (const char*)g.A + (size_t)cur.pm * tstep; const char* cB = (const char*)g.Bt + (size_t)cur.pn * tstep;
    S.a_ready(cur);
    if constexpr (SP2) {
        PG8_STAGE(PG8_SB(0, 0), cB, voffB); PG8_STAGE(PG8_SB(0, 1), cB + hstep, voffB); PG8_STAGE(PG8_SA(0, 0), cA, voffA); PG8_STAGE(PG8_SA(0, 1), cA + hstep, voffA);
        if (wr == 1) PG8_BAR;
        PG8_WAIT_V(2); PG8_BAR;
        PG8_STAGE(PG8_SB(1, 0), cB + kstep, voffB); PG8_STAGE(PG8_SA(1, 0), cA + kstep, voffA); PG8_STAGE(PG8_SB(1, 1), cB + hstep + kstep, voffB);
        PG8_WAIT_V(6); PG8_BAR;
    } else {
        PG8_STAGE(PG8_SB(0, 0), cB, voffB); PG8_STAGE(PG8_SA(0, 0), cA, voffA); PG8_STAGE(PG8_SB(0, 1), cB + hstep, voffB); PG8_STAGE(PG8_SA(0, 1), cA + hstep, voffA);
        if (wr == 1) PG8_BAR;
        PG8_WAIT_V(4); PG8_BAR;
        PG8_STAGE(PG8_SB(1, 0), cB + kstep, voffB); PG8_STAGE(PG8_SA(1, 0), cA + kstep, voffA); PG8_STAGE(PG8_SB(1, 1), cB + hstep + kstep, voffB);
        PG8_WAIT_V(6); PG8_BAR;
    }
    for (;;) {
        const bool has_next = S.next(ui + 1, nxt);
        const char* nA = has_next ? (const char*)g.A + (size_t)nxt.pm * tstep : cA; const char* nB = has_next ? (const char*)g.Bt + (size_t)nxt.pn * tstep : cB;
        for (int t = 0; t < nt; t += 2) {
            if constexpr (Epi::MIDK) { if (t == (nt >> 1)) E.mid(acc, cur, wr, wc, fr, fq); }
            const bool last = (t == nt - 2);
            const char* a1 = cA + (size_t)(t + 1) * kstep;
            const char* a2 = last ? nA : cA + (size_t)(t + 2) * kstep; const char* b2 = last ? nB : cB + (size_t)(t + 2) * kstep;
            const char* a3 = a2 + kstep; const char* b3 = b2 + kstep;
            if (last && has_next) S.a_ready(nxt);
            if constexpr (SP2) {
            PG8_LDB(B0, 0, 0); PG8_LDB(B1, 0, 1); PG8_SCHED; PG8_LDA(At, 0, 0); PG8_STAGE(PG8_SA(1, 1), a1 + hstep, voffA);
            PG8_WAIT_V(8); PG8_WAIT_L(0); PG8_BAR; PG8_MMA(0, 0, At, B0); PG8_MMA(0, 1, At, B1); PG8_BAR; PG8_SCHED;
            PG8_LDA(At, 0, 1); PG8_STAGE(PG8_SB(0, 0), b2, voffB); PG8_STAGE(PG8_SB(0, 1), b2 + hstep, voffB); PG8_STAGE(PG8_SA(0, 0), a2, voffA);
            PG8_WAIT_V(8); PG8_WAIT_L(0); PG8_BAR; PG8_MMA(1, 0, At, B0); PG8_MMA(1, 1, At, B1); PG8_BAR; PG8_SCHED;
            PG8_LDB(B0, 1, 0); PG8_LDB(B1, 1, 1); PG8_SCHED; PG8_LDA(At, 1, 0); PG8_STAGE(PG8_SA(0, 1), a2 + hstep, voffA);
            PG8_WAIT_V(8); PG8_WAIT_L(0); PG8_BAR; PG8_MMA(0, 0, At, B0); PG8_MMA(0, 1, At, B1); PG8_BAR; PG8_SCHED;
            PG8_LDA(At, 1, 1); PG8_STAGE(PG8_SB(1, 0), b3, voffB); PG8_STAGE(PG8_SB(1, 1), b3 + hstep, voffB); PG8_STAGE(PG8_SA(1, 0), a3, voffA);
            PG8_WAIT_V(8); PG8_WAIT_L(0); PG8_BAR; PG8_MMA(1, 0, At, B0); PG8_MMA(1, 1, At, B1); PG8_BAR; PG8_SCHED;
            } else {
            PG8_LDB(B0, 0, 0); PG8_SCHED; PG8_LDA(At, 0, 0); PG8_STAGE(PG8_SA(1, 1), a1 + hstep, voffA);
            PG8_WAIT_L(8); PG8_BAR; PG8_WAIT_L(0); PG8_MMA(0, 0, At, B0); PG8_BAR; PG8_SCHED;
            PG8_LDB(B1, 0, 1); PG8_STAGE(PG8_SB(0, 0), b2, voffB);
            PG8_BAR; PG8_WAIT_L(0); PG8_MMA(0, 1, At, B1); PG8_BAR;
            PG8_LDA(At, 0, 1); PG8_STAGE(PG8_SA(0, 0), a2, voffA);
            PG8_BAR; PG8_WAIT_L(0); PG8_MMA(1, 0, At, B0); PG8_BAR; PG8_SCHED;
            PG8_STAGE(PG8_SB(0, 1), b2 + hstep, voffB);
            PG8_WAIT_V(6); PG8_BAR; PG8_MMA(1, 1, At, B1); PG8_BAR;
            PG8_LDB(B0, 1, 0); PG8_SCHED; PG8_LDA(At, 1, 0); PG8_STAGE(PG8_SA(0, 1), a2 + hstep, voffA);
            PG8_WAIT_L(8); PG8_BAR; PG8_WAIT_L(0); PG8_MMA(0, 0, At, B0); PG8_BAR; PG8_SCHED;
            PG8_LDB(B1, 1, 1); PG8_STAGE(PG8_SB(1, 0), b3, voffB);
            PG8_BAR; PG8_WAIT_L(0); PG8_MMA(0, 1, At, B1); PG8_BAR;
            PG8_LDA(At, 1, 1); PG8_STAGE(PG8_SA(1, 0), a3, voffA);
            PG8_BAR; PG8_WAIT_L(0); PG8_MMA(1, 0, At, B0); PG8_BAR; PG8_SCHED;
            PG8_STAGE(PG8_SB(1, 1), b3 + hstep, voffB);
            PG8_WAIT_V(6); PG8_BAR; PG8_MMA(1, 1, At, B1); PG8_BAR;
            }
        }
        if constexpr (ALIGN_EPI) { if (wr == 0) PG8_BAR; }
        if constexpr (!Epi::AFTER_DRAIN) { E(acc, cur, wr, wc, fr, fq); S.done(cur); }
        if constexpr (Epi::MIDK) { if (has_next) E.prep(nxt); }
        if (!has_next) break;
#pragma unroll
        for (int a = 0; a < 2; ++a)
#pragma unroll
            for (int b = 0; b < 2; ++b)
#pragma unroll
                for (int m = 0; m < 4; ++m)
#pragma unroll
                    for (int n = 0; n < 2; ++n) acc[a][b][m][n] = (f32x4){0.f, 0.f, 0.f, 0.f};
        cur = nxt; cA = nA; cB = nB; ++ui;
        if constexpr (ALIGN_EPI) { if (wr == 1) PG8_BAR; }
    }
    PG8_WAIT_V(0);
    if constexpr (!ALIGN_EPI) { if (wr == 0) PG8_BAR; }
    PG8_BAR;
#undef PG8_SA
#undef PG8_SB
#undef PG8_STAGE
#undef PG8_LDA
#undef PG8_LDB
#undef PG8_MMA
#undef PG8_WAIT_V
#undef PG8_WAIT_L
#undef PG8_BAR
#undef PG8_SCHED
}
}

#define LDS_WAIT() asm volatile("s_waitcnt lgkmcnt(0)" ::: "memory")

__device__ __forceinline__ float wave_sum(float v) {
#pragma unroll
    for (int o = 1; o < 64; o <<= 1) v += __shfl_xor(v, o);
    return v;
}

__device__ __forceinline__ void p0_transpose_item(const float* W, const float* gain, int K, int N, bf16_t* WT, int ilv, LAS float* scr, int item, int lane, const float* gain2 = nullptr) {
    const int nblk = N / 32, kb = item / nblk, nb = item % nblk, k0 = 64 * kb, n0 = 32 * nb;
#pragma unroll 8
    for (int i = 0; i < 32; ++i) { const int kk = 2 * i + (lane >> 5); scr[kk * 33 + (lane & 31)] = W[(size_t)(k0 + kk) * N + n0 + (lane & 31)]; }
    LDS_WAIT(); asm volatile("" ::: "memory");
    const int c = lane & 7;
    f32x4 g0 = (f32x4){1.f, 1.f, 1.f, 1.f}, g1 = g0;
    if (gain) { const float* gp = (gain2 && k0 >= 1024) ? gain2 + (k0 - 1024) : gain + k0; g0 = *(const f32x4*)(gp + 8 * c); g1 = *(const f32x4*)(gp + 8 * c + 4); }
#pragma unroll
    for (int j = 0; j < 4; ++j) { const int n = (lane >> 3) + 8 * j; const LAS float* s = scr + (8 * c) * 33 + n;
        u32x4 o; o.x = cvt_pk_bf16(s[0 * 33] * g0.x, s[1 * 33] * g0.y); o.y = cvt_pk_bf16(s[2 * 33] * g0.z, s[3 * 33] * g0.w); o.z = cvt_pk_bf16(s[4 * 33] * g1.x, s[5 * 33] * g1.y); o.w = cvt_pk_bf16(s[6 * 33] * g1.z, s[7 * 33] * g1.w);
        const int nn = n0 + n; const int row = ilv < 0 ? nn : ((nn >> 7) * 256 + (nn & 127) + ilv);
        *(u32x4*)(WT + (size_t)row * K + k0 + 8 * c) = o; }
    LDS_WAIT(); asm volatile("" ::: "memory");
}

__device__ __forceinline__ void rms_rows_bf16(const float* x, const float* g, bf16_t* out, int gw, int NGW, int lane) {
    LAUNDER(lane);
    f32x4 gv[8];
#pragma unroll
    for (int j = 0; j < 8; ++j) gv[j] = *(const f32x4*)(g + 4 * lane + 256 * j);
    for (int m = gw; m < M; m += NGW) {
        const f32x4* xr = (const f32x4*)(x + (size_t)m * D) + lane; f32x4 v[8]; float s = 0.f;
#pragma unroll
        for (int j = 0; j < 8; ++j) { v[j] = xr[64 * j]; s += (v[j].x * v[j].x + v[j].y * v[j].y) + (v[j].z * v[j].z + v[j].w * v[j].w); }
        const float rstd = 1.0f / sqrtf(wave_sum(s) * (1.0f / D) + EPS);
        u32x2* o8 = (u32x2*)(out + (size_t)m * D) + lane;
#pragma unroll
        for (int j = 0; j < 8; ++j) { const f32x4 o = v[j] * rstd * gv[j]; u32x2 w; w.x = cvt_pk_bf16(o.x, o.y); w.y = cvt_pk_bf16(o.z, o.w); o8[64 * j] = w; }
    }
}
__device__ __forceinline__ void cast_rows_bf16(const float* x, bf16_t* out, float* ssq, int gw, int NGW, int lane) {
    LAUNDER(lane);
    for (int m = gw; m < M; m += NGW) {
        const f32x4* xr = (const f32x4*)(x + (size_t)m * D) + lane; f32x4 v[8]; float s = 0.f;
#pragma unroll
        for (int j = 0; j < 8; ++j) { v[j] = xr[64 * j]; s += (v[j].x * v[j].x + v[j].y * v[j].y) + (v[j].z * v[j].z + v[j].w * v[j].w); }
        s = wave_sum(s);
        if (lane == 0) { f32x4* pp = (f32x4*)(ssq + (size_t)m * 8); pp[0] = (f32x4){s, 0.f, 0.f, 0.f}; pp[1] = (f32x4){0.f, 0.f, 0.f, 0.f}; }
        u32x2* o8 = (u32x2*)(out + (size_t)m * D) + lane;
#pragma unroll
        for (int j = 0; j < 8; ++j) { u32x2 w; w.x = cvt_pk_bf16(v[j].x, v[j].y); w.y = cvt_pk_bf16(v[j].z, v[j].w); o8[64 * j] = w; }
    }
}
__device__ __forceinline__ void rms_rows_f32_inplace(float* x, const float* g, int gw, int NGW, int lane) {
    LAUNDER(lane);
    f32x4 gv[8];
#pragma unroll
    for (int j = 0; j < 8; ++j) gv[j] = *(const f32x4*)(g + 4 * lane + 256 * j);
    for (int m = gw; m < M; m += NGW) {
        f32x4* xr = (f32x4*)(x + (size_t)m * D) + lane; f32x4 v[8]; float s = 0.f;
#pragma unroll
        for (int j = 0; j < 8; ++j) { v[j] = xr[64 * j]; s += (v[j].x * v[j].x + v[j].y * v[j].y) + (v[j].z * v[j].z + v[j].w * v[j].w); }
        const float rstd = 1.0f / sqrtf(wave_sum(s) * (1.0f / D) + EPS);
#pragma unroll
        for (int j = 0; j < 8; ++j) xr[64 * j] = v[j] * rstd * gv[j];
    }
}
__device__ __forceinline__ void rms_rows_bf16_to_f32(const bf16_t* x, const float* g, float* out, int gw, int NGW, int lane) {
    LAUNDER(lane);
    f32x4 gv[4][2];
#pragma unroll
    for (int j = 0; j < 4; ++j) { const float* gp = g + 512 * j + 8 * lane; gv[j][0] = *(const f32x4*)gp; gv[j][1] = *(const f32x4*)(gp + 4); }
    for (int m = gw; m < M; m += NGW) {
        const u32x4* xr = (const u32x4*)(x + (size_t)m * D) + lane; u32x4 raw[4]; float s = 0.f;
#pragma unroll
        for (int j = 0; j < 4; ++j) raw[j] = xr[64 * j];
        float v[4][8];
#pragma unroll
        for (int j = 0; j < 4; ++j) {
            v[j][0] = bf_lo(raw[j].x); v[j][1] = bf_hi(raw[j].x); v[j][2] = bf_lo(raw[j].y); v[j][3] = bf_hi(raw[j].y);
            v[j][4] = bf_lo(raw[j].z); v[j][5] = bf_hi(raw[j].z); v[j][6] = bf_lo(raw[j].w); v[j][7] = bf_hi(raw[j].w);
#pragma unroll
            for (int e = 0; e < 8; ++e) s += v[j][e] * v[j][e];
        }
        const float rstd = 1.0f / sqrtf(wave_sum(s) * (1.0f / D) + EPS);
        f32x4* orow = (f32x4*)(out + (size_t)m * D + 8 * lane);
#pragma unroll
        for (int j = 0; j < 4; ++j) {
            orow[128 * j] = (f32x4){v[j][0] * rstd * gv[j][0].x, v[j][1] * rstd * gv[j][0].y, v[j][2] * rstd * gv[j][0].z, v[j][3] * rstd * gv[j][0].w};
            orow[128 * j + 1] = (f32x4){v[j][4] * rstd * gv[j][1].x, v[j][5] * rstd * gv[j][1].y, v[j][6] * rstd * gv[j][1].z, v[j][7] * rstd * gv[j][1].w};
        }
    }
}
__device__ __forceinline__ void ynorm_rows(bf16_t* y, const float* g_lru, const float* g_att, int gw, int NGW, int lane) {
    LAUNDER(lane);
    f32x4 gv[4][2];
#pragma unroll
    for (int j = 0; j < 4; ++j) { const float* gp = (j < 2 ? g_lru + 512 * j : g_att + 512 * (j - 2)) + 8 * lane; gv[j][0] = *(const f32x4*)gp; gv[j][1] = *(const f32x4*)(gp + 4); }
    for (int m = gw; m < M; m += NGW) {
        u32x4* yr = (u32x4*)(y + (size_t)m * D) + lane; u32x4 raw[4]; float s0 = 0.f, s1 = 0.f;
#pragma unroll
        for (int j = 0; j < 4; ++j) raw[j] = yr[64 * j];
        float v[4][8];
#pragma unroll
        for (int j = 0; j < 4; ++j) {
            v[j][0] = bf_lo(raw[j].x); v[j][1] = bf_hi(raw[j].x); v[j][2] = bf_lo(raw[j].y); v[j][3] = bf_hi(raw[j].y);
            v[j][4] = bf_lo(raw[j].z); v[j][5] = bf_hi(raw[j].z); v[j][6] = bf_lo(raw[j].w); v[j][7] = bf_hi(raw[j].w);
            float s = 0.f;
#pragma unroll
            for (int e = 0; e < 8; ++e) s += v[j][e] * v[j][e];
            if (j < 2) s0 += s; else s1 += s;
        }
        const float r0 = 1.0f / sqrtf(wave_sum(s0) * (1.0f / 1024.f) + EPS), r1 = 1.0f / sqrtf(wave_sum(s1) * (1.0f / 1024.f) + EPS);
#pragma unroll
        for (int j = 0; j < 4; ++j) { const float r = j < 2 ? r0 : r1; u32x4 w;
            w.x = cvt_pk_bf16(v[j][0] * r * gv[j][0].x, v[j][1] * r * gv[j][0].y); w.y = cvt_pk_bf16(v[j][2] * r * gv[j][0].z, v[j][3] * r * gv[j][0].w);
            w.z = cvt_pk_bf16(v[j][4] * r * gv[j][1].x, v[j][5] * r * gv[j][1].y); w.w = cvt_pk_bf16(v[j][6] * r * gv[j][1].z, v[j][7] * r * gv[j][1].w);
            yr[64 * j] = w; }
    }
}

constexpr int LM_BIAS = 0;
constexpr int LM_CW = 8448;
constexpr int LM_CB = 9472;
constexpr int LM_P = 10240;
constexpr int LM_H = 18432;
__device__ __forceinline__ void lru_unit(LAS unsigned char* lds, const bf16_t* zm, bf16_t* yraw, float* yp, const float* conv_w, const float* conv_b, const float* wa, const float* ba,
                                         const float* wx, const float* bx, const float* lam, int b, int hb, int tid) {
    LAUNDER(tid);
    const int lane = tid & 63, w = tid >> 6, fr = lane & 15, fq = lane >> 4;
    LAS float* cwL = (LAS float*)(lds + LM_CW); LAS float* cbL = (LAS float*)(lds + LM_CB);
    if (tid < 256) cwL[tid] = conv_w[(tid >> 6) * DL + hb * 64 + (tid & 63)];
    else if (tid < 320) cbL[tid - 256] = conv_b[hb * 64 + tid - 256];
    bf16x8 WA[4][2], WX[4][2];
#pragma unroll
    for (int nt = 0; nt < 4; ++nt)
#pragma unroll
        for (int ks = 0; ks < 2; ++ks) {
            const float* pa = wa + ((size_t)hb * 64 + ks * 32 + 8 * fq) * 64 + nt * 16 + fr; const float* px = wx + ((size_t)hb * 64 + ks * 32 + 8 * fq) * 64 + nt * 16 + fr;
            u32x4 ua, ux;
            ua.x = cvt_pk_bf16(pa[0 * 64], pa[1 * 64]); ua.y = cvt_pk_bf16(pa[2 * 64], pa[3 * 64]); ua.z = cvt_pk_bf16(pa[4 * 64], pa[5 * 64]); ua.w = cvt_pk_bf16(pa[6 * 64], pa[7 * 64]);
            ux.x = cvt_pk_bf16(px[0 * 64], px[1 * 64]); ux.y = cvt_pk_bf16(px[2 * 64], px[3 * 64]); ux.z = cvt_pk_bf16(px[4 * 64], px[5 * 64]); ux.w = cvt_pk_bf16(px[6 * 64], px[7 * 64]);
            WA[nt][ks] = __builtin_bit_cast(bf16x8, ua); WX[nt][ks] = __builtin_bit_cast(bf16x8, ux);
        }
    bf16x8 ID[2];
#pragma unroll
    for (int p = 0; p < 2; ++p)
#pragma unroll
        for (int e = 0; e < 8; ++e) ID[p][e] = (8 * fq + e == 16 * p + fr) ? (short)0x3F80 : (short)0;
    float pba[4], pbx[4], pcl[4];
#pragma unroll
    for (int nt = 0; nt < 4; ++nt) { const int c = hb * 64 + nt * 16 + fr; pba[nt] = ba[c]; pbx[nt] = bx[c]; pcl[nt] = -8.0f * log1pf(expf(-lam[c])); }
    __syncthreads();
    float hin[4] = {0.f, 0.f, 0.f, 0.f};
    const bf16_t* zb = zm + (size_t)b * SEQ * ZLD + hb * 64;
    LAS f32x2* TOT = (LAS f32x2*)(lds + LM_P);
    u32x4 XR[2][4], GR[2];
    {
        const int tA = 16 * w + fr;
#pragma unroll
        for (int ks = 0; ks < 2; ++ks) {
            const int ch0 = ks * 32 + 8 * fq;
#pragma unroll
            for (int tap = 0; tap < 4; ++tap) { const int t = tA - 3 + tap; const int tt = t >= 0 ? t : 0; XR[ks][tap] = *(const u32x4*)(zb + (size_t)tt * ZLD + ch0); }
            GR[ks] = *(const u32x4*)(zb + (size_t)tA * ZLD + 1024 + ch0);
        }
    }
#pragma unroll 1
    for (int sc = 0; sc < 16; ++sc) {
        const int tA = sc * 128 + 16 * w + fr;
        const int tN = sc < 15 ? tA + 128 : tA;
        u32x4 XN[2][4], GN[2];
#pragma unroll
        for (int ks = 0; ks < 2; ++ks) {
            const int ch0 = ks * 32 + 8 * fq;
#pragma unroll
            for (int tap = 0; tap < 4; ++tap) XN[ks][tap] = *(const u32x4*)(zb + (size_t)(tN - 3 + tap) * ZLD + ch0);
            GN[ks] = *(const u32x4*)(zb + (size_t)tN * ZLD + 1024 + ch0);
        }
        bf16x8 XC[2], GL[2];
#pragma unroll
        for (int ks = 0; ks < 2; ++ks) {
            const int ch0 = ks * 32 + 8 * fq;
            const f32x4 c0 = *(const LAS f32x4*)(cbL + ch0), c1 = *(const LAS f32x4*)(cbL + ch0 + 4);
            float a8[8] = {c0.x, c0.y, c0.z, c0.w, c1.x, c1.y, c1.z, c1.w};
#pragma unroll
            for (int tap = 0; tap < 4; ++tap) {
                const bool ok = (tA - 3 + tap) >= 0;
                u32x4 xr = XR[ks][tap];
                if (!ok) xr = (u32x4){0u, 0u, 0u, 0u};
                const f32x4 w0 = *(const LAS f32x4*)(cwL + tap * 64 + ch0), w1 = *(const LAS f32x4*)(cwL + tap * 64 + ch0 + 4);
                a8[0] += w0.x * bf_lo(xr.x); a8[1] += w0.y * bf_hi(xr.x); a8[2] += w0.z * bf_lo(xr.y); a8[3] += w0.w * bf_hi(xr.y);
                a8[4] += w1.x * bf_lo(xr.z); a8[5] += w1.y * bf_hi(xr.z); a8[6] += w1.z * bf_lo(xr.w); a8[7] += w1.w * bf_hi(xr.w);
            }
            u32x4 pk; pk.x = cvt_pk_bf16(a8[0], a8[1]); pk.y = cvt_pk_bf16(a8[2], a8[3]); pk.z = cvt_pk_bf16(a8[4], a8[5]); pk.w = cvt_pk_bf16(a8[6], a8[7]);
            XC[ks] = __builtin_bit_cast(bf16x8, pk);
            GL[ks] = __builtin_bit_cast(bf16x8, GR[ks]);
        }
        float hl[4][4], pc[4][4], gel[4][4], PE[4], HE[4];
        LAS f32x2* totw = TOT + ((sc & 1) * 8 + w) * 64;
#pragma unroll
        for (int nt = 0; nt < 4; ++nt) {
            f32x4 ga = (f32x4){0.f, 0.f, 0.f, 0.f}, gx = ga, xo = ga, go = ga;
#pragma unroll
            for (int ks = 0; ks < 2; ++ks) { ga = __builtin_amdgcn_mfma_f32_16x16x32_bf16(XC[ks], WA[nt][ks], ga, 0, 0, 0); gx = __builtin_amdgcn_mfma_f32_16x16x32_bf16(XC[ks], WX[nt][ks], gx, 0, 0, 0); }
            xo = __builtin_amdgcn_mfma_f32_16x16x32_bf16(XC[nt >> 1], ID[nt & 1], xo, 0, 0, 0);
            go = __builtin_amdgcn_mfma_f32_16x16x32_bf16(GL[nt >> 1], ID[nt & 1], go, 0, 0, 0);
#pragma unroll
            for (int j = 0; j < 4; ++j) {
                const float r = sigmoidf_(ga[j] + pba[nt]), ig = sigmoidf_(gx[j] + pbx[nt]);
                const float la = pcl[nt] * r;
                const float a = fast_exp2(la * LOG2E);
                const float x2 = 2.0f * la;
                float ome = -x2 * (1.0f + x2 * 0.5f * (1.0f + x2 * (1.0f / 3.0f)));
                if (x2 < -0.03f) ome = 1.0f - a * a;
                const float u = sqrtf(ome) * ig * xo[j];
                if (j == 0) { hl[nt][0] = u; pc[nt][0] = a; }
                else { hl[nt][j] = a * hl[nt][j - 1] + u; pc[nt][j] = pc[nt][j - 1] * a; }
                const float gv = go[j];
                gel[nt][j] = gv * sigmoidf_(1.5957691216057308f * (gv + 0.044715f * gv * gv * gv));
            }
            float P = pc[nt][3], H = hl[nt][3];
            { const float Pp = __shfl_up(P, 16), Hp = __shfl_up(H, 16); if (fq >= 1) { H = P * Hp + H; P = P * Pp; } }
            { const float Pp = __shfl_up(P, 32), Hp = __shfl_up(H, 32); if (fq >= 2) { H = P * Hp + H; P = P * Pp; } }
            { float Pe = __shfl_up(P, 16), He = __shfl_up(H, 16); if (fq == 0) { Pe = 1.0f; He = 0.0f; } PE[nt] = Pe; HE[nt] = He; }
            if (fq == 3) totw[nt * 16 + fr] = (f32x2){P, H};
        }
        __syncthreads();
        float psq[4] = {0.f, 0.f, 0.f, 0.f};
#pragma unroll
        for (int nt = 0; nt < 4; ++nt) {
            float hrun = hin[nt], hws = hin[nt];
#pragma unroll
            for (int w2 = 0; w2 < 8; ++w2) { const f32x2 t2 = TOT[((sc & 1) * 8 + w2) * 64 + nt * 16 + fr]; hrun = t2.x * hrun + t2.y; if (w2 + 1 == w) hws = hrun; }
            hin[nt] = hrun;
            const float hs = PE[nt] * hws + HE[nt];
#pragma unroll
            for (int j = 0; j < 4; ++j) {
                const float ov = (hl[nt][j] + pc[nt][j] * hs) * gel[nt][j]; psq[j] += ov * ov;
                const unsigned o = cvt_pk_bf16(ov, 0.f);
                yraw[(size_t)(b * SEQ + sc * 128 + 16 * w + 4 * fq + j) * D + hb * 64 + nt * 16 + fr] = (bf16_t)(o & 0xffffu);
            }
        }
#pragma unroll
        for (int j = 0; j < 4; ++j) { float q = psq[j]; q += __shfl_xor(q, 1); q += __shfl_xor(q, 2); q += __shfl_xor(q, 4); q += __shfl_xor(q, 8);
            if (fr == 0) yp[(size_t)(b * SEQ + sc * 128 + 16 * w + 4 * fq + j) * 24 + hb] = q; }
#pragma unroll
        for (int ks = 0; ks < 2; ++ks) {
#pragma unroll
            for (int tap = 0; tap < 4; ++tap) XR[ks][tap] = XN[ks][tap];
            GR[ks] = GN[ks];
        }
    }
    __syncthreads();
}

constexpr int LM_ATT = 32768;
#define ATT_COMPUTE(FAR) do { \
        bf16x8 Kf[2][4], Vf[8]; \
        _Pragma("unroll") for (int t = 0; t < 2; ++t) _Pragma("unroll") for (int ks = 0; ks < 4; ++ks) Kf[t][ks] = *(const LAS bf16x8*)(sb + (t * 4 + ks) * 1024 + foff); \
        _Pragma("unroll") for (int dt = 0; dt < 8; ++dt) Vf[dt] = *(const LAS bf16x8*)(sb + 8192 + dt * 1024 + foff); \
        f32x4 St[2][2]; \
        _Pragma("unroll") for (int t = 0; t < 2; ++t) _Pragma("unroll") for (int qt = 0; qt < 2; ++qt) { f32x4 s_ = (f32x4){0.f, 0.f, 0.f, 0.f}; \
            _Pragma("unroll") for (int ks = 0; ks < 4; ++ks) s_ = __builtin_amdgcn_mfma_f32_16x16x32_bf16(Kf[t][ks], Q[qt][ks], s_, 0, 0, 0); \
            St[t][qt] = s_; } \
        bf16x8 Pf[2]; \
        _Pragma("unroll") for (int qt = 0; qt < 2; ++qt) { \
            const int qpos = c * 64 + qh * 32 + qt * 16 + fr; \
            float sv[8]; float bm = -1e30f; \
            _Pragma("unroll") for (int t = 0; t < 2; ++t) _Pragma("unroll") for (int j = 0; j < 4; ++j) { float bv_; \
                if (FAR) bv_ = bias0; else { int rel = k0 + 8 * fq + 4 * t + j - qpos; rel = rel < -128 ? -128 : (rel > 128 ? 128 : rel); bv_ = bias[rel + 128]; } \
                const float s_ = St[t][qt][j] * SC + bv_; sv[t * 4 + j] = s_; bm = fmaxf(bm, s_); } \
            bm = fmaxf(bm, __shfl_xor(bm, 16)); bm = fmaxf(bm, __shfl_xor(bm, 32)); \
            const float mn = fmaxf(mrun[qt], bm); const float alpha = fast_exp2(mrun[qt] - mn); mrun[qt] = mn; \
            float ps = 0.f; \
            _Pragma("unroll") for (int e = 0; e < 8; ++e) { sv[e] = fast_exp2(sv[e] - mn); ps += sv[e]; } \
            lrun[qt] = lrun[qt] * alpha + ps; \
            _Pragma("unroll") for (int dt = 0; dt < 8; ++dt) O[dt][qt] = O[dt][qt] * alpha; \
            u32x4 pk; pk.x = cvt_pk_bf16(sv[0], sv[1]); pk.y = cvt_pk_bf16(sv[2], sv[3]); pk.z = cvt_pk_bf16(sv[4], sv[5]); pk.w = cvt_pk_bf16(sv[6], sv[7]); \
            Pf[qt] = __builtin_bit_cast(bf16x8, pk); } \
        _Pragma("unroll") for (int dt = 0; dt < 8; ++dt) _Pragma("unroll") for (int qt = 0; qt < 2; ++qt) O[dt][qt] = __builtin_amdgcn_mfma_f32_16x16x32_bf16(Vf[dt], Pf[qt], O[dt][qt], 0, 0, 0); \
    } while (0)
__device__ __forceinline__ void attn_block(LAS unsigned char* lds, const bf16_t* zm, const bf16_t* Kh, const bf16_t* Vt, bf16_t* yraw, float* yp, const LAS float* biasAll, int b, int h, int g, int tid) {
    LAUNDER(tid);
    const int lane = tid & 63, wave = tid >> 6, fr = lane & 15, fq = lane >> 4;
    const int c = 4 * g + (wave >> 1), qh = wave & 1;
    const LAS float* bias = biasAll + h * NREL;
    const float bias0 = bias[0];
    const float SC = 0.08838834764831845f * LOG2E;
    bf16x8 Q[2][4];
#pragma unroll
    for (int qt = 0; qt < 2; ++qt) { const size_t tok = (size_t)b * SEQ + c * 64 + qh * 32 + qt * 16 + fr;
#pragma unroll
        for (int ks = 0; ks < 4; ++ks) Q[qt][ks] = *(const bf16x8*)(zm + tok * ZLD + 2048 + h * HD + ks * 32 + 8 * fq); }
    f32x4 O[8][2];
#pragma unroll
    for (int dt = 0; dt < 8; ++dt)
#pragma unroll
        for (int qt = 0; qt < 2; ++qt) O[dt][qt] = (f32x4){0.f, 0.f, 0.f, 0.f};
    float mrun[2] = {-1e30f, -1e30f}, lrun[2] = {0.f, 0.f};
    const int lo = g >= 2 ? 4 * g - 8 : 0, nsteps = (4 * g + 4 - lo) * 2;
    const int kr = tid >> 4, c16 = tid & 15;
    const int krho = ((kr >> 3) << 2) | (kr & 3);
    const int kst = ((((kr >> 2) & 1) * 4 + (c16 >> 2)) * 1024) + ((krho * 64 + (c16 & 3) * 16) ^ (krho >= 8 ? 32 : 0));
    const bf16_t* kg = Kh + ((size_t)(b * NH + h) * SEQ + kr) * HD + 8 * c16;
    const int vd = tid >> 2, vq = tid & 3;
    const int vst = 8192 + (vd >> 4) * 1024 + (((vd & 15) * 64 + vq * 16) ^ ((vd & 15) >= 8 ? 32 : 0));
    const bf16_t* vg = Vt + ((size_t)(b * NH + h) * HD + vd) * SEQ + 8 * vq;
    const int foff = (fr * 64 + fq * 16) ^ (fr >= 8 ? 32 : 0);
    LAS unsigned char* st = lds + LM_ATT;
    { const int k0 = lo * 64; const u32x4 kv = *(const u32x4*)(kg + (size_t)k0 * HD); const u32x4 vv = *(const u32x4*)(vg + k0);
      *(LAS u32x4*)(st + kst) = kv; *(LAS u32x4*)(st + vst) = vv; }
    __syncthreads();
#pragma unroll 1
    for (int s = 0; s < nsteps; ++s) {
        const int kc = lo + (s >> 1), k0 = kc * 64 + (s & 1) * 32;
        const int sn = s + 1 < nsteps ? s + 1 : s;
        const int k0n = (lo + (sn >> 1)) * 64 + (sn & 1) * 32;
        const u32x4 kv = *(const u32x4*)(kg + (size_t)k0n * HD); const u32x4 vv = *(const u32x4*)(vg + k0n);
        const LAS unsigned char* sb = st + (s & 1) * 16384;
        if (kc >= c - 8 && kc <= c) {
            if (kc <= c - 3) ATT_COMPUTE(true); else ATT_COMPUTE(false);
        }
        LAS unsigned char* nb = st + ((s + 1) & 1) * 16384;
        *(LAS u32x4*)(nb + kst) = kv; *(LAS u32x4*)(nb + vst) = vv;
        __syncthreads();
    }
#pragma unroll
    for (int qt = 0; qt < 2; ++qt) {
        float l = lrun[qt]; l += __shfl_xor(l, 16); l += __shfl_xor(l, 32);
        const float inv = 1.0f / l;
        bf16_t* op = yraw + ((size_t)b * SEQ + c * 64 + qh * 32 + qt * 16 + fr) * D + 1024 + h * HD + 4 * fq;
        float q = 0.f;
#pragma unroll
        for (int dt = 0; dt < 8; ++dt) { const f32x4 o = O[dt][qt] * inv; u32x2 w; w.x = cvt_pk_bf16(o.x, o.y); w.y = cvt_pk_bf16(o.z, o.w); *(u32x2*)(op + dt * 16) = w; q += (o.x * o.x + o.y * o.y) + (o.z * o.z + o.w * o.w); }
        q += __shfl_xor(q, 16); q += __shfl_xor(q, 32);
        if (fq == 0) yp[((size_t)b * SEQ + c * 64 + qh * 32 + qt * 16 + fr) * 24 + 16 + h] = q;
    }
}
#undef ATT_COMPUTE

#define XB_TMO      128
#define XB_XCNT(j)  (256  + 64 * (j))
#define XB_XSUB(j)  (1280 + 64 * (j))
#define XB_XGEN(j)  (2304 + 64 * (j))
#define XB_TOP      3328
#define XB_TOPGEN   3392
#define XCD_BAR_WORDS 3456
#define XB_SPIN_CAP (1u << 18)
__device__ __forceinline__ unsigned xb_ld(unsigned* p)              { return __hip_atomic_load(p, __ATOMIC_RELAXED, __HIP_MEMORY_SCOPE_AGENT); }
__device__ __forceinline__ unsigned xb_add(unsigned* p, unsigned v) { return __hip_atomic_fetch_add(p, v, __ATOMIC_RELAXED, __HIP_MEMORY_SCOPE_AGENT); }
__device__ __forceinline__ unsigned xb_xcc_id() { return (unsigned)__builtin_amdgcn_s_getreg((3 << 11) | 20) & 0xFu; }
#define XB_SPIN(cond, bar) do { unsigned _sp = 0; while (cond) { __builtin_amdgcn_s_sleep(1); \
    if ((++_sp & 255u) == 0u) { if (xb_ld(&(bar)[XB_TMO])) break; if (_sp > XB_SPIN_CAP) { atomicAdd(&(bar)[XB_TMO], 1u); break; } } } } while (0)
struct XcdBarrier { unsigned* bar; unsigned x; volatile LAS unsigned* st; };
__device__ __forceinline__ XcdBarrier xcd_barrier_post(unsigned* bar, volatile LAS unsigned* st) {
    XcdBarrier b; b.bar = bar; b.x = xb_xcc_id(); b.st = st;
    if (threadIdx.x == 0) (void)xb_add(&bar[XB_XCNT(b.x)], 1u);
    return b;
}
__device__ __forceinline__ void xcd_barrier_complete(unsigned* bar, unsigned x, unsigned& nloc, unsigned& nx) {
    const unsigned G = gridDim.x * gridDim.y * gridDim.z;
    unsigned sum, cnt, mine, sp = 0u;
    for (;;) {
        sum = 0u; cnt = 0u; mine = 0u;
#pragma unroll
        for (unsigned j = 0; j < 16; ++j) { const unsigned c = xb_ld(&bar[XB_XCNT(j)]); sum += c; cnt += (c > 0u) ? 1u : 0u; mine = (j == x) ? c : mine; }
        if (sum == G) break;
        __builtin_amdgcn_s_sleep(1);
        if ((++sp & 255u) == 0u) { if (xb_ld(&bar[XB_TMO])) break; if (sp > XB_SPIN_CAP) { atomicAdd(&bar[XB_TMO], 1u); break; } }
    }
    nloc = mine > 0u ? mine : 1u; nx = cnt > 0u ? cnt : 1u;
}
__device__ __forceinline__ void xcd_barrier(const XcdBarrier& b) {
    asm volatile("s_waitcnt vmcnt(0)" ::: "memory");
    __syncthreads();
    if (threadIdx.x == 0) {
        unsigned* bar = b.bar;
        __builtin_amdgcn_s_waitcnt(0);
        unsigned nloc = b.st[0], nx = b.st[1];
        if (nloc == 0u) { xcd_barrier_complete(bar, b.x, nloc, nx); b.st[0] = nloc; b.st[1] = nx; }
        const unsigned old = xb_add(&bar[XB_XSUB(b.x)], 1u);
        const unsigned gen = old / nloc;
        if (old + 1u == (gen + 1u) * nloc) {
            __builtin_amdgcn_fence(__ATOMIC_RELEASE, "agent");
            asm volatile("s_waitcnt vmcnt(0)" ::: "memory");
            const unsigned og = xb_add(&bar[XB_TOP], 1u);
            const unsigned tg = og / nx;
            if (og + 1u == (tg + 1u) * nx) xb_add(&bar[XB_TOPGEN], 1u);
            else XB_SPIN(xb_ld(&bar[XB_TOPGEN]) == tg, bar);
            __builtin_amdgcn_fence(__ATOMIC_ACQUIRE, "agent");
            xb_add(&bar[XB_XGEN(b.x)], 1u);
            asm volatile("s_waitcnt vmcnt(0)" ::: "memory");
        } else {
            XB_SPIN(xb_ld(&bar[XB_XGEN(b.x)]) == gen, bar);
            __builtin_amdgcn_fence(__ATOMIC_ACQUIRE, "agent");
            asm volatile("s_waitcnt vmcnt(0)" ::: "memory");
        }
    }
    __syncthreads();
}

struct Args { const float* in[23]; float* out; unsigned char* ws; int pad0, pad1; };

__global__ void __launch_bounds__(NTHREADS, 2) mk_fwd(Args args) {
    extern __shared__ __attribute__((aligned(16))) unsigned char lds_raw[];
    LAS unsigned char* lds = (LAS unsigned char*)lds_raw;
    cg::grid_group grid = cg::this_grid();
    const int tid = threadIdx.x, lane = tid & 63, wave = __builtin_amdgcn_readfirstlane(tid >> 6);
    const int G = gridDim.x, bx = blockIdx.x;
    const int gw = bx * NWAVES + wave, NGW = G * NWAVES;
    typedef const float* cfp;
    const __attribute__((address_space(4))) cfp* inp = (const __attribute__((address_space(4))) cfp*)__builtin_amdgcn_kernarg_segment_ptr();
#define INP(k) (inp[k])
#define LAUNDER_S(v) asm volatile("" : "+s"(v))
    unsigned char* ws = args.ws;
    float* out = args.out;
    volatile LAS unsigned* bst = (volatile LAS unsigned*)(lds + 131072 + 64);
    if (tid < 2) bst[tid] = 0u;
    __syncthreads();
    (void)xcd_barrier_post((unsigned*)(ws + WS_CTL), bst);
#define GRID_BAR() do { XcdBarrier xb_; xb_.bar = (unsigned*)(args.ws + WS_CTL); xb_.x = xb_xcc_id(); xb_.st = (volatile LAS unsigned*)(lds + 131072 + 64); xcd_barrier(xb_); } while (0)
    bf16_t* HID = (bf16_t*)(ws + WS_BIG); bf16_t* ZM = (bf16_t*)(ws + WS_BIG); bf16_t* VT = (bf16_t*)(ws + WS_VT); bf16_t* KH = (bf16_t*)(ws + WS_KH); bf16_t* HB = (bf16_t*)(ws + WS_H); bf16_t* HB2 = (bf16_t*)(ws + WS_H2); float* SSQ = (float*)(ws + WS_SSQ); float* YP = (float*)(ws + WS_YP);

    {
        LAS float* scr = (LAS float*)(lds + wave * 16384);
        constexpr int I_G = (D / 64) * (FF / 32), I_D = (FF / 64) * (D / 32), I_IN = (D / 64) * (DIN / 32), I_O = (D / 64) * (D / 32);
        constexpr int PER_LAYER = 4 * I_G + 2 * I_D + I_IN + I_O;
        for (int it = gw; it < DEPTH * PER_LAYER; it += NGW) {
            const int l = it / PER_LAYER; int r = it % PER_LAYER;
            unsigned char* wl = ws + (size_t)l * LAYER_W;
            if (r < I_G) { p0_transpose_item(INP(2) + (size_t)l * D * FF, INP(1) + (size_t)l * D, D, FF, (bf16_t*)(wl + OFF_WGU1), 0, scr, r, lane); continue; } r -= I_G;
            if (r < I_G) { p0_transpose_item(INP(3) + (size_t)l * D * FF, INP(1) + (size_t)l * D, D, FF, (bf16_t*)(wl + OFF_WGU1), 128, scr, r, lane); continue; } r -= I_G;
            if (r < I_D) { p0_transpose_item(INP(4) + (size_t)l * FF * D, nullptr, FF, D, (bf16_t*)(wl + OFF_WD1), -1, scr, r, lane); continue; } r -= I_D;
            if (r < I_IN) { p0_transpose_item(INP(6) + (size_t)l * D * DIN, INP(5) + (size_t)l * D, D, DIN, (bf16_t*)(wl + OFF_WIN), -1, scr, r, lane); continue; } r -= I_IN;
            if (r < I_O) { p0_transpose_item(INP(17) + (size_t)l * D * D, INP(15) + (size_t)l * DL, D, D, (bf16_t*)(wl + OFF_WOUT), -1, scr, r, lane, INP(16) + (size_t)l * DL); continue; } r -= I_O;
            if (r < I_G) { p0_transpose_item(INP(19) + (size_t)l * D * FF, INP(18) + (size_t)l * D, D, FF, (bf16_t*)(wl + OFF_WGU2), 0, scr, r, lane); continue; } r -= I_G;
            if (r < I_G) { p0_transpose_item(INP(20) + (size_t)l * D * FF, INP(18) + (size_t)l * D, D, FF, (bf16_t*)(wl + OFF_WGU2), 128, scr, r, lane); continue; } r -= I_G;
            p0_transpose_item(INP(21) + (size_t)l * FF * D, nullptr, FF, D, (bf16_t*)(wl + OFF_WD2), -1, scr, r, lane);
        }
        cast_rows_bf16(INP(0), HB, SSQ, gw, NGW, lane);
    }
    grid.sync();

#pragma unroll 1
    for (int l = 0; l < DEPTH; ++l) {
        unsigned char* wl = ws + (size_t)l * LAYER_W;
#pragma unroll 1
        for (int f = 0; f < 2; ++f) {
            LAUNDER_S(inp);
            {
                pg8::Gemm g{HB, (const bf16_t*)(wl + (f ? OFF_WGU2 : OFF_WGU1)), M, 2 * FF, D}; pg8::StaticOrder S; S.init(M, 2 * FF, G, bx);
                { if (tid == 0) *(volatile LAS int*)(lds + pg8::LDS_RSPM) = -1; __syncthreads(); }
                pg8::EpiSwiGLU E{HID, FF, SSQ + (size_t)(3 * l + (f ? 2 : 0)) * M * 8, lds};
                pg8::gemm_phase<pg8::EpiSwiGLU, pg8::StaticOrder, true, true>(lds, g, S, E);
            }
            GRID_BAR();
            {
                pg8::Gemm g{HID, (const bf16_t*)(wl + (f ? OFF_WD2 : OFF_WD1)), M, D, FF}; pg8::StaticOrder S; S.init(M, D, G, bx);
                pg8::EpiResid<true> E{HB, SSQ + (size_t)(3 * l + (f ? 3 : 1)) * M * 8, lds};
                pg8::gemm_phase<pg8::EpiResid<true>, pg8::StaticOrder, true, true>(lds, g, S, E);
            }
            GRID_BAR();
            if (f == 0) {
                {
                    pg8::Gemm g{HB, (const bf16_t*)(wl + OFF_WIN), M, DIN, D}; pg8::StaticOrder S; S.init(M, DIN, G, bx);
                    { if (tid == 0) *(volatile LAS int*)(lds + pg8::LDS_RSPM) = -1; __syncthreads(); }
                    pg8::EpiZ E{ZM, VT, KH, SSQ + (size_t)(3 * l + 1) * M * 8, lds};
                    pg8::gemm_phase<pg8::EpiZ, pg8::StaticOrder, true, true>(lds, g, S, E);
                }
                GRID_BAR();
                {
                    LAS float* biasL = (LAS float*)(lds + LM_BIAS);
                    const float* rb = INP(14) + (size_t)l * NH * NREL;
                    int tid_m = tid; LAUNDER(tid_m);
                    for (int i = tid_m; i < NH * NREL; i += NTHREADS) biasL[i] = rb[i] * LOG2E;
                    __syncthreads();
                    for (int u = bx; u < NB * 16; u += G)
                        lru_unit(lds, ZM, HB2, YP, INP(7) + (size_t)l * 4 * DL, INP(8) + (size_t)l * DL, INP(9) + (size_t)l * 16 * 64 * 64, INP(10) + (size_t)l * DL,
                                 INP(11) + (size_t)l * 16 * 64 * 64, INP(12) + (size_t)l * DL, INP(13) + (size_t)l * DL, u >> 4, u & 15, tid);
                    for (int bu = bx; bu < 1024; bu += G) {
                        const int kk = bu >> 8, bxv = bu & 255;
                        const int ag = ((bxv & 7) + 2 * kk) & 7, ap = (bxv >> 3) + 32 * kk;
                        attn_block(lds, ZM, KH, VT, HB2, YP, biasL, ap >> 3, ap & 7, ag, tid);
                    }
                }
                GRID_BAR();
                {
                    pg8::Gemm g{HB2, (const bf16_t*)(wl + OFF_WOUT), M, D, D}; pg8::StaticOrder S; S.init(M, D, G, bx);
                    { if (tid == 0) *(volatile LAS int*)(lds + pg8::LDS_RS2PM) = -1; __syncthreads(); }
                    pg8::EpiResidY E{HB, SSQ + (size_t)(3 * l + 2) * M * 8, YP, lds};
                    { pg8::Unit u0; if (S.next(0, u0)) E.prep(u0); }
                    pg8::gemm_phase<pg8::EpiResidY, pg8::StaticOrder, true, true>(lds, g, S, E);
                }
                GRID_BAR();
            } else {
                if (l + 1 == DEPTH) rms_rows_bf16_to_f32(HB, INP(22), out, gw, NGW, lane);
            }
        }
    }
}

extern "C" void kernel_launch(void* const* d_in, const int* in_sizes, int n_in, void* d_out, int out_size, void* d_ws, size_t ws_size, hipStream_t stream) {
    static int grid = 0;
    if (grid == 0) {
        if (n_in != 23 || in_sizes[0] != M * D || out_size != M * D || ws_size < WS_END) {
            fprintf(stderr, "kernel_launch: unexpected shapes: n_in %d in0 %d out %d ws %zu (need %zu)\n", n_in, n_in > 0 ? in_sizes[0] : -1, out_size, ws_size, (size_t)WS_END); grid = -1; return; }
        int dev = 0, cus = 0, per_cu = 0;
        hipGetDevice(&dev); hipDeviceGetAttribute(&cus, hipDeviceAttributeMultiprocessorCount, dev);
        if (hipFuncSetAttribute((const void*)mk_fwd, hipFuncAttributeMaxDynamicSharedMemorySize, LDS_BYTES) != hipSuccess) fprintf(stderr, "kernel_launch: hipFuncSetAttribute failed\n");
        if (hipOccupancyMaxActiveBlocksPerMultiprocessor(&per_cu, (const void*)mk_fwd, NTHREADS, LDS_BYTES) != hipSuccess || per_cu < 1) { fprintf(stderr, "kernel_launch: occupancy query gave %d\n", per_cu); per_cu = 1; }
        (void)hipGetLastError();
        grid = cus * per_cu;
        if (grid > 256) grid = 256;
    }
    if (grid < 0) return;
    (void)hipMemsetAsync((char*)d_ws + WS_CTL, 0, CTL_BYTES, stream);
    Args a{};
    for (int i = 0; i < 23; ++i) a.in[i] = (const float*)d_in[i];
    a.out = (float*)d_out; a.ws = (unsigned char*)d_ws;
    void* kargs[] = {&a};
    hipError_t e = hipLaunchCooperativeKernel((const void*)mk_fwd, dim3(grid), dim3(NTHREADS), kargs, LDS_BYTES, stream);
    if (e != hipSuccess) fprintf(stderr, "kernel_launch: cooperative launch failed: %s (grid %d)\n", hipGetErrorString(e), grid);
}
```

```cpp
#include <hip/hip_runtime.h>
#include <hip/hip_cooperative_groups.h>
#include <cstdio>
#include <cstdint>
namespace cg = cooperative_groups;

#define LAS __attribute__((address_space(3)))
#define LAUNDER(v) asm volatile("" : "+v"(v))
typedef unsigned short bf16_t;
typedef short bf16x8 __attribute__((ext_vector_type(8)));
typedef float f32x4 __attribute__((ext_vector_type(4)));
typedef float f32x2 __attribute__((ext_vector_type(2)));
typedef unsigned u32x4 __attribute__((ext_vector_type(4)));
typedef unsigned u32x2 __attribute__((ext_vector_type(2)));

constexpr int NB = 16, SEQ = 2048, M = NB * SEQ, D = 2048, FF = 5632, DIN = 5120, DL = 1024, NH = 8, HD = 128, NREL = 257, DEPTH = 2;
constexpr int ZLD = 3072;
constexpr float EPS = 1e-6f;
constexpr float LOG2E = 1.4426950408889634f;

constexpr size_t MiB = 1u << 20;
constexpr size_t SZ_WGU = (size_t)2 * FF * D * 2, SZ_WD = (size_t)D * FF * 2, SZ_WIN = (size_t)DIN * D * 2, SZ_WOUT = (size_t)D * D * 2;
constexpr size_t OFF_WGU1 = 0, OFF_WD1 = OFF_WGU1 + SZ_WGU, OFF_WIN = OFF_WD1 + SZ_WD, OFF_WOUT = OFF_WIN + SZ_WIN, OFF_WGU2 = OFF_WOUT + SZ_WOUT, OFF_WD2 = OFF_WGU2 + SZ_WGU;
constexpr size_t LAYER_W = OFF_WD2 + SZ_WD;
static_assert(LAYER_W == 160 * MiB, "weights per layer");
constexpr size_t WS_BIG = 2 * LAYER_W;
constexpr size_t WS_VT = WS_BIG + (size_t)M * ZLD * 2;
constexpr size_t WS_KH = WS_VT + (size_t)M * 1024 * 2;
constexpr size_t WS_H = WS_BIG + 352 * MiB;
constexpr size_t WS_H2 = WS_H + 128 * MiB;
constexpr size_t WS_SSQ = WS_H2 + 128 * MiB;
constexpr size_t WS_YP = WS_SSQ + 8 * MiB;
constexpr size_t WS_CTL = WS_YP + 4 * MiB;
constexpr size_t CTL_BYTES = 16384;
constexpr size_t WS_END = WS_CTL + 1 * MiB;
static_assert((size_t)M * FF * 2 == 352 * MiB, "hidden size");

constexpr int NWAVES = 8, NTHREADS = 512;
constexpr int LDS_BYTES = 147456;

__device__ __forceinline__ unsigned cvt_pk_bf16(float lo, float hi) { unsigned r; asm volatile("v_cvt_pk_bf16_f32 %0, %1, %2" : "=v"(r) : "v"(lo), "v"(hi)); return r; }
__device__ __forceinline__ float bf_lo(unsigned u) { return __uint_as_float(u << 16); }
__device__ __forceinline__ float bf_hi(unsigned u) { return __uint_as_float(u & 0xffff0000u); }
__device__ __forceinline__ float fast_exp2(float x) { return __builtin_amdgcn_exp2f(x); }
__device__ __forceinline__ float fast_rcp(float x) { return __builtin_amdgcn_rcpf(x); }
__device__ __forceinline__ float sigmoidf_(float x) { return fast_rcp(1.0f + fast_exp2(-LOG2E * x)); }

namespace pg8 {
constexpr int BM = 256, BK = 64, HALF = 128, HTB = HALF * BK * 2, STAGE_BYTES = 8 * HTB, NXCD = 8, WGM = 8;
__host__ __device__ __forceinline__ int lds_byte(int r, int c) { const int st = (r >> 4) * 2 + (c >> 5), rr = r & 15, cc = c & 31, ob = rr * 64 + cc * 2; return st * 1024 + (ob ^ (((ob >> 9) & 1) << 5)); }
__host__ __device__ __forceinline__ void stage_rc(int b, int& R, int& C) { const int st = b / 1024, sb = b % 1024, swz = sb ^ (((sb >> 9) & 1) << 5); R = (st >> 1) * 16 + swz / 64; C = (st & 1) * 32 + (swz % 64) / 2; }
__host__ __device__ __forceinline__ int perm32(int rho) { const int n = rho >> 4, i = rho & 15; return 8 * (i >> 2) + 4 * n + (i & 3); }

struct Unit { int pm, pn; };
struct Gemm { const bf16_t* A; const bf16_t* Bt; int M, N, K; };

struct StaticOrder {
    int nM, nN, nwg, G, c;
    __host__ __device__ void init(int M_, int N_, int G_, int c_) { nM = M_ / BM; nN = N_ / BM; nwg = nM * nN; G = G_; c = c_; }
    __host__ __device__ bool next(int i, Unit& u) const {
        const long L = (long)i * G + c; if (L >= nwg) return false;
        int wgid = (int)L; { const int q = nwg / NXCD, r = nwg % NXCD, xcd = wgid % NXCD, off = wgid / NXCD; wgid = (xcd < r ? xcd * (q + 1) : r * (q + 1) + (xcd - r) * q) + off; }
        const int nig = WGM * nN, gid = wgid / nig, fm = gid * WGM, gsz = (nM - fm) < WGM ? (nM - fm) : WGM;
        u.pm = fm + ((wgid % nig) % gsz); u.pn = (wgid % nig) / gsz; return true;
    }
    __device__ __forceinline__ void a_ready(const Unit&) const {}
    __device__ __forceinline__ void done(const Unit&) const {}
};


constexpr int LDS_RS = 131072 + 1024, LDS_RSPM = 131072 + 2048 + 64, LDS_SSP = 131072 + 4096;
__device__ __forceinline__ void rs_panel(LAS unsigned char* lds, const float* ssq, int pm) {
    volatile LAS int* pmL = (volatile LAS int*)(lds + LDS_RSPM); LAS float* rsL = (LAS float*)(lds + LDS_RS);
    if (pmL[0] != pm) {
        asm volatile("s_waitcnt lgkmcnt(0)" ::: "memory"); __builtin_amdgcn_s_barrier();
        const int t = threadIdx.x;
        if (t < 256) { const f32x4* pp = (const f32x4*)(ssq + (size_t)(pm * 256 + t) * 8); const f32x4 pa = pp[0], pb = pp[1];
            rsL[t] = __builtin_amdgcn_rsqf((((pa.x + pa.y) + (pa.z + pa.w)) + ((pb.x + pb.y) + (pb.z + pb.w))) * (1.0f / D) + EPS); }
        if (t == 0) pmL[0] = pm;
        asm volatile("s_waitcnt vmcnt(0) lgkmcnt(0)" ::: "memory"); __builtin_amdgcn_s_barrier();
    }
}
struct EpiSwiGLU {
    static constexpr bool PERM = true, AFTER_DRAIN = false, MIDK = false;
    bf16_t* O; int ldc; const float* ssq; LAS unsigned char* lds;
    __device__ __forceinline__ void operator()(const f32x4 (&acc)[2][2][4][2], const Unit& u, int wr, int wc, int fr, int fq) const {
        rs_panel(lds, ssq, u.pm);
        const LAS float* rsL = (const LAS float*)(lds + LDS_RS) + wr * 64 + fr;
        const int row0 = u.pm * BM + wr * 64 + fr; const int col0 = u.pn * HALF + wc * 32 + 8 * fq;
#pragma unroll
        for (int ai = 0; ai < 2; ++ai)
#pragma unroll
            for (int m = 0; m < 4; ++m) {
                bf16_t* rowp = O + (size_t)(row0 + ai * HALF + m * 16) * ldc + col0;
                const float rs = rsL[ai * HALF + m * 16];
                float v[8];
#pragma unroll
                for (int n = 0; n < 2; ++n)
#pragma unroll
                    for (int i = 0; i < 4; ++i) { const float g = acc[ai][0][m][n][i] * rs, up = acc[ai][1][m][n][i] * rs; v[n * 4 + i] = g * sigmoidf_(g) * up; }
                u32x4 w; w.x = cvt_pk_bf16(v[0], v[1]); w.y = cvt_pk_bf16(v[2], v[3]); w.z = cvt_pk_bf16(v[4], v[5]); w.w = cvt_pk_bf16(v[6], v[7]);
                *(u32x4*)rowp = w;
            }
    }
};
template <bool HALFSC> struct EpiResid {
    static constexpr bool PERM = false, AFTER_DRAIN = false, MIDK = false;
    bf16_t* xb; float* ssq_part; LAS unsigned char* lds;
    __device__ __forceinline__ void operator()(const f32x4 (&acc)[2][2][4][2], const Unit& u, int wr, int wc, int fr, int fq) const {
        const float scale_ = HALFSC ? 0.5f : 1.0f; bf16_t* const xb_ = xb; float* const ssq_ = ssq_part;
        LAS float* pl = (LAS float*)(lds + LDS_SSP);
        const int col0 = u.pn * BM + wc * 32 + 4 * fq;
        const size_t base = (size_t)(u.pm * BM + wr * 64 + fr) * D + col0;
        u32x2 r[2][2][2][2];
#define ER_LOAD(buf, bb) do { _Pragma("unroll") for (int mm = 0; mm < 2; ++mm) _Pragma("unroll") for (int bj = 0; bj < 2; ++bj) _Pragma("unroll") for (int n = 0; n < 2; ++n) \
            r[buf][mm][bj][n] = *(const u32x2*)(xb_ + base + (size_t)(((bb) >> 1) * HALF + (((bb) & 1) * 2 + mm) * 16) * D + bj * HALF + n * 16); } while (0)
        ER_LOAD(0, 0);
#pragma unroll
        for (int bb = 0; bb < 4; ++bb) {
            if (bb < 3) ER_LOAD((bb + 1) & 1, bb + 1);
            const int ai = bb >> 1;
#pragma unroll
            for (int mm = 0; mm < 2; ++mm) { const int m = (bb & 1) * 2 + mm; const int rowl = ai * HALF + m * 16; const size_t off = base + (size_t)rowl * D; float ssum = 0.f;
#pragma unroll
                for (int bj = 0; bj < 2; ++bj)
#pragma unroll
                    for (int n = 0; n < 2; ++n) { const u32x2 rr = r[bb & 1][mm][bj][n]; const f32x4 a = acc[ai][bj][m][n];
                        const float o0 = bf_lo(rr.x) + a.x * scale_, o1 = bf_hi(rr.x) + a.y * scale_, o2 = bf_lo(rr.y) + a.z * scale_, o3 = bf_hi(rr.y) + a.w * scale_;
                        u32x2 w; w.x = cvt_pk_bf16(o0, o1); w.y = cvt_pk_bf16(o2, o3); *(u32x2*)(xb_ + off + bj * HALF + n * 16) = w;
                        ssum += (o0 * o0 + o1 * o1) + (o2 * o2 + o3 * o3); }
                ssum += __shfl_xor(ssum, 16); ssum += __shfl_xor(ssum, 32);
                if (fq == 0) pl[(rowl + wr * 64 + fr) * 4 + wc] = ssum;
            }
        }
#undef ER_LOAD
        asm volatile("s_waitcnt lgkmcnt(0)" ::: "memory"); __builtin_amdgcn_s_barrier();
        const int t = threadIdx.x;
        if (t < 256) { const f32x4 p = *(const LAS f32x4*)(pl + t * 4); ssq_[(size_t)(u.pm * BM + t) * 8 + u.pn] = (p.x + p.y) + (p.z + p.w); }
    }
};
constexpr int LDS_RS2 = 131072 + 8192, LDS_RS2PM = 131072 + 8192 + 2048 + 64;
__device__ __forceinline__ void rs2_panel(LAS unsigned char* lds, const float* yp, int pm) {
    volatile LAS int* pmL = (volatile LAS int*)(lds + LDS_RS2PM); LAS f32x2* rsL = (LAS f32x2*)(lds + LDS_RS2);
    if (pmL[0] != pm) {
        asm volatile("s_waitcnt lgkmcnt(0)" ::: "memory"); __builtin_amdgcn_s_barrier();
        const int t = threadIdx.x;
        if (t < 256) { const f32x4* pp = (const f32x4*)(yp + (size_t)(pm * 256 + t) * 24);
            const f32x4 a0 = pp[0], a1 = pp[1], a2 = pp[2], a3 = pp[3], b0 = pp[4], b1 = pp[5];
            const float sl = (((a0.x + a0.y) + (a0.z + a0.w)) + ((a1.x + a1.y) + (a1.z + a1.w))) + (((a2.x + a2.y) + (a2.z + a2.w)) + ((a3.x + a3.y) + (a3.z + a3.w)));
            const float sa = ((b0.x + b0.y) + (b0.z + b0.w)) + ((b1.x + b1.y) + (b1.z + b1.w));
            const float va = sa * (1.0f / 1024.f) + EPS, vl = sl * (1.0f / 1024.f) + EPS;
            rsL[t] = (f32x2){__builtin_amdgcn_rsqf(va), __builtin_amdgcn_rsqf(vl) * sqrtf(va)}; }
        if (t == 0) pmL[0] = pm;
        asm volatile("s_waitcnt vmcnt(0) lgkmcnt(0)" ::: "memory"); __builtin_amdgcn_s_barrier();
    }
}
struct EpiResidY {
    static constexpr bool PERM = false, AFTER_DRAIN = false, MIDK = true;
    bf16_t* xb; float* ssq_part; const float* yp; LAS unsigned char* lds;
    __device__ __forceinline__ void prep(const Unit& u) const { rs2_panel(lds, yp, u.pm); }
    __device__ __forceinline__ void mid(f32x4 (&acc)[2][2][4][2], const Unit& u, int wr, int wc, int fr, int fq) const {
        const LAS f32x2* rsL = (const LAS f32x2*)(lds + LDS_RS2) + wr * 64 + fr;
#pragma unroll
        for (int ai = 0; ai < 2; ++ai)
#pragma unroll
            for (int m = 0; m < 4; ++m) { const float q = rsL[ai * HALF + m * 16].y;
#pragma unroll
                for (int bj = 0; bj < 2; ++bj)
#pragma unroll
                    for (int n = 0; n < 2; ++n) acc[ai][bj][m][n] = acc[ai][bj][m][n] * q; }
    }
    __device__ __forceinline__ void operator()(const f32x4 (&acc)[2][2][4][2], const Unit& u, int wr, int wc, int fr, int fq) const {
        bf16_t* const xb_ = xb; float* const ssq_ = ssq_part;
        LAS float* pl = (LAS float*)(lds + LDS_SSP);
        const LAS f32x2* rsL = (const LAS f32x2*)(lds + LDS_RS2) + wr * 64 + fr;
        const int col0 = u.pn * BM + wc * 32 + 4 * fq;
        const size_t base = (size_t)(u.pm * BM + wr * 64 + fr) * D + col0;
        u32x2 r[2][2][2][2];
#define ER_LOAD(buf, bb) do { _Pragma("unroll") for (int mm = 0; mm < 2; ++mm) _Pragma("unroll") for (int bj = 0; bj < 2; ++bj) _Pragma("unroll") for (int n = 0; n < 2; ++n) \
            r[buf][mm][bj][n] = *(const u32x2*)(xb_ + base + (size_t)(((bb) >> 1) * HALF + (((bb) & 1) * 2 + mm) * 16) * D + bj * HALF + n * 16); } while (0)
        ER_LOAD(0, 0);
#pragma unroll
        for (int bb = 0; bb < 4; ++bb) {
            if (bb < 3) ER_LOAD((bb + 1) & 1, bb + 1);
            const int ai = bb >> 1;
#pragma unroll
            for (int mm = 0; mm < 2; ++mm) { const int m = (bb & 1) * 2 + mm; const int rowl = ai * HALF + m * 16; const size_t off = base + (size_t)rowl * D; float ssum = 0.f;
                const float scale_ = rsL[rowl].x;
#pragma unroll
                for (int bj = 0; bj < 2; ++bj)
#pragma unroll
                    for (int n = 0; n < 2; ++n) { const u32x2 rr = r[bb & 1][mm][bj][n]; const f32x4 a = acc[ai][bj][m][n];
                        const float o0 = bf_lo(rr.x) + a.x * scale_, o1 = bf_hi(rr.x) + a.y * scale_, o2 = bf_lo(rr.y) + a.z * scale_, o3 = bf_hi(rr.y) + a.w * scale_;
                        u32x2 w; w.x = cvt_pk_bf16(o0, o1); w.y = cvt_pk_bf16(o2, o3); *(u32x2*)(xb_ + off + bj * HALF + n * 16) = w;
                        ssum += (o0 * o0 + o1 * o1) + (o2 * o2 + o3 * o3); }
                ssum += __shfl_xor(ssum, 16); ssum += __shfl_xor(ssum, 32);
                if (fq == 0) pl[(rowl + wr * 64 + fr) * 4 + wc] = ssum;
            }
        }
#undef ER_LOAD
        asm volatile("s_waitcnt lgkmcnt(0)" ::: "memory"); __builtin_amdgcn_s_barrier();
        const int t = threadIdx.x;
        if (t < 256) { const f32x4 p = *(const LAS f32x4*)(pl + t * 4); ssq_[(size_t)(u.pm * BM + t) * 8 + u.pn] = (p.x + p.y) + (p.z + p.w); }
    }
};
struct EpiZ {
    static constexpr bool PERM = true, AFTER_DRAIN = false, MIDK = false;
    bf16_t* Z; bf16_t* Vt; bf16_t* Kh; const float* ssq; LAS unsigned char* lds;
    __device__ __forceinline__ void operator()(const f32x4 (&acc)[2][2][4][2], const Unit& u, int wr, int wc, int fr, int fq) const {
        rs_panel(lds, ssq, u.pm);
        float rs[2][4];
        { const LAS float* rsL = (const LAS float*)(lds + LDS_RS) + wr * 64 + fr;
#pragma unroll
          for (int ai = 0; ai < 2; ++ai)
#pragma unroll
            for (int m = 0; m < 4; ++m) rs[ai][m] = rsL[ai * HALF + m * 16]; }
        if (u.pn >= 12 && u.pn < 16) {
            const int b = (u.pm * BM) / SEQ; const int s0 = (u.pm * BM) % SEQ + wr * 64 + fr;
#pragma unroll
            for (int bj = 0; bj < 2; ++bj) {
                const int head = (u.pn - 12) * 2 + bj;
                bf16_t* hb = Kh + ((size_t)(b * NH + head) * SEQ + s0) * HD + wc * 32 + 8 * fq;
#pragma unroll
                for (int ai = 0; ai < 2; ++ai)
#pragma unroll
                    for (int m = 0; m < 4; ++m) { const f32x4 v0 = acc[ai][bj][m][0] * rs[ai][m], v1 = acc[ai][bj][m][1] * rs[ai][m];
                        u32x4 w; w.x = cvt_pk_bf16(v0[0], v0[1]); w.y = cvt_pk_bf16(v0[2], v0[3]); w.z = cvt_pk_bf16(v1[0], v1[1]); w.w = cvt_pk_bf16(v1[2], v1[3]);
                        *(u32x4*)(hb + (size_t)(ai * HALF + m * 16) * HD) = w; }
            }
        } else if (u.pn < 12) {
            const int row0 = u.pm * BM + wr * 64 + fr; const int col0 = u.pn * BM + wc * 32 + 8 * fq;
#pragma unroll
            for (int ai = 0; ai < 2; ++ai)
#pragma unroll
                for (int m = 0; m < 4; ++m) {
                    bf16_t* rowp = Z + (size_t)(row0 + ai * HALF + m * 16) * ZLD + col0;
#pragma unroll
                    for (int bj = 0; bj < 2; ++bj) { const f32x4 v0 = acc[ai][bj][m][0] * rs[ai][m], v1 = acc[ai][bj][m][1] * rs[ai][m];
                        u32x4 w; w.x = cvt_pk_bf16(v0[0], v0[1]); w.y = cvt_pk_bf16(v0[2], v0[3]); w.z = cvt_pk_bf16(v1[0], v1[1]); w.w = cvt_pk_bf16(v1[2], v1[3]);
                        *(u32x4*)(rowp + bj * HALF) = w; }
                }
        } else {
            const int b = (u.pm * BM) / SEQ; const int s0 = (u.pm * BM) % SEQ + wr * 64 + fr;
#pragma unroll
            for (int bj = 0; bj < 2; ++bj) {
                const int head = (u.pn - 16) * 2 + bj;
                bf16_t* hb = Vt + ((size_t)(b * NH + head) * HD + wc * 32 + 8 * fq) * SEQ + s0;
#pragma unroll
                for (int ai = 0; ai < 2; ++ai)
#pragma unroll
                    for (int m = 0; m < 4; ++m)
#pragma unroll
                        for (int n = 0; n < 2; ++n)
#pragma unroll
                            for (int i = 0; i < 4; ++i) {
                                const unsigned w = cvt_pk_bf16(acc[ai][bj][m][n][i] * rs[ai][m], 0.f);
                                hb[(size_t)(4 * n + i) * SEQ + ai * HALF + m * 16] = (bf16_t)(w & 0xffffu);
                            }
            }
        }
    }
};

template <class Epi, class Sched, bool ALIGN_EPI = false, bool SP2 = false>
__device__ __forceinline__ void gemm_phase(LAS unsigned char* lds, const Gemm g, const Sched& S, const Epi& E) {
    int tid_l = threadIdx.x; LAUNDER(tid_l);
    const int tid = tid_l, wid = __builtin_amdgcn_readfirstlane(tid >> 6), lane = tid & 63, wr = wid >> 2, wc = wid & 3, fr = lane & 15, fq = lane >> 4;
    const int K = g.K, nt = K / BK;
    unsigned voffA[2], voffB[2];
#pragma unroll
    for (int i = 0; i < 2; ++i) { int R, C; stage_rc(tid * 16 + i * 8192, R, C); const int Rb = Epi::PERM ? ((R & ~31) + perm32(R & 31)) : R;
        voffA[i] = (unsigned)(R * K + C) * 2u; voffB[i] = (unsigned)(Rb * K + C) * 2u; }
    const size_t kstep = (size_t)(BK * 2);
    const size_t hstep = (size_t)HALF * K * 2;
    const size_t tstep = 2 * hstep;
    const unsigned ldsw = (unsigned)wid * 1024u;
    const int aoff = lds_byte(wr * 64 + fr, fq * 8), boff = lds_byte(wc * 32 + fr, fq * 8);
#define PG8_SA(b, h) (((b) * 2 + (h)) * HTB)
#define PG8_SB(b, h) ((4 + (b) * 2 + (h)) * HTB)
#define PG8_STAGE(bufoff, gbase, voff) do { _Pragma("unroll") for (int _i = 0; _i < 2; ++_i) \
        __builtin_amdgcn_global_load_lds((const unsigned*)((const char*)(gbase) + (voff)[_i]), (LAS unsigned*)(lds + (bufoff) + ldsw + _i * 8192), 16, 0, 0); } while (0)
#define PG8_LDA(dst, b, h) do { _Pragma("unroll") for (int m = 0; m < 4; ++m) _Pragma("unroll") for (int k = 0; k < 2; ++k) dst[m][k] = *(const LAS bf16x8*)(lds + PG8_SA(b, h) + aoff + m * 2048 + k * 1024); } while (0)
#define PG8_LDB(dst, b, h) do { _Pragma("unroll") for (int n = 0; n < 2; ++n) _Pragma("unroll") for (int k = 0; k < 2; ++k) dst[n][k] = *(const LAS bf16x8*)(lds + PG8_SB(b, h) + boff + n * 2048 + k * 1024); } while (0)
#define PG8_MMA(ai, bj, At, Bt) do { __builtin_amdgcn_s_setprio(1); _Pragma("unroll") for (int m = 0; m < 4; ++m) _Pragma("unroll") for (int n = 0; n < 2; ++n) _Pragma("unroll") for (int k = 0; k < 2; ++k) \
        acc[ai][bj][m][n] = __builtin_amdgcn_mfma_f32_16x16x32_bf16(Bt[n][k], At[m][k], acc[ai][bj][m][n], 0, 0, 0); __builtin_amdgcn_s_setprio(0); } while (0)
#define PG8_WAIT_V(n) asm volatile("s_waitcnt vmcnt(" #n ")" ::: "memory")
#define PG8_WAIT_L(n) asm volatile("s_waitcnt lgkmcnt(" #n ")" ::: "memory")
#define PG8_BAR __builtin_amdgcn_s_barrier()
#define PG8_SCHED __builtin_amdgcn_sched_barrier(0)
    Unit cur, nxt; int ui = 0;
    if (!S.next(0, cur)) return;
    f32x4 acc[2][2][4][2];
#pragma unroll
    for (int a = 0; a < 2; ++a)
#pragma unroll
        for (int b = 0; b < 2; ++b)
#pragma unroll
            for (int m = 0; m < 4; ++m)
#pragma unroll
                for (int n = 0; n < 2; ++n) acc[a][b][m][n] = (f32x4){0.f, 0.f, 0.f, 0.f};
    bf16x8 At[4][2], B0[2][2], B1[2][2];
    const char* cA = (const char*)g.A + (size_t)cur.pm * tstep; const char* cB = (const char*)g.Bt + (size_t)cur.pn * tstep;
    S.a_ready(cur);
    if constexpr (SP2) {
        PG8_STAGE(PG8_SB(0, 0), cB, voffB); PG8_STAGE(PG8_SB(0, 1), cB + hstep, voffB); PG8_STAGE(PG8_SA(0, 0), cA, voffA); PG8_STAGE(PG8_SA(0, 1), cA + hstep, voffA);
        if (wr == 1) PG8_BAR;
        PG8_WAIT_V(2); PG8_BAR;
        PG8_STAGE(PG8_SB(1, 0), cB + kstep, voffB); PG8_STAGE(PG8_SA(1, 0), cA + kstep, voffA); PG8_STAGE(PG8_SB(1, 1), cB + hstep + kstep, voffB);
        PG8_WAIT_V(6); PG8_BAR;
    } else {
        PG8_STAGE(PG8_SB(0, 0), cB, voffB); PG8_STAGE(PG8_SA(0, 0), cA, voffA); PG8_STAGE(PG8_SB(0, 1), cB + hstep, voffB); PG8_STAGE(PG8_SA(0, 1), cA + hstep, voffA);
        if (wr == 1) PG8_BAR;
        PG8_WAIT_V(4); PG8_BAR;
        PG8_STAGE(PG8_SB(1, 0), cB + kstep, voffB); PG8_STAGE(PG8_SA(1, 0), cA + kstep, voffA); PG8_STAGE(PG8_SB(1, 1), cB + hstep + kstep, voffB);
        PG8_WAIT_V(6); PG8_BAR;
    }
    for (;;) {
        const bool has_next = S.next(ui + 1, nxt);
        const char* nA = has_next ? (const char*)g.A + (size_t)nxt.pm * tstep : cA; const char* nB = has_next ? (const char*)g.Bt + (size_t)nxt.pn * tstep : cB;
        for (int t = 0; t < nt; t += 2) {
            if constexpr (Epi::MIDK) { if (t == (nt >> 1)) E.mid(acc, cur, wr, wc, fr, fq); }
            const bool last = (t == nt - 2);
            const char* a1 = cA + (size_t)(t + 1) * kstep;
            const char* a2 = last ? nA : cA + (size_t)(t + 2) * kstep; const char* b2 = last ? nB : cB + (size_t)(t + 2) * kstep;
            const char* a3 = a2 + kstep; const char* b3 = b2 + kstep;
            if (last && has_next) S.a_ready(nxt);
            if constexpr (SP2) {
            PG8_LDB(B0, 0, 0); PG8_LDB(B1, 0, 1); PG8_SCHED; PG8_LDA(At, 0, 0); PG8_STAGE(PG8_SA(1, 1), a1 + hstep, voffA);
            PG8_WAIT_V(8); PG8_WAIT_L(0); PG8_BAR; PG8_MMA(0, 0, At, B0); PG8_MMA(0, 1, At, B1); PG8_BAR; PG8_SCHED;
            PG8_LDA(At, 0, 1); PG8_STAGE(PG8_SB(0, 0), b2, voffB); PG8_STAGE(PG8_SB(0, 1), b2 + hstep, voffB); PG8_STAGE(PG8_SA(0, 0), a2, voffA);
            PG8_WAIT_V(8); PG8_WAIT_L(0); PG8_BAR; PG8_MMA(1, 0, At, B0); PG8_MMA(1, 1, At, B1); PG8_BAR; PG8_SCHED;
            PG8_LDB(B0, 1, 0); PG8_LDB(B1, 1, 1); PG8_SCHED; PG8_LDA(At, 1, 0); PG8_STAGE(PG8_SA(0, 1), a2 + hstep, voffA);
            PG8_WAIT_V(8); PG8_WAIT_L(0); PG8_BAR; PG8_MMA(0, 0, At, B0); PG8_MMA(0, 1, At, B1); PG8_BAR; PG8_SCHED;
            PG8_LDA(At, 1, 1); PG8_STAGE(PG8_SB(1, 0), b3, voffB); PG8_STAGE(PG8_SB(1, 1), b3 + hstep, voffB); PG8_STAGE(PG8_SA(1, 0), a3, voffA);
            PG8_WAIT_V(8); PG8_WAIT_L(0); PG8_BAR; PG8_MMA(1, 0, At, B0); PG8_MMA(1, 1, At, B1); PG8_BAR; PG8_SCHED;
            } else {
            PG8_LDB(B0, 0, 0); PG8_SCHED; PG8_LDA(At, 0, 0); PG8_STAGE(PG8_SA(1, 1), a1 + hstep, voffA);
            PG8_WAIT_L(8); PG8_BAR; PG8_WAIT_L(0); PG8_MMA(0, 0, At, B0); PG8_BAR; PG8_SCHED;
            PG8_LDB(B1, 0, 1); PG8_STAGE(PG8_SB(0, 0), b2, voffB);
            PG8_BAR; PG8_WAIT_L(0); PG8_MMA(0, 1, At, B1); PG8_BAR;
            PG8_LDA(At, 0, 1); PG8_STAGE(PG8_SA(0, 0), a2, voffA);
            PG8_BAR; PG8_WAIT_L(0); PG8_MMA(1, 0, At, B0); PG8_BAR; PG8_SCHED;
            PG8_STAGE(PG8_SB(0, 1), b2 + hstep, voffB);
            PG8_WAIT_V(6); PG8_BAR; PG8_MMA(1, 1, At, B1); PG8_BAR;
            PG8_LDB(B0, 1, 0); PG8_SCHED; PG8_LDA(At, 1, 0); PG8_STAGE(PG8_SA(0, 1), a2 + hstep, voffA);
            PG8_WAIT_L(8); PG8_BAR; PG8_WAIT_L(0); PG8_MMA(0, 0, At, B0); PG8_BAR; PG8_SCHED;
            PG8_LDB(B1, 1, 1); PG8_STAGE(PG8_SB(1, 0), b3, voffB);
            PG8_BAR; PG8_WAIT_L(0); PG8_MMA(0, 1, At, B1); PG8_BAR;
            PG8_LDA(At, 1, 1); PG8_STAGE(PG8_SA(1, 0), a3, voffA);
            PG8_BAR; PG8_WAIT_L(0); PG8_MMA(1, 0, At, B0); PG8_BAR; PG8_SCHED;
            PG8_STAGE(PG8_SB(1, 1), b3 + hstep, voffB);
            PG8_WAIT_V(6); PG8_BAR; PG8_MMA(1, 1, At, B1); PG8_BAR;
            }
        }
        if constexpr (ALIGN_EPI) { if (wr == 0) PG8_BAR; }
        if constexpr (!Epi::AFTER_DRAIN) { E(acc, cur, wr, wc, fr, fq); S.done(cur); }
        if constexpr (Epi::MIDK) { if (has_next) E.prep(nxt); }
        if (!has_next) break;
#pragma unroll
        for (int a = 0; a < 2; ++a)
#pragma unroll
            for (int b = 0; b < 2; ++b)
#pragma unroll
                for (int m = 0; m < 4; ++m)
#pragma unroll
                    for (int n = 0; n < 2; ++n) acc[a][b][m][n] = (f32x4){0.f, 0.f, 0.f, 0.f};
        cur = nxt; cA = nA; cB = nB; ++ui;
        if constexpr (ALIGN_EPI) { if (wr == 1) PG8_BAR; }
    }
    PG8_WAIT_V(0);
    if constexpr (!ALIGN_EPI) { if (wr == 0) PG8_BAR; }
    PG8_BAR;
#undef PG8_SA
#undef PG8_SB
#undef PG8_STAGE
#undef PG8_LDA
#undef PG8_LDB
#undef PG8_MMA
#undef PG8_WAIT_V
#undef PG8_WAIT_L
#undef PG8_BAR
#undef PG8_SCHED
}
}

#define LDS_WAIT() asm volatile("s_waitcnt lgkmcnt(0)" ::: "memory")

__device__ __forceinline__ float wave_sum(float v) {
#pragma unroll
    for (int o = 1; o < 64; o <<= 1) v += __shfl_xor(v, o);
    return v;
}

__device__ __forceinline__ void p0_transpose_item(const float* W, const float* gain, int K, int N, bf16_t* WT, int ilv, LAS float* scr, int item, int lane, const float* gain2 = nullptr) {
    const int nblk = N / 32, kb = item / nblk, nb = item % nblk, k0 = 64 * kb, n0 = 32 * nb;
#pragma unroll 8
    for (int i = 0; i < 32; ++i) { const int kk = 2 * i + (lane >> 5); scr[kk * 33 + (lane & 31)] = W[(size_t)(k0 + kk) * N + n0 + (lane & 31)]; }
    LDS_WAIT(); asm volatile("" ::: "memory");
    const int c = lane & 7;
    f32x4 g0 = (f32x4){1.f, 1.f, 1.f, 1.f}, g1 = g0;
    if (gain) { const float* gp = (gain2 && k0 >= 1024) ? gain2 + (k0 - 1024) : gain + k0; g0 = *(const f32x4*)(gp + 8 * c); g1 = *(const f32x4*)(gp + 8 * c + 4); }
#pragma unroll
    for (int j = 0; j < 4; ++j) { const int n = (lane >> 3) + 8 * j; const LAS float* s = scr + (8 * c) * 33 + n;
        u32x4 o; o.x = cvt_pk_bf16(s[0 * 33] * g0.x, s[1 * 33] * g0.y); o.y = cvt_pk_bf16(s[2 * 33] * g0.z, s[3 * 33] * g0.w); o.z = cvt_pk_bf16(s[4 * 33] * g1.x, s[5 * 33] * g1.y); o.w = cvt_pk_bf16(s[6 * 33] * g1.z, s[7 * 33] * g1.w);
        const int nn = n0 + n; const int row = ilv < 0 ? nn : ((nn >> 7) * 256 + (nn & 127) + ilv);
        *(u32x4*)(WT + (size_t)row * K + k0 + 8 * c) = o; }
    LDS_WAIT(); asm volatile("" ::: "memory");
}

__device__ __forceinline__ void rms_rows_bf16(const float* x, const float* g, bf16_t* out, int gw, int NGW, int lane) {
    LAUNDER(lane);
    f32x4 gv[8];
#pragma unroll
    for (int j = 0; j < 8; ++j) gv[j] = *(const f32x4*)(g + 4 * lane + 256 * j);
    for (int m = gw; m < M; m += NGW) {
        const f32x4* xr = (const f32x4*)(x + (size_t)m * D) + lane; f32x4 v[8]; float s = 0.f;
#pragma unroll
        for (int j = 0; j < 8; ++j) { v[j] = xr[64 * j]; s += (v[j].x * v[j].x + v[j].y * v[j].y) + (v[j].z * v[j].z + v[j].w * v[j].w); }
        const float rstd = 1.0f / sqrtf(wave_sum(s) * (1.0f / D) + EPS);
        u32x2* o8 = (u32x2*)(out + (size_t)m * D) + lane;
#pragma unroll
        for (int j = 0; j < 8; ++j) { const f32x4 o = v[j] * rstd * gv[j]; u32x2 w; w.x = cvt_pk_bf16(o.x, o.y); w.y = cvt_pk_bf16(o.z, o.w); o8[64 * j] = w; }
    }
}
__device__ __forceinline__ void cast_rows_bf16(const float* x, bf16_t* out, float* ssq, int gw, int NGW, int lane) {
    LAUNDER(lane);
    for (int m = gw; m < M; m += NGW) {
        const f32x4* xr = (const f32x4*)(x + (size_t)m * D) + lane; f32x4 v[8]; float s = 0.f;
#pragma unroll
        for (int j = 0; j < 8; ++j) { v[j] = xr[64 * j]; s += (v[j].x * v[j].x + v[j].y * v[j].y) + (v[j].z * v[j].z + v[j].w * v[j].w); }
        s = wave_sum(s);
        if (lane == 0) { f32x4* pp = (f32x4*)(ssq + (size_t)m * 8); pp[0] = (f32x4){s, 0.f, 0.f, 0.f}; pp[1] = (f32x4){0.f, 0.f, 0.f, 0.f}; }
        u32x2* o8 = (u32x2*)(out + (size_t)m * D) + lane;
#pragma unroll
        for (int j = 0; j < 8; ++j) { u32x2 w; w.x = cvt_pk_bf16(v[j].x, v[j].y); w.y = cvt_pk_bf16(v[j].z, v[j].w); o8[64 * j] = w; }
    }
}
__device__ __forceinline__ void rms_rows_f32_inplace(float* x, const float* g, int gw, int NGW, int lane) {
    LAUNDER(lane);
    f32x4 gv[8];
#pragma unroll
    for (int j = 0; j < 8; ++j) gv[j] = *(const f32x4*)(g + 4 * lane + 256 * j);
    for (int m = gw; m < M; m += NGW) {
        f32x4* xr = (f32x4*)(x + (size_t)m * D) + lane; f32x4 v[8]; float s = 0.f;
#pragma unroll
        for (int j = 0; j < 8; ++j) { v[j] = xr[64 * j]; s += (v[j].x * v[j].x + v[j].y * v[j].y) + (v[j].z * v[j].z + v[j].w * v[j].w); }
        const float rstd = 1.0f / sqrtf(wave_sum(s) * (1.0f / D) + EPS);
#pragma unroll
        for (int j = 0; j < 8; ++j) xr[64 * j] = v[j] * rstd * gv[j];
    }
}
__device__ __forceinline__ void rms_rows_bf16_to_f32(const bf16_t* x, const float* g, float* out, int gw, int NGW, int lane) {
    LAUNDER(lane);
    f32x4 gv[4][2];
#pragma unroll
    for (int j = 0; j < 4; ++j) { const float* gp = g + 512 * j + 8 * lane; gv[j][0] = *(const f32x4*)gp; gv[j][1] = *(const f32x4*)(gp + 4); }
    for (int m = gw; m < M; m += NGW) {
        const u32x4* xr = (const u32x4*)(x + (size_t)m * D) + lane; u32x4 raw[4]; float s = 0.f;
#pragma unroll
        for (int j = 0; j < 4; ++j) raw[j] = xr[64 * j];
        float v[4][8];
#pragma unroll
        for (int j = 0; j < 4; ++j) {
            v[j][0] = bf_lo(raw[j].x); v[j][1] = bf_hi(raw[j].x); v[j][2] = bf_lo(raw[j].y); v[j][3] = bf_hi(raw[j].y);
            v[j][4] = bf_lo(raw[j].z); v[j][5] = bf_hi(raw[j].z); v[j][6] = bf_lo(raw[j].w); v[j][7] = bf_hi(raw[j].w);
#pragma unroll
            for (int e = 0; e < 8; ++e) s += v[j][e] * v[j][e];
        }
        const float rstd = 1.0f / sqrtf(wave_sum(s) * (1.0f / D) + EPS);
        f32x4* orow = (f32x4*)(out + (size_t)m * D + 8 * lane);
#pragma unroll
        for (int j = 0; j < 4; ++j) {
            orow[128 * j] = (f32x4){v[j][0] * rstd * gv[j][0].x, v[j][1] * rstd * gv[j][0].y, v[j][2] * rstd * gv[j][0].z, v[j][3] * rstd * gv[j][0].w};
            orow[128 * j + 1] = (f32x4){v[j][4] * rstd * gv[j][1].x, v[j][5] * rstd * gv[j][1].y, v[j][6] * rstd * gv[j][1].z, v[j][7] * rstd * gv[j][1].w};
        }
    }
}
__device__ __forceinline__ void ynorm_rows(bf16_t* y, const float* g_lru, const float* g_att, int gw, int NGW, int lane) {
    LAUNDER(lane);
    f32x4 gv[4][2];
#pragma unroll
    for (int j = 0; j < 4; ++j) { const float* gp = (j < 2 ? g_lru + 512 * j : g_att + 512 * (j - 2)) + 8 * lane; gv[j][0] = *(const f32x4*)gp; gv[j][1] = *(const f32x4*)(gp + 4); }
    for (int m = gw; m < M; m += NGW) {
        u32x4* yr = (u32x4*)(y + (size_t)m * D) + lane; u32x4 raw[4]; float s0 = 0.f, s1 = 0.f;
#pragma unroll
        for (int j = 0; j < 4; ++j) raw[j] = yr[64 * j];
        float v[4][8];
#pragma unroll
        for (int j = 0; j < 4; ++j) {
            v[j][0] = bf_lo(raw[j].x); v[j][1] = bf_hi(raw[j].x); v[j][2] = bf_lo(raw[j].y); v[j][3] = bf_hi(raw[j].y);
            v[j][4] = bf_lo(raw[j].z); v[j][5] = bf_hi(raw[j].z); v[j][6] = bf_lo(raw[j].w); v[j][7] = bf_hi(raw[j].w);
            float s = 0.f;
#pragma unroll
            for (int e = 0; e < 8; ++e) s += v[j][e] * v[j][e];
            if (j < 2) s0 += s; else s1 += s;
        }
        const float r0 = 1.0f / sqrtf(wave_sum(s0) * (1.0f / 1024.f) + EPS), r1 = 1.0f / sqrtf(wave_sum(s1) * (1.0f / 1024.f) + EPS);
#pragma unroll
        for (int j = 0; j < 4; ++j) { const float r = j < 2 ? r0 : r1; u32x4 w;
            w.x = cvt_pk_bf16(v[j][0] * r * gv[j][0].x, v[j][1] * r * gv[j][0].y); w.y = cvt_pk_bf16(v[j][2] * r * gv[j][0].z, v[j][3] * r * gv[j][0].w);
            w.z = cvt_pk_bf16(v[j][4] * r * gv[j][1].x, v[j][5] * r * gv[j][1].y); w.w = cvt_pk_bf16(v[j][6] * r * gv[j][1].z, v[j][7] * r * gv[j][1].w);
            yr[64 * j] = w; }
    }
}

constexpr int LM_BIAS = 0;
constexpr int LM_CW = 8448;
constexpr int LM_CB = 9472;
constexpr int LM_P = 10240;
constexpr int LM_H = 18432;
__device__ __forceinline__ void lru_unit(LAS unsigned char* lds, const bf16_t* zm, bf16_t* yraw, float* yp, const float* conv_w, const float* conv_b, const float* wa, const float* ba,
                                         const float* wx, const float* bx, const float* lam, int b, int hb, int tid) {
    LAUNDER(tid);
    const int lane = tid & 63, w = tid >> 6, fr = lane & 15, fq = lane >> 4;
    LAS float* cwL = (LAS float*)(lds + LM_CW); LAS float* cbL = (LAS float*)(lds + LM_CB);
    if (tid < 256) cwL[tid] = conv_w[(tid >> 6) * DL + hb * 64 + (tid & 63)];
    else if (tid < 320) cbL[tid - 256] = conv_b[hb * 64 + tid - 256];
    bf16x8 WA[4][2], WX[4][2];
#pragma unroll
    for (int nt = 0; nt < 4; ++nt)
#pragma unroll
        for (int ks = 0; ks < 2; ++ks) {
            const float* pa = wa + ((size_t)hb * 64 + ks * 32 + 8 * fq) * 64 + nt * 16 + fr; const float* px = wx + ((size_t)hb * 64 + ks * 32 + 8 * fq) * 64 + nt * 16 + fr;
            u32x4 ua, ux;
            ua.x = cvt_pk_bf16(pa[0 * 64], pa[1 * 64]); ua.y = cvt_pk_bf16(pa[2 * 64], pa[3 * 64]); ua.z = cvt_pk_bf16(pa[4 * 64], pa[5 * 64]); ua.w = cvt_pk_bf16(pa[6 * 64], pa[7 * 64]);
            ux.x = cvt_pk_bf16(px[0 * 64], px[1 * 64]); ux.y = cvt_pk_bf16(px[2 * 64], px[3 * 64]); ux.z = cvt_pk_bf16(px[4 * 64], px[5 * 64]); ux.w = cvt_pk_bf16(px[6 * 64], px[7 * 64]);
            WA[nt][ks] = __builtin_bit_cast(bf16x8, ua); WX[nt][ks] = __builtin_bit_cast(bf16x8, ux);
        }
    bf16x8 ID[2];
#pragma unroll
    for (int p = 0; p < 2; ++p)
#pragma unroll
        for (int e = 0; e < 8; ++e) ID[p][e] = (8 * fq + e == 16 * p + fr) ? (short)0x3F80 : (short)0;
    float pba[4], pbx[4], pcl[4];
#pragma unroll
    for (int nt = 0; nt < 4; ++nt) { const int c = hb * 64 + nt * 16 + fr; pba[nt] = ba[c]; pbx[nt] = bx[c]; pcl[nt] = -8.0f * log1pf(expf(-lam[c])); }
    __syncthreads();
    float hin[4] = {0.f, 0.f, 0.f, 0.f};
    const bf16_t* zb = zm + (size_t)b * SEQ * ZLD + hb * 64;
    LAS f32x2* TOT = (LAS f32x2*)(lds + LM_P);
    u32x4 XR[2][4], GR[2];
    {
        const int tA = 16 * w + fr;
#pragma unroll
        for (int ks = 0; ks < 2; ++ks) {
            const int ch0 = ks * 32 + 8 * fq;
#pragma unroll
            for (int tap = 0; tap < 4; ++tap) { const int t = tA - 3 + tap; const int tt = t >= 0 ? t : 0; XR[ks][tap] = *(const u32x4*)(zb + (size_t)tt * ZLD + ch0); }
            GR[ks] = *(const u32x4*)(zb + (size_t)tA * ZLD + 1024 + ch0);
        }
    }
#pragma unroll 1
    for (int sc = 0; sc < 16; ++sc) {
        const int tA = sc * 128 + 16 * w + fr;
        const int tN = sc < 15 ? tA + 128 : tA;
        u32x4 XN[2][4], GN[2];
#pragma unroll
        for (int ks = 0; ks < 2; ++ks) {
            const int ch0 = ks * 32 + 8 * fq;
#pragma unroll
            for (int tap = 0; tap < 4; ++tap) XN[ks][tap] = *(const u32x4*)(zb + (size_t)(tN - 3 + tap) * ZLD + ch0);
            GN[ks] = *(const u32x4*)(zb + (size_t)tN * ZLD + 1024 + ch0);
        }
        bf16x8 XC[2], GL[2];
#pragma unroll
        for (int ks = 0; ks < 2; ++ks) {
            const int ch0 = ks * 32 + 8 * fq;
            const f32x4 c0 = *(const LAS f32x4*)(cbL + ch0), c1 = *(const LAS f32x4*)(cbL + ch0 + 4);
            float a8[8] = {c0.x, c0.y, c0.z, c0.w, c1.x, c1.y, c1.z, c1.w};
#pragma unroll
            for (int tap = 0; tap < 4; ++tap) {
                const bool ok = (tA - 3 + tap) >= 0;
                u32x4 xr = XR[ks][tap];
                if (!ok) xr = (u32x4){0u, 0u, 0u, 0u};
                const f32x4 w0 = *(const LAS f32x4*)(cwL + tap * 64 + ch0), w1 = *(const LAS f32x4*)(cwL + tap * 64 + ch0 + 4);
                a8[0] += w0.x * bf_lo(xr.x); a8[1] += w0.y * bf_hi(xr.x); a8[2] += w0.z * bf_lo(xr.y); a8[3] += w0.w * bf_hi(xr.y);
                a8[4] += w1.x * bf_lo(xr.z); a8[5] += w1.y * bf_hi(xr.z); a8[6] += w1.z * bf_lo(xr.w); a8[7] += w1.w * bf_hi(xr.w);
            }
            u32x4 pk; pk.x = cvt_pk_bf16(a8[0], a8[1]); pk.y = cvt_pk_bf16(a8[2], a8[3]); pk.z = cvt_pk_bf16(a8[4], a8[5]); pk.w = cvt_pk_bf16(a8[6], a8[7]);
            XC[ks] = __builtin_bit_cast(bf16x8, pk);
            GL[ks] = __builtin_bit_cast(bf16x8, GR[ks]);
        }
        float hl[4][4], pc[4][4], gel[4][4], PE[4], HE[4];
        LAS f32x2* totw = TOT + ((sc & 1) * 8 + w) * 64;
#pragma unroll
        for (int nt = 0; nt < 4; ++nt) {
            f32x4 ga = (f32x4){0.f, 0.f, 0.f, 0.f}, gx = ga, xo = ga, go = ga;
#pragma unroll
            for (int ks = 0; ks < 2; ++ks) { ga = __builtin_amdgcn_mfma_f32_16x16x32_bf16(XC[ks], WA[nt][ks], ga, 0, 0, 0); gx = __builtin_amdgcn_mfma_f32_16x16x32_bf16(XC[ks], WX[nt][ks], gx, 0, 0, 0); }
            xo = __builtin_amdgcn_mfma_f32_16x16x32_bf16(XC[nt >> 1], ID[nt & 1], xo, 0, 0, 0);
            go = __builtin_amdgcn_mfma_f32_16x16x32_bf16(GL[nt >> 1], ID[nt & 1], go, 0, 0, 0);
#pragma unroll
            for (int j = 0; j < 4; ++j) {
                const float r = sigmoidf_(ga[j] + pba[nt]), ig = sigmoidf_(gx[j] + pbx[nt]);
                const float la = pcl[nt] * r;
                const float a = fast_exp2(la * LOG2E);
                const float x2 = 2.0f * la;
                float ome = -x2 * (1.0f + x2 * 0.5f * (1.0f + x2 * (1.0f / 3.0f)));
                if (x2 < -0.03f) ome = 1.0f - a * a;
                const float u = sqrtf(ome) * ig * xo[j];
                if (j == 0) { hl[nt][0] = u; pc[nt][0] = a; }
                else { hl[nt][j] = a * hl[nt][j - 1] + u; pc[nt][j] = pc[nt][j - 1] * a; }
                const float gv = go[j];
                gel[nt][j] = gv * sigmoidf_(1.5957691216057308f * (gv + 0.044715f * gv * gv * gv));
            }
            float P = pc[nt][3], H = hl[nt][3];
            { const float Pp = __shfl_up(P, 16), Hp = __shfl_up(H, 16); if (fq >= 1) { H = P * Hp + H; P = P * Pp; } }
            { const float Pp = __shfl_up(P, 32), Hp = __shfl_up(H, 32); if (fq >= 2) { H = P * Hp + H; P = P * Pp; } }
            { float Pe = __shfl_up(P, 16), He = __shfl_up(H, 16); if (fq == 0) { Pe = 1.0f; He = 0.0f; } PE[nt] = Pe; HE[nt] = He; }
            if (fq == 3) totw[nt * 16 + fr] = (f32x2){P, H};
        }
        __syncthreads();
        float psq[4] = {0.f, 0.f, 0.f, 0.f};
#pragma unroll
        for (int nt = 0; nt < 4; ++nt) {
            float hrun = hin[nt], hws = hin[nt];
#pragma unroll
            for (int w2 = 0; w2 < 8; ++w2) { const f32x2 t2 = TOT[((sc & 1) * 8 + w2) * 64 + nt * 16 + fr]; hrun = t2.x * hrun + t2.y; if (w2 + 1 == w) hws = hrun; }
            hin[nt] = hrun;
            const float hs = PE[nt] * hws + HE[nt];
#pragma unroll
            for (int j = 0; j < 4; ++j) {
                const float ov = (hl[nt][j] + pc[nt][j] * hs) * gel[nt][j]; psq[j] += ov * ov;
                const unsigned o = cvt_pk_bf16(ov, 0.f);
                yraw[(size_t)(b * SEQ + sc * 128 + 16 * w + 4 * fq + j) * D + hb * 64 + nt * 16 + fr] = (bf16_t)(o & 0xffffu);
            }
        }
#pragma unroll
        for (int j = 0; j < 4; ++j) { float q = psq[j]; q += __shfl_xor(q, 1); q += __shfl_xor(q, 2); q += __shfl_xor(q, 4); q += __shfl_xor(q, 8);
            if (fr == 0) yp[(size_t)(b * SEQ + sc * 128 + 16 * w + 4 * fq + j) * 24 + hb] = q; }
#pragma unroll
        for (int ks = 0; ks < 2; ++ks) {
#pragma unroll
            for (int tap = 0; tap < 4; ++tap) XR[ks][tap] = XN[ks][tap];
            GR[ks] = GN[ks];
        }
    }
    __syncthreads();
}

constexpr int LM_ATT = 32768;
#define ATT_COMPUTE(FAR) do { \
        bf16x8 Kf[2][4], Vf[8]; \
        _Pragma("unroll") for (int t = 0; t < 2; ++t) _Pragma("unroll") for (int ks = 0; ks < 4; ++ks) Kf[t][ks] = *(const LAS bf16x8*)(sb + (t * 4 + ks) * 1024 + foff); \
        _Pragma("unroll") for (int dt = 0; dt < 8; ++dt) Vf[dt] = *(const LAS bf16x8*)(sb + 8192 + dt * 1024 + foff); \
        f32x4 St[2][2]; \
        _Pragma("unroll") for (int t = 0; t < 2; ++t) _Pragma("unroll") for (int qt = 0; qt < 2; ++qt) { f32x4 s_ = (f32x4){0.f, 0.f, 0.f, 0.f}; \
            _Pragma("unroll") for (int ks = 0; ks < 4; ++ks) s_ = __builtin_amdgcn_mfma_f32_16x16x32_bf16(Kf[t][ks], Q[qt][ks], s_, 0, 0, 0); \
            St[t][qt] = s_; } \
        bf16x8 Pf[2]; \
        _Pragma("unroll") for (int qt = 0; qt < 2; ++qt) { \
            const int qpos = c * 64 + qh * 32 + qt * 16 + fr; \
            float sv[8]; float bm = -1e30f; \
            _Pragma("unroll") for (int t = 0; t < 2; ++t) _Pragma("unroll") for (int j = 0; j < 4; ++j) { float bv_; \
                if (FAR) bv_ = bias0; else { int rel = k0 + 8 * fq + 4 * t + j - qpos; rel = rel < -128 ? -128 : (rel > 128 ? 128 : rel); bv_ = bias[rel + 128]; } \
                const float s_ = St[t][qt][j] * SC + bv_; sv[t * 4 + j] = s_; bm = fmaxf(bm, s_); } \
            bm = fmaxf(bm, __shfl_xor(bm, 16)); bm = fmaxf(bm, __shfl_xor(bm, 32)); \
            const float mn = fmaxf(mrun[qt], bm); const float alpha = fast_exp2(mrun[qt] - mn); mrun[qt] = mn; \
            float ps = 0.f; \
            _Pragma("unroll") for (int e = 0; e < 8; ++e) { sv[e] = fast_exp2(sv[e] - mn); ps += sv[e]; } \
            lrun[qt] = lrun[qt] * alpha + ps; \
            _Pragma("unroll") for (int dt = 0; dt < 8; ++dt) O[dt][qt] = O[dt][qt] * alpha; \
            u32x4 pk; pk.x = cvt_pk_bf16(sv[0], sv[1]); pk.y = cvt_pk_bf16(sv[2], sv[3]); pk.z = cvt_pk_bf16(sv[4], sv[5]); pk.w = cvt_pk_bf16(sv[6], sv[7]); \
            Pf[qt] = __builtin_bit_cast(bf16x8, pk); } \
        _Pragma("unroll") for (int dt = 0; dt < 8; ++dt) _Pragma("unroll") for (int qt = 0; qt < 2; ++qt) O[dt][qt] = __builtin_amdgcn_mfma_f32_16x16x32_bf16(Vf[dt], Pf[qt], O[dt][qt], 0, 0, 0); \
    } while (0)
__device__ __forceinline__ void attn_block(LAS unsigned char* lds, const bf16_t* zm, const bf16_t* Kh, const bf16_t* Vt, bf16_t* yraw, float* yp, const LAS float* biasAll, int b, int h, int g, int tid) {
    LAUNDER(tid);
    const int lane = tid & 63, wave = tid >> 6, fr = lane & 15, fq = lane >> 4;
    const int c = 4 * g + (wave >> 1), qh = wave & 1;
    const LAS float* bias = biasAll + h * NREL;
    const float bias0 = bias[0];
    const float SC = 0.08838834764831845f * LOG2E;
    bf16x8 Q[2][4];
#pragma unroll
    for (int qt = 0; qt < 2; ++qt) { const size_t tok = (size_t)b * SEQ + c * 64 + qh * 32 + qt * 16 + fr;
#pragma unroll
        for (int ks = 0; ks < 4; ++ks) Q[qt][ks] = *(const bf16x8*)(zm + tok * ZLD + 2048 + h * HD + ks * 32 + 8 * fq); }
    f32x4 O[8][2];
#pragma unroll
    for (int dt = 0; dt < 8; ++dt)
#pragma unroll
        for (int qt = 0; qt < 2; ++qt) O[dt][qt] = (f32x4){0.f, 0.f, 0.f, 0.f};
    float mrun[2] = {-1e30f, -1e30f}, lrun[2] = {0.f, 0.f};
    const int lo = g >= 2 ? 4 * g - 8 : 0, nsteps = (4 * g + 4 - lo) * 2;
    const int kr = tid >> 4, c16 = tid & 15;
    const int krho = ((kr >> 3) << 2) | (kr & 3);
    const int kst = ((((kr >> 2) & 1) * 4 + (c16 >> 2)) * 1024) + ((krho * 64 + (c16 & 3) * 16) ^ (krho >= 8 ? 32 : 0));
    const bf16_t* kg = Kh + ((size_t)(b * NH + h) * SEQ + kr) * HD + 8 * c16;
    const int vd = tid >> 2, vq = tid & 3;
    const int vst = 8192 + (vd >> 4) * 1024 + (((vd & 15) * 64 + vq * 16) ^ ((vd & 15) >= 8 ? 32 : 0));
    const bf16_t* vg = Vt + ((size_t)(b * NH + h) * HD + vd) * SEQ + 8 * vq;
    const int foff = (fr * 64 + fq * 16) ^ (fr >= 8 ? 32 : 0);
    LAS unsigned char* st = lds + LM_ATT;
    { const int k0 = lo * 64; const u32x4 kv = *(const u32x4*)(kg + (size_t)k0 * HD); const u32x4 vv = *(const u32x4*)(vg + k0);
      *(LAS u32x4*)(st + kst) = kv; *(LAS u32x4*)(st + vst) = vv; }
    __syncthreads();
#pragma unroll 1
    for (int s = 0; s < nsteps; ++s) {
        const int kc = lo + (s >> 1), k0 = kc * 64 + (s & 1) * 32;
        const int sn = s + 1 < nsteps ? s + 1 : s;
        const int k0n = (lo + (sn >> 1)) * 64 + (sn & 1) * 32;
        const u32x4 kv = *(const u32x4*)(kg + (size_t)k0n * HD); const u32x4 vv = *(const u32x4*)(vg + k0n);
        const LAS unsigned char* sb = st + (s & 1) * 16384;
        if (kc >= c - 8 && kc <= c) {
            if (kc <= c - 3) ATT_COMPUTE(true); else ATT_COMPUTE(false);
        }
        LAS unsigned char* nb = st + ((s + 1) & 1) * 16384;
        *(LAS u32x4*)(nb + kst) = kv; *(LAS u32x4*)(nb + vst) = vv;
        __syncthreads();
    }
#pragma unroll
    for (int qt = 0; qt < 2; ++qt) {
        float l = lrun[qt]; l += __shfl_xor(l, 16); l += __shfl_xor(l, 32);
        const float inv = 1.0f / l;
        bf16_t* op = yraw + ((size_t)b * SEQ + c * 64 + qh * 32 + qt * 16 + fr) * D + 1024 + h * HD + 4 * fq;
        float q = 0.f;
#pragma unroll
        for (int dt = 0; dt < 8; ++dt) { const f32x4 o = O[dt][qt] * inv; u32x2 w; w.x = cvt_pk_bf16(o.x, o.y); w.y = cvt_pk_bf16(o.z, o.w); *(u32x2*)(op + dt * 16) = w; q += (o.x * o.x + o.y * o.y) + (o.z * o.z + o.w * o.w); }
        q += __shfl_xor(q, 16); q += __shfl_xor(q, 32);
        if (fq == 0) yp[((size_t)b * SEQ + c * 64 + qh * 32 + qt * 16 + fr) * 24 + 16 + h] = q;
    }
}
#undef ATT_COMPUTE

#define XB_TMO      128
#define XB_XCNT(j)  (256  + 64 * (j))
#define XB_XSUB(j)  (1280 + 64 * (j))
#define XB_XGEN(j)  (2304 + 64 * (j))
#define XB_TOP      3328
#define XB_TOPGEN   3392
#define XCD_BAR_WORDS 3456
#define XB_SPIN_CAP (1u << 18)
__device__ __forceinline__ unsigned xb_ld(unsigned* p)              { return __hip_atomic_load(p, __ATOMIC_RELAXED, __HIP_MEMORY_SCOPE_AGENT); }
__device__ __forceinline__ unsigned xb_add(unsigned* p, unsigned v) { return __hip_atomic_fetch_add(p, v, __ATOMIC_RELAXED, __HIP_MEMORY_SCOPE_AGENT); }
__device__ __forceinline__ unsigned xb_xcc_id() { return (unsigned)__builtin_amdgcn_s_getreg((3 << 11) | 20) & 0xFu; }
#define XB_SPIN(cond, bar) do { unsigned _sp = 0; while (cond) { __builtin_amdgcn_s_sleep(1); \
    if ((++_sp & 255u) == 0u) { if (xb_ld(&(bar)[XB_TMO])) break; if (_sp > XB_SPIN_CAP) { atomicAdd(&(bar)[XB_TMO], 1u); break; } } } } while (0)
struct XcdBarrier { unsigned* bar; unsigned x; volatile LAS unsigned* st; };
__device__ __forceinline__ XcdBarrier xcd_barrier_post(unsigned* bar, volatile LAS unsigned* st) {
    XcdBarrier b; b.bar = bar; b.x = xb_xcc_id(); b.st = st;
    if (threadIdx.x == 0) (void)xb_add(&bar[XB_XCNT(b.x)], 1u);
    return b;
}
__device__ __forceinline__ void xcd_barrier_complete(unsigned* bar, unsigned x, unsigned& nloc, unsigned& nx) {
    const unsigned G = gridDim.x * gridDim.y * gridDim.z;
    unsigned sum, cnt, mine, sp = 0u;
    for (;;) {
        sum = 0u; cnt = 0u; mine = 0u;
#pragma unroll
        for (unsigned j = 0; j < 16; ++j) { const unsigned c = xb_ld(&bar[XB_XCNT(j)]); sum += c; cnt += (c > 0u) ? 1u : 0u; mine = (j == x) ? c : mine; }
        if (sum == G) break;
        __builtin_amdgcn_s_sleep(1);
        if ((++sp & 255u) == 0u) { if (xb_ld(&bar[XB_TMO])) break; if (sp > XB_SPIN_CAP) { atomicAdd(&bar[XB_TMO], 1u); break; } }
    }
    nloc = mine > 0u ? mine : 1u; nx = cnt > 0u ? cnt : 1u;
}
__device__ __forceinline__ void xcd_barrier(const XcdBarrier& b) {
    asm volatile("s_waitcnt vmcnt(0)" ::: "memory");
    __syncthreads();
    if (threadIdx.x == 0) {
        unsigned* bar = b.bar;
        __builtin_amdgcn_s_waitcnt(0);
        unsigned nloc = b.st[0], nx = b.st[1];
        if (nloc == 0u) { xcd_barrier_complete(bar, b.x, nloc, nx); b.st[0] = nloc; b.st[1] = nx; }
        const unsigned old = xb_add(&bar[XB_XSUB(b.x)], 1u);
        const unsigned gen = old / nloc;
        if (old + 1u == (gen + 1u) * nloc) {
            __builtin_amdgcn_fence(__ATOMIC_RELEASE, "agent");
            asm volatile("s_waitcnt vmcnt(0)" ::: "memory");
            const unsigned og = xb_add(&bar[XB_TOP], 1u);
            const unsigned tg = og / nx;
            if (og + 1u == (tg + 1u) * nx) xb_add(&bar[XB_TOPGEN], 1u);
            else XB_SPIN(xb_ld(&bar[XB_TOPGEN]) == tg, bar);
            __builtin_amdgcn_fence(__ATOMIC_ACQUIRE, "agent");
            xb_add(&bar[XB_XGEN(b.x)], 1u);
            asm volatile("s_waitcnt vmcnt(0)" ::: "memory");
        } else {
            XB_SPIN(xb_ld(&bar[XB_XGEN(b.x)]) == gen, bar);
            __builtin_amdgcn_fence(__ATOMIC_ACQUIRE, "agent");
            asm volatile("s_waitcnt vmcnt(0)" ::: "memory");
        }
    }
    __syncthreads();
}

struct Args { const float* in[23]; float* out; unsigned char* ws; int pad0, pad1; };

__global__ void __launch_bounds__(NTHREADS, 2) mk_fwd(Args args) {
    extern __shared__ __attribute__((aligned(16))) unsigned char lds_raw[];
    LAS unsigned char* lds = (LAS unsigned char*)lds_raw;
    cg::grid_group grid = cg::this_grid();
    const int tid = threadIdx.x, lane = tid & 63, wave = __builtin_amdgcn_readfirstlane(tid >> 6);
    const int G = gridDim.x, bx = blockIdx.x;
    const int gw = bx * NWAVES + wave, NGW = G * NWAVES;
    typedef const float* cfp;
    const __attribute__((address_space(4))) cfp* inp = (const __attribute__((address_space(4))) cfp*)__builtin_amdgcn_kernarg_segment_ptr();
#define INP(k) (inp[k])
#define LAUNDER_S(v) asm volatile("" : "+s"(v))
    unsigned char* ws = args.ws;
    float* out = args.out;
    volatile LAS unsigned* bst = (volatile LAS unsigned*)(lds + 131072 + 64);
    if (tid < 2) bst[tid] = 0u;
    __syncthreads();
    if (bx == 0) for (int i = tid; i < XCD_BAR_WORDS; i += NTHREADS) ((unsigned*)(ws + WS_CTL))[i] = 0u;
#define GRID_BAR() do { XcdBarrier xb_; xb_.bar = (unsigned*)(args.ws + WS_CTL); xb_.x = xb_xcc_id(); xb_.st = (volatile LAS unsigned*)(lds + 131072 + 64); xcd_barrier(xb_); } while (0)
    bf16_t* HID = (bf16_t*)(ws + WS_BIG); bf16_t* ZM = (bf16_t*)(ws + WS_BIG); bf16_t* VT = (bf16_t*)(ws + WS_VT); bf16_t* KH = (bf16_t*)(ws + WS_KH); bf16_t* HB = (bf16_t*)(ws + WS_H); bf16_t* HB2 = (bf16_t*)(ws + WS_H2); float* SSQ = (float*)(ws + WS_SSQ); float* YP = (float*)(ws + WS_YP);

    {
        LAS float* scr = (LAS float*)(lds + wave * 16384);
        constexpr int I_G = (D / 64) * (FF / 32), I_D = (FF / 64) * (D / 32), I_IN = (D / 64) * (DIN / 32), I_O = (D / 64) * (D / 32);
        constexpr int PER_LAYER = 4 * I_G + 2 * I_D + I_IN + I_O;
        for (int it = gw; it < DEPTH * PER_LAYER; it += NGW) {
            const int l = it / PER_LAYER; int r = it % PER_LAYER;
            unsigned char* wl = ws + (size_t)l * LAYER_W;
            if (r < I_G) { p0_transpose_item(INP(2) + (size_t)l * D * FF, INP(1) + (size_t)l * D, D, FF, (bf16_t*)(wl + OFF_WGU1), 0, scr, r, lane); continue; } r -= I_G;
            if (r < I_G) { p0_transpose_item(INP(3) + (size_t)l * D * FF, INP(1) + (size_t)l * D, D, FF, (bf16_t*)(wl + OFF_WGU1), 128, scr, r, lane); continue; } r -= I_G;
            if (r < I_D) { p0_transpose_item(INP(4) + (size_t)l * FF * D, nullptr, FF, D, (bf16_t*)(wl + OFF_WD1), -1, scr, r, lane); continue; } r -= I_D;
            if (r < I_IN) { p0_transpose_item(INP(6) + (size_t)l * D * DIN, INP(5) + (size_t)l * D, D, DIN, (bf16_t*)(wl + OFF_WIN), -1, scr, r, lane); continue; } r -= I_IN;
            if (r < I_O) { p0_transpose_item(INP(17) + (size_t)l * D * D, INP(15) + (size_t)l * DL, D, D, (bf16_t*)(wl + OFF_WOUT), -1, scr, r, lane, INP(16) + (size_t)l * DL); continue; } r -= I_O;
            if (r < I_G) { p0_transpose_item(INP(19) + (size_t)l * D * FF, INP(18) + (size_t)l * D, D, FF, (bf16_t*)(wl + OFF_WGU2), 0, scr, r, lane); continue; } r -= I_G;
            if (r < I_G) { p0_transpose_item(INP(20) + (size_t)l * D * FF, INP(18) + (size_t)l * D, D, FF, (bf16_t*)(wl + OFF_WGU2), 128, scr, r, lane); continue; } r -= I_G;
            p0_transpose_item(INP(21) + (size_t)l * FF * D, nullptr, FF, D, (bf16_t*)(wl + OFF_WD2), -1, scr, r, lane);
        }
        cast_rows_bf16(INP(0), HB, SSQ, gw, NGW, lane);
    }
    grid.sync();
    (void)xcd_barrier_post((unsigned*)(ws + WS_CTL), bst);

#pragma unroll 1
    for (int l = 0; l < DEPTH; ++l) {
        unsigned char* wl = ws + (size_t)l * LAYER_W;
#pragma unroll 1
        for (int f = 0; f < 2; ++f) {
            LAUNDER_S(inp);
            {
                pg8::Gemm g{HB, (const bf16_t*)(wl + (f ? OFF_WGU2 : OFF_WGU1)), M, 2 * FF, D}; pg8::StaticOrder S; S.init(M, 2 * FF, G, bx);
                { if (tid == 0) *(volatile LAS int*)(lds + pg8::LDS_RSPM) = -1; __syncthreads(); }
                pg8::EpiSwiGLU E{HID, FF, SSQ + (size_t)(3 * l + (f ? 2 : 0)) * M * 8, lds};
                pg8::gemm_phase<pg8::EpiSwiGLU, pg8::StaticOrder, true, true>(lds, g, S, E);
            }
            GRID_BAR();
            {
                pg8::Gemm g{HID, (const bf16_t*)(wl + (f ? OFF_WD2 : OFF_WD1)), M, D, FF}; pg8::StaticOrder S; S.init(M, D, G, bx);
                pg8::EpiResid<true> E{HB, SSQ + (size_t)(3 * l + (f ? 3 : 1)) * M * 8, lds};
                pg8::gemm_phase<pg8::EpiResid<true>, pg8::StaticOrder, true, true>(lds, g, S, E);
            }
            GRID_BAR();
            if (f == 0) {
                {
                    pg8::Gemm g{HB, (const bf16_t*)(wl + OFF_WIN), M, DIN, D}; pg8::StaticOrder S; S.init(M, DIN, G, bx);
                    { if (tid == 0) *(volatile LAS int*)(lds + pg8::LDS_RSPM) = -1; __syncthreads(); }
                    pg8::EpiZ E{ZM, VT, KH, SSQ + (size_t)(3 * l + 1) * M * 8, lds};
                    pg8::gemm_phase<pg8::EpiZ, pg8::StaticOrder, true, true>(lds, g, S, E);
                }
                GRID_BAR();
                {
                    LAS float* biasL = (LAS float*)(lds + LM_BIAS);
                    const float* rb = INP(14) + (size_t)l * NH * NREL;
                    int tid_m = tid; LAUNDER(tid_m);
                    for (int i = tid_m; i < NH * NREL; i += NTHREADS) biasL[i] = rb[i] * LOG2E;
                    __syncthreads();
                    for (int u = bx; u < NB * 16; u += G)
                        lru_unit(lds, ZM, HB2, YP, INP(7) + (size_t)l * 4 * DL, INP(8) + (size_t)l * DL, INP(9) + (size_t)l * 16 * 64 * 64, INP(10) + (size_t)l * DL,
                                 INP(11) + (size_t)l * 16 * 64 * 64, INP(12) + (size_t)l * DL, INP(13) + (size_t)l * DL, u >> 4, u & 15, tid);
                    for (int bu = bx; bu < 1024; bu += G) {
                        const int kk = bu >> 8, bxv = bu & 255;
                        const int ag = ((bxv & 7) + 2 * kk) & 7, ap = (bxv >> 3) + 32 * kk;
                        attn_block(lds, ZM, KH, VT, HB2, YP, biasL, ap >> 3, ap & 7, ag, tid);
                    }
                }
                GRID_BAR();
                {
                    pg8::Gemm g{HB2, (const bf16_t*)(wl + OFF_WOUT), M, D, D}; pg8::StaticOrder S; S.init(M, D, G, bx);
                    { if (tid == 0) *(volatile LAS int*)(lds + pg8::LDS_RS2PM) = -1; __syncthreads(); }
                    pg8::EpiResidY E{HB, SSQ + (size_t)(3 * l + 2) * M * 8, YP, lds};
                    { pg8::Unit u0; if (S.next(0, u0)) E.prep(u0); }
                    pg8::gemm_phase<pg8::EpiResidY, pg8::StaticOrder, true, true>(lds, g, S, E);
                }
                GRID_BAR();
            } else {
                if (l + 1 == DEPTH) rms_rows_bf16_to_f32(HB, INP(22), out, gw, NGW, lane);
            }
        }
    }
}

extern "C" void kernel_launch(void* const* d_in, const int* in_sizes, int n_in, void* d_out, int out_size, void* d_ws, size_t ws_size, hipStream_t stream) {
    static int grid = 0;
    if (grid == 0) {
        if (n_in != 23 || in_sizes[0] != M * D || out_size != M * D || ws_size < WS_END) {
            fprintf(stderr, "kernel_launch: unexpected shapes: n_in %d in0 %d out %d ws %zu (need %zu)\n", n_in, n_in > 0 ? in_sizes[0] : -1, out_size, ws_size, (size_t)WS_END); grid = -1; return; }
        int dev = 0, cus = 0, per_cu = 0;
        hipGetDevice(&dev); hipDeviceGetAttribute(&cus, hipDeviceAttributeMultiprocessorCount, dev);
        if (hipFuncSetAttribute((const void*)mk_fwd, hipFuncAttributeMaxDynamicSharedMemorySize, LDS_BYTES) != hipSuccess) fprintf(stderr, "kernel_launch: hipFuncSetAttribute failed\n");
        if (hipOccupancyMaxActiveBlocksPerMultiprocessor(&per_cu, (const void*)mk_fwd, NTHREADS, LDS_BYTES) != hipSuccess || per_cu < 1) { fprintf(stderr, "kernel_launch: occupancy query gave %d\n", per_cu); per_cu = 1; }
        (void)hipGetLastError();
        grid = cus * per_cu;
        if (grid > 256) grid = 256;
    }
    if (grid < 0) return;
    Args a{};
    for (int i = 0; i < 23; ++i) a.in[i] = (const float*)d_in[i];
    a.out = (float*)d_out; a.ws = (unsigned char*)d_ws;
    void* kargs[] = {&a};
    hipError_t e = hipLaunchCooperativeKernel((const void*)mk_fwd, dim3(grid), dim3(NTHREADS), kargs, LDS_BYTES, stream);
    if (e != hipSuccess) fprintf(stderr, "kernel_launch: cooperative launch failed: %s (grid %d)\n", hipGetErrorString(e), grid);
}
```

```cpp
#include <hip/hip_runtime.h>
#include <hip/hip_cooperative_groups.h>
#include <cstdio>
#include <cstdint>
namespace cg = cooperative_groups;

#define LAS __attribute__((address_space(3)))
#define LAUNDER(v) asm volatile("" : "+v"(v))
typedef unsigned short bf16_t;
typedef short bf16x8 __attribute__((ext_vector_type(8)));
typedef float f32x4 __attribute__((ext_vector_type(4)));
typedef float f32x2 __attribute__((ext_vector_type(2)));
typedef unsigned u32x4 __attribute__((ext_vector_type(4)));
typedef unsigned u32x2 __attribute__((ext_vector_type(2)));

constexpr int NB = 16, SEQ = 2048, M = NB * SEQ, D = 2048, FF = 5632, DIN = 5120, DL = 1024, NH = 8, HD = 128, NREL = 257, DEPTH = 2;
constexpr int ZLD = 3072;
constexpr float EPS = 1e-6f;
constexpr float LOG2E = 1.4426950408889634f;

constexpr size_t MiB = 1u << 20;
constexpr size_t SZ_WGU = (size_t)2 * FF * D * 2, SZ_WD = (size_t)D * FF * 2, SZ_WIN = (size_t)DIN * D * 2, SZ_WOUT = (size_t)D * D * 2;
constexpr size_t OFF_WGU1 = 0, OFF_WD1 = OFF_WGU1 + SZ_WGU, OFF_WIN = OFF_WD1 + SZ_WD, OFF_WOUT = OFF_WIN + SZ_WIN, OFF_WGU2 = OFF_WOUT + SZ_WOUT, OFF_WD2 = OFF_WGU2 + SZ_WGU;
constexpr size_t LAYER_W = OFF_WD2 + SZ_WD;
static_assert(LAYER_W == 160 * MiB, "weights per layer");
constexpr size_t WS_BIG = 2 * LAYER_W;
constexpr size_t WS_VT = WS_BIG + (size_t)M * ZLD * 2;
constexpr size_t WS_KH = WS_VT + (size_t)M * 1024 * 2;
constexpr size_t WS_H = WS_BIG + 352 * MiB;
constexpr size_t WS_H2 = WS_H + 128 * MiB;
constexpr size_t WS_SSQ = WS_H2 + 128 * MiB;
constexpr size_t WS_YP = WS_SSQ + 8 * MiB;
constexpr size_t WS_CTL = WS_YP + 4 * MiB;
constexpr size_t CTL_BYTES = 16384;
constexpr size_t WS_END = WS_CTL + 1 * MiB;
static_assert((size_t)M * FF * 2 == 352 * MiB, "hidden size");

constexpr int NWAVES = 8, NTHREADS = 512;
constexpr int LDS_BYTES = 147456;

__device__ __forceinline__ unsigned cvt_pk_bf16(float lo, float hi) { unsigned r; asm volatile("v_cvt_pk_bf16_f32 %0, %1, %2" : "=v"(r) : "v"(lo), "v"(hi)); return r; }
__device__ __forceinline__ float bf_lo(unsigned u) { return __uint_as_float(u << 16); }
__device__ __forceinline__ float bf_hi(unsigned u) { return __uint_as_float(u & 0xffff0000u); }
__device__ __forceinline__ float fast_exp2(float x) { return __builtin_amdgcn_exp2f(x); }
__device__ __forceinline__ float fast_rcp(float x) { return __builtin_amdgcn_rcpf(x); }
__device__ __forceinline__ float sigmoidf_(float x) { return fast_rcp(1.0f + fast_exp2(-LOG2E * x)); }

namespace pg8 {
constexpr int BM = 256, BK = 64, HALF = 128, HTB = HALF * BK * 2, STAGE_BYTES = 8 * HTB, NXCD = 8, WGM = 8;
__host__ __device__ __forceinline__ int lds_byte(int r, int c) { const int st = (r >> 4) * 2 + (c >> 5), rr = r & 15, cc = c & 31, ob = rr * 64 + cc * 2; return st * 1024 + (ob ^ (((ob >> 9) & 1) << 5)); }
__host__ __device__ __forceinline__ void stage_rc(int b, int& R, int& C) { const int st = b / 1024, sb = b % 1024, swz = sb ^ (((sb >> 9) & 1) << 5); R = (st >> 1) * 16 + swz / 64; C = (st & 1) * 32 + (swz % 64) / 2; }
__host__ __device__ __forceinline__ int perm32(int rho) { const int n = rho >> 4, i = rho & 15; return 8 * (i >> 2) + 4 * n + (i & 3); }

struct Unit { int pm, pn; };
struct Gemm { const bf16_t* A; const bf16_t* Bt; int M, N, K; };

struct StaticOrder {
    int nM, nN, nwg, G, c;
    __host__ __device__ void init(int M_, int N_, int G_, int c_) { nM = M_ / BM; nN = N_ / BM; nwg = nM * nN; G = G_; c = c_; }
    __host__ __device__ bool next(int i, Unit& u) const {
        const long L = (long)i * G + c; if (L >= nwg) return false;
        int wgid = (int)L; { const int q = nwg / NXCD, r = nwg % NXCD, xcd = wgid % NXCD, off = wgid / NXCD; wgid = (xcd < r ? xcd * (q + 1) : r * (q + 1) + (xcd - r) * q) + off; }
        const int nig = WGM * nN, gid = wgid / nig, fm = gid * WGM, gsz = (nM - fm) < WGM ? (nM - fm) : WGM;
        u.pm = fm + ((wgid % nig) % gsz); u.pn = (wgid % nig) / gsz; return true;
    }
    __device__ __forceinline__ void a_ready(const Unit&) const {}
    __device__ __forceinline__ void done(const Unit&) const {}
};


constexpr int LDS_RS = 131072 + 1024, LDS_RSPM = 131072 + 2048 + 64, LDS_SSP = 131072 + 4096;
__device__ __forceinline__ void rs_panel(LAS unsigned char* lds, const float* ssq, int pm) {
    volatile LAS int* pmL = (volatile LAS int*)(lds + LDS_RSPM); LAS float* rsL = (LAS float*)(lds + LDS_RS);
    if (pmL[0] != pm) {
        asm volatile("s_waitcnt lgkmcnt(0)" ::: "memory"); __builtin_amdgcn_s_barrier();
        const int t = threadIdx.x;
        if (t < 256) { const f32x4* pp = (const f32x4*)(ssq + (size_t)(pm * 256 + t) * 8); const f32x4 pa = pp[0], pb = pp[1];
            rsL[t] = __builtin_amdgcn_rsqf((((pa.x + pa.y) + (pa.z + pa.w)) + ((pb.x + pb.y) + (pb.z + pb.w))) * (1.0f / D) + EPS); }
        if (t == 0) pmL[0] = pm;
        asm volatile("s_waitcnt vmcnt(0) lgkmcnt(0)" ::: "memory"); __builtin_amdgcn_s_barrier();
    }
}
struct EpiSwiGLU {
    static constexpr bool PERM = true, AFTER_DRAIN = false, MIDK = false;
    bf16_t* O; int ldc; const float* ssq; LAS unsigned char* lds;
    __device__ __forceinline__ void operator()(const f32x4 (&acc)[2][2][4][2], const Unit& u, int wr, int wc, int fr, int fq) const {
        rs_panel(lds, ssq, u.pm);
        const LAS float* rsL = (const LAS float*)(lds + LDS_RS) + wr * 64 + fr;
        const int row0 = u.pm * BM + wr * 64 + fr; const int col0 = u.pn * HALF + wc * 32 + 8 * fq;
#pragma unroll
        for (int ai = 0; ai < 2; ++ai)
#pragma unroll
            for (int m = 0; m < 4; ++m) {
                bf16_t* rowp = O + (size_t)(row0 + ai * HALF + m * 16) * ldc + col0;
                const float rs = rsL[ai * HALF + m * 16];
                float v[8];
#pragma unroll
                for (int n = 0; n < 2; ++n)
#pragma unroll
                    for (int i = 0; i < 4; ++i) { const float g = acc[ai][0][m][n][i] * rs, up = acc[ai][1][m][n][i] * rs; v[n * 4 + i] = g * sigmoidf_(g) * up; }
                u32x4 w; w.x = cvt_pk_bf16(v[0], v[1]); w.y = cvt_pk_bf16(v[2], v[3]); w.z = cvt_pk_bf16(v[4], v[5]); w.w = cvt_pk_bf16(v[6], v[7]);
                *(u32x4*)rowp = w;
            }
    }
};
template <bool HALFSC> struct EpiResid {
    static constexpr bool PERM = false, AFTER_DRAIN = false, MIDK = false;
    bf16_t* xb; float* ssq_part; LAS unsigned char* lds;
    __device__ __forceinline__ void operator()(const f32x4 (&acc)[2][2][4][2], const Unit& u, int wr, int wc, int fr, int fq) const {
        const float scale_ = HALFSC ? 0.5f : 1.0f; bf16_t* const xb_ = xb; float* const ssq_ = ssq_part;
        LAS float* pl = (LAS float*)(lds + LDS_SSP);
        const int col0 = u.pn * BM + wc * 32 + 4 * fq;
        const size_t base = (size_t)(u.pm * BM + wr * 64 + fr) * D + col0;
        u32x2 r[2][2][2][2];
#define ER_LOAD(buf, bb) do { _Pragma("unroll") for (int mm = 0; mm < 2; ++mm) _Pragma("unroll") for (int bj = 0; bj < 2; ++bj) _Pragma("unroll") for (int n = 0; n < 2; ++n) \
            r[buf][mm][bj][n] = *(const u32x2*)(xb_ + base + (size_t)(((bb) >> 1) * HALF + (((bb) & 1) * 2 + mm) * 16) * D + bj * HALF + n * 16); } while (0)
        ER_LOAD(0, 0);
#pragma unroll
        for (int bb = 0; bb < 4; ++bb) {
            if (bb < 3) ER_LOAD((bb + 1) & 1, bb + 1);
            const int ai = bb >> 1;
#pragma unroll
            for (int mm = 0; mm < 2; ++mm) { const int m = (bb & 1) * 2 + mm; const int rowl = ai * HALF + m * 16; const size_t off = base + (size_t)rowl * D; float ssum = 0.f;
#pragma unroll
                for (int bj = 0; bj < 2; ++bj)
#pragma unroll
                    for (int n = 0; n < 2; ++n) { const u32x2 rr = r[bb & 1][mm][bj][n]; const f32x4 a = acc[ai][bj][m][n];
                        const float o0 = bf_lo(rr.x) + a.x * scale_, o1 = bf_hi(rr.x) + a.y * scale_, o2 = bf_lo(rr.y) + a.z * scale_, o3 = bf_hi(rr.y) + a.w * scale_;
                        u32x2 w; w.x = cvt_pk_bf16(o0, o1); w.y = cvt_pk_bf16(o2, o3); *(u32x2*)(xb_ + off + bj * HALF + n * 16) = w;
                        ssum += (o0 * o0 + o1 * o1) + (o2 * o2 + o3 * o3); }
                ssum += __shfl_xor(ssum, 16); ssum += __shfl_xor(ssum, 32);
                if (fq == 0) pl[(rowl + wr * 64 + fr) * 4 + wc] = ssum;
            }
        }
#undef ER_LOAD
        asm volatile("s_waitcnt lgkmcnt(0)" ::: "memory"); __builtin_amdgcn_s_barrier();
        const int t = threadIdx.x;
        if (t < 256) { const f32x4 p = *(const LAS f32x4*)(pl + t * 4); ssq_[(size_t)(u.pm * BM + t) * 8 + u.pn] = (p.x + p.y) + (p.z + p.w); }
    }
};
constexpr int LDS_RS2 = 131072 + 8192, LDS_RS2PM = 131072 + 8192 + 2048 + 64;
__device__ __forceinline__ void rs2_panel(LAS unsigned char* lds, const float* yp, int pm) {
    volatile LAS int* pmL = (volatile LAS int*)(lds + LDS_RS2PM); LAS f32x2* rsL = (LAS f32x2*)(lds + LDS_RS2);
    if (pmL[0] != pm) {
        asm volatile("s_waitcnt lgkmcnt(0)" ::: "memory"); __builtin_amdgcn_s_barrier();
        const int t = threadIdx.x;
        if (t < 256) { const f32x4* pp = (const f32x4*)(yp + (size_t)(pm * 256 + t) * 24);
            const f32x4 a0 = pp[0], a1 = pp[1], a2 = pp[2], a3 = pp[3], b0 = pp[4], b1 = pp[5];
            const float sl = (((a0.x + a0.y) + (a0.z + a0.w)) + ((a1.x + a1.y) + (a1.z + a1.w))) + (((a2.x + a2.y) + (a2.z + a2.w)) + ((a3.x + a3.y) + (a3.z + a3.w)));
            const float sa = ((b0.x + b0.y) + (b0.z + b0.w)) + ((b1.x + b1.y) + (b1.z + b1.w));
            const float va = sa * (1.0f / 1024.f) + EPS, vl = sl * (1.0f / 1024.f) + EPS;
            rsL[t] = (f32x2){__builtin_amdgcn_rsqf(va), __builtin_amdgcn_rsqf(vl) * sqrtf(va)}; }
        if (t == 0) pmL[0] = pm;
        asm volatile("s_waitcnt vmcnt(0) lgkmcnt(0)" ::: "memory"); __builtin_amdgcn_s_barrier();
    }
}
struct EpiResidY {
    static constexpr bool PERM = false, AFTER_DRAIN = false, MIDK = true;
    bf16_t* xb; float* ssq_part; const float* yp; LAS unsigned char* lds;
    __device__ __forceinline__ void prep(const Unit& u) const { rs2_panel(lds, yp, u.pm); }
    __device__ __forceinline__ void mid(f32x4 (&acc)[2][2][4][2], const Unit& u, int wr, int wc, int fr, int fq) const {
        const LAS f32x2* rsL = (const LAS f32x2*)(lds + LDS_RS2) + wr * 64 + fr;
#pragma unroll
        for (int ai = 0; ai < 2; ++ai)
#pragma unroll
            for (int m = 0; m < 4; ++m) { const float q = rsL[ai * HALF + m * 16].y;
#pragma unroll
                for (int bj = 0; bj < 2; ++bj)
#pragma unroll
                    for (int n = 0; n < 2; ++n) acc[ai][bj][m][n] = acc[ai][bj][m][n] * q; }
    }
    __device__ __forceinline__ void operator()(const f32x4 (&acc)[2][2][4][2], const Unit& u, int wr, int wc, int fr, int fq) const {
        bf16_t* const xb_ = xb; float* const ssq_ = ssq_part;
        LAS float* pl = (LAS float*)(lds + LDS_SSP);
        const LAS f32x2* rsL = (const LAS f32x2*)(lds + LDS_RS2) + wr * 64 + fr;
        const int col0 = u.pn * BM + wc * 32 + 4 * fq;
        const size_t base = (size_t)(u.pm * BM + wr * 64 + fr) * D + col0;
        u32x2 r[2][2][2][2];
#define ER_LOAD(buf, bb) do { _Pragma("unroll") for (int mm = 0; mm < 2; ++mm) _Pragma("unroll") for (int bj = 0; bj < 2; ++bj) _Pragma("unroll") for (int n = 0; n < 2; ++n) \
            r[buf][mm][bj][n] = *(const u32x2*)(xb_ + base + (size_t)(((bb) >> 1) * HALF + (((bb) & 1) * 2 + mm) * 16) * D + bj * HALF + n * 16); } while (0)
        ER_LOAD(0, 0);
#pragma unroll
        for (int bb = 0; bb < 4; ++bb) {
            if (bb < 3) ER_LOAD((bb + 1) & 1, bb + 1);
            const int ai = bb >> 1;
#pragma unroll
            for (int mm = 0; mm < 2; ++mm) { const int m = (bb & 1) * 2 + mm; const int rowl = ai * HALF + m * 16; const size_t off = base + (size_t)rowl * D; float ssum = 0.f;
                const float scale_ = rsL[rowl].x;
#pragma unroll
                for (int bj = 0; bj < 2; ++bj)
#pragma unroll
                    for (int n = 0; n < 2; ++n) { const u32x2 rr = r[bb & 1][mm][bj][n]; const f32x4 a = acc[ai][bj][m][n];
                        const float o0 = bf_lo(rr.x) + a.x * scale_, o1 = bf_hi(rr.x) + a.y * scale_, o2 = bf_lo(rr.y) + a.z * scale_, o3 = bf_hi(rr.y) + a.w * scale_;
                        u32x2 w; w.x = cvt_pk_bf16(o0, o1); w.y = cvt_pk_bf16(o2, o3); *(u32x2*)(xb_ + off + bj * HALF + n * 16) = w;
                        ssum += (o0 * o0 + o1 * o1) + (o2 * o2 + o3 * o3); }
                ssum += __shfl_xor(ssum, 16); ssum += __shfl_xor(ssum, 32);
                if (fq == 0) pl[(rowl + wr * 64 + fr) * 4 + wc] = ssum;
            }
        }
#undef ER_LOAD
        asm volatile("s_waitcnt lgkmcnt(0)" ::: "memory"); __builtin_amdgcn_s_barrier();
        const int t = threadIdx.x;
        if (t < 256) { const f32x4 p = *(const LAS f32x4*)(pl + t * 4); ssq_[(size_t)(u.pm * BM + t) * 8 + u.pn] = (p.x + p.y) + (p.z + p.w); }
    }
};
struct EpiZ {
    static constexpr bool PERM = true, AFTER_DRAIN = false, MIDK = false;
    bf16_t* Z; bf16_t* Vt; bf16_t* Kh; const float* ssq; LAS unsigned char* lds;
    __device__ __forceinline__ void operator()(const f32x4 (&acc)[2][2][4][2], const Unit& u, int wr, int wc, int fr, int fq) const {
        rs_panel(lds, ssq, u.pm);
        float rs[2][4];
        { const LAS float* rsL = (const LAS float*)(lds + LDS_RS) + wr * 64 + fr;
#pragma unroll
          for (int ai = 0; ai < 2; ++ai)
#pragma unroll
            for (int m = 0; m < 4; ++m) rs[ai][m] = rsL[ai * HALF + m * 16]; }
        if (u.pn >= 12 && u.pn < 16) {
            const int b = (u.pm * BM) / SEQ; const int s0 = (u.pm * BM) % SEQ + wr * 64 + fr;
#pragma unroll
            for (int bj = 0; bj < 2; ++bj) {
                const int head = (u.pn - 12) * 2 + bj;
                bf16_t* hb = Kh + ((size_t)(b * NH + head) * SEQ + s0) * HD + wc * 32 + 8 * fq;
#pragma unroll
                for (int ai = 0; ai < 2; ++ai)
#pragma unroll
                    for (int m = 0; m < 4; ++m) { const f32x4 v0 = acc[ai][bj][m][0] * rs[ai][m], v1 = acc[ai][bj][m][1] * rs[ai][m];
                        u32x4 w; w.x = cvt_pk_bf16(v0[0], v0[1]); w.y = cvt_pk_bf16(v0[2], v0[3]); w.z = cvt_pk_bf16(v1[0], v1[1]); w.w = cvt_pk_bf16(v1[2], v1[3]);
                        *(u32x4*)(hb + (size_t)(ai * HALF + m * 16) * HD) = w; }
            }
        } else if (u.pn < 12) {
            const int row0 = u.pm * BM + wr * 64 + fr; const int col0 = u.pn * BM + wc * 32 + 8 * fq;
#pragma unroll
            for (int ai = 0; ai < 2; ++ai)
#pragma unroll
                for (int m = 0; m < 4; ++m) {
                    bf16_t* rowp = Z + (size_t)(row0 + ai * HALF + m * 16) * ZLD + col0;
#pragma unroll
                    for (int bj = 0; bj < 2; ++bj) { const f32x4 v0 = acc[ai][bj][m][0] * rs[ai][m], v1 = acc[ai][bj][m][1] * rs[ai][m];
                        u32x4 w; w.x = cvt_pk_bf16(v0[0], v0[1]); w.y = cvt_pk_bf16(v0[2], v0[3]); w.z = cvt_pk_bf16(v1[0], v1[1]); w.w = cvt_pk_bf16(v1[2], v1[3]);
                        *(u32x4*)(rowp + bj * HALF) = w; }
                }
        } else {
            const int b = (u.pm * BM) / SEQ; const int s0 = (u.pm * BM) % SEQ + wr * 64 + fr;
#pragma unroll
            for (int bj = 0; bj < 2; ++bj) {
                const int head = (u.pn - 16) * 2 + bj;
                bf16_t* hb = Vt + ((size_t)(b * NH + head) * HD + wc * 32 + 8 * fq) * SEQ + s0;
#pragma unroll
                for (int ai = 0; ai < 2; ++ai)
#pragma unroll
                    for (int m = 0; m < 4; ++m)
#pragma unroll
                        for (int n = 0; n < 2; ++n)
#pragma unroll
                            for (int i = 0; i < 4; ++i) {
                                const unsigned w = cvt_pk_bf16(acc[ai][bj][m][n][i] * rs[ai][m], 0.f);
                                hb[(size_t)(4 * n + i) * SEQ + ai * HALF + m * 16] = (bf16_t)(w & 0xffffu);
                            }
            }
        }
    }
};

template <class Epi, class Sched, bool ALIGN_EPI = false, bool SP2 = false>
__device__ __forceinline__ void gemm_phase(LAS unsigned char* lds, const Gemm g, const Sched& S, const Epi& E) {
    int tid_l = threadIdx.x; LAUNDER(tid_l);
    const int tid = tid_l, wid = __builtin_amdgcn_readfirstlane(tid >> 6), lane = tid & 63, wr = wid >> 2, wc = wid & 3, fr = lane & 15, fq = lane >> 4;
    const int K = g.K, nt = K / BK;
    unsigned voffA[2], voffB[2];
#pragma unroll
    for (int i = 0; i < 2; ++i) { int R, C; stage_rc(tid * 16 + i * 8192, R, C); const int Rb = Epi::PERM ? ((R & ~31) + perm32(R & 31)) : R;
        voffA[i] = (unsigned)(R * K + C) * 2u; voffB[i] = (unsigned)(Rb * K + C) * 2u; }
    const size_t kstep = (size_t)(BK * 2);
    const size_t hstep = (size_t)HALF * K * 2;
    const size_t tstep = 2 * hstep;
    const unsigned ldsw = (unsigned)wid * 1024u;
    const int aoff = lds_byte(wr * 64 + fr, fq * 8), boff = lds_byte(wc * 32 + fr, fq * 8);
#define PG8_SA(b, h) (((b) * 2 + (h)) * HTB)
#define PG8_SB(b, h) ((4 + (b) * 2 + (h)) * HTB)
#define PG8_STAGE(bufoff, gbase, voff) do { _Pragma("unroll") for (int _i = 0; _i < 2; ++_i) \
        __builtin_amdgcn_global_load_lds((const unsigned*)((const char*)(gbase) + (voff)[_i]), (LAS unsigned*)(lds + (bufoff) + ldsw + _i * 8192), 16, 0, 0); } while (0)
#define PG8_LDA(dst, b, h) do { _Pragma("unroll") for (int m = 0; m < 4; ++m) _Pragma("unroll") for (int k = 0; k < 2; ++k) dst[m][k] = *(const LAS bf16x8*)(lds + PG8_SA(b, h) + aoff + m * 2048 + k * 1024); } while (0)
#define PG8_LDB(dst, b, h) do { _Pragma("unroll") for (int n = 0; n < 2; ++n) _Pragma("unroll") for (int k = 0; k < 2; ++k) dst[n][k] = *(const LAS bf16x8*)(lds + PG8_SB(b, h) + boff + n * 2048 + k * 1024); } while (0)
#define PG8_MMA(ai, bj, At, Bt) do { __builtin_amdgcn_s_setprio(1); _Pragma("unroll") for (int m = 0; m < 4; ++m) _Pragma("unroll") for (int n = 0; n < 2; ++n) _Pragma("unroll") for (int k = 0; k < 2; ++k) \
        acc[ai][bj][m][n] = __builtin_amdgcn_mfma_f32_16x16x32_bf16(Bt[n][k], At[m][k], acc[ai][bj][m][n], 0, 0, 0); __builtin_amdgcn_s_setprio(0); } while (0)
#define PG8_WAIT_V(n) asm volatile("s_waitcnt vmcnt(" #n ")" ::: "memory")
#define PG8_WAIT_L(n) asm volatile("s_waitcnt lgkmcnt(" #n ")" ::: "memory")
#define PG8_BAR __builtin_amdgcn_s_barrier()
#define PG8_SCHED __builtin_amdgcn_sched_barrier(0)
    Unit cur, nxt; int ui = 0;
    if (!S.next(0, cur)) return;
    f32x4 acc[2][2][4][2];
#pragma unroll
    for (int a = 0; a < 2; ++a)
#pragma unroll
        for (int b = 0; b < 2; ++b)
#pragma unroll
            for (int m = 0; m < 4; ++m)
#pragma unroll
                for (int n = 0; n < 2; ++n) acc[a][b][m][n] = (f32x4){0.f, 0.f, 0.f, 0.f};
    bf16x8 At[4][2], B0[2][2], B1[2][2];
    const char* cA = (const char*)g.A + (size_t)cur.pm * tstep; const char* cB = (const char*)g.Bt + (size_t)cur.pn * tstep;
    S.a_ready(cur);
    if constexpr (SP2) {
        PG8_STAGE(PG8_SB(0, 0), cB, voffB); PG8_STAGE(PG8_SB(0, 1), cB + hstep, voffB); PG8_STAGE(PG8_SA(0, 0), cA, voffA); PG8_STAGE(PG8_SA(0, 1), cA + hstep, voffA);
        if (wr == 1) PG8_BAR;
        PG8_WAIT_V(2); PG8_BAR;
        PG8_STAGE(PG8_SB(1, 0), cB + kstep, voffB); PG8_STAGE(PG8_SA(1, 0), cA + kstep, voffA); PG8_STAGE(PG8_SB(1, 1), cB + hstep + kstep, voffB);
        PG8_WAIT_V(6); PG8_BAR;
    } else {
        PG8_STAGE(PG8_SB(0, 0), cB, voffB); PG8_STAGE(PG8_SA(0, 0), cA, voffA); PG8_STAGE(PG8_SB(0, 1), cB + hstep, voffB); PG8_STAGE(PG8_SA(0, 1), cA + hstep, voffA);
        if (wr == 1) PG8_BAR;
        PG8_WAIT_V(4); PG8_BAR;
        PG8_STAGE(PG8_SB(1, 0), cB + kstep, voffB); PG8_STAGE(PG8_SA(1, 0), cA + kstep, voffA); PG8_STAGE(PG8_SB(1, 1), cB + hstep + kstep, voffB);
        PG8_WAIT_V(6); PG8_BAR;
    }
    for (;;) {
        const bool has_next = S.next(ui + 1, nxt);
        const char* nA = has_next ? (const char*)g.A + (size_t)nxt.pm * tstep : cA; const char* nB = has_next ? (const char*)g.Bt + (size_t)nxt.pn * tstep : cB;
        for (int t = 0; t < nt; t += 2) {
            if constexpr (Epi::MIDK) { if (t == (nt >> 1)) E.mid(acc, cur, wr, wc, fr, fq); }
            const bool last = (t == nt - 2);
            const char* a1 = cA + (size_t)(t + 1) * kstep;
            const char* a2 = last ? nA : cA + (size_t)(t + 2) * kstep; const char* b2 = last ? nB : cB + (size_t)(t + 2) * kstep;
            const char* a3 = a2 + kstep; const char* b3 = b2 + kstep;
            if (last && has_next) S.a_ready(nxt);
            if constexpr (SP2) {
            PG8_LDB(B0, 0, 0); PG8_LDB(B1, 0, 1); PG8_SCHED; PG8_LDA(At, 0, 0); PG8_STAGE(PG8_SA(1, 1), a1 + hstep, voffA);
            PG8_WAIT_V(8); PG8_WAIT_L(0); PG8_BAR; PG8_MMA(0, 0, At, B0); PG8_MMA(0, 1, At, B1); PG8_BAR; PG8_SCHED;
            PG8_LDA(At, 0, 1); PG8_STAGE(PG8_SB(0, 0), b2, voffB); PG8_STAGE(PG8_SB(0, 1), b2 + hstep, voffB); PG8_STAGE(PG8_SA(0, 0), a2, voffA);
            PG8_WAIT_V(8); PG8_WAIT_L(0); PG8_BAR; PG8_MMA(1, 0, At, B0); PG8_MMA(1, 1, At, B1); PG8_BAR; PG8_SCHED;
            PG8_LDB(B0, 1, 0); PG8_LDB(B1, 1, 1); PG8_SCHED; PG8_LDA(At, 1, 0); PG8_STAGE(PG8_SA(0, 1), a2 + hstep, voffA);
            PG8_WAIT_V(8); PG8_WAIT_L(0); PG8_BAR; PG8_MMA(0, 0, At, B0); PG8_MMA(0, 1, At, B1); PG8_BAR; PG8_SCHED;
            PG8_LDA(At, 1, 1); PG8_STAGE(PG8_SB(1, 0), b3, voffB); PG8_STAGE(PG8_SB(1, 1), b3 + hstep, voffB); PG8_STAGE(PG8_SA(1, 0), a3, voffA);
            PG8_WAIT_V(8); PG8_WAIT_L(0); PG8_BAR; PG8_MMA(1, 0, At, B0); PG8_MMA(1, 1, At, B1); PG8_BAR; PG8_SCHED;
            } else {
            PG8_LDB(B0, 0, 0); PG8_SCHED; PG8_LDA(At, 0, 0); PG8_STAGE(PG8_SA(1, 1), a1 + hstep, voffA);
            PG8_WAIT_L(8); PG8_BAR; PG8_WAIT_L(0); PG8_MMA(0, 0, At, B0); PG8_BAR; PG8_SCHED;
            PG8_LDB(B1, 0, 1); PG8_STAGE(PG8_SB(0, 0), b2, voffB);
            PG8_BAR; PG8_WAIT_L(0); PG8_MMA(0, 1, At, B1); PG8_BAR;
            PG8_LDA(At, 0, 1); PG8_STAGE(PG8_SA(0, 0), a2, voffA);
            PG8_BAR; PG8_WAIT_L(0); PG8_MMA(1, 0, At, B0); PG8_BAR; PG8_SCHED;
            PG8_STAGE(PG8_SB(0, 1), b2 + hstep, voffB);
            PG8_WAIT_V(6); PG8_BAR; PG8_MMA(1, 1, At, B1); PG8_BAR;
            PG8_LDB(B0, 1, 0); PG8_SCHED; PG8_LDA(At, 1, 0); PG8_STAGE(PG8_SA(0, 1), a2 + hstep, voffA);
            PG8_WAIT_L(8); PG8_BAR; PG8_WAIT_L(0); PG8_MMA(0, 0, At, B0); PG8_BAR; PG8_SCHED;
            PG8_LDB(B1, 1, 1); PG8_STAGE(PG8_SB(1, 0), b3, voffB);
            PG8_BAR; PG8_WAIT_L(0); PG8_MMA(0, 1, At, B1); PG8_BAR;
            PG8_LDA(At, 1, 1); PG8_STAGE(PG8_SA(1, 0), a3, voffA);
            PG8_BAR; PG8_WAIT_L(0); PG8_MMA(1, 0, At, B0); PG8_BAR; PG8_SCHED;
            PG8_STAGE(PG8_SB(1, 1), b3 + hstep, voffB);
            PG8_WAIT_V(6); PG8_BAR; PG8_MMA(1, 1, At, B1); PG8_BAR;
            }
        }
        if constexpr (ALIGN_EPI) { if (wr == 0) PG8_BAR; }
        if constexpr (!Epi::AFTER_DRAIN) { E(acc, cur, wr, wc, fr, fq); S.done(cur); }
        if constexpr (Epi::MIDK) { if (has_next) E.prep(nxt); }
        if (!has_next) break;
#pragma unroll
        for (int a = 0; a < 2; ++a)
#pragma unroll
            for (int b = 0; b < 2; ++b)
#pragma unroll
                for (int m = 0; m < 4; ++m)
#pragma unroll
                    for (int n = 0; n < 2; ++n) acc[a][b][m][n] = (f32x4){0.f, 0.f, 0.f, 0.f};
        cur = nxt; cA = nA; cB = nB; ++ui;
        if constexpr (ALIGN_EPI) { if (wr == 1) PG8_BAR; }
    }
    PG8_WAIT_V(0);
    if constexpr (!ALIGN_EPI) { if (wr == 0) PG8_BAR; }
    PG8_BAR;
#undef PG8_SA
#undef PG8_SB
#undef PG8_STAGE
#undef PG8_LDA
#undef PG8_LDB
#undef PG8_MMA
#undef PG8_WAIT_V
#undef PG8_WAIT_L
#undef PG8_BAR
#undef PG8_SCHED
}
}

#define LDS_WAIT() asm volatile("s_waitcnt lgkmcnt(0)" ::: "memory")

__device__ __forceinline__ float wave_sum(float v) {
#pragma unroll
    for (int o = 1; o < 64; o <<= 1) v += __shfl_xor(v, o);
    return v;
}

__device__ __forceinline__ void p0_transpose_item(const float* W, const float* gain, int K, int N, bf16_t* WT, int ilv, LAS float* scr, int item, int lane, const float* gain2 = nullptr) {
    const int nblk = N / 32, kb = item / nblk, nb = item % nblk, k0 = 64 * kb, n0 = 32 * nb;
#pragma unroll 8
    for (int i = 0; i < 32; ++i) { const int kk = 2 * i + (lane >> 5); scr[kk * 33 + (lane & 31)] = W[(size_t)(k0 + kk) * N + n0 + (lane & 31)]; }
    LDS_WAIT(); asm volatile("" ::: "memory");
    const int c = lane & 7;
    f32x4 g0 = (f32x4){1.f, 1.f, 1.f, 1.f}, g1 = g0;
    if (gain) { const float* gp = (gain2 && k0 >= 1024) ? gain2 + (k0 - 1024) : gain + k0; g0 = *(const f32x4*)(gp + 8 * c); g1 = *(const f32x4*)(gp + 8 * c + 4); }
#pragma unroll
    for (int j = 0; j < 4; ++j) { const int n = (lane >> 3) + 8 * j; const LAS float* s = scr + (8 * c) * 33 + n;
        u32x4 o; o.x = cvt_pk_bf16(s[0 * 33] * g0.x, s[1 * 33] * g0.y); o.y = cvt_pk_bf16(s[2 * 33] * g0.z, s[3 * 33] * g0.w); o.z = cvt_pk_bf16(s[4 * 33] * g1.x, s[5 * 33] * g1.y); o.w = cvt_pk_bf16(s[6 * 33] * g1.z, s[7 * 33] * g1.w);
        const int nn = n0 + n; const int row = ilv < 0 ? nn : ((nn >> 7) * 256 + (nn & 127) + ilv);
        *(u32x4*)(WT + (size_t)row * K + k0 + 8 * c) = o; }
    LDS_WAIT(); asm volatile("" ::: "memory");
}

__device__ __forceinline__ void rms_rows_bf16(const float* x, const float* g, bf16_t* out, int gw, int NGW, int lane) {
    LAUNDER(lane);
    f32x4 gv[8];
#pragma unroll
    for (int j = 0; j < 8; ++j) gv[j] = *(const f32x4*)(g + 4 * lane + 256 * j);
    for (int m = gw; m < M; m += NGW) {
        const f32x4* xr = (const f32x4*)(x + (size_t)m * D) + lane; f32x4 v[8]; float s = 0.f;
#pragma unroll
        for (int j = 0; j < 8; ++j) { v[j] = xr[64 * j]; s += (v[j].x * v[j].x + v[j].y * v[j].y) + (v[j].z * v[j].z + v[j].w * v[j].w); }
        const float rstd = 1.0f / sqrtf(wave_sum(s) * (1.0f / D) + EPS);
        u32x2* o8 = (u32x2*)(out + (size_t)m * D) + lane;
#pragma unroll
        for (int j = 0; j < 8; ++j) { const f32x4 o = v[j] * rstd * gv[j]; u32x2 w; w.x = cvt_pk_bf16(o.x, o.y); w.y = cvt_pk_bf16(o.z, o.w); o8[64 * j] = w; }
    }
}
__device__ __forceinline__ void cast_rows_bf16(const float* x, bf16_t* out, float* ssq, int gw, int NGW, int lane) {
    LAUNDER(lane);
    for (int m = gw; m < M; m += NGW) {
        const f32x4* xr = (const f32x4*)(x + (size_t)m * D) + lane; f32x4 v[8]; float s = 0.f;
#pragma unroll
        for (int j = 0; j < 8; ++j) { v[j] = xr[64 * j]; s += (v[j].x * v[j].x + v[j].y * v[j].y) + (v[j].z * v[j].z + v[j].w * v[j].w); }
        s = wave_sum(s);
        if (lane == 0) { f32x4* pp = (f32x4*)(ssq + (size_t)m * 8); pp[0] = (f32x4){s, 0.f, 0.f, 0.f}; pp[1] = (f32x4){0.f, 0.f, 0.f, 0.f}; }
        u32x2* o8 = (u32x2*)(out + (size_t)m * D) + lane;
#pragma unroll
        for (int j = 0; j < 8; ++j) { u32x2 w; w.x = cvt_pk_bf16(v[j].x, v[j].y); w.y = cvt_pk_bf16(v[j].z, v[j].w); o8[64 * j] = w; }
    }
}
__device__ __forceinline__ void rms_rows_f32_inplace(float* x, const float* g, int gw, int NGW, int lane) {
    LAUNDER(lane);
    f32x4 gv[8];
#pragma unroll
    for (int j = 0; j < 8; ++j) gv[j] = *(const f32x4*)(g + 4 * lane + 256 * j);
    for (int m = gw; m < M; m += NGW) {
        f32x4* xr = (f32x4*)(x + (size_t)m * D) + lane; f32x4 v[8]; float s = 0.f;
#pragma unroll
        for (int j = 0; j < 8; ++j) { v[j] = xr[64 * j]; s += (v[j].x * v[j].x + v[j].y * v[j].y) + (v[j].z * v[j].z + v[j].w * v[j].w); }
        const float rstd = 1.0f / sqrtf(wave_sum(s) * (1.0f / D) + EPS);
#pragma unroll
        for (int j = 0; j < 8; ++j) xr[64 * j] = v[j] * rstd * gv[j];
    }
}
__device__ __forceinline__ void rms_rows_bf16_to_f32(const bf16_t* x, const float* g, float* out, int gw, int NGW, int lane) {
    LAUNDER(lane);
    f32x4 gv[4][2];
#pragma unroll
    for (int j = 0; j < 4; ++j) { const float* gp = g + 512 * j + 8 * lane; gv[j][0] = *(const f32x4*)gp; gv[j][1] = *(const f32x4*)(gp + 4); }
    for (int m = gw; m < M; m += NGW) {
        const u32x4* xr = (const u32x4*)(x + (size_t)m * D) + lane; u32x4 raw[4]; float s = 0.f;
#pragma unroll
        for (int j = 0; j < 4; ++j) raw[j] = xr[64 * j];
        float v[4][8];
#pragma unroll
        for (int j = 0; j < 4; ++j) {
            v[j][0] = bf_lo(raw[j].x); v[j][1] = bf_hi(raw[j].x); v[j][2] = bf_lo(raw[j].y); v[j][3] = bf_hi(raw[j].y);
            v[j][4] = bf_lo(raw[j].z); v[j][5] = bf_hi(raw[j].z); v[j][6] = bf_lo(raw[j].w); v[j][7] = bf_hi(raw[j].w);
#pragma unroll
            for (int e = 0; e < 8; ++e) s += v[j][e] * v[j][e];
        }
        const float rstd = 1.0f / sqrtf(wave_sum(s) * (1.0f / D) + EPS);
        f32x4* orow = (f32x4*)(out + (size_t)m * D + 8 * lane);
#pragma unroll
        for (int j = 0; j < 4; ++j) {
            orow[128 * j] = (f32x4){v[j][0] * rstd * gv[j][0].x, v[j][1] * rstd * gv[j][0].y, v[j][2] * rstd * gv[j][0].z, v[j][3] * rstd * gv[j][0].w};
            orow[128 * j + 1] = (f32x4){v[j][4] * rstd * gv[j][1].x, v[j][5] * rstd * gv[j][1].y, v[j][6] * rstd * gv[j][1].z, v[j][7] * rstd * gv[j][1].w};
        }
    }
}
__device__ __forceinline__ void ynorm_rows(bf16_t* y, const float* g_lru, const float* g_att, int gw, int NGW, int lane) {
    LAUNDER(lane);
    f32x4 gv[4][2];
#pragma unroll
    for (int j = 0; j < 4; ++j) { const float* gp = (j < 2 ? g_lru + 512 * j : g_att + 512 * (j - 2)) + 8 * lane; gv[j][0] = *(const f32x4*)gp; gv[j][1] = *(const f32x4*)(gp + 4); }
    for (int m = gw; m < M; m += NGW) {
        u32x4* yr = (u32x4*)(y + (size_t)m * D) + lane; u32x4 raw[4]; float s0 = 0.f, s1 = 0.f;
#pragma unroll
        for (int j = 0; j < 4; ++j) raw[j] = yr[64 * j];
        float v[4][8];
#pragma unroll
        for (int j = 0; j < 4; ++j) {
            v[j][0] = bf_lo(raw[j].x); v[j][1] = bf_hi(raw[j].x); v[j][2] = bf_lo(raw[j].y); v[j][3] = bf_hi(raw[j].y);
            v[j][4] = bf_lo(raw[j].z); v[j][5] = bf_hi(raw[j].z); v[j][6] = bf_lo(raw[j].w); v[j][7] = bf_hi(raw[j].w);
            float s = 0.f;
#pragma unroll
            for (int e = 0; e < 8; ++e) s += v[j][e] * v[j][e];
            if (j < 2) s0 += s; else s1 += s;
        }
        const float r0 = 1.0f / sqrtf(wave_sum(s0) * (1.0f / 1024.f) + EPS), r1 = 1.0f / sqrtf(wave_sum(s1) * (1.0f / 1024.f) + EPS);
#pragma unroll
        for (int j = 0; j < 4; ++j) { const float r = j < 2 ? r0 : r1; u32x4 w;
            w.x = cvt_pk_bf16(v[j][0] * r * gv[j][0].x, v[j][1] * r * gv[j][0].y); w.y = cvt_pk_bf16(v[j][2] * r * gv[j][0].z, v[j][3] * r * gv[j][0].w);
            w.z = cvt_pk_bf16(v[j][4] * r * gv[j][1].x, v[j][5] * r * gv[j][1].y); w.w = cvt_pk_bf16(v[j][6] * r * gv[j][1].z, v[j][7] * r * gv[j][1].w);
            yr[64 * j] = w; }
    }
}

constexpr int LM_BIAS = 0;
constexpr int LM_CW = 8448;
constexpr int LM_CB = 9472;
constexpr int LM_P = 10240;
constexpr int LM_H = 18432;
__device__ __forceinline__ void lru_unit(LAS unsigned char* lds, const bf16_t* zm, bf16_t* yraw, float* yp, const float* conv_w, const float* conv_b, const float* wa, const float* ba,
                                         const float* wx, const float* bx, const float* lam, int b, int hb, int tid) {
    LAUNDER(tid);
    const int lane = tid & 63, w = tid >> 6, fr = lane & 15, fq = lane >> 4;
    LAS float* cwL = (LAS float*)(lds + LM_CW); LAS float* cbL = (LAS float*)(lds + LM_CB);
    if (tid < 256) cwL[tid] = conv_w[(tid >> 6) * DL + hb * 64 + (tid & 63)];
    else if (tid < 320) cbL[tid - 256] = conv_b[hb * 64 + tid - 256];
    bf16x8 WA[4][2], WX[4][2];
#pragma unroll
    for (int nt = 0; nt < 4; ++nt)
#pragma unroll
        for (int ks = 0; ks < 2; ++ks) {
            const float* pa = wa + ((size_t)hb * 64 + ks * 32 + 8 * fq) * 64 + nt * 16 + fr; const float* px = wx + ((size_t)hb * 64 + ks * 32 + 8 * fq) * 64 + nt * 16 + fr;
            u32x4 ua, ux;
            ua.x = cvt_pk_bf16(pa[0 * 64], pa[1 * 64]); ua.y = cvt_pk_bf16(pa[2 * 64], pa[3 * 64]); ua.z = cvt_pk_bf16(pa[4 * 64], pa[5 * 64]); ua.w = cvt_pk_bf16(pa[6 * 64], pa[7 * 64]);
            ux.x = cvt_pk_bf16(px[0 * 64], px[1 * 64]); ux.y = cvt_pk_bf16(px[2 * 64], px[3 * 64]); ux.z = cvt_pk_bf16(px[4 * 64], px[5 * 64]); ux.w = cvt_pk_bf16(px[6 * 64], px[7 * 64]);
            WA[nt][ks] = __builtin_bit_cast(bf16x8, ua); WX[nt][ks] = __builtin_bit_cast(bf16x8, ux);
        }
    bf16x8 ID[2];
#pragma unroll
    for (int p = 0; p < 2; ++p)
#pragma unroll
        for (int e = 0; e < 8; ++e) ID[p][e] = (8 * fq + e == 16 * p + fr) ? (short)0x3F80 : (short)0;
    float pba[4], pbx[4], pcl[4];
#pragma unroll
    for (int nt = 0; nt < 4; ++nt) { const int c = hb * 64 + nt * 16 + fr; pba[nt] = ba[c]; pbx[nt] = bx[c]; pcl[nt] = -8.0f * log1pf(expf(-lam[c])); }
    __syncthreads();
    float hin[4] = {0.f, 0.f, 0.f, 0.f};
    const bf16_t* zb = zm + (size_t)b * SEQ * ZLD + hb * 64;
    LAS f32x2* TOT = (LAS f32x2*)(lds + LM_P);
    u32x4 XR[2][4], GR[2];
    {
        const int tA = 16 * w + fr;
#pragma unroll
        for (int ks = 0; ks < 2; ++ks) {
            const int ch0 = ks * 32 + 8 * fq;
#pragma unroll
            for (int tap = 0; tap < 4; ++tap) { const int t = tA - 3 + tap; const int tt = t >= 0 ? t : 0; XR[ks][tap] = *(const u32x4*)(zb + (size_t)tt * ZLD + ch0); }
            GR[ks] = *(const u32x4*)(zb + (size_t)tA * ZLD + 1024 + ch0);
        }
    }
#pragma unroll 1
    for (int sc = 0; sc < 16; ++sc) {
        const int tA = sc * 128 + 16 * w + fr;
        const int tN = sc < 15 ? tA + 128 : tA;
        u32x4 XN[2][4], GN[2];
#pragma unroll
        for (int ks = 0; ks < 2; ++ks) {
            const int ch0 = ks * 32 + 8 * fq;
#pragma unroll
            for (int tap = 0; tap < 4; ++tap) XN[ks][tap] = *(const u32x4*)(zb + (size_t)(tN - 3 + tap) * ZLD + ch0);
            GN[ks] = *(const u32x4*)(zb + (size_t)tN * ZLD + 1024 + ch0);
        }
        bf16x8 XC[2], GL[2];
#pragma unroll
        for (int ks = 0; ks < 2; ++ks) {
            const int ch0 = ks * 32 + 8 * fq;
            const f32x4 c0 = *(const LAS f32x4*)(cbL + ch0), c1 = *(const LAS f32x4*)(cbL + ch0 + 4);
            float a8[8] = {c0.x, c0.y, c0.z, c0.w, c1.x, c1.y, c1.z, c1.w};
#pragma unroll
            for (int tap = 0; tap < 4; ++tap) {
                const bool ok = (tA - 3 + tap) >= 0;
                u32x4 xr = XR[ks][tap];
                if (!ok) xr = (u32x4){0u, 0u, 0u, 0u};
                const f32x4 w0 = *(const LAS f32x4*)(cwL + tap * 64 + ch0), w1 = *(const LAS f32x4*)(cwL + tap * 64 + ch0 + 4);
                a8[0] += w0.x * bf_lo(xr.x); a8[1] += w0.y * bf_hi(xr.x); a8[2] += w0.z * bf_lo(xr.y); a8[3] += w0.w * bf_hi(xr.y);
                a8[4] += w1.x * bf_lo(xr.z); a8[5] += w1.y * bf_hi(xr.z); a8[6] += w1.z * bf_lo(xr.w); a8[7] += w1.w * bf_hi(xr.w);
            }
            u32x4 pk; pk.x = cvt_pk_bf16(a8[0], a8[1]); pk.y = cvt_pk_bf16(a8[2], a8[3]); pk.z = cvt_pk_bf16(a8[4], a8[5]); pk.w = cvt_pk_bf16(a8[6], a8[7]);
            XC[ks] = __builtin_bit_cast(bf16x8, pk);
            GL[ks] = __builtin_bit_cast(bf16x8, GR[ks]);
        }
        float hl[4][4], pc[4][4], gel[4][4], PE[4], HE[4];
        LAS f32x2* totw = TOT + ((sc & 1) * 8 + w) * 64;
#pragma unroll
        for (int nt = 0; nt < 4; ++nt) {
            f32x4 ga = (f32x4){0.f, 0.f, 0.f, 0.f}, gx = ga, xo = ga, go = ga;
#pragma unroll
            for (int ks = 0; ks < 2; ++ks) { ga = __builtin_amdgcn_mfma_f32_16x16x32_bf16(XC[ks], WA[nt][ks], ga, 0, 0, 0); gx = __builtin_amdgcn_mfma_f32_16x16x32_bf16(XC[ks], WX[nt][ks], gx, 0, 0, 0); }
            xo = __builtin_amdgcn_mfma_f32_16x16x32_bf16(XC[nt >> 1], ID[nt & 1], xo, 0, 0, 0);
            go = __builtin_amdgcn_mfma_f32_16x16x32_bf16(GL[nt >> 1], ID[nt & 1], go, 0, 0, 0);
#pragma unroll
            for (int j = 0; j < 4; ++j) {
                const float r = sigmoidf_(ga[j] + pba[nt]), ig = sigmoidf_(gx[j] + pbx[nt]);
                const float la = pcl[nt] * r;
                const float a = fast_exp2(la * LOG2E);
                const float x2 = 2.0f * la;
                float ome = -x2 * (1.0f + x2 * 0.5f * (1.0f + x2 * (1.0f / 3.0f)));
                if (x2 < -0.03f) ome = 1.0f - a * a;
                const float u = sqrtf(ome) * ig * xo[j];
                if (j == 0) { hl[nt][0] = u; pc[nt][0] = a; }
                else { hl[nt][j] = a * hl[nt][j - 1] + u; pc[nt][j] = pc[nt][j - 1] * a; }
                const float gv = go[j];
                gel[nt][j] = gv * sigmoidf_(1.5957691216057308f * (gv + 0.044715f * gv * gv * gv));
            }
            float P = pc[nt][3], H = hl[nt][3];
            { const float Pp = __shfl_up(P, 16), Hp = __shfl_up(H, 16); if (fq >= 1) { H = P * Hp + H; P = P * Pp; } }
            { const float Pp = __shfl_up(P, 32), Hp = __shfl_up(H, 32); if (fq >= 2) { H = P * Hp + H; P = P * Pp; } }
            { float Pe = __shfl_up(P, 16), He = __shfl_up(H, 16); if (fq == 0) { Pe = 1.0f; He = 0.0f; } PE[nt] = Pe; HE[nt] = He; }
            if (fq == 3) totw[nt * 16 + fr] = (f32x2){P, H};
        }
        __syncthreads();
        float psq[4] = {0.f, 0.f, 0.f, 0.f};
#pragma unroll
        for (int nt = 0; nt < 4; ++nt) {
            float hrun = hin[nt], hws = hin[nt];
#pragma unroll
            for (int w2 = 0; w2 < 8; ++w2) { const f32x2 t2 = TOT[((sc & 1) * 8 + w2) * 64 + nt * 16 + fr]; hrun = t2.x * hrun + t2.y; if (w2 + 1 == w) hws = hrun; }
            hin[nt] = hrun;
            const float hs = PE[nt] * hws + HE[nt];
#pragma unroll
            for (int j = 0; j < 4; ++j) {
                const float ov = (hl[nt][j] + pc[nt][j] * hs) * gel[nt][j]; psq[j] += ov * ov;
                const unsigned o = cvt_pk_bf16(ov, 0.f);
                yraw[(size_t)(b * SEQ + sc * 128 + 16 * w + 4 * fq + j) * D + hb * 64 + nt * 16 + fr] = (bf16_t)(o & 0xffffu);
            }
        }
#pragma unroll
        for (int j = 0; j < 4; ++j) { float q = psq[j]; q += __shfl_xor(q, 1); q += __shfl_xor(q, 2); q += __shfl_xor(q, 4); q += __shfl_xor(q, 8);
            if (fr == 0) yp[(size_t)(b * SEQ + sc * 128 + 16 * w + 4 * fq + j) * 24 + hb] = q; }
#pragma unroll
        for (int ks = 0; ks < 2; ++ks) {
#pragma unroll
            for (int tap = 0; tap < 4; ++tap) XR[ks][tap] = XN[ks][tap];
            GR[ks] = GN[ks];
        }
    }
    __syncthreads();
}

constexpr int LM_ATT = 32768;
#define ATT_COMPUTE(FAR) do { \
        bf16x8 Kf[2][4], Vf[8]; \
        _Pragma("unroll") for (int t = 0; t < 2; ++t) _Pragma("unroll") for (int ks = 0; ks < 4; ++ks) Kf[t][ks] = *(const LAS bf16x8*)(sb + (t * 4 + ks) * 1024 + foff); \
        _Pragma("unroll") for (int dt = 0; dt < 8; ++dt) Vf[dt] = *(const LAS bf16x8*)(sb + 8192 + dt * 1024 + foff); \
        f32x4 St[2][2]; \
        _Pragma("unroll") for (int t = 0; t < 2; ++t) _Pragma("unroll") for (int qt = 0; qt < 2; ++qt) { f32x4 s_ = (f32x4){0.f, 0.f, 0.f, 0.f}; \
            _Pragma("unroll") for (int ks = 0; ks < 4; ++ks) s_ = __builtin_amdgcn_mfma_f32_16x16x32_bf16(Kf[t][ks], Q[qt][ks], s_, 0, 0, 0); \
            St[t][qt] = s_; } \
        bf16x8 Pf[2]; \
        _Pragma("unroll") for (int qt = 0; qt < 2; ++qt) { \
            const int qpos = c * 64 + qh * 32 + qt * 16 + fr; \
            float sv[8]; float bm = -1e30f; \
            _Pragma("unroll") for (int t = 0; t < 2; ++t) _Pragma("unroll") for (int j = 0; j < 4; ++j) { float bv_; \
                if (FAR) bv_ = bias0; else { int rel = k0 + 8 * fq + 4 * t + j - qpos; rel = rel < -128 ? -128 : (rel > 128 ? 128 : rel); bv_ = bias[rel + 128]; } \
                const float s_ = St[t][qt][j] * SC + bv_; sv[t * 4 + j] = s_; bm = fmaxf(bm, s_); } \
            bm = fmaxf(bm, __shfl_xor(bm, 16)); bm = fmaxf(bm, __shfl_xor(bm, 32)); \
            const float mn = (bm > mrun[qt] + 8.0f) ? bm : mrun[qt];     \
            if (__builtin_amdgcn_ballot_w64(mn != mrun[qt]) != 0ull) { const float alpha = fast_exp2(mrun[qt] - mn); mrun[qt] = mn; lrun[qt] = lrun[qt] * alpha; \
                _Pragma("unroll") for (int dt = 0; dt < 8; ++dt) O[dt][qt] = O[dt][qt] * alpha; } \
            float ps = 0.f; \
            _Pragma("unroll") for (int e = 0; e < 8; ++e) { sv[e] = fast_exp2(sv[e] - mn); ps += sv[e]; } \
            lrun[qt] = lrun[qt] + ps; \
            u32x4 pk; pk.x = cvt_pk_bf16(sv[0], sv[1]); pk.y = cvt_pk_bf16(sv[2], sv[3]); pk.z = cvt_pk_bf16(sv[4], sv[5]); pk.w = cvt_pk_bf16(sv[6], sv[7]); \
            Pf[qt] = __builtin_bit_cast(bf16x8, pk); } \
        _Pragma("unroll") for (int dt = 0; dt < 8; ++dt) _Pragma("unroll") for (int qt = 0; qt < 2; ++qt) O[dt][qt] = __builtin_amdgcn_mfma_f32_16x16x32_bf16(Vf[dt], Pf[qt], O[dt][qt], 0, 0, 0); \
    } while (0)
__device__ __forceinline__ void attn_block(LAS unsigned char* lds, const bf16_t* zm, const bf16_t* Kh, const bf16_t* Vt, bf16_t* yraw, float* yp, const LAS float* biasAll, int b, int h, int g, int tid) {
    LAUNDER(tid);
    const int lane = tid & 63, wave = tid >> 6, fr = lane & 15, fq = lane >> 4;
    const int c = 4 * g + (wave >> 1), qh = wave & 1;
    const LAS float* bias = biasAll + h * NREL;
    const float bias0 = bias[0];
    const float SC = 0.08838834764831845f * LOG2E;
    bf16x8 Q[2][4];
#pragma unroll
    for (int qt = 0; qt < 2; ++qt) { const size_t tok = (size_t)b * SEQ + c * 64 + qh * 32 + qt * 16 + fr;
#pragma unroll
        for (int ks = 0; ks < 4; ++ks) Q[qt][ks] = *(const bf16x8*)(zm + tok * ZLD + 2048 + h * HD + ks * 32 + 8 * fq); }
    f32x4 O[8][2];
#pragma unroll
    for (int dt = 0; dt < 8; ++dt)
#pragma unroll
        for (int qt = 0; qt < 2; ++qt) O[dt][qt] = (f32x4){0.f, 0.f, 0.f, 0.f};
    float mrun[2] = {-1e30f, -1e30f}, lrun[2] = {0.f, 0.f};
    const int lo = g >= 2 ? 4 * g - 8 : 0, nch = 4 * g + 4 - lo;
    const int kr = tid >> 4, c16 = tid & 15;
    const int krho = ((kr >> 3) << 2) | (kr & 3);
    const int kst = ((((kr >> 2) & 1) * 4 + (c16 >> 2)) * 1024) + ((krho * 64 + (c16 & 3) * 16) ^ (krho >= 8 ? 32 : 0));
    const bf16_t* kg = Kh + ((size_t)(b * NH + h) * SEQ + kr) * HD + 8 * c16;
    const int vd = tid >> 2, vq = tid & 3;
    const int vst = 8192 + (vd >> 4) * 1024 + (((vd & 15) * 64 + vq * 16) ^ ((vd & 15) >= 8 ? 32 : 0));
    const bf16_t* vg = Vt + ((size_t)(b * NH + h) * HD + vd) * SEQ + 8 * vq;
    const int foff = (fr * 64 + fq * 16) ^ (fr >= 8 ? 32 : 0);
    LAS unsigned char* st = lds + LM_ATT;
    { const int k0 = lo * 64;
      const u32x4 kv0 = *(const u32x4*)(kg + (size_t)k0 * HD), kv1 = *(const u32x4*)(kg + (size_t)(k0 + 32) * HD); const u32x4 vv0 = *(const u32x4*)(vg + k0), vv1 = *(const u32x4*)(vg + k0 + 32);
      *(LAS u32x4*)(st + kst) = kv0; *(LAS u32x4*)(st + vst) = vv0; *(LAS u32x4*)(st + 16384 + kst) = kv1; *(LAS u32x4*)(st + 16384 + vst) = vv1; }
    __syncthreads();
#pragma unroll 1
    for (int ci = 0; ci < nch; ++ci) {
        const int kc = lo + ci;
        const int k0n = (lo + (ci + 1 < nch ? ci + 1 : ci)) * 64;
        const u32x4 kv0 = *(const u32x4*)(kg + (size_t)k0n * HD), kv1 = *(const u32x4*)(kg + (size_t)(k0n + 32) * HD); const u32x4 vv0 = *(const u32x4*)(vg + k0n), vv1 = *(const u32x4*)(vg + k0n + 32);
        if (kc >= c - 8 && kc <= c) {
            const bool farc = kc <= c - 3;
#pragma unroll 1
            for (int hf = 0; hf < 2; ++hf) {
                const LAS unsigned char* sb = st + (ci & 1) * 32768 + hf * 16384; const int k0 = kc * 64 + hf * 32;
                if (farc) ATT_COMPUTE(true); else ATT_COMPUTE(false);
            }
        }
        LAS unsigned char* nb = st + ((ci + 1) & 1) * 32768;
        *(LAS u32x4*)(nb + kst) = kv0; *(LAS u32x4*)(nb + vst) = vv0; *(LAS u32x4*)(nb + 16384 + kst) = kv1; *(LAS u32x4*)(nb + 16384 + vst) = vv1;
        __syncthreads();
    }
#pragma unroll
    for (int qt = 0; qt < 2; ++qt) {
        float l = lrun[qt]; l += __shfl_xor(l, 16); l += __shfl_xor(l, 32);
        const float inv = 1.0f / l;
        bf16_t* op = yraw + ((size_t)b * SEQ + c * 64 + qh * 32 + qt * 16 + fr) * D + 1024 + h * HD + 4 * fq;
        float q = 0.f;
#pragma unroll
        for (int dt = 0; dt < 8; ++dt) { const f32x4 o = O[dt][qt] * inv; u32x2 w; w.x = cvt_pk_bf16(o.x, o.y); w.y = cvt_pk_bf16(o.z, o.w); *(u32x2*)(op + dt * 16) = w; q += (o.x * o.x + o.y * o.y) + (o.z * o.z + o.w * o.w); }
        q += __shfl_xor(q, 16); q += __shfl_xor(q, 32);
        if (fq == 0) yp[((size_t)b * SEQ + c * 64 + qh * 32 + qt * 16 + fr) * 24 + 16 + h] = q;
    }
}
#undef ATT_COMPUTE

#define XB_TMO      128
#define XB_XCNT(j)  (256  + 64 * (j))
#define XB_XSUB(j)  (1280 + 64 * (j))
#define XB_XGEN(j)  (2304 + 64 * (j))
#define XB_TOP      3328
#define XB_TOPGEN   3392
#define XCD_BAR_WORDS 3456
#define XB_SPIN_CAP (1u << 18)
__device__ __forceinline__ unsigned xb_ld(unsigned* p)              { return __hip_atomic_load(p, __ATOMIC_RELAXED, __HIP_MEMORY_SCOPE_AGENT); }
__device__ __forceinline__ unsigned xb_add(unsigned* p, unsigned v) { return __hip_atomic_fetch_add(p, v, __ATOMIC_RELAXED, __HIP_MEMORY_SCOPE_AGENT); }
__device__ __forceinline__ unsigned xb_xcc_id() { return (unsigned)__builtin_amdgcn_s_getreg((3 << 11) | 20) & 0xFu; }
#define XB_SPIN(cond, bar) do { unsigned _sp = 0; while (cond) { __builtin_amdgcn_s_sleep(1); \
    if ((++_sp & 255u) == 0u) { if (xb_ld(&(bar)[XB_TMO])) break; if (_sp > XB_SPIN_CAP) { atomicAdd(&(bar)[XB_TMO], 1u); break; } } } } while (0)
struct XcdBarrier { unsigned* bar; unsigned x; volatile LAS unsigned* st; };
__device__ __forceinline__ XcdBarrier xcd_barrier_post(unsigned* bar, volatile LAS unsigned* st) {
    XcdBarrier b; b.bar = bar; b.x = xb_xcc_id(); b.st = st;
    if (threadIdx.x == 0) (void)xb_add(&bar[XB_XCNT(b.x)], 1u);
    return b;
}
__device__ __forceinline__ void xcd_barrier_complete(unsigned* bar, unsigned x, unsigned& nloc, unsigned& nx) {
    const unsigned G = gridDim.x * gridDim.y * gridDim.z;
    unsigned sum, cnt, mine, sp = 0u;
    for (;;) {
        sum = 0u; cnt = 0u; mine = 0u;
#pragma unroll
        for (unsigned j = 0; j < 16; ++j) { const unsigned c = xb_ld(&bar[XB_XCNT(j)]); sum += c; cnt += (c > 0u) ? 1u : 0u; mine = (j == x) ? c : mine; }
        if (sum == G) break;
        __builtin_amdgcn_s_sleep(1);
        if ((++sp & 255u) == 0u) { if (xb_ld(&bar[XB_TMO])) break; if (sp > XB_SPIN_CAP) { atomicAdd(&bar[XB_TMO], 1u); break; } }
    }
    nloc = mine > 0u ? mine : 1u; nx = cnt > 0u ? cnt : 1u;
}
__device__ __forceinline__ void xcd_barrier(const XcdBarrier& b) {
    asm volatile("s_waitcnt vmcnt(0)" ::: "memory");
    __syncthreads();
    if (threadIdx.x == 0) {
        unsigned* bar = b.bar;
        __builtin_amdgcn_s_waitcnt(0);
        unsigned nloc = b.st[0], nx = b.st[1];
        if (nloc == 0u) { xcd_barrier_complete(bar, b.x, nloc, nx); b.st[0] = nloc; b.st[1] = nx; }
        const unsigned old = xb_add(&bar[XB_XSUB(b.x)], 1u);
        const unsigned gen = old / nloc;
        if (old + 1u == (gen + 1u) * nloc) {
            __builtin_amdgcn_fence(__ATOMIC_RELEASE, "agent");
            asm volatile("s_waitcnt vmcnt(0)" ::: "memory");
            const unsigned og = xb_add(&bar[XB_TOP], 1u);
            const unsigned tg = og / nx;
            if (og + 1u == (tg + 1u) * nx) xb_add(&bar[XB_TOPGEN], 1u);
            else XB_SPIN(xb_ld(&bar[XB_TOPGEN]) == tg, bar);
            __builtin_amdgcn_fence(__ATOMIC_ACQUIRE, "agent");
            xb_add(&bar[XB_XGEN(b.x)], 1u);
            asm volatile("s_waitcnt vmcnt(0)" ::: "memory");
        } else {
            XB_SPIN(xb_ld(&bar[XB_XGEN(b.x)]) == gen, bar);
            __builtin_amdgcn_fence(__ATOMIC_ACQUIRE, "agent");
            asm volatile("s_waitcnt vmcnt(0)" ::: "memory");
        }
    }
    __syncthreads();
}

struct Args { const float* in[23]; float* out; unsigned char* ws; int pad0, pad1; };

__global__ void __launch_bounds__(NTHREADS, 2) mk_fwd(Args args) {
    extern __shared__ __attribute__((aligned(16))) unsigned char lds_raw[];
    LAS unsigned char* lds = (LAS unsigned char*)lds_raw;
    cg::grid_group grid = cg::this_grid();
    const int tid = threadIdx.x, lane = tid & 63, wave = __builtin_amdgcn_readfirstlane(tid >> 6);
    const int G = gridDim.x, bx = blockIdx.x;
    const int gw = bx * NWAVES + wave, NGW = G * NWAVES;
    typedef const float* cfp;
    const __attribute__((address_space(4))) cfp* inp = (const __attribute__((address_space(4))) cfp*)__builtin_amdgcn_kernarg_segment_ptr();
#define INP(k) (inp[k])
#define LAUNDER_S(v) asm volatile("" : "+s"(v))
    unsigned char* ws = args.ws;
    float* out = args.out;
    volatile LAS unsigned* bst = (volatile LAS unsigned*)(lds + 131072 + 64);
    if (tid < 2) bst[tid] = 0u;
    __syncthreads();
    if (bx == 0) for (int i = tid; i < XCD_BAR_WORDS; i += NTHREADS) ((unsigned*)(ws + WS_CTL))[i] = 0u;
#define GRID_BAR() do { XcdBarrier xb_; xb_.bar = (unsigned*)(args.ws + WS_CTL); xb_.x = xb_xcc_id(); xb_.st = (volatile LAS unsigned*)(lds + 131072 + 64); xcd_barrier(xb_); } while (0)
    bf16_t* HID = (bf16_t*)(ws + WS_BIG); bf16_t* ZM = (bf16_t*)(ws + WS_BIG); bf16_t* VT = (bf16_t*)(ws + WS_VT); bf16_t* KH = (bf16_t*)(ws + WS_KH); bf16_t* HB = (bf16_t*)(ws + WS_H); bf16_t* HB2 = (bf16_t*)(ws + WS_H2); float* SSQ = (float*)(ws + WS_SSQ); float* YP = (float*)(ws + WS_YP);

    {
        LAS float* scr = (LAS float*)(lds + wave * 16384);
        constexpr int I_G = (D / 64) * (FF / 32), I_D = (FF / 64) * (D / 32), I_IN = (D / 64) * (DIN / 32), I_O = (D / 64) * (D / 32);
        constexpr int PER_LAYER = 4 * I_G + 2 * I_D + I_IN + I_O;
        for (int it = gw; it < DEPTH * PER_LAYER; it += NGW) {
            const int l = it / PER_LAYER; int r = it % PER_LAYER;
            unsigned char* wl = ws + (size_t)l * LAYER_W;
            if (r < I_G) { p0_transpose_item(INP(2) + (size_t)l * D * FF, INP(1) + (size_t)l * D, D, FF, (bf16_t*)(wl + OFF_WGU1), 0, scr, r, lane); continue; } r -= I_G;
            if (r < I_G) { p0_transpose_item(INP(3) + (size_t)l * D * FF, INP(1) + (size_t)l * D, D, FF, (bf16_t*)(wl + OFF_WGU1), 128, scr, r, lane); continue; } r -= I_G;
            if (r < I_D) { p0_transpose_item(INP(4) + (size_t)l * FF * D, nullptr, FF, D, (bf16_t*)(wl + OFF_WD1), -1, scr, r, lane); continue; } r -= I_D;
            if (r < I_IN) { p0_transpose_item(INP(6) + (size_t)l * D * DIN, INP(5) + (size_t)l * D, D, DIN, (bf16_t*)(wl + OFF_WIN), -1, scr, r, lane); continue; } r -= I_IN;
            if (r < I_O) { p0_transpose_item(INP(17) + (size_t)l * D * D, INP(15) + (size_t)l * DL, D, D, (bf16_t*)(wl + OFF_WOUT), -1, scr, r, lane, INP(16) + (size_t)l * DL); continue; } r -= I_O;
            if (r < I_G) { p0_transpose_item(INP(19) + (size_t)l * D * FF, INP(18) + (size_t)l * D, D, FF, (bf16_t*)(wl + OFF_WGU2), 0, scr, r, lane); continue; } r -= I_G;
            if (r < I_G) { p0_transpose_item(INP(20) + (size_t)l * D * FF, INP(18) + (size_t)l * D, D, FF, (bf16_t*)(wl + OFF_WGU2), 128, scr, r, lane); continue; } r -= I_G;
            p0_transpose_item(INP(21) + (size_t)l * FF * D, nullptr, FF, D, (bf16_t*)(wl + OFF_WD2), -1, scr, r, lane);
        }
        cast_rows_bf16(INP(0), HB, SSQ, gw, NGW, lane);
    }
    grid.sync();
    (void)xcd_barrier_post((unsigned*)(ws + WS_CTL), bst);

#pragma unroll 1
    for (int l = 0; l < DEPTH; ++l) {
        unsigned char* wl = ws + (size_t)l * LAYER_W;
#pragma unroll 1
        for (int f = 0; f < 2; ++f) {
            LAUNDER_S(inp);
            {
                pg8::Gemm g{HB, (const bf16_t*)(wl + (f ? OFF_WGU2 : OFF_WGU1)), M, 2 * FF, D}; pg8::StaticOrder S; S.init(M, 2 * FF, G, bx);
                { if (tid == 0) *(volatile LAS int*)(lds + pg8::LDS_RSPM) = -1; __syncthreads(); }
                pg8::EpiSwiGLU E{HID, FF, SSQ + (size_t)(3 * l + (f ? 2 : 0)) * M * 8, lds};
                pg8::gemm_phase<pg8::EpiSwiGLU, pg8::StaticOrder, true, true>(lds, g, S, E);
            }
            GRID_BAR();
            {
                pg8::Gemm g{HID, (const bf16_t*)(wl + (f ? OFF_WD2 : OFF_WD1)), M, D, FF}; pg8::StaticOrder S; S.init(M, D, G, bx);
                pg8::EpiResid<true> E{HB, SSQ + (size_t)(3 * l + (f ? 3 : 1)) * M * 8, lds};
                pg8::gemm_phase<pg8::EpiResid<true>, pg8::StaticOrder, true, true>(lds, g, S, E);
            }
            GRID_BAR();
            if (f == 0) {
                {
                    pg8::Gemm g{HB, (const bf16_t*)(wl + OFF_WIN), M, DIN, D}; pg8::StaticOrder S; S.init(M, DIN, G, bx);
                    { if (tid == 0) *(volatile LAS int*)(lds + pg8::LDS_RSPM) = -1; __syncthreads(); }
                    pg8::EpiZ E{ZM, VT, KH, SSQ + (size_t)(3 * l + 1) * M * 8, lds};
                    pg8::gemm_phase<pg8::EpiZ, pg8::StaticOrder, true, true>(lds, g, S, E);
                }
                GRID_BAR();
                {
                    LAS float* biasL = (LAS float*)(lds + LM_BIAS);
                    const float* rb = INP(14) + (size_t)l * NH * NREL;
                    int tid_m = tid; LAUNDER(tid_m);
                    for (int i = tid_m; i < NH * NREL; i += NTHREADS) biasL[i] = rb[i] * LOG2E;
                    __syncthreads();
                    for (int u = bx; u < NB * 16; u += G)
                        lru_unit(lds, ZM, HB2, YP, INP(7) + (size_t)l * 4 * DL, INP(8) + (size_t)l * DL, INP(9) + (size_t)l * 16 * 64 * 64, INP(10) + (size_t)l * DL,
                                 INP(11) + (size_t)l * 16 * 64 * 64, INP(12) + (size_t)l * DL, INP(13) + (size_t)l * DL, u >> 4, u & 15, tid);
                    for (int bu = bx; bu < 1024; bu += G) {
                        const int kk = bu >> 8, bxv = bu & 255;
                        const int ag = ((bxv & 7) + 2 * kk) & 7, ap = (bxv >> 3) + 32 * kk;
                        attn_block(lds, ZM, KH, VT, HB2, YP, biasL, ap >> 3, ap & 7, ag, tid);
                    }
                }
                GRID_BAR();
                {
                    pg8::Gemm g{HB2, (const bf16_t*)(wl + OFF_WOUT), M, D, D}; pg8::StaticOrder S; S.init(M, D, G, bx);
                    { if (tid == 0) *(volatile LAS int*)(lds + pg8::LDS_RS2PM) = -1; __syncthreads(); }
                    pg8::EpiResidY E{HB, SSQ + (size_t)(3 * l + 2) * M * 8, YP, lds};
                    { pg8::Unit u0; if (S.next(0, u0)) E.prep(u0); }
                    pg8::gemm_phase<pg8::EpiResidY, pg8::StaticOrder, true, true>(lds, g, S, E);
                }
                GRID_BAR();
            } else {
                if (l + 1 == DEPTH) rms_rows_bf16_to_f32(HB, INP(22), out, gw, NGW, lane);
            }
        }
    }
}

extern "C" void kernel_launch(void* const* d_in, const int* in_sizes, int n_in, void* d_out, int out_size, void* d_ws, size_t ws_size, hipStream_t stream) {
    static int grid = 0;
    if (grid == 0) {
        if (n_in != 23 || in_sizes[0] != M * D || out_size != M * D || ws_size < WS_END) {
            fprintf(stderr, "kernel_launch: unexpected shapes: n_in %d in0 %d out %d ws %zu (need %zu)\n", n_in, n_in > 0 ? in_sizes[0] : -1, out_size, ws_size, (size_t)WS_END); grid = -1; return; }
        int dev = 0, cus = 0, per_cu = 0;
        hipGetDevice(&dev); hipDeviceGetAttribute(&cus, hipDeviceAttributeMultiprocessorCount, dev);
        if (hipFuncSetAttribute((const void*)mk_fwd, hipFuncAttributeMaxDynamicSharedMemorySize, LDS_BYTES) != hipSuccess) fprintf(stderr, "kernel_launch: hipFuncSetAttribute failed\n");
        if (hipOccupancyMaxActiveBlocksPerMultiprocessor(&per_cu, (const void*)mk_fwd, NTHREADS, LDS_BYTES) != hipSuccess || per_cu < 1) { fprintf(stderr, "kernel_launch: occupancy query gave %d\n", per_cu); per_cu = 1; }
        (void)hipGetLastError();
        grid = cus * per_cu;
        if (grid > 256) grid = 256;
    }
    if (grid < 0) return;
    Args a{};
    for (int i = 0; i < 23; ++i) a.in[i] = (const float*)d_in[i];
    a.out = (float*)d_out; a.ws = (unsigned char*)d_ws;
    void* kargs[] = {&a};
    hipError_t e = hipLaunchCooperativeKernel((const void*)mk_fwd, dim3(grid), dim3(NTHREADS), kargs, LDS_BYTES, stream);
    if (e != hipSuccess) fprintf(stderr, "kernel_launch: cooperative launch failed: %s (grid %d)\n", hipGetErrorString(e), grid);
}
```

```cpp
#include <hip/hip_runtime.h>
#include <hip/hip_cooperative_groups.h>
#include <cstdio>
#include <cstdint>
namespace cg = cooperative_groups;

#define LAS __attribute__((address_space(3)))
#define LAUNDER(v) asm volatile("" : "+v"(v))
typedef unsigned short bf16_t;
typedef short bf16x8 __attribute__((ext_vector_type(8)));
typedef float f32x4 __attribute__((ext_vector_type(4)));
typedef float f32x2 __attribute__((ext_vector_type(2)));
typedef unsigned u32x4 __attribute__((ext_vector_type(4)));
typedef unsigned u32x2 __attribute__((ext_vector_type(2)));

constexpr int NB = 16, SEQ = 2048, M = NB * SEQ, D = 2048, FF = 5632, DIN = 5120, DL = 1024, NH = 8, HD = 128, NREL = 257, DEPTH = 2;
constexpr int ZLD = 3072;
constexpr float EPS = 1e-6f;
constexpr float LOG2E = 1.4426950408889634f;

constexpr size_t MiB = 1u << 20;
constexpr size_t SZ_WGU = (size_t)2 * FF * D * 2, SZ_WD = (size_t)D * FF * 2, SZ_WIN = (size_t)DIN * D * 2, SZ_WOUT = (size_t)D * D * 2;
constexpr size_t OFF_WGU1 = 0, OFF_WD1 = OFF_WGU1 + SZ_WGU, OFF_WIN = OFF_WD1 + SZ_WD, OFF_WOUT = OFF_WIN + SZ_WIN, OFF_WGU2 = OFF_WOUT + SZ_WOUT, OFF_WD2 = OFF_WGU2 + SZ_WGU;
constexpr size_t LAYER_W = OFF_WD2 + SZ_WD;
static_assert(LAYER_W == 160 * MiB, "weights per layer");
constexpr size_t WS_BIG = 2 * LAYER_W;
constexpr size_t WS_VT = WS_BIG + (size_t)M * ZLD * 2;
constexpr size_t WS_KH = WS_VT + (size_t)M * 1024 * 2;
constexpr size_t WS_H = WS_BIG + 352 * MiB;
constexpr size_t WS_H2 = WS_H + 128 * MiB;
constexpr size_t WS_SSQ = WS_H2 + 128 * MiB;
constexpr size_t WS_YP = WS_SSQ + 8 * MiB;
constexpr size_t WS_CTL = WS_YP + 4 * MiB;
constexpr size_t CTL_BYTES = 16384;
constexpr size_t WS_END = WS_CTL + 1 * MiB;
static_assert((size_t)M * FF * 2 == 352 * MiB, "hidden size");

constexpr int NWAVES = 8, NTHREADS = 512;
constexpr int LDS_BYTES = 147456;

__device__ __forceinline__ unsigned cvt_pk_bf16(float lo, float hi) { unsigned r; asm volatile("v_cvt_pk_bf16_f32 %0, %1, %2" : "=v"(r) : "v"(lo), "v"(hi)); return r; }
__device__ __forceinline__ float bf_lo(unsigned u) { return __uint_as_float(u << 16); }
__device__ __forceinline__ float bf_hi(unsigned u) { return __uint_as_float(u & 0xffff0000u); }
__device__ __forceinline__ float fast_exp2(float x) { return __builtin_amdgcn_exp2f(x); }
__device__ __forceinline__ float fast_rcp(float x) { return __builtin_amdgcn_rcpf(x); }
__device__ __forceinline__ float sigmoidf_(float x) { return fast_rcp(1.0f + fast_exp2(-LOG2E * x)); }

namespace pg8 {
constexpr int BM = 256, BK = 64, HALF = 128, HTB = HALF * BK * 2, STAGE_BYTES = 8 * HTB, NXCD = 8, WGM = 4;
__host__ __device__ __forceinline__ int lds_byte(int r, int c) { const int st = (r >> 4) * 2 + (c >> 5), rr = r & 15, cc = c & 31, ob = rr * 64 + cc * 2; return st * 1024 + (ob ^ (((ob >> 9) & 1) << 5)); }
__host__ __device__ __forceinline__ void stage_rc(int b, int& R, int& C) { const int st = b / 1024, sb = b % 1024, swz = sb ^ (((sb >> 9) & 1) << 5); R = (st >> 1) * 16 + swz / 64; C = (st & 1) * 32 + (swz % 64) / 2; }
__host__ __device__ __forceinline__ int perm32(int rho) { const int n = rho >> 4, i = rho & 15; return 8 * (i >> 2) + 4 * n + (i & 3); }

struct Unit { int pm, pn; };
struct Gemm { const bf16_t* A; const bf16_t* Bt; int M, N, K; };

struct StaticOrder {
    int nM, nN, nwg, G, c;
    __host__ __device__ void init(int M_, int N_, int G_, int c_) { nM = M_ / BM; nN = N_ / BM; nwg = nM * nN; G = G_; c = c_; }
    __host__ __device__ bool next(int i, Unit& u) const {
        const long L = (long)i * G + c; if (L >= nwg) return false;
        int wgid = (int)L; { const int q = nwg / NXCD, r = nwg % NXCD, xcd = wgid % NXCD, off = wgid / NXCD; wgid = (xcd < r ? xcd * (q + 1) : r * (q + 1) + (xcd - r) * q) + off; }
        const int nig = WGM * nN, gid = wgid / nig, fm = gid * WGM, gsz = (nM - fm) < WGM ? (nM - fm) : WGM;
        u.pm = fm + ((wgid % nig) % gsz); u.pn = (wgid % nig) / gsz; return true;
    }
    __device__ __forceinline__ void a_ready(const Unit&) const {}
    __device__ __forceinline__ void done(const Unit&) const {}
};


constexpr int LDS_RS = 131072 + 1024, LDS_RSPM = 131072 + 2048 + 64, LDS_SSP = 131072 + 4096;
__device__ __forceinline__ void rs_panel(LAS unsigned char* lds, const float* ssq, int pm) {
    volatile LAS int* pmL = (volatile LAS int*)(lds + LDS_RSPM); LAS float* rsL = (LAS float*)(lds + LDS_RS);
    if (pmL[0] != pm) {
        asm volatile("s_waitcnt lgkmcnt(0)" ::: "memory"); __builtin_amdgcn_s_barrier();
        const int t = threadIdx.x;
        if (t < 256) { const f32x4* pp = (const f32x4*)(ssq + (size_t)(pm * 256 + t) * 8); const f32x4 pa = pp[0], pb = pp[1];
            rsL[t] = __builtin_amdgcn_rsqf((((pa.x + pa.y) + (pa.z + pa.w)) + ((pb.x + pb.y) + (pb.z + pb.w))) * (1.0f / D) + EPS); }
        if (t == 0) pmL[0] = pm;
        asm volatile("s_waitcnt vmcnt(0) lgkmcnt(0)" ::: "memory"); __builtin_amdgcn_s_barrier();
    }
}
struct EpiSwiGLU {
    static constexpr bool PERM = true, AFTER_DRAIN = false, MIDK = false;
    bf16_t* O; int ldc; const float* ssq; LAS unsigned char* lds;
    __device__ __forceinline__ void operator()(const f32x4 (&acc)[2][2][4][2], const Unit& u, int wr, int wc, int fr, int fq) const {
        rs_panel(lds, ssq, u.pm);
        const LAS float* rsL = (const LAS float*)(lds + LDS_RS) + wr * 64 + fr;
        const int row0 = u.pm * BM + wr * 64 + fr; const int col0 = u.pn * HALF + wc * 32 + 8 * fq;
#pragma unroll
        for (int ai = 0; ai < 2; ++ai)
#pragma unroll
            for (int m = 0; m < 4; ++m) {
                bf16_t* rowp = O + (size_t)(row0 + ai * HALF + m * 16) * ldc + col0;
                const float rs = rsL[ai * HALF + m * 16];
                float v[8];
#pragma unroll
                for (int n = 0; n < 2; ++n)
#pragma unroll
                    for (int i = 0; i < 4; ++i) { const float g = acc[ai][0][m][n][i] * rs, up = acc[ai][1][m][n][i] * rs; v[n * 4 + i] = g * sigmoidf_(g) * up; }
                u32x4 w; w.x = cvt_pk_bf16(v[0], v[1]); w.y = cvt_pk_bf16(v[2], v[3]); w.z = cvt_pk_bf16(v[4], v[5]); w.w = cvt_pk_bf16(v[6], v[7]);
                *(u32x4*)rowp = w;
            }
    }
};
template <bool HALFSC> struct EpiResid {
    static constexpr bool PERM = false, AFTER_DRAIN = false, MIDK = false;
    bf16_t* xb; float* ssq_part; LAS unsigned char* lds;
    __device__ __forceinline__ void operator()(const f32x4 (&acc)[2][2][4][2], const Unit& u, int wr, int wc, int fr, int fq) const {
        const float scale_ = HALFSC ? 0.5f : 1.0f; bf16_t* const xb_ = xb; float* const ssq_ = ssq_part;
        LAS float* pl = (LAS float*)(lds + LDS_SSP);
        const int col0 = u.pn * BM + wc * 32 + 4 * fq;
        const size_t base = (size_t)(u.pm * BM + wr * 64 + fr) * D + col0;
        u32x2 r[2][2][2][2];
#define ER_LOAD(buf, bb) do { _Pragma("unroll") for (int mm = 0; mm < 2; ++mm) _Pragma("unroll") for (int bj = 0; bj < 2; ++bj) _Pragma("unroll") for (int n = 0; n < 2; ++n) \
            r[buf][mm][bj][n] = *(const u32x2*)(xb_ + base + (size_t)(((bb) >> 1) * HALF + (((bb) & 1) * 2 + mm) * 16) * D + bj * HALF + n * 16); } while (0)
        ER_LOAD(0, 0);
#pragma unroll
        for (int bb = 0; bb < 4; ++bb) {
            if (bb < 3) ER_LOAD((bb + 1) & 1, bb + 1);
            const int ai = bb >> 1;
#pragma unroll
            for (int mm = 0; mm < 2; ++mm) { const int m = (bb & 1) * 2 + mm; const int rowl = ai * HALF + m * 16; const size_t off = base + (size_t)rowl * D; float ssum = 0.f;
#pragma unroll
                for (int bj = 0; bj < 2; ++bj)
#pragma unroll
                    for (int n = 0; n < 2; ++n) { const u32x2 rr = r[bb & 1][mm][bj][n]; const f32x4 a = acc[ai][bj][m][n];
                        const float o0 = bf_lo(rr.x) + a.x * scale_, o1 = bf_hi(rr.x) + a.y * scale_, o2 = bf_lo(rr.y) + a.z * scale_, o3 = bf_hi(rr.y) + a.w * scale_;
                        u32x2 w; w.x = cvt_pk_bf16(o0, o1); w.y = cvt_pk_bf16(o2, o3); *(u32x2*)(xb_ + off + bj * HALF + n * 16) = w;
                        ssum += (o0 * o0 + o1 * o1) + (o2 * o2 + o3 * o3); }
                ssum += __shfl_xor(ssum, 16); ssum += __shfl_xor(ssum, 32);
                if (fq == 0) pl[(rowl + wr * 64 + fr) * 4 + wc] = ssum;
            }
        }
#undef ER_LOAD
        asm volatile("s_waitcnt lgkmcnt(0)" ::: "memory"); __builtin_amdgcn_s_barrier();
        const int t = threadIdx.x;
        if (t < 256) { const f32x4 p = *(const LAS f32x4*)(pl + t * 4); ssq_[(size_t)(u.pm * BM + t) * 8 + u.pn] = (p.x + p.y) + (p.z + p.w); }
    }
};
constexpr int LDS_RS2 = 131072 + 8192, LDS_RS2PM = 131072 + 8192 + 2048 + 64;
__device__ __forceinline__ void rs2_panel(LAS unsigned char* lds, const float* yp, int pm) {
    volatile LAS int* pmL = (volatile LAS int*)(lds + LDS_RS2PM); LAS f32x2* rsL = (LAS f32x2*)(lds + LDS_RS2);
    if (pmL[0] != pm) {
        asm volatile("s_waitcnt lgkmcnt(0)" ::: "memory"); __builtin_amdgcn_s_barrier();
        const int t = threadIdx.x;
        if (t < 256) { const f32x4* pp = (const f32x4*)(yp + (size_t)(pm * 256 + t) * 24);
            const f32x4 a0 = pp[0], a1 = pp[1], a2 = pp[2], a3 = pp[3], b0 = pp[4], b1 = pp[5];
            const float sl = (((a0.x + a0.y) + (a0.z + a0.w)) + ((a1.x + a1.y) + (a1.z + a1.w))) + (((a2.x + a2.y) + (a2.z + a2.w)) + ((a3.x + a3.y) + (a3.z + a3.w)));
            const float sa = ((b0.x + b0.y) + (b0.z + b0.w)) + ((b1.x + b1.y) + (b1.z + b1.w));
            const float va = sa * (1.0f / 1024.f) + EPS, vl = sl * (1.0f / 1024.f) + EPS;
            rsL[t] = (f32x2){__builtin_amdgcn_rsqf(va), __builtin_amdgcn_rsqf(vl) * sqrtf(va)}; }
        if (t == 0) pmL[0] = pm;
        asm volatile("s_waitcnt vmcnt(0) lgkmcnt(0)" ::: "memory"); __builtin_amdgcn_s_barrier();
    }
}
struct EpiResidY {
    static constexpr bool PERM = false, AFTER_DRAIN = false, MIDK = true;
    bf16_t* xb; float* ssq_part; const float* yp; LAS unsigned char* lds;
    __device__ __forceinline__ void prep(const Unit& u) const { rs2_panel(lds, yp, u.pm); }
    __device__ __forceinline__ void mid(f32x4 (&acc)[2][2][4][2], const Unit& u, int wr, int wc, int fr, int fq) const {
        const LAS f32x2* rsL = (const LAS f32x2*)(lds + LDS_RS2) + wr * 64 + fr;
#pragma unroll
        for (int ai = 0; ai < 2; ++ai)
#pragma unroll
            for (int m = 0; m < 4; ++m) { const float q = rsL[ai * HALF + m * 16].y;
#pragma unroll
                for (int bj = 0; bj < 2; ++bj)
#pragma unroll
                    for (int n = 0; n < 2; ++n) acc[ai][bj][m][n] = acc[ai][bj][m][n] * q; }
    }
    __device__ __forceinline__ void operator()(const f32x4 (&acc)[2][2][4][2], const Unit& u, int wr, int wc, int fr, int fq) const {
        bf16_t* const xb_ = xb; float* const ssq_ = ssq_part;
        LAS float* pl = (LAS float*)(lds + LDS_SSP);
        const LAS f32x2* rsL = (const LAS f32x2*)(lds + LDS_RS2) + wr * 64 + fr;
        const int col0 = u.pn * BM + wc * 32 + 4 * fq;
        const size_t base = (size_t)(u.pm * BM + wr * 64 + fr) * D + col0;
        u32x2 r[2][2][2][2];
#define ER_LOAD(buf, bb) do { _Pragma("unroll") for (int mm = 0; mm < 2; ++mm) _Pragma("unroll") for (int bj = 0; bj < 2; ++bj) _Pragma("unroll") for (int n = 0; n < 2; ++n) \
            r[buf][mm][bj][n] = *(const u32x2*)(xb_ + base + (size_t)(((bb) >> 1) * HALF + (((bb) & 1) * 2 + mm) * 16) * D + bj * HALF + n * 16); } while (0)
        ER_LOAD(0, 0);
#pragma unroll
        for (int bb = 0; bb < 4; ++bb) {
            if (bb < 3) ER_LOAD((bb + 1) & 1, bb + 1);
            const int ai = bb >> 1;
#pragma unroll
            for (int mm = 0; mm < 2; ++mm) { const int m = (bb & 1) * 2 + mm; const int rowl = ai * HALF + m * 16; const size_t off = base + (size_t)rowl * D; float ssum = 0.f;
                const float scale_ = rsL[rowl].x;
#pragma unroll
                for (int bj = 0; bj < 2; ++bj)
#pragma unroll
                    for (int n = 0; n < 2; ++n) { const u32x2 rr = r[bb & 1][mm][bj][n]; const f32x4 a = acc[ai][bj][m][n];
                        const float o0 = bf_lo(rr.x) + a.x * scale_, o1 = bf_hi(rr.x) + a.y * scale_, o2 = bf_lo(rr.y) + a.z * scale_, o3 = bf_hi(rr.y) + a.w * scale_;
                        u32x2 w; w.x = cvt_pk_bf16(o0, o1); w.y = cvt_pk_bf16(o2, o3); *(u32x2*)(xb_ + off + bj * HALF + n * 16) = w;
                        ssum += (o0 * o0 + o1 * o1) + (o2 * o2 + o3 * o3); }
                ssum += __shfl_xor(ssum, 16); ssum += __shfl_xor(ssum, 32);
                if (fq == 0) pl[(rowl + wr * 64 + fr) * 4 + wc] = ssum;
            }
        }
#undef ER_LOAD
        asm volatile("s_waitcnt lgkmcnt(0)" ::: "memory"); __builtin_amdgcn_s_barrier();
        const int t = threadIdx.x;
        if (t < 256) { const f32x4 p = *(const LAS f32x4*)(pl + t * 4); ssq_[(size_t)(u.pm * BM + t) * 8 + u.pn] = (p.x + p.y) + (p.z + p.w); }
    }
};
struct EpiZ {
    static constexpr bool PERM = true, AFTER_DRAIN = false, MIDK = false;
    bf16_t* Z; bf16_t* Vt; bf16_t* Kh; const float* ssq; LAS unsigned char* lds;
    __device__ __forceinline__ void operator()(const f32x4 (&acc)[2][2][4][2], const Unit& u, int wr, int wc, int fr, int fq) const {
        rs_panel(lds, ssq, u.pm);
        float rs[2][4];
        { const LAS float* rsL = (const LAS float*)(lds + LDS_RS) + wr * 64 + fr;
#pragma unroll
          for (int ai = 0; ai < 2; ++ai)
#pragma unroll
            for (int m = 0; m < 4; ++m) rs[ai][m] = rsL[ai * HALF + m * 16]; }
        if (u.pn >= 12 && u.pn < 16) {
            const int b = (u.pm * BM) / SEQ; const int s0 = (u.pm * BM) % SEQ + wr * 64 + fr;
#pragma unroll
            for (int bj = 0; bj < 2; ++bj) {
                const int head = (u.pn - 12) * 2 + bj;
                bf16_t* hb = Kh + ((size_t)(b * NH + head) * SEQ + s0) * HD + wc * 32 + 8 * fq;
#pragma unroll
                for (int ai = 0; ai < 2; ++ai)
#pragma unroll
                    for (int m = 0; m < 4; ++m) { const f32x4 v0 = acc[ai][bj][m][0] * rs[ai][m], v1 = acc[ai][bj][m][1] * rs[ai][m];
                        u32x4 w; w.x = cvt_pk_bf16(v0[0], v0[1]); w.y = cvt_pk_bf16(v0[2], v0[3]); w.z = cvt_pk_bf16(v1[0], v1[1]); w.w = cvt_pk_bf16(v1[2], v1[3]);
                        *(u32x4*)(hb + (size_t)(ai * HALF + m * 16) * HD) = w; }
            }
        } else if (u.pn < 12) {
            const int row0 = u.pm * BM + wr * 64 + fr; const int col0 = u.pn * BM + wc * 32 + 8 * fq;
#pragma unroll
            for (int ai = 0; ai < 2; ++ai)
#pragma unroll
                for (int m = 0; m < 4; ++m) {
                    bf16_t* rowp = Z + (size_t)(row0 + ai * HALF + m * 16) * ZLD + col0;
#pragma unroll
                    for (int bj = 0; bj < 2; ++bj) { const f32x4 v0 = acc[ai][bj][m][0] * rs[ai][m], v1 = acc[ai][bj][m][1] * rs[ai][m];
                        u32x4 w; w.x = cvt_pk_bf16(v0[0], v0[1]); w.y = cvt_pk_bf16(v0[2], v0[3]); w.z = cvt_pk_bf16(v1[0], v1[1]); w.w = cvt_pk_bf16(v1[2], v1[3]);
                        *(u32x4*)(rowp + bj * HALF) = w; }
                }
        } else {
            const int b = (u.pm * BM) / SEQ; const int s0 = (u.pm * BM) % SEQ + wr * 64 + fr;
#pragma unroll
            for (int bj = 0; bj < 2; ++bj) {
                const int head = (u.pn - 16) * 2 + bj;
                bf16_t* hb = Vt + ((size_t)(b * NH + head) * HD + wc * 32 + 8 * fq) * SEQ + s0;
#pragma unroll
                for (int ai = 0; ai < 2; ++ai)
#pragma unroll
                    for (int m = 0; m < 4; ++m)
#pragma unroll
                        for (int n = 0; n < 2; ++n)
#pragma unroll
                            for (int i = 0; i < 4; ++i) {
                                const unsigned w = cvt_pk_bf16(acc[ai][bj][m][n][i] * rs[ai][m], 0.f);
                                hb[(size_t)(4 * n + i) * SEQ + ai * HALF + m * 16] = (bf16_t)(w & 0xffffu);
                            }
            }
        }
    }
};

template <class Epi, class Sched, bool ALIGN_EPI = false, bool SP2 = false>
__device__ __forceinline__ void gemm_phase(LAS unsigned char* lds, const Gemm g, const Sched& S, const Epi& E) {
    int tid_l = threadIdx.x; LAUNDER(tid_l);
    const int tid = tid_l, wid = __builtin_amdgcn_readfirstlane(tid >> 6), lane = tid & 63, wr = wid >> 2, wc = wid & 3, fr = lane & 15, fq = lane >> 4;
    const int K = g.K, nt = K / BK;
    unsigned voffA[2], voffB[2];
#pragma unroll
    for (int i = 0; i < 2; ++i) { int R, C; stage_rc(tid * 16 + i * 8192, R, C); const int Rb = Epi::PERM ? ((R & ~31) + perm32(R & 31)) : R;
        voffA[i] = (unsigned)(R * K + C) * 2u; voffB[i] = (unsigned)(Rb * K + C) * 2u; }
    const size_t kstep = (size_t)(BK * 2);
    const size_t hstep = (size_t)HALF * K * 2;
    const size_t tstep = 2 * hstep;
    const unsigned ldsw = (unsigned)wid * 1024u;
    const int aoff = lds_byte(wr * 64 + fr, fq * 8), boff = lds_byte(wc * 32 + fr, fq * 8);
#define PG8_SA(b, h) (((b) * 2 + (h)) * HTB)
#define PG8_SB(b, h) ((4 + (b) * 2 + (h)) * HTB)
#define PG8_STAGE(bufoff, gbase, voff) do { _Pragma("unroll") for (int _i = 0; _i < 2; ++_i) \
        __builtin_amdgcn_global_load_lds((const unsigned*)((const char*)(gbase) + (voff)[_i]), (LAS unsigned*)(lds + (bufoff) + ldsw + _i * 8192), 16, 0, 0); } while (0)
#define PG8_LDA(dst, b, h) do { _Pragma("unroll") for (int m = 0; m < 4; ++m) _Pragma("unroll") for (int k = 0; k < 2; ++k) dst[m][k] = *(const LAS bf16x8*)(lds + PG8_SA(b, h) + aoff + m * 2048 + k * 1024); } while (0)
#define PG8_LDB(dst, b, h) do { _Pragma("unroll") for (int n = 0; n < 2; ++n) _Pragma("unroll") for (int k = 0; k < 2; ++k) dst[n][k] = *(const LAS bf16x8*)(lds + PG8_SB(b, h) + boff + n * 2048 + k * 1024); } while (0)
#define PG8_MMA(ai, bj, At, Bt) do { __builtin_amdgcn_s_setprio(1); _Pragma("unroll") for (int m = 0; m < 4; ++m) _Pragma("unroll") for (int n = 0; n < 2; ++n) _Pragma("unroll") for (int k = 0; k < 2; ++k) \
        acc[ai][bj][m][n] = __builtin_amdgcn_mfma_f32_16x16x32_bf16(Bt[n][k], At[m][k], acc[ai][bj][m][n], 0, 0, 0); __builtin_amdgcn_s_setprio(0); } while (0)
#define PG8_WAIT_V(n) asm volatile("s_waitcnt vmcnt(" #n ")" ::: "memory")
#define PG8_WAIT_L(n) asm volatile("s_waitcnt lgkmcnt(" #n ")" ::: "memory")
#define PG8_BAR __builtin_amdgcn_s_barrier()
#define PG8_SCHED __builtin_amdgcn_sched_barrier(0)
    Unit cur, nxt; int ui = 0;
    if (!S.next(0, cur)) return;
    f32x4 acc[2][2][4][2];
#pragma unroll
    for (int a = 0; a < 2; ++a)
#pragma unroll
        for (int b = 0; b < 2; ++b)
#pragma unroll
            for (int m = 0; m < 4; ++m)
#pragma unroll
                for (int n = 0; n < 2; ++n) acc[a][b][m][n] = (f32x4){0.f, 0.f, 0.f, 0.f};
    bf16x8 At[4][2], B0[2][2], B1[2][2];
    const char* cA = (const char*)g.A + (size_t)cur.pm * tstep; const char* cB = (const char*)g.Bt + (size_t)cur.pn * tstep;
    S.a_ready(cur);
    if constexpr (SP2) {
        PG8_STAGE(PG8_SB(0, 0), cB, voffB); PG8_STAGE(PG8_SB(0, 1), cB + hstep, voffB); PG8_STAGE(PG8_SA(0, 0), cA, voffA); PG8_STAGE(PG8_SA(0, 1), cA + hstep, voffA);
        if (wr == 1) PG8_BAR;
        PG8_WAIT_V(2); PG8_BAR;
        PG8_STAGE(PG8_SB(1, 0), cB + kstep, voffB); PG8_STAGE(PG8_SA(1, 0), cA + kstep, voffA); PG8_STAGE(PG8_SB(1, 1), cB + hstep + kstep, voffB);
        PG8_WAIT_V(6); PG8_BAR;
    } else {
        PG8_STAGE(PG8_SB(0, 0), cB, voffB); PG8_STAGE(PG8_SA(0, 0), cA, voffA); PG8_STAGE(PG8_SB(0, 1), cB + hstep, voffB); PG8_STAGE(PG8_SA(0, 1), cA + hstep, voffA);
        if (wr == 1) PG8_BAR;
        PG8_WAIT_V(4); PG8_BAR;
        PG8_STAGE(PG8_SB(1, 0), cB + kstep, voffB); PG8_STAGE(PG8_SA(1, 0), cA + kstep, voffA); PG8_STAGE(PG8_SB(1, 1), cB + hstep + kstep, voffB);
        PG8_WAIT_V(6); PG8_BAR;
    }
    for (;;) {
        const bool has_next = S.next(ui + 1, nxt);
        const char* nA = has_next ? (const char*)g.A + (size_t)nxt.pm * tstep : cA; const char* nB = has_next ? (const char*)g.Bt + (size_t)nxt.pn * tstep : cB;
        for (int t = 0; t < nt; t += 2) {
            if constexpr (Epi::MIDK) { if (t == (nt >> 1)) E.mid(acc, cur, wr, wc, fr, fq); }
            const bool last = (t == nt - 2);
            const char* a1 = cA + (size_t)(t + 1) * kstep;
            const char* a2 = last ? nA : cA + (size_t)(t + 2) * kstep; const char* b2 = last ? nB : cB + (size_t)(t + 2) * kstep;
            const char* a3 = a2 + kstep; const char* b3 = b2 + kstep;
            if (last && has_next) S.a_ready(nxt);
            if constexpr (SP2) {
            PG8_LDB(B0, 0, 0); PG8_LDB(B1, 0, 1); PG8_SCHED; PG8_LDA(At, 0, 0); PG8_STAGE(PG8_SA(1, 1), a1 + hstep, voffA);
            PG8_WAIT_V(8); PG8_WAIT_L(0); PG8_BAR; PG8_MMA(0, 0, At, B0); PG8_MMA(0, 1, At, B1); PG8_BAR; PG8_SCHED;
            PG8_LDA(At, 0, 1); PG8_STAGE(PG8_SB(0, 0), b2, voffB); PG8_STAGE(PG8_SB(0, 1), b2 + hstep, voffB); PG8_STAGE(PG8_SA(0, 0), a2, voffA);
            PG8_WAIT_V(8); PG8_WAIT_L(0); PG8_BAR; PG8_MMA(1, 0, At, B0); PG8_MMA(1, 1, At, B1); PG8_BAR; PG8_SCHED;
            PG8_LDB(B0, 1, 0); PG8_LDB(B1, 1, 1); PG8_SCHED; PG8_LDA(At, 1, 0); PG8_STAGE(PG8_SA(0, 1), a2 + hstep, voffA);
            PG8_WAIT_V(8); PG8_WAIT_L(0); PG8_BAR; PG8_MMA(0, 0, At, B0); PG8_MMA(0, 1, At, B1); PG8_BAR; PG8_SCHED;
            PG8_LDA(At, 1, 1); PG8_STAGE(PG8_SB(1, 0), b3, voffB); PG8_STAGE(PG8_SB(1, 1), b3 + hstep, voffB); PG8_STAGE(PG8_SA(1, 0), a3, voffA);
            PG8_WAIT_V(8); PG8_WAIT_L(0); PG8_BAR; PG8_MMA(1, 0, At, B0); PG8_MMA(1, 1, At, B1); PG8_BAR; PG8_SCHED;
            } else {
            PG8_LDB(B0, 0, 0); PG8_SCHED; PG8_LDA(At, 0, 0); PG8_STAGE(PG8_SA(1, 1), a1 + hstep, voffA);
            PG8_WAIT_L(8); PG8_BAR; PG8_WAIT_L(0); PG8_MMA(0, 0, At, B0); PG8_BAR; PG8_SCHED;
            PG8_LDB(B1, 0, 1); PG8_STAGE(PG8_SB(0, 0), b2, voffB);
            PG8_BAR; PG8_WAIT_L(0); PG8_MMA(0, 1, At, B1); PG8_BAR;
            PG8_LDA(At, 0, 1); PG8_STAGE(PG8_SA(0, 0), a2, voffA);
            PG8_BAR; PG8_WAIT_L(0); PG8_MMA(1, 0, At, B0); PG8_BAR; PG8_SCHED;
            PG8_STAGE(PG8_SB(0, 1), b2 + hstep, voffB);
            PG8_WAIT_V(6); PG8_BAR; PG8_MMA(1, 1, At, B1); PG8_BAR;
            PG8_LDB(B0, 1, 0); PG8_SCHED; PG8_LDA(At, 1, 0); PG8_STAGE(PG8_SA(0, 1), a2 + hstep, voffA);
            PG8_WAIT_L(8); PG8_BAR; PG8_WAIT_L(0); PG8_MMA(0, 0, At, B0); PG8_BAR; PG8_SCHED;
            PG8_LDB(B1, 1, 1); PG8_STAGE(PG8_SB(1, 0), b3, voffB);
            PG8_BAR; PG8_WAIT_L(0); PG8_MMA(0, 1, At, B1); PG8_BAR;
            PG8_LDA(At, 1, 1); PG8_STAGE(PG8_SA(1, 0), a3, voffA);
            PG8_BAR; PG8_WAIT_L(0); PG8_MMA(1, 0, At, B0); PG8_BAR; PG8_SCHED;
            PG8_STAGE(PG8_SB(1, 1), b3 + hstep, voffB);
            PG8_WAIT_V(6); PG8_BAR; PG8_MMA(1, 1, At, B1); PG8_BAR;
            }
        }
        if constexpr (ALIGN_EPI) { if (wr == 0) PG8_BAR; }
        if constexpr (!Epi::AFTER_DRAIN) { E(acc, cur, wr, wc, fr, fq); S.done(cur); }
        if constexpr (Epi::MIDK) { if (has_next) E.prep(nxt); }
        if (!has_next) break;
#pragma unroll
        for (int a = 0; a < 2; ++a)
#pragma unroll
            for (int b = 0; b < 2; ++b)
#pragma unroll
                for (int m = 0; m < 4; ++m)
#pragma unroll
                    for (int n = 0; n < 2; ++n) acc[a][b][m][n] = (f32x4){0.f, 0.f, 0.f, 0.f};
        cur = nxt; cA = nA; cB = nB; ++ui;
        if constexpr (ALIGN_EPI) { if (wr == 1) PG8_BAR; }
    }
    PG8_WAIT_V(0);
    if constexpr (!ALIGN_EPI) { if (wr == 0) PG8_BAR; }
    PG8_BAR;
#undef PG8_SA
#undef PG8_SB
#undef PG8_STAGE
#undef PG8_LDA
#undef PG8_LDB
#undef PG8_MMA
#undef PG8_WAIT_V
#undef PG8_WAIT_L
#undef PG8_BAR
#undef PG8_SCHED
}
}

#define LDS_WAIT() asm volatile("s_waitcnt lgkmcnt(0)" ::: "memory")

__device__ __forceinline__ float wave_sum(float v) {
#pragma unroll
    for (int o = 1; o < 64; o <<= 1) v += __shfl_xor(v, o);
    return v;
}

__device__ __forceinline__ void p0_transpose_item(const float* W, const float* gain, int K, int N, bf16_t* WT, int ilv, LAS float* scr, int item, int lane, const float* gain2 = nullptr) {
    const int nblk = N / 32, kb = item / nblk, nb = item % nblk, k0 = 64 * kb, n0 = 32 * nb;
#pragma unroll 8
    for (int i = 0; i < 32; ++i) { const int kk = 2 * i + (lane >> 5); scr[kk * 33 + (lane & 31)] = W[(size_t)(k0 + kk) * N + n0 + (lane & 31)]; }
    LDS_WAIT(); asm volatile("" ::: "memory");
    const int c = lane & 7;
    f32x4 g0 = (f32x4){1.f, 1.f, 1.f, 1.f}, g1 = g0;
    if (gain) { const float* gp = (gain2 && k0 >= 1024) ? gain2 + (k0 - 1024) : gain + k0; g0 = *(const f32x4*)(gp + 8 * c); g1 = *(const f32x4*)(gp + 8 * c + 4); }
#pragma unroll
    for (int j = 0; j < 4; ++j) { const int n = (lane >> 3) + 8 * j; const LAS float* s = scr + (8 * c) * 33 + n;
        u32x4 o; o.x = cvt_pk_bf16(s[0 * 33] * g0.x, s[1 * 33] * g0.y); o.y = cvt_pk_bf16(s[2 * 33] * g0.z, s[3 * 33] * g0.w); o.z = cvt_pk_bf16(s[4 * 33] * g1.x, s[5 * 33] * g1.y); o.w = cvt_pk_bf16(s[6 * 33] * g1.z, s[7 * 33] * g1.w);
        const int nn = n0 + n; const int row = ilv < 0 ? nn : ((nn >> 7) * 256 + (nn & 127) + ilv);
        *(u32x4*)(WT + (size_t)row * K + k0 + 8 * c) = o; }
    LDS_WAIT(); asm volatile("" ::: "memory");
}

__device__ __forceinline__ void rms_rows_bf16(const float* x, const float* g, bf16_t* out, int gw, int NGW, int lane) {
    LAUNDER(lane);
    f32x4 gv[8];
#pragma unroll
    for (int j = 0; j < 8; ++j) gv[j] = *(const f32x4*)(g + 4 * lane + 256 * j);
    for (int m = gw; m < M; m += NGW) {
        const f32x4* xr = (const f32x4*)(x + (size_t)m * D) + lane; f32x4 v[8]; float s = 0.f;
#pragma unroll
        for (int j = 0; j < 8; ++j) { v[j] = xr[64 * j]; s += (v[j].x * v[j].x + v[j].y * v[j].y) + (v[j].z * v[j].z + v[j].w * v[j].w); }
        const float rstd = 1.0f / sqrtf(wave_sum(s) * (1.0f / D) + EPS);
        u32x2* o8 = (u32x2*)(out + (size_t)m * D) + lane;
#pragma unroll
        for (int j = 0; j < 8; ++j) { const f32x4 o = v[j] * rstd * gv[j]; u32x2 w; w.x = cvt_pk_bf16(o.x, o.y); w.y = cvt_pk_bf16(o.z, o.w); o8[64 * j] = w; }
    }
}
__device__ __forceinline__ void cast_rows_bf16(const float* x, bf16_t* out, float* ssq, int gw, int NGW, int lane) {
    LAUNDER(lane);
    for (int m = gw; m < M; m += NGW) {
        const f32x4* xr = (const f32x4*)(x + (size_t)m * D) + lane; f32x4 v[8]; float s = 0.f;
#pragma unroll
        for (int j = 0; j < 8; ++j) { v[j] = xr[64 * j]; s += (v[j].x * v[j].x + v[j].y * v[j].y) + (v[j].z * v[j].z + v[j].w * v[j].w); }
        s = wave_sum(s);
        if (lane == 0) { f32x4* pp = (f32x4*)(ssq + (size_t)m * 8); pp[0] = (f32x4){s, 0.f, 0.f, 0.f}; pp[1] = (f32x4){0.f, 0.f, 0.f, 0.f}; }
        u32x2* o8 = (u32x2*)(out + (size_t)m * D) + lane;
#pragma unroll
        for (int j = 0; j < 8; ++j) { u32x2 w; w.x = cvt_pk_bf16(v[j].x, v[j].y); w.y = cvt_pk_bf16(v[j].z, v[j].w); o8[64 * j] = w; }
    }
}
__device__ __forceinline__ void rms_rows_f32_inplace(float* x, const float* g, int gw, int NGW, int lane) {
    LAUNDER(lane);
    f32x4 gv[8];
#pragma unroll
    for (int j = 0; j < 8; ++j) gv[j] = *(const f32x4*)(g + 4 * lane + 256 * j);
    for (int m = gw; m < M; m += NGW) {
        f32x4* xr = (f32x4*)(x + (size_t)m * D) + lane; f32x4 v[8]; float s = 0.f;
#pragma unroll
        for (int j = 0; j < 8; ++j) { v[j] = xr[64 * j]; s += (v[j].x * v[j].x + v[j].y * v[j].y) + (v[j].z * v[j].z + v[j].w * v[j].w); }
        const float rstd = 1.0f / sqrtf(wave_sum(s) * (1.0f / D) + EPS);
#pragma unroll
        for (int j = 0; j < 8; ++j) xr[64 * j] = v[j] * rstd * gv[j];
    }
}
__device__ __forceinline__ void rms_rows_bf16_to_f32(const bf16_t* x, const float* g, float* out, int gw, int NGW, int lane) {
    LAUNDER(lane);
    f32x4 gv[4][2];
#pragma unroll
    for (int j = 0; j < 4; ++j) { const float* gp = g + 512 * j + 8 * lane; gv[j][0] = *(const f32x4*)gp; gv[j][1] = *(const f32x4*)(gp + 4); }
    for (int m = gw; m < M; m += NGW) {
        const u32x4* xr = (const u32x4*)(x + (size_t)m * D) + lane; u32x4 raw[4]; float s = 0.f;
#pragma unroll
        for (int j = 0; j < 4; ++j) raw[j] = xr[64 * j];
        float v[4][8];
#pragma unroll
        for (int j = 0; j < 4; ++j) {
            v[j][0] = bf_lo(raw[j].x); v[j][1] = bf_hi(raw[j].x); v[j][2] = bf_lo(raw[j].y); v[j][3] = bf_hi(raw[j].y);
            v[j][4] = bf_lo(raw[j].z); v[j][5] = bf_hi(raw[j].z); v[j][6] = bf_lo(raw[j].w); v[j][7] = bf_hi(raw[j].w);
#pragma unroll
            for (int e = 0; e < 8; ++e) s += v[j][e] * v[j][e];
        }
        const float rstd = 1.0f / sqrtf(wave_sum(s) * (1.0f / D) + EPS);
        f32x4* orow = (f32x4*)(out + (size_t)m * D + 8 * lane);
#pragma unroll
        for (int j = 0; j < 4; ++j) {
            orow[128 * j] = (f32x4){v[j][0] * rstd * gv[j][0].x, v[j][1] * rstd * gv[j][0].y, v[j][2] * rstd * gv[j][0].z, v[j][3] * rstd * gv[j][0].w};
            orow[128 * j + 1] = (f32x4){v[j][4] * rstd * gv[j][1].x, v[j][5] * rstd * gv[j][1].y, v[j][6] * rstd * gv[j][1].z, v[j][7] * rstd * gv[j][1].w};
        }
    }
}
__device__ __forceinline__ void ynorm_rows(bf16_t* y, const float* g_lru, const float* g_att, int gw, int NGW, int lane) {
    LAUNDER(lane);
    f32x4 gv[4][2];
#pragma unroll
    for (int j = 0; j < 4; ++j) { const float* gp = (j < 2 ? g_lru + 512 * j : g_att + 512 * (j - 2)) + 8 * lane; gv[j][0] = *(const f32x4*)gp; gv[j][1] = *(const f32x4*)(gp + 4); }
    for (int m = gw; m < M; m += NGW) {
        u32x4* yr = (u32x4*)(y + (size_t)m * D) + lane; u32x4 raw[4]; float s0 = 0.f, s1 = 0.f;
#pragma unroll
        for (int j = 0; j < 4; ++j) raw[j] = yr[64 * j];
        float v[4][8];
#pragma unroll
        for (int j = 0; j < 4; ++j) {
            v[j][0] = bf_lo(raw[j].x); v[j][1] = bf_hi(raw[j].x); v[j][2] = bf_lo(raw[j].y); v[j][3] = bf_hi(raw[j].y);
            v[j][4] = bf_lo(raw[j].z); v[j][5] = bf_hi(raw[j].z); v[j][6] = bf_lo(raw[j].w); v[j][7] = bf_hi(raw[j].w);
            float s = 0.f;
#pragma unroll
            for (int e = 0; e < 8; ++e) s += v[j][e] * v[j][e];
            if (j < 2) s0 += s; else s1 += s;
        }
        const float r0 = 1.0f / sqrtf(wave_sum(s0) * (1.0f / 1024.f) + EPS), r1 = 1.0f / sqrtf(wave_sum(s1) * (1.0f / 1024.f) + EPS);
#pragma unroll
        for (int j = 0; j < 4; ++j) { const float r = j < 2 ? r0 : r1; u32x4 w;
            w.x = cvt_pk_bf16(v[j][0] * r * gv[j][0].x, v[j][1] * r * gv[j][0].y); w.y = cvt_pk_bf16(v[j][2] * r * gv[j][0].z, v[j][3] * r * gv[j][0].w);
            w.z = cvt_pk_bf16(v[j][4] * r * gv[j][1].x, v[j][5] * r * gv[j][1].y); w.w = cvt_pk_bf16(v[j][6] * r * gv[j][1].z, v[j][7] * r * gv[j][1].w);
            yr[64 * j] = w; }
    }
}

constexpr int LM_BIAS = 0;
constexpr int LM_CW = 8448;
constexpr int LM_CB = 9472;
constexpr int LM_P = 10240;
constexpr int LM_H = 18432;
__device__ __forceinline__ void lru_unit(LAS unsigned char* lds, const bf16_t* zm, bf16_t* yraw, float* yp, const float* conv_w, const float* conv_b, const float* wa, const float* ba,
                                         const float* wx, const float* bx, const float* lam, int b, int hb, int tid) {
    LAUNDER(tid);
    const int lane = tid & 63, w = tid >> 6, fr = lane & 15, fq = lane >> 4;
    LAS float* cwL = (LAS float*)(lds + LM_CW); LAS float* cbL = (LAS float*)(lds + LM_CB);
    if (tid < 256) cwL[tid] = conv_w[(tid >> 6) * DL + hb * 64 + (tid & 63)];
    else if (tid < 320) cbL[tid - 256] = conv_b[hb * 64 + tid - 256];
    bf16x8 WA[4][2], WX[4][2];
#pragma unroll
    for (int nt = 0; nt < 4; ++nt)
#pragma unroll
        for (int ks = 0; ks < 2; ++ks) {
            const float* pa = wa + ((size_t)hb * 64 + ks * 32 + 8 * fq) * 64 + nt * 16 + fr; const float* px = wx + ((size_t)hb * 64 + ks * 32 + 8 * fq) * 64 + nt * 16 + fr;
            u32x4 ua, ux;
            ua.x = cvt_pk_bf16(pa[0 * 64], pa[1 * 64]); ua.y = cvt_pk_bf16(pa[2 * 64], pa[3 * 64]); ua.z = cvt_pk_bf16(pa[4 * 64], pa[5 * 64]); ua.w = cvt_pk_bf16(pa[6 * 64], pa[7 * 64]);
            ux.x = cvt_pk_bf16(px[0 * 64], px[1 * 64]); ux.y = cvt_pk_bf16(px[2 * 64], px[3 * 64]); ux.z = cvt_pk_bf16(px[4 * 64], px[5 * 64]); ux.w = cvt_pk_bf16(px[6 * 64], px[7 * 64]);
            WA[nt][ks] = __builtin_bit_cast(bf16x8, ua); WX[nt][ks] = __builtin_bit_cast(bf16x8, ux);
        }
    bf16x8 ID[2];
#pragma unroll
    for (int p = 0; p < 2; ++p)
#pragma unroll
        for (int e = 0; e < 8; ++e) ID[p][e] = (8 * fq + e == 16 * p + fr) ? (short)0x3F80 : (short)0;
    float pba[4], pbx[4], pcl[4];
#pragma unroll
    for (int nt = 0; nt < 4; ++nt) { const int c = hb * 64 + nt * 16 + fr; pba[nt] = ba[c]; pbx[nt] = bx[c]; pcl[nt] = -8.0f * log1pf(expf(-lam[c])); }
    __syncthreads();
    float hin[4] = {0.f, 0.f, 0.f, 0.f};
    const bf16_t* zb = zm + (size_t)b * SEQ * ZLD + hb * 64;
    LAS f32x2* TOT = (LAS f32x2*)(lds + LM_P);
    u32x4 XR[2][4], GR[2];
    {
        const int tA = 16 * w + fr;
#pragma unroll
        for (int ks = 0; ks < 2; ++ks) {
            const int ch0 = ks * 32 + 8 * fq;
#pragma unroll
            for (int tap = 0; tap < 4; ++tap) { const int t = tA - 3 + tap; const int tt = t >= 0 ? t : 0; XR[ks][tap] = *(const u32x4*)(zb + (size_t)tt * ZLD + ch0); }
            GR[ks] = *(const u32x4*)(zb + (size_t)tA * ZLD + 1024 + ch0);
        }
    }
#pragma unroll 1
    for (int sc = 0; sc < 16; ++sc) {
        const int tA = sc * 128 + 16 * w + fr;
        const int tN = sc < 15 ? tA + 128 : tA;
        u32x4 XN[2][4], GN[2];
#pragma unroll
        for (int ks = 0; ks < 2; ++ks) {
            const int ch0 = ks * 32 + 8 * fq;
#pragma unroll
            for (int tap = 0; tap < 4; ++tap) XN[ks][tap] = *(const u32x4*)(zb + (size_t)(tN - 3 + tap) * ZLD + ch0);
            GN[ks] = *(const u32x4*)(zb + (size_t)tN * ZLD + 1024 + ch0);
        }
        bf16x8 XC[2], GL[2];
#pragma unroll
        for (int ks = 0; ks < 2; ++ks) {
            const int ch0 = ks * 32 + 8 * fq;
            const f32x4 c0 = *(const LAS f32x4*)(cbL + ch0), c1 = *(const LAS f32x4*)(cbL + ch0 + 4);
            float a8[8] = {c0.x, c0.y, c0.z, c0.w, c1.x, c1.y, c1.z, c1.w};
#pragma unroll
            for (int tap = 0; tap < 4; ++tap) {
                const bool ok = (tA - 3 + tap) >= 0;
                u32x4 xr = XR[ks][tap];
                if (!ok) xr = (u32x4){0u, 0u, 0u, 0u};
                const f32x4 w0 = *(const LAS f32x4*)(cwL + tap * 64 + ch0), w1 = *(const LAS f32x4*)(cwL + tap * 64 + ch0 + 4);
                a8[0] += w0.x * bf_lo(xr.x); a8[1] += w0.y * bf_hi(xr.x); a8[2] += w0.z * bf_lo(xr.y); a8[3] += w0.w * bf_hi(xr.y);
                a8[4] += w1.x * bf_lo(xr.z); a8[5] += w1.y * bf_hi(xr.z); a8[6] += w1.z * bf_lo(xr.w); a8[7] += w1.w * bf_hi(xr.w);
            }
            u32x4 pk; pk.x = cvt_pk_bf16(a8[0], a8[1]); pk.y = cvt_pk_bf16(a8[2], a8[3]); pk.z = cvt_pk_bf16(a8[4], a8[5]); pk.w = cvt_pk_bf16(a8[6], a8[7]);
            XC[ks] = __builtin_bit_cast(bf16x8, pk);
            GL[ks] = __builtin_bit_cast(bf16x8, GR[ks]);
        }
        float hl[4][4], pc[4][4], gel[4][4], PE[4], HE[4];
        LAS f32x2* totw = TOT + ((sc & 1) * 8 + w) * 64;
#pragma unroll
        for (int nt = 0; nt < 4; ++nt) {
            f32x4 ga = (f32x4){0.f, 0.f, 0.f, 0.f}, gx = ga, xo = ga, go = ga;
#pragma unroll
            for (int ks = 0; ks < 2; ++ks) { ga = __builtin_amdgcn_mfma_f32_16x16x32_bf16(XC[ks], WA[nt][ks], ga, 0, 0, 0); gx = __builtin_amdgcn_mfma_f32_16x16x32_bf16(XC[ks], WX[nt][ks], gx, 0, 0, 0); }
            xo = __builtin_amdgcn_mfma_f32_16x16x32_bf16(XC[nt >> 1], ID[nt & 1], xo, 0, 0, 0);
            go = __builtin_amdgcn_mfma_f32_16x16x32_bf16(GL[nt >> 1], ID[nt & 1], go, 0, 0, 0);
#pragma unroll
            for (int j = 0; j < 4; ++j) {
                const float r = sigmoidf_(ga[j] + pba[nt]), ig = sigmoidf_(gx[j] + pbx[nt]);
                const float la = pcl[nt] * r;
                const float a = fast_exp2(la * LOG2E);
                const float x2 = 2.0f * la;
                float ome = -x2 * (1.0f + x2 * 0.5f * (1.0f + x2 * (1.0f / 3.0f)));
                if (x2 < -0.03f) ome = 1.0f - a * a;
                const float u = sqrtf(ome) * ig * xo[j];
                if (j == 0) { hl[nt][0] = u; pc[nt][0] = a; }
                else { hl[nt][j] = a * hl[nt][j - 1] + u; pc[nt][j] = pc[nt][j - 1] * a; }
                const float gv = go[j];
                gel[nt][j] = gv * sigmoidf_(1.5957691216057308f * (gv + 0.044715f * gv * gv * gv));
            }
            float P = pc[nt][3], H = hl[nt][3];
            { const float Pp = __shfl_up(P, 16), Hp = __shfl_up(H, 16); if (fq >= 1) { H = P * Hp + H; P = P * Pp; } }
            { const float Pp = __shfl_up(P, 32), Hp = __shfl_up(H, 32); if (fq >= 2) { H = P * Hp + H; P = P * Pp; } }
            { float Pe = __shfl_up(P, 16), He = __shfl_up(H, 16); if (fq == 0) { Pe = 1.0f; He = 0.0f; } PE[nt] = Pe; HE[nt] = He; }
            if (fq == 3) totw[nt * 16 + fr] = (f32x2){P, H};
        }
        __syncthreads();
        float psq[4] = {0.f, 0.f, 0.f, 0.f};
#pragma unroll
        for (int nt = 0; nt < 4; ++nt) {
            float hrun = hin[nt], hws = hin[nt];
#pragma unroll
            for (int w2 = 0; w2 < 8; ++w2) { const f32x2 t2 = TOT[((sc & 1) * 8 + w2) * 64 + nt * 16 + fr]; hrun = t2.x * hrun + t2.y; if (w2 + 1 == w) hws = hrun; }
            hin[nt] = hrun;
            const float hs = PE[nt] * hws + HE[nt];
#pragma unroll
            for (int j = 0; j < 4; ++j) {
                const float ov = (hl[nt][j] + pc[nt][j] * hs) * gel[nt][j]; psq[j] += ov * ov;
                const unsigned o = cvt_pk_bf16(ov, 0.f);
                yraw[(size_t)(b * SEQ + sc * 128 + 16 * w + 4 * fq + j) * D + hb * 64 + nt * 16 + fr] = (bf16_t)(o & 0xffffu);
            }
        }
#pragma unroll
        for (int j = 0; j < 4; ++j) { float q = psq[j]; q += __shfl_xor(q, 1); q += __shfl_xor(q, 2); q += __shfl_xor(q, 4); q += __shfl_xor(q, 8);
            if (fr == 0) yp[(size_t)(b * SEQ + sc * 128 + 16 * w + 4 * fq + j) * 24 + hb] = q; }
#pragma unroll
        for (int ks = 0; ks < 2; ++ks) {
#pragma unroll
            for (int tap = 0; tap < 4; ++tap) XR[ks][tap] = XN[ks][tap];
            GR[ks] = GN[ks];
        }
    }
    __syncthreads();
}

constexpr int LM_ATT = 32768;
#define ATT_COMPUTE(FAR) do { \
        bf16x8 Kf[2][4], Vf[8]; \
        _Pragma("unroll") for (int t = 0; t < 2; ++t) _Pragma("unroll") for (int ks = 0; ks < 4; ++ks) Kf[t][ks] = *(const LAS bf16x8*)(sb + (t * 4 + ks) * 1024 + foff); \
        _Pragma("unroll") for (int dt = 0; dt < 8; ++dt) Vf[dt] = *(const LAS bf16x8*)(sb + 8192 + dt * 1024 + foff); \
        f32x4 St[2][2]; \
        _Pragma("unroll") for (int t = 0; t < 2; ++t) _Pragma("unroll") for (int qt = 0; qt < 2; ++qt) { f32x4 s_ = (f32x4){0.f, 0.f, 0.f, 0.f}; \
            _Pragma("unroll") for (int ks = 0; ks < 4; ++ks) s_ = __builtin_amdgcn_mfma_f32_16x16x32_bf16(Kf[t][ks], Q[qt][ks], s_, 0, 0, 0); \
            St[t][qt] = s_; } \
        bf16x8 Pf[2]; \
        _Pragma("unroll") for (int qt = 0; qt < 2; ++qt) { \
            const int qpos = c * 64 + qh * 32 + qt * 16 + fr; \
            float sv[8]; float bm = -1e30f; \
            _Pragma("unroll") for (int t = 0; t < 2; ++t) _Pragma("unroll") for (int j = 0; j < 4; ++j) { float bv_; \
                if (FAR) bv_ = bias0; else { int rel = k0 + 8 * fq + 4 * t + j - qpos; rel = rel < -128 ? -128 : (rel > 128 ? 128 : rel); bv_ = bias[rel + 128]; } \
                const float s_ = St[t][qt][j] * SC + bv_; sv[t * 4 + j] = s_; bm = fmaxf(bm, s_); } \
            bm = fmaxf(bm, __shfl_xor(bm, 16)); bm = fmaxf(bm, __shfl_xor(bm, 32)); \
            const float mn = (bm > mrun[qt] + 8.0f) ? bm : mrun[qt];     \
            if (__builtin_amdgcn_ballot_w64(mn != mrun[qt]) != 0ull) { const float alpha = fast_exp2(mrun[qt] - mn); mrun[qt] = mn; lrun[qt] = lrun[qt] * alpha; \
                _Pragma("unroll") for (int dt = 0; dt < 8; ++dt) O[dt][qt] = O[dt][qt] * alpha; } \
            float ps = 0.f; \
            _Pragma("unroll") for (int e = 0; e < 8; ++e) { sv[e] = fast_exp2(sv[e] - mn); ps += sv[e]; } \
            lrun[qt] = lrun[qt] + ps; \
            u32x4 pk; pk.x = cvt_pk_bf16(sv[0], sv[1]); pk.y = cvt_pk_bf16(sv[2], sv[3]); pk.z = cvt_pk_bf16(sv[4], sv[5]); pk.w = cvt_pk_bf16(sv[6], sv[7]); \
            Pf[qt] = __builtin_bit_cast(bf16x8, pk); } \
        _Pragma("unroll") for (int dt = 0; dt < 8; ++dt) _Pragma("unroll") for (int qt = 0; qt < 2; ++qt) O[dt][qt] = __builtin_amdgcn_mfma_f32_16x16x32_bf16(Vf[dt], Pf[qt], O[dt][qt], 0, 0, 0); \
    } while (0)
__device__ __forceinline__ void attn_block(LAS unsigned char* lds, const bf16_t* zm, const bf16_t* Kh, const bf16_t* Vt, bf16_t* yraw, float* yp, const LAS float* biasAll, int b, int h, int g, int tid) {
    LAUNDER(tid);
    const int lane = tid & 63, wave = tid >> 6, fr = lane & 15, fq = lane >> 4;
    const int c = 4 * g + (wave >> 1), qh = wave & 1;
    const LAS float* bias = biasAll + h * NREL;
    const float bias0 = bias[0];
    const float SC = 0.08838834764831845f * LOG2E;
    bf16x8 Q[2][4];
#pragma unroll
    for (int qt = 0; qt < 2; ++qt) { const size_t tok = (size_t)b * SEQ + c * 64 + qh * 32 + qt * 16 + fr;
#pragma unroll
        for (int ks = 0; ks < 4; ++ks) Q[qt][ks] = *(const bf16x8*)(zm + tok * ZLD + 2048 + h * HD + ks * 32 + 8 * fq); }
    f32x4 O[8][2];
#pragma unroll
    for (int dt = 0; dt < 8; ++dt)
#pragma unroll
        for (int qt = 0; qt < 2; ++qt) O[dt][qt] = (f32x4){0.f, 0.f, 0.f, 0.f};
    float mrun[2] = {-1e30f, -1e30f}, lrun[2] = {0.f, 0.f};
    const int lo = g >= 2 ? 4 * g - 8 : 0, nch = 4 * g + 4 - lo;
    const int kr = tid >> 4, c16 = tid & 15;
    const int krho = ((kr >> 3) << 2) | (kr & 3);
    const int kst = ((((kr >> 2) & 1) * 4 + (c16 >> 2)) * 1024) + ((krho * 64 + (c16 & 3) * 16) ^ (krho >= 8 ? 32 : 0));
    const bf16_t* kg = Kh + ((size_t)(b * NH + h) * SEQ + kr) * HD + 8 * c16;
    const int vd = tid >> 2, vq = tid & 3;
    const int vst = 8192 + (vd >> 4) * 1024 + (((vd & 15) * 64 + vq * 16) ^ ((vd & 15) >= 8 ? 32 : 0));
    const bf16_t* vg = Vt + ((size_t)(b * NH + h) * HD + vd) * SEQ + 8 * vq;
    const int foff = (fr * 64 + fq * 16) ^ (fr >= 8 ? 32 : 0);
    LAS unsigned char* st = lds + LM_ATT;
    { const int k0 = lo * 64;
      const u32x4 kv0 = *(const u32x4*)(kg + (size_t)k0 * HD), kv1 = *(const u32x4*)(kg + (size_t)(k0 + 32) * HD); const u32x4 vv0 = *(const u32x4*)(vg + k0), vv1 = *(const u32x4*)(vg + k0 + 32);
      *(LAS u32x4*)(st + kst) = kv0; *(LAS u32x4*)(st + vst) = vv0; *(LAS u32x4*)(st + 16384 + kst) = kv1; *(LAS u32x4*)(st + 16384 + vst) = vv1; }
    __syncthreads();
#pragma unroll 1
    for (int ci = 0; ci < nch; ++ci) {
        const int kc = lo + ci;
        const int k0n = (lo + (ci + 1 < nch ? ci + 1 : ci)) * 64;
        const u32x4 kv0 = *(const u32x4*)(kg + (size_t)k0n * HD), kv1 = *(const u32x4*)(kg + (size_t)(k0n + 32) * HD); const u32x4 vv0 = *(const u32x4*)(vg + k0n), vv1 = *(const u32x4*)(vg + k0n + 32);
        if (kc >= c - 8 && kc <= c) {
            const bool farc = kc <= c - 3;
#pragma unroll 1
            for (int hf = 0; hf < 2; ++hf) {
                const LAS unsigned char* sb = st + (ci & 1) * 32768 + hf * 16384; const int k0 = kc * 64 + hf * 32;
                if (farc) ATT_COMPUTE(true); else ATT_COMPUTE(false);
            }
        }
        LAS unsigned char* nb = st + ((ci + 1) & 1) * 32768;
        *(LAS u32x4*)(nb + kst) = kv0; *(LAS u32x4*)(nb + vst) = vv0; *(LAS u32x4*)(nb + 16384 + kst) = kv1; *(LAS u32x4*)(nb + 16384 + vst) = vv1;
        __syncthreads();
    }
#pragma unroll
    for (int qt = 0; qt < 2; ++qt) {
        float l = lrun[qt]; l += __shfl_xor(l, 16); l += __shfl_xor(l, 32);
        const float inv = 1.0f / l;
        bf16_t* op = yraw + ((size_t)b * SEQ + c * 64 + qh * 32 + qt * 16 + fr) * D + 1024 + h * HD + 4 * fq;
        float q = 0.f;
#pragma unroll
        for (int dt = 0; dt < 8; ++dt) { const f32x4 o = O[dt][qt] * inv; u32x2 w; w.x = cvt_pk_bf16(o.x, o.y); w.y = cvt_pk_bf16(o.z, o.w); *(u32x2*)(op + dt * 16) = w; q += (o.x * o.x + o.y * o.y) + (o.z * o.z + o.w * o.w); }
        q += __shfl_xor(q, 16); q += __shfl_xor(q, 32);
        if (fq == 0) yp[((size_t)b * SEQ + c * 64 + qh * 32 + qt * 16 + fr) * 24 + 16 + h] = q;
    }
}
#undef ATT_COMPUTE

#define XB_TMO      128
#define XB_XCNT(j)  (256  + 64 * (j))
#define XB_XSUB(j)  (1280 + 64 * (j))
#define XB_XGEN(j)  (2304 + 64 * (j))
#define XB_TOP      3328
#define XB_TOPGEN   3392
#define XCD_BAR_WORDS 3456
#define XB_SPIN_CAP (1u << 18)
__device__ __forceinline__ unsigned xb_ld(unsigned* p)              { return __hip_atomic_load(p, __ATOMIC_RELAXED, __HIP_MEMORY_SCOPE_AGENT); }
__device__ __forceinline__ unsigned xb_add(unsigned* p, unsigned v) { return __hip_atomic_fetch_add(p, v, __ATOMIC_RELAXED, __HIP_MEMORY_SCOPE_AGENT); }
__device__ __forceinline__ unsigned xb_xcc_id() { return (unsigned)__builtin_amdgcn_s_getreg((3 << 11) | 20) & 0xFu; }
#define XB_SPIN(cond, bar) do { unsigned _sp = 0; while (cond) { __builtin_amdgcn_s_sleep(1); \
    if ((++_sp & 255u) == 0u) { if (xb_ld(&(bar)[XB_TMO])) break; if (_sp > XB_SPIN_CAP) { atomicAdd(&(bar)[XB_TMO], 1u); break; } } } } while (0)
struct XcdBarrier { unsigned* bar; unsigned x; volatile LAS unsigned* st; };
__device__ __forceinline__ XcdBarrier xcd_barrier_post(unsigned* bar, volatile LAS unsigned* st) {
    XcdBarrier b; b.bar = bar; b.x = xb_xcc_id(); b.st = st;
    if (threadIdx.x == 0) (void)xb_add(&bar[XB_XCNT(b.x)], 1u);
    return b;
}
__device__ __forceinline__ void xcd_barrier_complete(unsigned* bar, unsigned x, unsigned& nloc, unsigned& nx) {
    const unsigned G = gridDim.x * gridDim.y * gridDim.z;
    unsigned sum, cnt, mine, sp = 0u;
    for (;;) {
        sum = 0u; cnt = 0u; mine = 0u;
#pragma unroll
        for (unsigned j = 0; j < 16; ++j) { const unsigned c = xb_ld(&bar[XB_XCNT(j)]); sum += c; cnt += (c > 0u) ? 1u : 0u; mine = (j == x) ? c : mine; }
        if (sum == G) break;
        __builtin_amdgcn_s_sleep(1);
        if ((++sp & 255u) == 0u) { if (xb_ld(&bar[XB_TMO])) break; if (sp > XB_SPIN_CAP) { atomicAdd(&bar[XB_TMO], 1u); break; } }
    }
    nloc = mine > 0u ? mine : 1u; nx = cnt > 0u ? cnt : 1u;
}
__device__ __forceinline__ void xcd_barrier(const XcdBarrier& b) {
    asm volatile("s_waitcnt vmcnt(0)" ::: "memory");
    __syncthreads();
    if (threadIdx.x == 0) {
        unsigned* bar = b.bar;
        __builtin_amdgcn_s_waitcnt(0);
        unsigned nloc = b.st[0], nx = b.st[1];
        if (nloc == 0u) { xcd_barrier_complete(bar, b.x, nloc, nx); b.st[0] = nloc; b.st[1] = nx; }
        const unsigned old = xb_add(&bar[XB_XSUB(b.x)], 1u);
        const unsigned gen = old / nloc;
        if (old + 1u == (gen + 1u) * nloc) {
            __builtin_amdgcn_fence(__ATOMIC_RELEASE, "agent");
            asm volatile("s_waitcnt vmcnt(0)" ::: "memory");
            const unsigned og = xb_add(&bar[XB_TOP], 1u);
            const unsigned tg = og / nx;
            if (og + 1u == (tg + 1u) * nx) xb_add(&bar[XB_TOPGEN], 1u);
            else XB_SPIN(xb_ld(&bar[XB_TOPGEN]) == tg, bar);
            __builtin_amdgcn_fence(__ATOMIC_ACQUIRE, "agent");
            xb_add(&bar[XB_XGEN(b.x)], 1u);
            asm volatile("s_waitcnt vmcnt(0)" ::: "memory");
        } else {
            XB_SPIN(xb_ld(&bar[XB_XGEN(b.x)]) == gen, bar);
            __builtin_amdgcn_fence(__ATOMIC_ACQUIRE, "agent");
            asm volatile("s_waitcnt vmcnt(0)" ::: "memory");
        }
    }
    __syncthreads();
}

struct Args { const float* in[23]; float* out; unsigned char* ws; int pad0, pad1; };

__global__ void __launch_bounds__(NTHREADS, 2) mk_fwd(Args args) {
    extern __shared__ __attribute__((aligned(16))) unsigned char lds_raw[];
    LAS unsigned char* lds = (LAS unsigned char*)lds_raw;
    cg::grid_group grid = cg::this_grid();
    const int tid = threadIdx.x, lane = tid & 63, wave = __builtin_amdgcn_readfirstlane(tid >> 6);
    const int G = gridDim.x, bx = blockIdx.x;
    const int gw = bx * NWAVES + wave, NGW = G * NWAVES;
    typedef const float* cfp;
    const __attribute__((address_space(4))) cfp* inp = (const __attribute__((address_space(4))) cfp*)__builtin_amdgcn_kernarg_segment_ptr();
#define INP(k) (inp[k])
#define LAUNDER_S(v) asm volatile("" : "+s"(v))
    unsigned char* ws = args.ws;
    float* out = args.out;
    volatile LAS unsigned* bst = (volatile LAS unsigned*)(lds + 131072 + 64);
    if (tid < 2) bst[tid] = 0u;
    __syncthreads();
    if (bx == 0) for (int i = tid; i < XCD_BAR_WORDS; i += NTHREADS) ((unsigned*)(ws + WS_CTL))[i] = 0u;
#define GRID_BAR() do { XcdBarrier xb_; xb_.bar = (unsigned*)(args.ws + WS_CTL); xb_.x = xb_xcc_id(); xb_.st = (volatile LAS unsigned*)(lds + 131072 + 64); xcd_barrier(xb_); } while (0)
    bf16_t* HID = (bf16_t*)(ws + WS_BIG); bf16_t* ZM = (bf16_t*)(ws + WS_BIG); bf16_t* VT = (bf16_t*)(ws + WS_VT); bf16_t* KH = (bf16_t*)(ws + WS_KH); bf16_t* HB = (bf16_t*)(ws + WS_H); bf16_t* HB2 = (bf16_t*)(ws + WS_H2); float* SSQ = (float*)(ws + WS_SSQ); float* YP = (float*)(ws + WS_YP);

    {
        LAS float* scr = (LAS float*)(lds + wave * 16384);
        constexpr int I_G = (D / 64) * (FF / 32), I_D = (FF / 64) * (D / 32), I_IN = (D / 64) * (DIN / 32), I_O = (D / 64) * (D / 32);
        constexpr int PER_LAYER = 4 * I_G + 2 * I_D + I_IN + I_O;
        for (int it = gw; it < DEPTH * PER_LAYER; it += NGW) {
            const int l = it / PER_LAYER; int r = it % PER_LAYER;
            unsigned char* wl = ws + (size_t)l * LAYER_W;
            if (r < I_G) { p0_transpose_item(INP(2) + (size_t)l * D * FF, INP(1) + (size_t)l * D, D, FF, (bf16_t*)(wl + OFF_WGU1), 0, scr, r, lane); continue; } r -= I_G;
            if (r < I_G) { p0_transpose_item(INP(3) + (size_t)l * D * FF, INP(1) + (size_t)l * D, D, FF, (bf16_t*)(wl + OFF_WGU1), 128, scr, r, lane); continue; } r -= I_G;
            if (r < I_D) { p0_transpose_item(INP(4) + (size_t)l * FF * D, nullptr, FF, D, (bf16_t*)(wl + OFF_WD1), -1, scr, r, lane); continue; } r -= I_D;
            if (r < I_IN) { p0_transpose_item(INP(6) + (size_t)l * D * DIN, INP(5) + (size_t)l * D, D, DIN, (bf16_t*)(wl + OFF_WIN), -1, scr, r, lane); continue; } r -= I_IN;
            if (r < I_O) { p0_transpose_item(INP(17) + (size_t)l * D * D, INP(15) + (size_t)l * DL, D, D, (bf16_t*)(wl + OFF_WOUT), -1, scr, r, lane, INP(16) + (size_t)l * DL); continue; } r -= I_O;
            if (r < I_G) { p0_transpose_item(INP(19) + (size_t)l * D * FF, INP(18) + (size_t)l * D, D, FF, (bf16_t*)(wl + OFF_WGU2), 0, scr, r, lane); continue; } r -= I_G;
            if (r < I_G) { p0_transpose_item(INP(20) + (size_t)l * D * FF, INP(18) + (size_t)l * D, D, FF, (bf16_t*)(wl + OFF_WGU2), 128, scr, r, lane); continue; } r -= I_G;
            p0_transpose_item(INP(21) + (size_t)l * FF * D, nullptr, FF, D, (bf16_t*)(wl + OFF_WD2), -1, scr, r, lane);
        }
        cast_rows_bf16(INP(0), HB, SSQ, gw, NGW, lane);
    }
    grid.sync();
    (void)xcd_barrier_post((unsigned*)(ws + WS_CTL), bst);

#pragma unroll 1
    for (int l = 0; l < DEPTH; ++l) {
        unsigned char* wl = ws + (size_t)l * LAYER_W;
#pragma unroll 1
        for (int f = 0; f < 2; ++f) {
            LAUNDER_S(inp);
            {
                pg8::Gemm g{HB, (const bf16_t*)(wl + (f ? OFF_WGU2 : OFF_WGU1)), M, 2 * FF, D}; pg8::StaticOrder S; S.init(M, 2 * FF, G, bx);
                { if (tid == 0) *(volatile LAS int*)(lds + pg8::LDS_RSPM) = -1; __syncthreads(); }
                pg8::EpiSwiGLU E{HID, FF, SSQ + (size_t)(3 * l + (f ? 2 : 0)) * M * 8, lds};
                pg8::gemm_phase<pg8::EpiSwiGLU, pg8::StaticOrder, true, true>(lds, g, S, E);
            }
            GRID_BAR();
            {
                pg8::Gemm g{HID, (const bf16_t*)(wl + (f ? OFF_WD2 : OFF_WD1)), M, D, FF}; pg8::StaticOrder S; S.init(M, D, G, bx);
                pg8::EpiResid<true> E{HB, SSQ + (size_t)(3 * l + (f ? 3 : 1)) * M * 8, lds};
                pg8::gemm_phase<pg8::EpiResid<true>, pg8::StaticOrder, true, true>(lds, g, S, E);
            }
            GRID_BAR();
            if (f == 0) {
                {
                    pg8::Gemm g{HB, (const bf16_t*)(wl + OFF_WIN), M, DIN, D}; pg8::StaticOrder S; S.init(M, DIN, G, bx);
                    { if (tid == 0) *(volatile LAS int*)(lds + pg8::LDS_RSPM) = -1; __syncthreads(); }
                    pg8::EpiZ E{ZM, VT, KH, SSQ + (size_t)(3 * l + 1) * M * 8, lds};
                    pg8::gemm_phase<pg8::EpiZ, pg8::StaticOrder, true, true>(lds, g, S, E);
                }
                GRID_BAR();
                {
                    LAS float* biasL = (LAS float*)(lds + LM_BIAS);
                    const float* rb = INP(14) + (size_t)l * NH * NREL;
                    int tid_m = tid; LAUNDER(tid_m);
                    for (int i = tid_m; i < NH * NREL; i += NTHREADS) biasL[i] = rb[i] * LOG2E;
                    __syncthreads();
                    for (int u = bx; u < NB * 16; u += G)
                        lru_unit(lds, ZM, HB2, YP, INP(7) + (size_t)l * 4 * DL, INP(8) + (size_t)l * DL, INP(9) + (size_t)l * 16 * 64 * 64, INP(10) + (size_t)l * DL,
                                 INP(11) + (size_t)l * 16 * 64 * 64, INP(12) + (size_t)l * DL, INP(13) + (size_t)l * DL, u >> 4, u & 15, tid);
                    for (int bu = bx; bu < 1024; bu += G) {
                        const int kk = bu >> 8, bxv = bu & 255;
                        const int ag = ((bxv & 7) + 2 * kk) & 7, ap = (bxv >> 3) + 32 * kk;
                        attn_block(lds, ZM, KH, VT, HB2, YP, biasL, ap >> 3, ap & 7, ag, tid);
                    }
                }
                GRID_BAR();
                {
                    pg8::Gemm g{HB2, (const bf16_t*)(wl + OFF_WOUT), M, D, D}; pg8::StaticOrder S; S.init(M, D, G, bx);
                    { if (tid == 0) *(volatile LAS int*)(lds + pg8::LDS_RS2PM) = -1; __syncthreads(); }
                    pg8::EpiResidY E{HB, SSQ + (size_t)(3 * l + 2) * M * 8, YP, lds};
                    { pg8::Unit u0; if (S.next(0, u0)) E.prep(u0); }
                    pg8::gemm_phase<pg8::EpiResidY, pg8::StaticOrder, true, true>(lds, g, S, E);
                }
                GRID_BAR();
            } else {
                if (l + 1 == DEPTH) rms_rows_bf16_to_f32(HB, INP(22), out, gw, NGW, lane);
            }
        }
    }
}

extern "C" void kernel_launch(void* const* d_in, const int* in_sizes, int n_in, void* d_out, int out_size, void* d_ws, size_t ws_size, hipStream_t stream) {
    static int grid = 0;
    if (grid == 0) {
        if (n_in != 23 || in_sizes[0] != M * D || out_size != M * D || ws_size < WS_END) {
            fprintf(stderr, "kernel_launch: unexpected shapes: n_in %d in0 %d out %d ws %zu (need %zu)\n", n_in, n_in > 0 ? in_sizes[0] : -1, out_size, ws_size, (size_t)WS_END); grid = -1; return; }
        int dev = 0, cus = 0, per_cu = 0;
        hipGetDevice(&dev); hipDeviceGetAttribute(&cus, hipDeviceAttributeMultiprocessorCount, dev);
        if (hipFuncSetAttribute((const void*)mk_fwd, hipFuncAttributeMaxDynamicSharedMemorySize, LDS_BYTES) != hipSuccess) fprintf(stderr, "kernel_launch: hipFuncSetAttribute failed\n");
        if (hipOccupancyMaxActiveBlocksPerMultiprocessor(&per_cu, (const void*)mk_fwd, NTHREADS, LDS_BYTES) != hipSuccess || per_cu < 1) { fprintf(stderr, "kernel_launch: occupancy query gave %d\n", per_cu); per_cu = 1; }
        (void)hipGetLastError();
        grid = cus * per_cu;
        if (grid > 256) grid = 256;
    }
    if (grid < 0) return;
    Args a{};
    for (int i = 0; i < 23; ++i) a.in[i] = (const float*)d_in[i];
    a.out = (float*)d_out; a.ws = (unsigned char*)d_ws;
    void* kargs[] = {&a};
    hipError_t e = hipLaunchCooperativeKernel((const void*)mk_fwd, dim3(grid), dim3(NTHREADS), kargs, LDS_BYTES, stream);
    if (e != hipSuccess) fprintf(stderr, "kernel_launch: cooperative launch failed: %s (grid %d)\n", hipGetErrorString(e), grid);
}
```

```cpp
#include <hip/hip_runtime.h>
#include <hip/hip_cooperative_groups.h>
#include <cstdio>
#include <cstdint>
namespace cg = cooperative_groups;

#define LAS __attribute__((address_space(3)))
#define LAUNDER(v) asm volatile("" : "+v"(v))
typedef unsigned short bf16_t;
typedef short bf16x8 __attribute__((ext_vector_type(8)));
typedef float f32x4 __attribute__((ext_vector_type(4)));
typedef float f32x2 __attribute__((ext_vector_type(2)));
typedef unsigned u32x4 __attribute__((ext_vector_type(4)));
typedef unsigned u32x2 __attribute__((ext_vector_type(2)));

constexpr int NB = 16, SEQ = 2048, M = NB * SEQ, D = 2048, FF = 5632, DIN = 5120, DL = 1024, NH = 8, HD = 128, NREL = 257, DEPTH = 2;
constexpr int ZLD = 3072;
constexpr float EPS = 1e-6f;
constexpr float LOG2E = 1.4426950408889634f;

constexpr size_t MiB = 1u << 20;
constexpr size_t SZ_WGU = (size_t)2 * FF * D * 2, SZ_WD = (size_t)D * FF * 2, SZ_WIN = (size_t)DIN * D * 2, SZ_WOUT = (size_t)D * D * 2;
constexpr size_t OFF_WGU1 = 0, OFF_WD1 = OFF_WGU1 + SZ_WGU, OFF_WIN = OFF_WD1 + SZ_WD, OFF_WOUT = OFF_WIN + SZ_WIN, OFF_WGU2 = OFF_WOUT + SZ_WOUT, OFF_WD2 = OFF_WGU2 + SZ_WGU;
constexpr size_t LAYER_W = OFF_WD2 + SZ_WD;
static_assert(LAYER_W == 160 * MiB, "weights per layer");
constexpr size_t WS_BIG = 2 * LAYER_W;
constexpr size_t WS_VT = WS_BIG + (size_t)M * ZLD * 2;
constexpr size_t WS_KH = WS_VT + (size_t)M * 1024 * 2;
constexpr size_t WS_H = WS_BIG + 352 * MiB;
constexpr size_t WS_H2 = WS_H + 128 * MiB;
constexpr size_t WS_SSQ = WS_H2 + 128 * MiB;
constexpr size_t WS_YP = WS_SSQ + 8 * MiB;
constexpr size_t WS_CTL = WS_YP + 4 * MiB;
constexpr size_t CTL_BYTES = 16384;
constexpr size_t WS_END = WS_CTL + 1 * MiB;
static_assert((size_t)M * FF * 2 == 352 * MiB, "hidden size");

constexpr int NWAVES = 8, NTHREADS = 512;
constexpr int LDS_BYTES = 147456;

__device__ __forceinline__ unsigned cvt_pk_bf16(float lo, float hi) { unsigned r; asm volatile("v_cvt_pk_bf16_f32 %0, %1, %2" : "=v"(r) : "v"(lo), "v"(hi)); return r; }
__device__ __forceinline__ float bf_lo(unsigned u) { return __uint_as_float(u << 16); }
__device__ __forceinline__ float bf_hi(unsigned u) { return __uint_as_float(u & 0xffff0000u); }
__device__ __forceinline__ float fast_exp2(float x) { return __builtin_amdgcn_exp2f(x); }
__device__ __forceinline__ float fast_rcp(float x) { return __builtin_amdgcn_rcpf(x); }
__device__ __forceinline__ float sigmoidf_(float x) { return fast_rcp(1.0f + fast_exp2(-LOG2E * x)); }

namespace pg8 {
constexpr int BM = 256, BK = 64, HALF = 128, HTB = HALF * BK * 2, STAGE_BYTES = 8 * HTB, NXCD = 8, WGM = 4;
__host__ __device__ __forceinline__ int lds_byte(int r, int c) { const int st = (r >> 4) * 2 + (c >> 5), rr = r & 15, cc = c & 31, ob = rr * 64 + cc * 2; return st * 1024 + (ob ^ (((ob >> 9) & 1) << 5)); }
__host__ __device__ __forceinline__ void stage_rc(int b, int& R, int& C) { const int st = b / 1024, sb = b % 1024, swz = sb ^ (((sb >> 9) & 1) << 5); R = (st >> 1) * 16 + swz / 64; C = (st & 1) * 32 + (swz % 64) / 2; }
__host__ __device__ __forceinline__ int perm32(int rho) { const int n = rho >> 4, i = rho & 15; return 8 * (i >> 2) + 4 * n + (i & 3); }

struct Unit { int pm, pn; };
struct Gemm { const bf16_t* A; const bf16_t* Bt; int M, N, K; };

struct StaticOrder {
    int nM, nN, nwg, G, c;
    __host__ __device__ void init(int M_, int N_, int G_, int c_) { nM = M_ / BM; nN = N_ / BM; nwg = nM * nN; G = G_; c = c_; }
    __host__ __device__ bool next(int i, Unit& u) const {
        const long L = (long)i * G + c; if (L >= nwg) return false;
        int wgid = (int)L; { const int q = nwg / NXCD, r = nwg % NXCD, xcd = wgid % NXCD, off = wgid / NXCD; wgid = (xcd < r ? xcd * (q + 1) : r * (q + 1) + (xcd - r) * q) + off; }
        const int nig = WGM * nN, gid = wgid / nig, fm = gid * WGM, gsz = (nM - fm) < WGM ? (nM - fm) : WGM;
        u.pm = fm + ((wgid % nig) % gsz); u.pn = (wgid % nig) / gsz; return true;
    }
    __device__ __forceinline__ void a_ready(const Unit&) const {}
    __device__ __forceinline__ void done(const Unit&) const {}
};


constexpr int LDS_RS = 131072 + 1024, LDS_RSPM = 131072 + 2048 + 64, LDS_SSP = 131072 + 4096;
__device__ __forceinline__ void rs_panel(LAS unsigned char* lds, const float* ssq, int pm) {
    volatile LAS int* pmL = (volatile LAS int*)(lds + LDS_RSPM); LAS float* rsL = (LAS float*)(lds + LDS_RS);
    if (pmL[0] != pm) {
        asm volatile("s_waitcnt lgkmcnt(0)" ::: "memory"); __builtin_amdgcn_s_barrier();
        const int t = threadIdx.x;
        if (t < 256) { const f32x4* pp = (const f32x4*)(ssq + (size_t)(pm * 256 + t) * 8); const f32x4 pa = pp[0], pb = pp[1];
            rsL[t] = __builtin_amdgcn_rsqf((((pa.x + pa.y) + (pa.z + pa.w)) + ((pb.x + pb.y) + (pb.z + pb.w))) * (1.0f / D) + EPS); }
        if (t == 0) pmL[0] = pm;
        asm volatile("s_waitcnt vmcnt(0) lgkmcnt(0)" ::: "memory"); __builtin_amdgcn_s_barrier();
    }
}
struct EpiSwiGLU {
    static constexpr bool PERM = true, AFTER_DRAIN = false, MIDK = false;
    bf16_t* O; int ldc; const float* ssq; LAS unsigned char* lds;
    __device__ __forceinline__ void operator()(const f32x4 (&acc)[2][2][4][2], const Unit& u, int wr, int wc, int fr, int fq) const {
        rs_panel(lds, ssq, u.pm);
        const LAS float* rsL = (const LAS float*)(lds + LDS_RS) + wr * 64 + fr;
        const int row0 = u.pm * BM + wr * 64 + fr; const int col0 = u.pn * HALF + wc * 32 + 8 * fq;
#pragma unroll
        for (int ai = 0; ai < 2; ++ai)
#pragma unroll
            for (int m = 0; m < 4; ++m) {
                bf16_t* rowp = O + (size_t)(row0 + ai * HALF + m * 16) * ldc + col0;
                const float rs = rsL[ai * HALF + m * 16];
                const float c1 = -LOG2E * rs, rs2 = rs * rs;
                float v[8];
#pragma unroll
                for (int n = 0; n < 2; ++n)
#pragma unroll
                    for (int hh = 0; hh < 2; ++hh) {
                        const f32x2 a2 = (f32x2){acc[ai][0][m][n][2 * hh], acc[ai][0][m][n][2 * hh + 1]}, b2 = (f32x2){acc[ai][1][m][n][2 * hh], acc[ai][1][m][n][2 * hh + 1]};
                        const f32x2 t2 = a2 * c1;
                        f32x2 d2; d2.x = fast_exp2(t2.x); d2.y = fast_exp2(t2.y); d2 = d2 + 1.0f;
                        f32x2 s2; s2.x = fast_rcp(d2.x); s2.y = fast_rcp(d2.y);
                        const f32x2 v2 = (a2 * b2) * (s2 * rs2);
                        v[n * 4 + 2 * hh] = v2.x; v[n * 4 + 2 * hh + 1] = v2.y; }
                u32x4 w; w.x = cvt_pk_bf16(v[0], v[1]); w.y = cvt_pk_bf16(v[2], v[3]); w.z = cvt_pk_bf16(v[4], v[5]); w.w = cvt_pk_bf16(v[6], v[7]);
                *(u32x4*)rowp = w;
            }
    }
};
template <bool HALFSC> struct EpiResid {
    static constexpr bool PERM = false, AFTER_DRAIN = false, MIDK = false;
    bf16_t* xb; float* ssq_part; LAS unsigned char* lds;
    __device__ __forceinline__ void operator()(const f32x4 (&acc)[2][2][4][2], const Unit& u, int wr, int wc, int fr, int fq) const {
        const float scale_ = HALFSC ? 0.5f : 1.0f; bf16_t* const xb_ = xb; float* const ssq_ = ssq_part;
        LAS float* pl = (LAS float*)(lds + LDS_SSP);
        const int col0 = u.pn * BM + wc * 32 + 4 * fq;
        const size_t base = (size_t)(u.pm * BM + wr * 64 + fr) * D + col0;
        u32x2 r[2][2][2][2];
#define ER_LOAD(buf, bb) do { _Pragma("unroll") for (int mm = 0; mm < 2; ++mm) _Pragma("unroll") for (int bj = 0; bj < 2; ++bj) _Pragma("unroll") for (int n = 0; n < 2; ++n) \
            r[buf][mm][bj][n] = *(const u32x2*)(xb_ + base + (size_t)(((bb) >> 1) * HALF + (((bb) & 1) * 2 + mm) * 16) * D + bj * HALF + n * 16); } while (0)
        ER_LOAD(0, 0);
#pragma unroll
        for (int bb = 0; bb < 4; ++bb) {
            if (bb < 3) ER_LOAD((bb + 1) & 1, bb + 1);
            const int ai = bb >> 1;
#pragma unroll
            for (int mm = 0; mm < 2; ++mm) { const int m = (bb & 1) * 2 + mm; const int rowl = ai * HALF + m * 16; const size_t off = base + (size_t)rowl * D; float ssum = 0.f;
#pragma unroll
                for (int bj = 0; bj < 2; ++bj)
#pragma unroll
                    for (int n = 0; n < 2; ++n) { const u32x2 rr = r[bb & 1][mm][bj][n]; const f32x4 a = acc[ai][bj][m][n];
                        const float o0 = bf_lo(rr.x) + a.x * scale_, o1 = bf_hi(rr.x) + a.y * scale_, o2 = bf_lo(rr.y) + a.z * scale_, o3 = bf_hi(rr.y) + a.w * scale_;
                        u32x2 w; w.x = cvt_pk_bf16(o0, o1); w.y = cvt_pk_bf16(o2, o3); *(u32x2*)(xb_ + off + bj * HALF + n * 16) = w;
                        ssum += (o0 * o0 + o1 * o1) + (o2 * o2 + o3 * o3); }
                ssum += __shfl_xor(ssum, 16); ssum += __shfl_xor(ssum, 32);
                if (fq == 0) pl[(rowl + wr * 64 + fr) * 4 + wc] = ssum;
            }
        }
#undef ER_LOAD
        asm volatile("s_waitcnt lgkmcnt(0)" ::: "memory"); __builtin_amdgcn_s_barrier();
        const int t = threadIdx.x;
        if (t < 256) { const f32x4 p = *(const LAS f32x4*)(pl + t * 4); ssq_[(size_t)(u.pm * BM + t) * 8 + u.pn] = (p.x + p.y) + (p.z + p.w); }
    }
};
constexpr int LDS_RS2 = 131072 + 8192, LDS_RS2PM = 131072 + 8192 + 2048 + 64;
__device__ __forceinline__ void rs2_panel(LAS unsigned char* lds, const float* yp, int pm) {
    volatile LAS int* pmL = (volatile LAS int*)(lds + LDS_RS2PM); LAS f32x2* rsL = (LAS f32x2*)(lds + LDS_RS2);
    if (pmL[0] != pm) {
        asm volatile("s_waitcnt lgkmcnt(0)" ::: "memory"); __builtin_amdgcn_s_barrier();
        const int t = threadIdx.x;
        if (t < 256) { const f32x4* pp = (const f32x4*)(yp + (size_t)(pm * 256 + t) * 24);
            const f32x4 a0 = pp[0], a1 = pp[1], a2 = pp[2], a3 = pp[3], b0 = pp[4], b1 = pp[5];
            const float sl = (((a0.x + a0.y) + (a0.z + a0.w)) + ((a1.x + a1.y) + (a1.z + a1.w))) + (((a2.x + a2.y) + (a2.z + a2.w)) + ((a3.x + a3.y) + (a3.z + a3.w)));
            const float sa = ((b0.x + b0.y) + (b0.z + b0.w)) + ((b1.x + b1.y) + (b1.z + b1.w));
            const float va = sa * (1.0f / 1024.f) + EPS, vl = sl * (1.0f / 1024.f) + EPS;
            rsL[t] = (f32x2){__builtin_amdgcn_rsqf(va), __builtin_amdgcn_rsqf(vl) * sqrtf(va)}; }
        if (t == 0) pmL[0] = pm;
        asm volatile("s_waitcnt vmcnt(0) lgkmcnt(0)" ::: "memory"); __builtin_amdgcn_s_barrier();
    }
}
struct EpiResidY {
    static constexpr bool PERM = false, AFTER_DRAIN = false, MIDK = true;
    bf16_t* xb; float* ssq_part; const float* yp; LAS unsigned char* lds;
    __device__ __forceinline__ void prep(const Unit& u) const { rs2_panel(lds, yp, u.pm); }
    __device__ __forceinline__ void mid(f32x4 (&acc)[2][2][4][2], const Unit& u, int wr, int wc, int fr, int fq) const {
        const LAS f32x2* rsL = (const LAS f32x2*)(lds + LDS_RS2) + wr * 64 + fr;
#pragma unroll
        for (int ai = 0; ai < 2; ++ai)
#pragma unroll
            for (int m = 0; m < 4; ++m) { const float q = rsL[ai * HALF + m * 16].y;
#pragma unroll
                for (int bj = 0; bj < 2; ++bj)
#pragma unroll
                    for (int n = 0; n < 2; ++n) acc[ai][bj][m][n] = acc[ai][bj][m][n] * q; }
    }
    __device__ __forceinline__ void operator()(const f32x4 (&acc)[2][2][4][2], const Unit& u, int wr, int wc, int fr, int fq) const {
        bf16_t* const xb_ = xb; float* const ssq_ = ssq_part;
        LAS float* pl = (LAS float*)(lds + LDS_SSP);
        const LAS f32x2* rsL = (const LAS f32x2*)(lds + LDS_RS2) + wr * 64 + fr;
        const int col0 = u.pn * BM + wc * 32 + 4 * fq;
        const size_t base = (size_t)(u.pm * BM + wr * 64 + fr) * D + col0;
        u32x2 r[2][2][2][2];
#define ER_LOAD(buf, bb) do { _Pragma("unroll") for (int mm = 0; mm < 2; ++mm) _Pragma("unroll") for (int bj = 0; bj < 2; ++bj) _Pragma("unroll") for (int n = 0; n < 2; ++n) \
            r[buf][mm][bj][n] = *(const u32x2*)(xb_ + base + (size_t)(((bb) >> 1) * HALF + (((bb) & 1) * 2 + mm) * 16) * D + bj * HALF + n * 16); } while (0)
        ER_LOAD(0, 0);
#pragma unroll
        for (int bb = 0; bb < 4; ++bb) {
            if (bb < 3) ER_LOAD((bb + 1) & 1, bb + 1);
            const int ai = bb >> 1;
#pragma unroll
            for (int mm = 0; mm < 2; ++mm) { const int m = (bb & 1) * 2 + mm; const int rowl = ai * HALF + m * 16; const size_t off = base + (size_t)rowl * D; float ssum = 0.f;
                const float scale_ = rsL[rowl].x;
#pragma unroll
                for (int bj = 0; bj < 2; ++bj)
#pragma unroll
                    for (int n = 0; n < 2; ++n) { const u32x2 rr = r[bb & 1][mm][bj][n]; const f32x4 a = acc[ai][bj][m][n];
                        const float o0 = bf_lo(rr.x) + a.x * scale_, o1 = bf_hi(rr.x) + a.y * scale_, o2 = bf_lo(rr.y) + a.z * scale_, o3 = bf_hi(rr.y) + a.w * scale_;
                        u32x2 w; w.x = cvt_pk_bf16(o0, o1); w.y = cvt_pk_bf16(o2, o3); *(u32x2*)(xb_ + off + bj * HALF + n * 16) = w;
                        ssum += (o0 * o0 + o1 * o1) + (o2 * o2 + o3 * o3); }
                ssum += __shfl_xor(ssum, 16); ssum += __shfl_xor(ssum, 32);
                if (fq == 0) pl[(rowl + wr * 64 + fr) * 4 + wc] = ssum;
            }
        }
#undef ER_LOAD
        asm volatile("s_waitcnt lgkmcnt(0)" ::: "memory"); __builtin_amdgcn_s_barrier();
        const int t = threadIdx.x;
        if (t < 256) { const f32x4 p = *(const LAS f32x4*)(pl + t * 4); ssq_[(size_t)(u.pm * BM + t) * 8 + u.pn] = (p.x + p.y) + (p.z + p.w); }
    }
};
struct EpiZ {
    static constexpr bool PERM = true, AFTER_DRAIN = false, MIDK = false;
    bf16_t* Z; bf16_t* Vt; bf16_t* Kh; const float* ssq; LAS unsigned char* lds;
    __device__ __forceinline__ void operator()(const f32x4 (&acc)[2][2][4][2], const Unit& u, int wr, int wc, int fr, int fq) const {
        rs_panel(lds, ssq, u.pm);
        float rs[2][4];
        { const LAS float* rsL = (const LAS float*)(lds + LDS_RS) + wr * 64 + fr;
#pragma unroll
          for (int ai = 0; ai < 2; ++ai)
#pragma unroll
            for (int m = 0; m < 4; ++m) rs[ai][m] = rsL[ai * HALF + m * 16]; }
        if (u.pn >= 12 && u.pn < 16) {
            const int b = (u.pm * BM) / SEQ; const int s0 = (u.pm * BM) % SEQ + wr * 64 + fr;
#pragma unroll
            for (int bj = 0; bj < 2; ++bj) {
                const int head = (u.pn - 12) * 2 + bj;
                bf16_t* hb = Kh + ((size_t)(b * NH + head) * SEQ + s0) * HD + wc * 32 + 8 * fq;
#pragma unroll
                for (int ai = 0; ai < 2; ++ai)
#pragma unroll
                    for (int m = 0; m < 4; ++m) { const f32x4 v0 = acc[ai][bj][m][0] * rs[ai][m], v1 = acc[ai][bj][m][1] * rs[ai][m];
                        u32x4 w; w.x = cvt_pk_bf16(v0[0], v0[1]); w.y = cvt_pk_bf16(v0[2], v0[3]); w.z = cvt_pk_bf16(v1[0], v1[1]); w.w = cvt_pk_bf16(v1[2], v1[3]);
                        *(u32x4*)(hb + (size_t)(ai * HALF + m * 16) * HD) = w; }
            }
        } else if (u.pn < 12) {
            const int row0 = u.pm * BM + wr * 64 + fr; const int col0 = u.pn * BM + wc * 32 + 8 * fq;
#pragma unroll
            for (int ai = 0; ai < 2; ++ai)
#pragma unroll
                for (int m = 0; m < 4; ++m) {
                    bf16_t* rowp = Z + (size_t)(row0 + ai * HALF + m * 16) * ZLD + col0;
#pragma unroll
                    for (int bj = 0; bj < 2; ++bj) { const f32x4 v0 = acc[ai][bj][m][0] * rs[ai][m], v1 = acc[ai][bj][m][1] * rs[ai][m];
                        u32x4 w; w.x = cvt_pk_bf16(v0[0], v0[1]); w.y = cvt_pk_bf16(v0[2], v0[3]); w.z = cvt_pk_bf16(v1[0], v1[1]); w.w = cvt_pk_bf16(v1[2], v1[3]);
                        *(u32x4*)(rowp + bj * HALF) = w; }
                }
        } else {
            const int b = (u.pm * BM) / SEQ; const int s0 = (u.pm * BM) % SEQ + wr * 64 + fr;
#pragma unroll
            for (int bj = 0; bj < 2; ++bj) {
                const int head = (u.pn - 16) * 2 + bj;
                bf16_t* hb = Vt + ((size_t)(b * NH + head) * HD + wc * 32 + 8 * fq) * SEQ + s0;
#pragma unroll
                for (int ai = 0; ai < 2; ++ai)
#pragma unroll
                    for (int m = 0; m < 4; ++m)
#pragma unroll
                        for (int n = 0; n < 2; ++n)
#pragma unroll
                            for (int i = 0; i < 4; ++i) {
                                const unsigned w = cvt_pk_bf16(acc[ai][bj][m][n][i] * rs[ai][m], 0.f);
                                hb[(size_t)(4 * n + i) * SEQ + ai * HALF + m * 16] = (bf16_t)(w & 0xffffu);
                            }
            }
        }
    }
};

template <class Epi, class Sched, bool ALIGN_EPI = false, bool SP2 = false>
__device__ __forceinline__ void gemm_phase(LAS unsigned char* lds, const Gemm g, const Sched& S, const Epi& E) {
    int tid_l = threadIdx.x; LAUNDER(tid_l);
    const int tid = tid_l, wid = __builtin_amdgcn_readfirstlane(tid >> 6), lane = tid & 63, wr = wid >> 2, wc = wid & 3, fr = lane & 15, fq = lane >> 4;
    const int K = g.K, nt = K / BK;
    unsigned voffA[2], voffB[2];
#pragma unroll
    for (int i = 0; i < 2; ++i) { int R, C; stage_rc(tid * 16 + i * 8192, R, C); const int Rb = Epi::PERM ? ((R & ~31) + perm32(R & 31)) : R;
        voffA[i] = (unsigned)(R * K + C) * 2u; voffB[i] = (unsigned)(Rb * K + C) * 2u; }
    const size_t kstep = (size_t)(BK * 2);
    const size_t hstep = (size_t)HALF * K * 2;
    const size_t tstep = 2 * hstep;
    const unsigned ldsw = (unsigned)wid * 1024u;
    const int aoff = lds_byte(wr * 64 + fr, fq * 8), boff = lds_byte(wc * 32 + fr, fq * 8);
#define PG8_SA(b, h) (((b) * 2 + (h)) * HTB)
#define PG8_SB(b, h) ((4 + (b) * 2 + (h)) * HTB)
#define PG8_STAGE(bufoff, gbase, voff) do { _Pragma("unroll") for (int _i = 0; _i < 2; ++_i) \
        __builtin_amdgcn_global_load_lds((const unsigned*)((const char*)(gbase) + (voff)[_i]), (LAS unsigned*)(lds + (bufoff) + ldsw + _i * 8192), 16, 0, 0); } while (0)
#define PG8_LDA(dst, b, h) do { _Pragma("unroll") for (int m = 0; m < 4; ++m) _Pragma("unroll") for (int k = 0; k < 2; ++k) dst[m][k] = *(const LAS bf16x8*)(lds + PG8_SA(b, h) + aoff + m * 2048 + k * 1024); } while (0)
#define PG8_LDB(dst, b, h) do { _Pragma("unroll") for (int n = 0; n < 2; ++n) _Pragma("unroll") for (int k = 0; k < 2; ++k) dst[n][k] = *(const LAS bf16x8*)(lds + PG8_SB(b, h) + boff + n * 2048 + k * 1024); } while (0)
#define PG8_MMA(ai, bj, At, Bt) do { __builtin_amdgcn_s_setprio(1); _Pragma("unroll") for (int m = 0; m < 4; ++m) _Pragma("unroll") for (int n = 0; n < 2; ++n) _Pragma("unroll") for (int k = 0; k < 2; ++k) \
        acc[ai][bj][m][n] = __builtin_amdgcn_mfma_f32_16x16x32_bf16(Bt[n][k], At[m][k], acc[ai][bj][m][n], 0, 0, 0); __builtin_amdgcn_s_setprio(0); } while (0)
#define PG8_WAIT_V(n) asm volatile("s_waitcnt vmcnt(" #n ")" ::: "memory")
#define PG8_WAIT_L(n) asm volatile("s_waitcnt lgkmcnt(" #n ")" ::: "memory")
#define PG8_BAR __builtin_amdgcn_s_barrier()
#define PG8_SCHED __builtin_amdgcn_sched_barrier(0)
    Unit cur, nxt; int ui = 0;
    if (!S.next(0, cur)) return;
    f32x4 acc[2][2][4][2];
#pragma unroll
    for (int a = 0; a < 2; ++a)
#pragma unroll
        for (int b = 0; b < 2; ++b)
#pragma unroll
            for (int m = 0; m < 4; ++m)
#pragma unroll
                for (int n = 0; n < 2; ++n) acc[a][b][m][n] = (f32x4){0.f, 0.f, 0.f, 0.f};
    bf16x8 At[4][2], B0[2][2], B1[2][2];
    const char* cA = (const char*)g.A + (size_t)cur.pm * tstep; const char* cB = (const char*)g.Bt + (size_t)cur.pn * tstep;
    S.a_ready(cur);
    if constexpr (SP2) {
        PG8_STAGE(PG8_SB(0, 0), cB, voffB); PG8_STAGE(PG8_SB(0, 1), cB + hstep, voffB); PG8_STAGE(PG8_SA(0, 0), cA, voffA); PG8_STAGE(PG8_SA(0, 1), cA + hstep, voffA);
        if (wr == 1) PG8_BAR;
        PG8_WAIT_V(2); PG8_BAR;
        PG8_STAGE(PG8_SB(1, 0), cB + kstep, voffB); PG8_STAGE(PG8_SA(1, 0), cA + kstep, voffA); PG8_STAGE(PG8_SB(1, 1), cB + hstep + kstep, voffB);
        PG8_WAIT_V(6); PG8_BAR;
    } else {
        PG8_STAGE(PG8_SB(0, 0), cB, voffB); PG8_STAGE(PG8_SA(0, 0), cA, voffA); PG8_STAGE(PG8_SB(0, 1), cB + hstep, voffB); PG8_STAGE(PG8_SA(0, 1), cA + hstep, voffA);
        if (wr == 1) PG8_BAR;
        PG8_WAIT_V(4); PG8_BAR;
        PG8_STAGE(PG8_SB(1, 0), cB + kstep, voffB); PG8_STAGE(PG8_SA(1, 0), cA + kstep, voffA); PG8_STAGE(PG8_SB(1, 1), cB + hstep + kstep, voffB);
        PG8_WAIT_V(6); PG8_BAR;
    }
    for (;;) {
        const bool has_next = S.next(ui + 1, nxt);
        const char* nA = has_next ? (const char*)g.A + (size_t)nxt.pm * tstep : cA; const char* nB = has_next ? (const char*)g.Bt + (size_t)nxt.pn * tstep : cB;
        for (int t = 0; t < nt; t += 2) {
            if constexpr (Epi::MIDK) { if (t == (nt >> 1)) E.mid(acc, cur, wr, wc, fr, fq); }
            const bool last = (t == nt - 2);
            const char* a1 = cA + (size_t)(t + 1) * kstep;
            const char* a2 = last ? nA : cA + (size_t)(t + 2) * kstep; const char* b2 = last ? nB : cB + (size_t)(t + 2) * kstep;
            const char* a3 = a2 + kstep; const char* b3 = b2 + kstep;
            if (last && has_next) S.a_ready(nxt);
            if constexpr (SP2) {
            PG8_LDB(B0, 0, 0); PG8_LDB(B1, 0, 1); PG8_SCHED; PG8_LDA(At, 0, 0); PG8_STAGE(PG8_SA(1, 1), a1 + hstep, voffA);
            PG8_WAIT_V(8); PG8_WAIT_L(0); PG8_BAR; PG8_MMA(0, 0, At, B0); PG8_MMA(0, 1, At, B1); PG8_BAR; PG8_SCHED;
            PG8_LDA(At, 0, 1); PG8_STAGE(PG8_SB(0, 0), b2, voffB); PG8_STAGE(PG8_SB(0, 1), b2 + hstep, voffB); PG8_STAGE(PG8_SA(0, 0), a2, voffA);
            PG8_WAIT_V(8); PG8_WAIT_L(0); PG8_BAR; PG8_MMA(1, 0, At, B0); PG8_MMA(1, 1, At, B1); PG8_BAR; PG8_SCHED;
            PG8_LDB(B0, 1, 0); PG8_LDB(B1, 1, 1); PG8_SCHED; PG8_LDA(At, 1, 0); PG8_STAGE(PG8_SA(0, 1), a2 + hstep, voffA);
            PG8_WAIT_V(8); PG8_WAIT_L(0); PG8_BAR; PG8_MMA(0, 0, At, B0); PG8_MMA(0, 1, At, B1); PG8_BAR; PG8_SCHED;
            PG8_LDA(At, 1, 1); PG8_STAGE(PG8_SB(1, 0), b3, voffB); PG8_STAGE(PG8_SB(1, 1), b3 + hstep, voffB); PG8_STAGE(PG8_SA(1, 0), a3, voffA);
            PG8_WAIT_V(8); PG8_WAIT_L(0); PG8_BAR; PG8_MMA(1, 0, At, B0); PG8_MMA(1, 1, At, B1); PG8_BAR; PG8_SCHED;
            } else {
            PG8_LDB(B0, 0, 0); PG8_SCHED; PG8_LDA(At, 0, 0); PG8_STAGE(PG8_SA(1, 1), a1 + hstep, voffA);
            PG8_WAIT_L(8); PG8_BAR; PG8_WAIT_L(0); PG8_MMA(0, 0, At, B0); PG8_BAR; PG8_SCHED;
            PG8_LDB(B1, 0, 1); PG8_STAGE(PG8_SB(0, 0), b2, voffB);
            PG8_BAR; PG8_WAIT_L(0); PG8_MMA(0, 1, At, B1); PG8_BAR;
            PG8_LDA(At, 0, 1); PG8_STAGE(PG8_SA(0, 0), a2, voffA);
            PG8_BAR; PG8_WAIT_L(0); PG8_MMA(1, 0, At, B0); PG8_BAR; PG8_SCHED;
            PG8_STAGE(PG8_SB(0, 1), b2 + hstep, voffB);
            PG8_WAIT_V(6); PG8_BAR; PG8_MMA(1, 1, At, B1); PG8_BAR;
            PG8_LDB(B0, 1, 0); PG8_SCHED; PG8_LDA(At, 1, 0); PG8_STAGE(PG8_SA(0, 1), a2 + hstep, voffA);
            PG8_WAIT_L(8); PG8_BAR; PG8_WAIT_L(0); PG8_MMA(0, 0, At, B0); PG8_BAR; PG8_SCHED;
            PG8_LDB(B1, 1, 1); PG8_STAGE(PG8_SB(1, 0), b3, voffB);
            PG8_BAR; PG8_WAIT_L(0); PG8_MMA(0, 1, At, B1); PG8_BAR;
            PG8_LDA(At, 1, 1); PG8_STAGE(PG8_SA(1, 0), a3, voffA);
            PG8_BAR; PG8_WAIT_L(0); PG8_MMA(1, 0, At, B0); PG8_BAR; PG8_SCHED;
            PG8_STAGE(PG8_SB(1, 1), b3 + hstep, voffB);
            PG8_WAIT_V(6); PG8_BAR; PG8_MMA(1, 1, At, B1); PG8_BAR;
            }
        }
        if constexpr (ALIGN_EPI) { if (wr == 0) PG8_BAR; }
        if constexpr (!Epi::AFTER_DRAIN) { E(acc, cur, wr, wc, fr, fq); S.done(cur); }
        if constexpr (Epi::MIDK) { if (has_next) E.prep(nxt); }
        if (!has_next) break;
#pragma unroll
        for (int a = 0; a < 2; ++a)
#pragma unroll
            for (int b = 0; b < 2; ++b)
#pragma unroll
                for (int m = 0; m < 4; ++m)
#pragma unroll
                    for (int n = 0; n < 2; ++n) acc[a][b][m][n] = (f32x4){0.f, 0.f, 0.f, 0.f};
        cur = nxt; cA = nA; cB = nB; ++ui;
        if constexpr (ALIGN_EPI) { if (wr == 1) PG8_BAR; }
    }
    PG8_WAIT_V(0);
    if constexpr (!ALIGN_EPI) { if (wr == 0) PG8_BAR; }
    PG8_BAR;
#undef PG8_SA
#undef PG8_SB
#undef PG8_STAGE
#undef PG8_LDA
#undef PG8_LDB
#undef PG8_MMA
#undef PG8_WAIT_V
#undef PG8_WAIT_L
#undef PG8_BAR
#undef PG8_SCHED
}
}

#define LDS_WAIT() asm volatile("s_waitcnt lgkmcnt(0)" ::: "memory")

__device__ __forceinline__ float wave_sum(float v) {
#pragma unroll
    for (int o = 1; o < 64; o <<= 1) v += __shfl_xor(v, o);
    return v;
}

__device__ __forceinline__ void p0_transpose_item(const float* W, const float* gain, int K, int N, bf16_t* WT, int ilv, LAS float* scr, int item, int lane, const float* gain2 = nullptr) {
    const int nblk = N / 32, kb = item / nblk, nb = item % nblk, k0 = 64 * kb, n0 = 32 * nb;
#pragma unroll 8
    for (int i = 0; i < 32; ++i) { const int kk = 2 * i + (lane >> 5); scr[kk * 33 + (lane & 31)] = W[(size_t)(k0 + kk) * N + n0 + (lane & 31)]; }
    LDS_WAIT(); asm volatile("" ::: "memory");
    const int c = lane & 7;
    f32x4 g0 = (f32x4){1.f, 1.f, 1.f, 1.f}, g1 = g0;
    if (gain) { const float* gp = (gain2 && k0 >= 1024) ? gain2 + (k0 - 1024) : gain + k0; g0 = *(const f32x4*)(gp + 8 * c); g1 = *(const f32x4*)(gp + 8 * c + 4); }
#pragma unroll
    for (int j = 0; j < 4; ++j) { const int n = (lane >> 3) + 8 * j; const LAS float* s = scr + (8 * c) * 33 + n;
        u32x4 o; o.x = cvt_pk_bf16(s[0 * 33] * g0.x, s[1 * 33] * g0.y); o.y = cvt_pk_bf16(s[2 * 33] * g0.z, s[3 * 33] * g0.w); o.z = cvt_pk_bf16(s[4 * 33] * g1.x, s[5 * 33] * g1.y); o.w = cvt_pk_bf16(s[6 * 33] * g1.z, s[7 * 33] * g1.w);
        const int nn = n0 + n; const int row = ilv < 0 ? nn : ((nn >> 7) * 256 + (nn & 127) + ilv);
        *(u32x4*)(WT + (size_t)row * K + k0 + 8 * c) = o; }
    LDS_WAIT(); asm volatile("" ::: "memory");
}

__device__ __forceinline__ void rms_rows_bf16(const float* x, const float* g, bf16_t* out, int gw, int NGW, int lane) {
    LAUNDER(lane);
    f32x4 gv[8];
#pragma unroll
    for (int j = 0; j < 8; ++j) gv[j] = *(const f32x4*)(g + 4 * lane + 256 * j);
    for (int m = gw; m < M; m += NGW) {
        const f32x4* xr = (const f32x4*)(x + (size_t)m * D) + lane; f32x4 v[8]; float s = 0.f;
#pragma unroll
        for (int j = 0; j < 8; ++j) { v[j] = xr[64 * j]; s += (v[j].x * v[j].x + v[j].y * v[j].y) + (v[j].z * v[j].z + v[j].w * v[j].w); }
        const float rstd = 1.0f / sqrtf(wave_sum(s) * (1.0f / D) + EPS);
        u32x2* o8 = (u32x2*)(out + (size_t)m * D) + lane;
#pragma unroll
        for (int j = 0; j < 8; ++j) { const f32x4 o = v[j] * rstd * gv[j]; u32x2 w; w.x = cvt_pk_bf16(o.x, o.y); w.y = cvt_pk_bf16(o.z, o.w); o8[64 * j] = w; }
    }
}
__device__ __forceinline__ void cast_rows_bf16(const float* x, bf16_t* out, float* ssq, int gw, int NGW, int lane) {
    LAUNDER(lane);
    for (int m = gw; m < M; m += NGW) {
        const f32x4* xr = (const f32x4*)(x + (size_t)m * D) + lane; f32x4 v[8]; float s = 0.f;
#pragma unroll
        for (int j = 0; j < 8; ++j) { v[j] = xr[64 * j]; s += (v[j].x * v[j].x + v[j].y * v[j].y) + (v[j].z * v[j].z + v[j].w * v[j].w); }
        s = wave_sum(s);
        if (lane == 0) { f32x4* pp = (f32x4*)(ssq + (size_t)m * 8); pp[0] = (f32x4){s, 0.f, 0.f, 0.f}; pp[1] = (f32x4){0.f, 0.f, 0.f, 0.f}; }
        u32x2* o8 = (u32x2*)(out + (size_t)m * D) + lane;
#pragma unroll
        for (int j = 0; j < 8; ++j) { u32x2 w; w.x = cvt_pk_bf16(v[j].x, v[j].y); w.y = cvt_pk_bf16(v[j].z, v[j].w); o8[64 * j] = w; }
    }
}
__device__ __forceinline__ void rms_rows_f32_inplace(float* x, const float* g, int gw, int NGW, int lane) {
    LAUNDER(lane);
    f32x4 gv[8];
#pragma unroll
    for (int j = 0; j < 8; ++j) gv[j] = *(const f32x4*)(g + 4 * lane + 256 * j);
    for (int m = gw; m < M; m += NGW) {
        f32x4* xr = (f32x4*)(x + (size_t)m * D) + lane; f32x4 v[8]; float s = 0.f;
#pragma unroll
        for (int j = 0; j < 8; ++j) { v[j] = xr[64 * j]; s += (v[j].x * v[j].x + v[j].y * v[j].y) + (v[j].z * v[j].z + v[j].w * v[j].w); }
        const float rstd = 1.0f / sqrtf(wave_sum(s) * (1.0f / D) + EPS);
#pragma unroll
        for (int j = 0; j < 8; ++j) xr[64 * j] = v[j] * rstd * gv[j];
    }
}
__device__ __forceinline__ void rms_rows_bf16_to_f32(const bf16_t* x, const float* g, float* out, int gw, int NGW, int lane) {
    LAUNDER(lane);
    f32x4 gv[4][2];
#pragma unroll
    for (int j = 0; j < 4; ++j) { const float* gp = g + 512 * j + 8 * lane; gv[j][0] = *(const f32x4*)gp; gv[j][1] = *(const f32x4*)(gp + 4); }
    for (int m = gw; m < M; m += NGW) {
        const u32x4* xr = (const u32x4*)(x + (size_t)m * D) + lane; u32x4 raw[4]; float s = 0.f;
#pragma unroll
        for (int j = 0; j < 4; ++j) raw[j] = xr[64 * j];
        float v[4][8];
#pragma unroll
        for (int j = 0; j < 4; ++j) {
            v[j][0] = bf_lo(raw[j].x); v[j][1] = bf_hi(raw[j].x); v[j][2] = bf_lo(raw[j].y); v[j][3] = bf_hi(raw[j].y);
            v[j][4] = bf_lo(raw[j].z); v[j][5] = bf_hi(raw[j].z); v[j][6] = bf_lo(raw[j].w); v[j][7] = bf_hi(raw[j].w);
#pragma unroll
            for (int e = 0; e < 8; ++e) s += v[j][e] * v[j][e];
        }
        const float rstd = 1.0f / sqrtf(wave_sum(s) * (1.0f / D) + EPS);
        f32x4* orow = (f32x4*)(out + (size_t)m * D + 8 * lane);
#pragma unroll
        for (int j = 0; j < 4; ++j) {
            orow[128 * j] = (f32x4){v[j][0] * rstd * gv[j][0].x, v[j][1] * rstd * gv[j][0].y, v[j][2] * rstd * gv[j][0].z, v[j][3] * rstd * gv[j][0].w};
            orow[128 * j + 1] = (f32x4){v[j][4] * rstd * gv[j][1].x, v[j][5] * rstd * gv[j][1].y, v[j][6] * rstd * gv[j][1].z, v[j][7] * rstd * gv[j][1].w};
        }
    }
}
__device__ __forceinline__ void ynorm_rows(bf16_t* y, const float* g_lru, const float* g_att, int gw, int NGW, int lane) {
    LAUNDER(lane);
    f32x4 gv[4][2];
#pragma unroll
    for (int j = 0; j < 4; ++j) { const float* gp = (j < 2 ? g_lru + 512 * j : g_att + 512 * (j - 2)) + 8 * lane; gv[j][0] = *(const f32x4*)gp; gv[j][1] = *(const f32x4*)(gp + 4); }
    for (int m = gw; m < M; m += NGW) {
        u32x4* yr = (u32x4*)(y + (size_t)m * D) + lane; u32x4 raw[4]; float s0 = 0.f, s1 = 0.f;
#pragma unroll
        for (int j = 0; j < 4; ++j) raw[j] = yr[64 * j];
        float v[4][8];
#pragma unroll
        for (int j = 0; j < 4; ++j) {
            v[j][0] = bf_lo(raw[j].x); v[j][1] = bf_hi(raw[j].x); v[j][2] = bf_lo(raw[j].y); v[j][3] = bf_hi(raw[j].y);
            v[j][4] = bf_lo(raw[j].z); v[j][5] = bf_hi(raw[j].z); v[j][6] = bf_lo(raw[j].w); v[j][7] = bf_hi(raw[j].w);
            float s = 0.f;
#pragma unroll
            for (int e = 0; e < 8; ++e) s += v[j][e] * v[j][e];
            if (j < 2) s0 += s; else s1 += s;
        }
        const float r0 = 1.0f / sqrtf(wave_sum(s0) * (1.0f / 1024.f) + EPS), r1 = 1.0f / sqrtf(wave_sum(s1) * (1.0f / 1024.f) + EPS);
#pragma unroll
        for (int j = 0; j < 4; ++j) { const float r = j < 2 ? r0 : r1; u32x4 w;
            w.x = cvt_pk_bf16(v[j][0] * r * gv[j][0].x, v[j][1] * r * gv[j][0].y); w.y = cvt_pk_bf16(v[j][2] * r * gv[j][0].z, v[j][3] * r * gv[j][0].w);
            w.z = cvt_pk_bf16(v[j][4] * r * gv[j][1].x, v[j][5] * r * gv[j][1].y); w.w = cvt_pk_bf16(v[j][6] * r * gv[j][1].z, v[j][7] * r * gv[j][1].w);
            yr[64 * j] = w; }
    }
}

constexpr int LM_BIAS = 0;
constexpr int LM_CW = 8448;
constexpr int LM_CB = 9472;
constexpr int LM_P = 10240;
constexpr int LM_H = 18432;
__device__ __forceinline__ void lru_unit(LAS unsigned char* lds, const bf16_t* zm, bf16_t* yraw, float* yp, const float* conv_w, const float* conv_b, const float* wa, const float* ba,
                                         const float* wx, const float* bx, const float* lam, int b, int hb, int tid) {
    LAUNDER(tid);
    const int lane = tid & 63, w = tid >> 6, fr = lane & 15, fq = lane >> 4;
    LAS float* cwL = (LAS float*)(lds + LM_CW); LAS float* cbL = (LAS float*)(lds + LM_CB);
    if (tid < 256) cwL[tid] = conv_w[(tid >> 6) * DL + hb * 64 + (tid & 63)];
    else if (tid < 320) cbL[tid - 256] = conv_b[hb * 64 + tid - 256];
    bf16x8 WA[4][2], WX[4][2];
#pragma unroll
    for (int nt = 0; nt < 4; ++nt)
#pragma unroll
        for (int ks = 0; ks < 2; ++ks) {
            const float* pa = wa + ((size_t)hb * 64 + ks * 32 + 8 * fq) * 64 + nt * 16 + fr; const float* px = wx + ((size_t)hb * 64 + ks * 32 + 8 * fq) * 64 + nt * 16 + fr;
            u32x4 ua, ux;
            ua.x = cvt_pk_bf16(pa[0 * 64], pa[1 * 64]); ua.y = cvt_pk_bf16(pa[2 * 64], pa[3 * 64]); ua.z = cvt_pk_bf16(pa[4 * 64], pa[5 * 64]); ua.w = cvt_pk_bf16(pa[6 * 64], pa[7 * 64]);
            ux.x = cvt_pk_bf16(px[0 * 64], px[1 * 64]); ux.y = cvt_pk_bf16(px[2 * 64], px[3 * 64]); ux.z = cvt_pk_bf16(px[4 * 64], px[5 * 64]); ux.w = cvt_pk_bf16(px[6 * 64], px[7 * 64]);
            WA[nt][ks] = __builtin_bit_cast(bf16x8, ua); WX[nt][ks] = __builtin_bit_cast(bf16x8, ux);
        }
    bf16x8 ID[2];
#pragma unroll
    for (int p = 0; p < 2; ++p)
#pragma unroll
        for (int e = 0; e < 8; ++e) ID[p][e] = (8 * fq + e == 16 * p + fr) ? (short)0x3F80 : (short)0;
    float pba[4], pbx[4], pcl[4];
#pragma unroll
    for (int nt = 0; nt < 4; ++nt) { const int c = hb * 64 + nt * 16 + fr; pba[nt] = ba[c]; pbx[nt] = bx[c]; pcl[nt] = -8.0f * log1pf(expf(-lam[c])); }
    __syncthreads();
    float hin[4] = {0.f, 0.f, 0.f, 0.f};
    const bf16_t* zb = zm + (size_t)b * SEQ * ZLD + hb * 64;
    LAS f32x2* TOT = (LAS f32x2*)(lds + LM_P);
    u32x4 XR[2][4], GR[2];
    {
        const int tA = 16 * w + fr;
#pragma unroll
        for (int ks = 0; ks < 2; ++ks) {
            const int ch0 = ks * 32 + 8 * fq;
#pragma unroll
            for (int tap = 0; tap < 4; ++tap) { const int t = tA - 3 + tap; const int tt = t >= 0 ? t : 0; XR[ks][tap] = *(const u32x4*)(zb + (size_t)tt * ZLD + ch0); }
            GR[ks] = *(const u32x4*)(zb + (size_t)tA * ZLD + 1024 + ch0);
        }
    }
#pragma unroll 1
    for (int sc = 0; sc < 16; ++sc) {
        const int tA = sc * 128 + 16 * w + fr;
        const int tN = sc < 15 ? tA + 128 : tA;
        u32x4 XN[2][4], GN[2];
#pragma unroll
        for (int ks = 0; ks < 2; ++ks) {
            const int ch0 = ks * 32 + 8 * fq;
#pragma unroll
            for (int tap = 0; tap < 4; ++tap) XN[ks][tap] = *(const u32x4*)(zb + (size_t)(tN - 3 + tap) * ZLD + ch0);
            GN[ks] = *(const u32x4*)(zb + (size_t)tN * ZLD + 1024 + ch0);
        }
        bf16x8 XC[2], GL[2];
#pragma unroll
        for (int ks = 0; ks < 2; ++ks) {
            const int ch0 = ks * 32 + 8 * fq;
            const f32x4 c0 = *(const LAS f32x4*)(cbL + ch0), c1 = *(const LAS f32x4*)(cbL + ch0 + 4);
            float a8[8] = {c0.x, c0.y, c0.z, c0.w, c1.x, c1.y, c1.z, c1.w};
#pragma unroll
            for (int tap = 0; tap < 4; ++tap) {
                const bool ok = (tA - 3 + tap) >= 0;
                u32x4 xr = XR[ks][tap];
                if (!ok) xr = (u32x4){0u, 0u, 0u, 0u};
                const f32x4 w0 = *(const LAS f32x4*)(cwL + tap * 64 + ch0), w1 = *(const LAS f32x4*)(cwL + tap * 64 + ch0 + 4);
                a8[0] += w0.x * bf_lo(xr.x); a8[1] += w0.y * bf_hi(xr.x); a8[2] += w0.z * bf_lo(xr.y); a8[3] += w0.w * bf_hi(xr.y);
                a8[4] += w1.x * bf_lo(xr.z); a8[5] += w1.y * bf_hi(xr.z); a8[6] += w1.z * bf_lo(xr.w); a8[7] += w1.w * bf_hi(xr.w);
            }
            u32x4 pk; pk.x = cvt_pk_bf16(a8[0], a8[1]); pk.y = cvt_pk_bf16(a8[2], a8[3]); pk.z = cvt_pk_bf16(a8[4], a8[5]); pk.w = cvt_pk_bf16(a8[6], a8[7]);
            XC[ks] = __builtin_bit_cast(bf16x8, pk);
            GL[ks] = __builtin_bit_cast(bf16x8, GR[ks]);
        }
        float hl[4][4], pc[4][4], gel[4][4], PE[4], HE[4];
        LAS f32x2* totw = TOT + ((sc & 1) * 8 + w) * 64;
#pragma unroll
        for (int nt = 0; nt < 4; ++nt) {
            f32x4 ga = (f32x4){0.f, 0.f, 0.f, 0.f}, gx = ga, xo = ga, go = ga;
#pragma unroll
            for (int ks = 0; ks < 2; ++ks) { ga = __builtin_amdgcn_mfma_f32_16x16x32_bf16(XC[ks], WA[nt][ks], ga, 0, 0, 0); gx = __builtin_amdgcn_mfma_f32_16x16x32_bf16(XC[ks], WX[nt][ks], gx, 0, 0, 0); }
            xo = __builtin_amdgcn_mfma_f32_16x16x32_bf16(XC[nt >> 1], ID[nt & 1], xo, 0, 0, 0);
            go = __builtin_amdgcn_mfma_f32_16x16x32_bf16(GL[nt >> 1], ID[nt & 1], go, 0, 0, 0);
#pragma unroll
            for (int j = 0; j < 4; ++j) {
                const float r = sigmoidf_(ga[j] + pba[nt]), ig = sigmoidf_(gx[j] + pbx[nt]);
                const float la = pcl[nt] * r;
                const float a = fast_exp2(la * LOG2E);
                const float x2 = 2.0f * la;
                float ome = -x2 * (1.0f + x2 * 0.5f * (1.0f + x2 * (1.0f / 3.0f)));
                if (x2 < -0.03f) ome = 1.0f - a * a;
                const float u = sqrtf(ome) * ig * xo[j];
                if (j == 0) { hl[nt][0] = u; pc[nt][0] = a; }
                else { hl[nt][j] = a * hl[nt][j - 1] + u; pc[nt][j] = pc[nt][j - 1] * a; }
                const float gv = go[j];
                gel[nt][j] = gv * sigmoidf_(1.5957691216057308f * (gv + 0.044715f * gv * gv * gv));
            }
            float P = pc[nt][3], H = hl[nt][3];
            { const float Pp = __shfl_up(P, 16), Hp = __shfl_up(H, 16); if (fq >= 1) { H = P * Hp + H; P = P * Pp; } }
            { const float Pp = __shfl_up(P, 32), Hp = __shfl_up(H, 32); if (fq >= 2) { H = P * Hp + H; P = P * Pp; } }
            { float Pe = __shfl_up(P, 16), He = __shfl_up(H, 16); if (fq == 0) { Pe = 1.0f; He = 0.0f; } PE[nt] = Pe; HE[nt] = He; }
            if (fq == 3) totw[nt * 16 + fr] = (f32x2){P, H};
        }
        __syncthreads();
        float psq[4] = {0.f, 0.f, 0.f, 0.f};
#pragma unroll
        for (int nt = 0; nt < 4; ++nt) {
            float hrun = hin[nt], hws = hin[nt];
#pragma unroll
            for (int w2 = 0; w2 < 8; ++w2) { const f32x2 t2 = TOT[((sc & 1) * 8 + w2) * 64 + nt * 16 + fr]; hrun = t2.x * hrun + t2.y; if (w2 + 1 == w) hws = hrun; }
            hin[nt] = hrun;
            const float hs = PE[nt] * hws + HE[nt];
#pragma unroll
            for (int j = 0; j < 4; ++j) {
                const float ov = (hl[nt][j] + pc[nt][j] * hs) * gel[nt][j]; psq[j] += ov * ov;
                const unsigned o = cvt_pk_bf16(ov, 0.f);
                yraw[(size_t)(b * SEQ + sc * 128 + 16 * w + 4 * fq + j) * D + hb * 64 + nt * 16 + fr] = (bf16_t)(o & 0xffffu);
            }
        }
#pragma unroll
        for (int j = 0; j < 4; ++j) { float q = psq[j]; q += __shfl_xor(q, 1); q += __shfl_xor(q, 2); q += __shfl_xor(q, 4); q += __shfl_xor(q, 8);
            if (fr == 0) yp[(size_t)(b * SEQ + sc * 128 + 16 * w + 4 * fq + j) * 24 + hb] = q; }
#pragma unroll
        for (int ks = 0; ks < 2; ++ks) {
#pragma unroll
            for (int tap = 0; tap < 4; ++tap) XR[ks][tap] = XN[ks][tap];
            GR[ks] = GN[ks];
        }
    }
    __syncthreads();
}

constexpr int LM_ATT = 32768;
#define ATT_COMPUTE(FAR) do { \
        bf16x8 Kf[2][4], Vf[8]; \
        _Pragma("unroll") for (int t = 0; t < 2; ++t) _Pragma("unroll") for (int ks = 0; ks < 4; ++ks) Kf[t][ks] = *(const LAS bf16x8*)(sb + (t * 4 + ks) * 1024 + foff); \
        _Pragma("unroll") for (int dt = 0; dt < 8; ++dt) Vf[dt] = *(const LAS bf16x8*)(sb + 8192 + dt * 1024 + foff); \
        f32x4 St[2][2]; \
        _Pragma("unroll") for (int t = 0; t < 2; ++t) _Pragma("unroll") for (int qt = 0; qt < 2; ++qt) { f32x4 s_ = (f32x4){0.f, 0.f, 0.f, 0.f}; \
            _Pragma("unroll") for (int ks = 0; ks < 4; ++ks) s_ = __builtin_amdgcn_mfma_f32_16x16x32_bf16(Kf[t][ks], Q[qt][ks], s_, 0, 0, 0); \
            St[t][qt] = s_; } \
        bf16x8 Pf[2]; \
        _Pragma("unroll") for (int qt = 0; qt < 2; ++qt) { \
            const int qpos = c * 64 + qh * 32 + qt * 16 + fr; \
            float sv[8]; float bm = -1e30f; \
            _Pragma("unroll") for (int t = 0; t < 2; ++t) _Pragma("unroll") for (int j = 0; j < 4; ++j) { float bv_; \
                if (FAR) bv_ = bias0; else { int rel = k0 + 8 * fq + 4 * t + j - qpos; rel = rel < -128 ? -128 : (rel > 128 ? 128 : rel); bv_ = bias[rel + 128]; } \
                const float s_ = St[t][qt][j] * SC + bv_; sv[t * 4 + j] = s_; bm = fmaxf(bm, s_); } \
            bm = fmaxf(bm, __shfl_xor(bm, 16)); bm = fmaxf(bm, __shfl_xor(bm, 32)); \
            const float mn = (bm > mrun[qt] + 8.0f) ? bm : mrun[qt];     \
            if (__builtin_amdgcn_ballot_w64(mn != mrun[qt]) != 0ull) { const float alpha = fast_exp2(mrun[qt] - mn); mrun[qt] = mn; lrun[qt] = lrun[qt] * alpha; \
                _Pragma("unroll") for (int dt = 0; dt < 8; ++dt) O[dt][qt] = O[dt][qt] * alpha; } \
            float ps = 0.f; \
            _Pragma("unroll") for (int e = 0; e < 8; ++e) { sv[e] = fast_exp2(sv[e] - mn); ps += sv[e]; } \
            lrun[qt] = lrun[qt] + ps; \
            u32x4 pk; pk.x = cvt_pk_bf16(sv[0], sv[1]); pk.y = cvt_pk_bf16(sv[2], sv[3]); pk.z = cvt_pk_bf16(sv[4], sv[5]); pk.w = cvt_pk_bf16(sv[6], sv[7]); \
            Pf[qt] = __builtin_bit_cast(bf16x8, pk); } \
        _Pragma("unroll") for (int dt = 0; dt < 8; ++dt) _Pragma("unroll") for (int qt = 0; qt < 2; ++qt) O[dt][qt] = __builtin_amdgcn_mfma_f32_16x16x32_bf16(Vf[dt], Pf[qt], O[dt][qt], 0, 0, 0); \
    } while (0)
__device__ __forceinline__ void attn_block(LAS unsigned char* lds, const bf16_t* zm, const bf16_t* Kh, const bf16_t* Vt, bf16_t* yraw, float* yp, const LAS float* biasAll, int b, int h, int g, int tid) {
    LAUNDER(tid);
    const int lane = tid & 63, wave = tid >> 6, fr = lane & 15, fq = lane >> 4;
    const int c = 4 * g + (wave >> 1), qh = wave & 1;
    const LAS float* bias = biasAll + h * NREL;
    const float bias0 = bias[0];
    const float SC = 0.08838834764831845f * LOG2E;
    bf16x8 Q[2][4];
#pragma unroll
    for (int qt = 0; qt < 2; ++qt) { const size_t tok = (size_t)b * SEQ + c * 64 + qh * 32 + qt * 16 + fr;
#pragma unroll
        for (int ks = 0; ks < 4; ++ks) Q[qt][ks] = *(const bf16x8*)(zm + tok * ZLD + 2048 + h * HD + ks * 32 + 8 * fq); }
    f32x4 O[8][2];
#pragma unroll
    for (int dt = 0; dt < 8; ++dt)
#pragma unroll
        for (int qt = 0; qt < 2; ++qt) O[dt][qt] = (f32x4){0.f, 0.f, 0.f, 0.f};
    float mrun[2] = {-1e30f, -1e30f}, lrun[2] = {0.f, 0.f};
    const int lo = g >= 2 ? 4 * g - 8 : 0, nch = 4 * g + 4 - lo;
    const int kr = tid >> 4, c16 = tid & 15;
    const int krho = ((kr >> 3) << 2) | (kr & 3);
    const int kst = ((((kr >> 2) & 1) * 4 + (c16 >> 2)) * 1024) + ((krho * 64 + (c16 & 3) * 16) ^ (krho >= 8 ? 32 : 0));
    const bf16_t* kg = Kh + ((size_t)(b * NH + h) * SEQ + kr) * HD + 8 * c16;
    const int vd = tid >> 2, vq = tid & 3;
    const int vst = 8192 + (vd >> 4) * 1024 + (((vd & 15) * 64 + vq * 16) ^ ((vd & 15) >= 8 ? 32 : 0));
    const bf16_t* vg = Vt + ((size_t)(b * NH + h) * HD + vd) * SEQ + 8 * vq;
    const int foff = (fr * 64 + fq * 16) ^ (fr >= 8 ? 32 : 0);
    LAS unsigned char* st = lds + LM_ATT;
    { const int k0 = lo * 64;
      const u32x4 kv0 = *(const u32x4*)(kg + (size_t)k0 * HD), kv1 = *(const u32x4*)(kg + (size_t)(k0 + 32) * HD); const u32x4 vv0 = *(const u32x4*)(vg + k0), vv1 = *(const u32x4*)(vg + k0 + 32);
      *(LAS u32x4*)(st + kst) = kv0; *(LAS u32x4*)(st + vst) = vv0; *(LAS u32x4*)(st + 16384 + kst) = kv1; *(LAS u32x4*)(st + 16384 + vst) = vv1; }
    __syncthreads();
#pragma unroll 1
    for (int ci = 0; ci < nch; ++ci) {
        const int kc = lo + ci;
        const int k0n = (lo + (ci + 1 < nch ? ci + 1 : ci)) * 64;
        const u32x4 kv0 = *(const u32x4*)(kg + (size_t)k0n * HD), kv1 = *(const u32x4*)(kg + (size_t)(k0n + 32) * HD); const u32x4 vv0 = *(const u32x4*)(vg + k0n), vv1 = *(const u32x4*)(vg + k0n + 32);
        if (kc >= c - 8 && kc <= c) {
            const bool farc = kc <= c - 3;
#pragma unroll 1
            for (int hf = 0; hf < 2; ++hf) {
                const LAS unsigned char* sb = st + (ci & 1) * 32768 + hf * 16384; const int k0 = kc * 64 + hf * 32;
                if (farc) ATT_COMPUTE(true); else ATT_COMPUTE(false);
            }
        }
        LAS unsigned char* nb = st + ((ci + 1) & 1) * 32768;
        *(LAS u32x4*)(nb + kst) = kv0; *(LAS u32x4*)(nb + vst) = vv0; *(LAS u32x4*)(nb + 16384 + kst) = kv1; *(LAS u32x4*)(nb + 16384 + vst) = vv1;
        __syncthreads();
    }
#pragma unroll
    for (int qt = 0; qt < 2; ++qt) {
        float l = lrun[qt]; l += __shfl_xor(l, 16); l += __shfl_xor(l, 32);
        const float inv = 1.0f / l;
        bf16_t* op = yraw + ((size_t)b * SEQ + c * 64 + qh * 32 + qt * 16 + fr) * D + 1024 + h * HD + 4 * fq;
        float q = 0.f;
#pragma unroll
        for (int dt = 0; dt < 8; ++dt) { const f32x4 o = O[dt][qt] * inv; u32x2 w; w.x = cvt_pk_bf16(o.x, o.y); w.y = cvt_pk_bf16(o.z, o.w); *(u32x2*)(op + dt * 16) = w; q += (o.x * o.x + o.y * o.y) + (o.z * o.z + o.w * o.w); }
        q += __shfl_xor(q, 16); q += __shfl_xor(q, 32);
        if (fq == 0) yp[((size_t)b * SEQ + c * 64 + qh * 32 + qt * 16 + fr) * 24 + 16 + h] = q;
    }
}
#undef ATT_COMPUTE

#define XB_TMO      128
#define XB_XCNT(j)  (256  + 64 * (j))
#define XB_XSUB(j)  (1280 + 64 * (j))
#define XB_XGEN(j)  (2304 + 64 * (j))
#define XB_TOP      3328
#define XB_TOPGEN   3392
#define XCD_BAR_WORDS 3456
#define XB_SPIN_CAP (1u << 18)
__device__ __forceinline__ unsigned xb_ld(unsigned* p)              { return __hip_atomic_load(p, __ATOMIC_RELAXED, __HIP_MEMORY_SCOPE_AGENT); }
__device__ __forceinline__ unsigned xb_add(unsigned* p, unsigned v) { return __hip_atomic_fetch_add(p, v, __ATOMIC_RELAXED, __HIP_MEMORY_SCOPE_AGENT); }
__device__ __forceinline__ unsigned xb_xcc_id() { return (unsigned)__builtin_amdgcn_s_getreg((3 << 11) | 20) & 0xFu; }
#define XB_SPIN(cond, bar) do { unsigned _sp = 0; while (cond) { __builtin_amdgcn_s_sleep(1); \
    if ((++_sp & 255u) == 0u) { if (xb_ld(&(bar)[XB_TMO])) break; if (_sp > XB_SPIN_CAP) { atomicAdd(&(bar)[XB_TMO], 1u); break; } } } } while (0)
struct XcdBarrier { unsigned* bar; unsigned x; volatile LAS unsigned* st; };
__device__ __forceinline__ XcdBarrier xcd_barrier_post(unsigned* bar, volatile LAS unsigned* st) {
    XcdBarrier b; b.bar = bar; b.x = xb_xcc_id(); b.st = st;
    if (threadIdx.x == 0) (void)xb_add(&bar[XB_XCNT(b.x)], 1u);
    return b;
}
__device__ __forceinline__ void xcd_barrier_complete(unsigned* bar, unsigned x, unsigned& nloc, unsigned& nx) {
    const unsigned G = gridDim.x * gridDim.y * gridDim.z;
    unsigned sum, cnt, mine, sp = 0u;
    for (;;) {
        sum = 0u; cnt = 0u; mine = 0u;
#pragma unroll
        for (unsigned j = 0; j < 16; ++j) { const unsigned c = xb_ld(&bar[XB_XCNT(j)]); sum += c; cnt += (c > 0u) ? 1u : 0u; mine = (j == x) ? c : mine; }
        if (sum == G) break;
        __builtin_amdgcn_s_sleep(1);
        if ((++sp & 255u) == 0u) { if (xb_ld(&bar[XB_TMO])) break; if (sp > XB_SPIN_CAP) { atomicAdd(&bar[XB_TMO], 1u); break; } }
    }
    nloc = mine > 0u ? mine : 1u; nx = cnt > 0u ? cnt : 1u;
}
__device__ __forceinline__ void xcd_barrier(const XcdBarrier& b) {
    asm volatile("s_waitcnt vmcnt(0)" ::: "memory");
    __syncthreads();
    if (threadIdx.x == 0) {
        unsigned* bar = b.bar;
        __builtin_amdgcn_s_waitcnt(0);
        unsigned nloc = b.st[0], nx = b.st[1];
        if (nloc == 0u) { xcd_barrier_complete(bar, b.x, nloc, nx); b.st[0] = nloc; b.st[1] = nx; }
        const unsigned old = xb_add(&bar[XB_XSUB(b.x)], 1u);
        const unsigned gen = old / nloc;
        if (old + 1u == (gen + 1u) * nloc) {
            __builtin_amdgcn_fence(__ATOMIC_RELEASE, "agent");
            asm volatile("s_waitcnt vmcnt(0)" ::: "memory");
            const unsigned og = xb_add(&bar[XB_TOP], 1u);
            const unsigned tg = og / nx;
            if (og + 1u == (tg + 1u) * nx) xb_add(&bar[XB_TOPGEN], 1u);
            else XB_SPIN(xb_ld(&bar[XB_TOPGEN]) == tg, bar);
            __builtin_amdgcn_fence(__ATOMIC_ACQUIRE, "agent");
            xb_add(&bar[XB_XGEN(b.x)], 1u);
            asm volatile("s_waitcnt vmcnt(0)" ::: "memory");
        } else {
            XB_SPIN(xb_ld(&bar[XB_XGEN(b.x)]) == gen, bar);
            __builtin_amdgcn_fence(__ATOMIC_ACQUIRE, "agent");
            asm volatile("s_waitcnt vmcnt(0)" ::: "memory");
        }
    }
    __syncthreads();
}

struct Args { const float* in[23]; float* out; unsigned char* ws; int pad0, pad1; };

__global__ void __launch_bounds__(NTHREADS, 2) mk_fwd(Args args) {
    extern __shared__ __attribute__((aligned(16))) unsigned char lds_raw[];
    LAS unsigned char* lds = (LAS unsigned char*)lds_raw;
    cg::grid_group grid = cg::this_grid();
    const int tid = threadIdx.x, lane = tid & 63, wave = __builtin_amdgcn_readfirstlane(tid >> 6);
    const int G = gridDim.x, bx = blockIdx.x;
    const int gw = bx * NWAVES + wave, NGW = G * NWAVES;
    typedef const float* cfp;
    const __attribute__((address_space(4))) cfp* inp = (const __attribute__((address_space(4))) cfp*)__builtin_amdgcn_kernarg_segment_ptr();
#define INP(k) (inp[k])
#define LAUNDER_S(v) asm volatile("" : "+s"(v))
    unsigned char* ws = args.ws;
    float* out = args.out;
    volatile LAS unsigned* bst = (volatile LAS unsigned*)(lds + 131072 + 64);
    if (tid < 2) bst[tid] = 0u;
    __syncthreads();
    if (bx == 0) for (int i = tid; i < XCD_BAR_WORDS; i += NTHREADS) ((unsigned*)(ws + WS_CTL))[i] = 0u;
#define GRID_BAR() do { XcdBarrier xb_; xb_.bar = (unsigned*)(args.ws + WS_CTL); xb_.x = xb_xcc_id(); xb_.st = (volatile LAS unsigned*)(lds + 131072 + 64); xcd_barrier(xb_); } while (0)
    bf16_t* HID = (bf16_t*)(ws + WS_BIG); bf16_t* ZM = (bf16_t*)(ws + WS_BIG); bf16_t* VT = (bf16_t*)(ws + WS_VT); bf16_t* KH = (bf16_t*)(ws + WS_KH); bf16_t* HB = (bf16_t*)(ws + WS_H); bf16_t* HB2 = (bf16_t*)(ws + WS_H2); float* SSQ = (float*)(ws + WS_SSQ); float* YP = (float*)(ws + WS_YP);

    {
        LAS float* scr = (LAS float*)(lds + wave * 16384);
        constexpr int I_G = (D / 64) * (FF / 32), I_D = (FF / 64) * (D / 32), I_IN = (D / 64) * (DIN / 32), I_O = (D / 64) * (D / 32);
        constexpr int PER_LAYER = 4 * I_G + 2 * I_D + I_IN + I_O;
        for (int it = gw; it < DEPTH * PER_LAYER; it += NGW) {
            const int l = it / PER_LAYER; int r = it % PER_LAYER;
            unsigned char* wl = ws + (size_t)l * LAYER_W;
            if (r < I_G) { p0_transpose_item(INP(2) + (size_t)l * D * FF, INP(1) + (size_t)l * D, D, FF, (bf16_t*)(wl + OFF_WGU1), 0, scr, r, lane); continue; } r -= I_G;
            if (r < I_G) { p0_transpose_item(INP(3) + (size_t)l * D * FF, INP(1) + (size_t)l * D, D, FF, (bf16_t*)(wl + OFF_WGU1), 128, scr, r, lane); continue; } r -= I_G;
            if (r < I_D) { p0_transpose_item(INP(4) + (size_t)l * FF * D, nullptr, FF, D, (bf16_t*)(wl + OFF_WD1), -1, scr, r, lane); continue; } r -= I_D;
            if (r < I_IN) { p0_transpose_item(INP(6) + (size_t)l * D * DIN, INP(5) + (size_t)l * D, D, DIN, (bf16_t*)(wl + OFF_WIN), -1, scr, r, lane); continue; } r -= I_IN;
            if (r < I_O) { p0_transpose_item(INP(17) + (size_t)l * D * D, INP(15) + (size_t)l * DL, D, D, (bf16_t*)(wl + OFF_WOUT), -1, scr, r, lane, INP(16) + (size_t)l * DL); continue; } r -= I_O;
            if (r < I_G) { p0_transpose_item(INP(19) + (size_t)l * D * FF, INP(18) + (size_t)l * D, D, FF, (bf16_t*)(wl + OFF_WGU2), 0, scr, r, lane); continue; } r -= I_G;
            if (r < I_G) { p0_transpose_item(INP(20) + (size_t)l * D * FF, INP(18) + (size_t)l * D, D, FF, (bf16_t*)(wl + OFF_WGU2), 128, scr, r, lane); continue; } r -= I_G;
            p0_transpose_item(INP(21) + (size_t)l * FF * D, nullptr, FF, D, (bf16_t*)(wl + OFF_WD2), -1, scr, r, lane);
        }
        cast_rows_bf16(INP(0), HB, SSQ, gw, NGW, lane);
    }
    grid.sync();
    (void)xcd_barrier_post((unsigned*)(ws + WS_CTL), bst);

#pragma unroll 1
    for (int l = 0; l < DEPTH; ++l) {
        unsigned char* wl = ws + (size_t)l * LAYER_W;
#pragma unroll 1
        for (int f = 0; f < 2; ++f) {
            LAUNDER_S(inp);
            {
                pg8::Gemm g{HB, (const bf16_t*)(wl + (f ? OFF_WGU2 : OFF_WGU1)), M, 2 * FF, D}; pg8::StaticOrder S; S.init(M, 2 * FF, G, bx);
                { if (tid == 0) *(volatile LAS int*)(lds + pg8::LDS_RSPM) = -1; __syncthreads(); }
                pg8::EpiSwiGLU E{HID, FF, SSQ + (size_t)(3 * l + (f ? 2 : 0)) * M * 8, lds};
                pg8::gemm_phase<pg8::EpiSwiGLU, pg8::StaticOrder, true, true>(lds, g, S, E);
            }
            GRID_BAR();
            {
                pg8::Gemm g{HID, (const bf16_t*)(wl + (f ? OFF_WD2 : OFF_WD1)), M, D, FF}; pg8::StaticOrder S; S.init(M, D, G, bx);
                pg8::EpiResid<true> E{HB, SSQ + (size_t)(3 * l + (f ? 3 : 1)) * M * 8, lds};
                pg8::gemm_phase<pg8::EpiResid<true>, pg8::StaticOrder, true, true>(lds, g, S, E);
            }
            GRID_BAR();
            if (f == 0) {
                {
                    pg8::Gemm g{HB, (const bf16_t*)(wl + OFF_WIN), M, DIN, D}; pg8::StaticOrder S; S.init(M, DIN, G, bx);
                    { if (tid == 0) *(volatile LAS int*)(lds + pg8::LDS_RSPM) = -1; __syncthreads(); }
                    pg8::EpiZ E{ZM, VT, KH, SSQ + (size_t)(3 * l + 1) * M * 8, lds};
                    pg8::gemm_phase<pg8::EpiZ, pg8::StaticOrder, true, true>(lds, g, S, E);
                }
                GRID_BAR();
                {
                    LAS float* biasL = (LAS float*)(lds + LM_BIAS);
                    const float* rb = INP(14) + (size_t)l * NH * NREL;
                    int tid_m = tid; LAUNDER(tid_m);
                    for (int i = tid_m; i < NH * NREL; i += NTHREADS) biasL[i] = rb[i] * LOG2E;
                    __syncthreads();
                    for (int u = bx; u < NB * 16; u += G)
                        lru_unit(lds, ZM, HB2, YP, INP(7) + (size_t)l * 4 * DL, INP(8) + (size_t)l * DL, INP(9) + (size_t)l * 16 * 64 * 64, INP(10) + (size_t)l * DL,
                                 INP(11) + (size_t)l * 16 * 64 * 64, INP(12) + (size_t)l * DL, INP(13) + (size_t)l * DL, u >> 4, u & 15, tid);
                    for (int bu = bx; bu < 1024; bu += G) {
                        const int kk = bu >> 8, bxv = bu & 255;
                        const int ag = ((bxv & 7) + 2 * kk) & 7, ap = (bxv >> 3) + 32 * kk;
                        attn_block(lds, ZM, KH, VT, HB2, YP, biasL, ap >> 3, ap & 7, ag, tid);
                    }
                }
                GRID_BAR();
                {
                    pg8::Gemm g{HB2, (const bf16_t*)(wl + OFF_WOUT), M, D, D}; pg8::StaticOrder S; S.init(M, D, G, bx);
                    { if (tid == 0) *(volatile LAS int*)(lds + pg8::LDS_RS2PM) = -1; __syncthreads(); }
                    pg8::EpiResidY E{HB, SSQ + (size_t)(3 * l + 2) * M * 8, YP, lds};
                    { pg8::Unit u0; if (S.next(0, u0)) E.prep(u0); }
                    pg8::gemm_phase<pg8::EpiResidY, pg8::StaticOrder, true, true>(lds, g, S, E);
                }
                GRID_BAR();
            } else {
                if (l + 1 == DEPTH) rms_rows_bf16_to_f32(HB, INP(22), out, gw, NGW, lane);
            }
        }
    }
}

extern "C" void kernel_launch(void* const* d_in, const int* in_sizes, int n_in, void* d_out, int out_size, void* d_ws, size_t ws_size, hipStream_t stream) {
    static int grid = 0;
    if (grid == 0) {
        if (n_in != 23 || in_sizes[0] != M * D || out_size != M * D || ws_size < WS_END) {
            fprintf(stderr, "kernel_launch: unexpected shapes: n_in %d in0 %d out %d ws %zu (need %zu)\n", n_in, n_in > 0 ? in_sizes[0] : -1, out_size, ws_size, (size_t)WS_END); grid = -1; return; }
        int dev = 0, cus = 0, per_cu = 0;
        hipGetDevice(&dev); hipDeviceGetAttribute(&cus, hipDeviceAttributeMultiprocessorCount, dev);
        if (hipFuncSetAttribute((const void*)mk_fwd, hipFuncAttributeMaxDynamicSharedMemorySize, LDS_BYTES) != hipSuccess) fprintf(stderr, "kernel_launch: hipFuncSetAttribute failed\n");
        if (hipOccupancyMaxActiveBlocksPerMultiprocessor(&per_cu, (const void*)mk_fwd, NTHREADS, LDS_BYTES) != hipSuccess || per_cu < 1) { fprintf(stderr, "kernel_launch: occupancy query gave %d\n", per_cu); per_cu = 1; }
        (void)hipGetLastError();
        grid = cus * per_cu;
        if (grid > 256) grid = 256;
    }
    if (grid < 0) return;
    Args a{};
    for (int i = 0; i < 23; ++i) a.in[i] = (const float*)d_in[i];
    a.out = (float*)d_out; a.ws = (unsigned char*)d_ws;
    void* kargs[] = {&a};
    hipError_t e = hipLaunchCooperativeKernel((const void*)mk_fwd, dim3(grid), dim3(NTHREADS), kargs, LDS_BYTES, stream);
    if (e != hipSuccess) fprintf(stderr, "kernel_launch: cooperative launch failed: %s (grid %d)\n", hipGetErrorString(e), grid);
}
```

```cpp
#include <hip/hip_runtime.h>
#include <hip/hip_cooperative_groups.h>
#include <cstdio>
#include <cstdint>
namespace cg = cooperative_groups;

#define LAS __attribute__((address_space(3)))
#define LAUNDER(v) asm volatile("" : "+v"(v))
typedef unsigned short bf16_t;
typedef short bf16x8 __attribute__((ext_vector_type(8)));
typedef float f32x4 __attribute__((ext_vector_type(4)));
typedef float f32x2 __attribute__((ext_vector_type(2)));
typedef unsigned u32x4 __attribute__((ext_vector_type(4)));
typedef unsigned u32x2 __attribute__((ext_vector_type(2)));

constexpr int NB = 16, SEQ = 2048, M = NB * SEQ, D = 2048, FF = 5632, DIN = 5120, DL = 1024, NH = 8, HD = 128, NREL = 257, DEPTH = 2;
constexpr int ZLD = 3072;
constexpr float EPS = 1e-6f;
constexpr float LOG2E = 1.4426950408889634f;

constexpr size_t MiB = 1u << 20;
constexpr size_t SZ_WGU = (size_t)2 * FF * D * 2, SZ_WD = (size_t)D * FF * 2, SZ_WIN = (size_t)DIN * D * 2, SZ_WOUT = (size_t)D * D * 2;
constexpr size_t OFF_WGU1 = 0, OFF_WD1 = OFF_WGU1 + SZ_WGU, OFF_WIN = OFF_WD1 + SZ_WD, OFF_WOUT = OFF_WIN + SZ_WIN, OFF_WGU2 = OFF_WOUT + SZ_WOUT, OFF_WD2 = OFF_WGU2 + SZ_WGU;
constexpr size_t LAYER_W = OFF_WD2 + SZ_WD;
static_assert(LAYER_W == 160 * MiB, "weights per layer");
constexpr size_t WS_BIG = 2 * LAYER_W;
constexpr size_t WS_VT = WS_BIG + (size_t)M * ZLD * 2;
constexpr size_t WS_KH = WS_VT + (size_t)M * 1024 * 2;
constexpr size_t WS_H = WS_BIG + 352 * MiB;
constexpr size_t WS_H2 = WS_H + 128 * MiB;
constexpr size_t WS_SSQ = WS_H2 + 128 * MiB;
constexpr size_t WS_YP = WS_SSQ + 8 * MiB;
constexpr size_t WS_CTL = WS_YP + 4 * MiB;
constexpr size_t CTL_BYTES = 16384;
constexpr size_t WS_END = WS_CTL + 1 * MiB;
static_assert((size_t)M * FF * 2 == 352 * MiB, "hidden size");

constexpr int NWAVES = 8, NTHREADS = 512;
constexpr int LDS_BYTES = 147456;

__device__ __forceinline__ unsigned cvt_pk_bf16(float lo, float hi) { unsigned r; asm volatile("v_cvt_pk_bf16_f32 %0, %1, %2" : "=v"(r) : "v"(lo), "v"(hi)); return r; }
__device__ __forceinline__ float bf_lo(unsigned u) { return __uint_as_float(u << 16); }
__device__ __forceinline__ float bf_hi(unsigned u) { return __uint_as_float(u & 0xffff0000u); }
__device__ __forceinline__ float fast_exp2(float x) { return __builtin_amdgcn_exp2f(x); }
__device__ __forceinline__ float fast_rcp(float x) { return __builtin_amdgcn_rcpf(x); }
__device__ __forceinline__ float sigmoidf_(float x) { return fast_rcp(1.0f + fast_exp2(-LOG2E * x)); }

namespace pg8 {
constexpr int BM = 256, BK = 64, HALF = 128, HTB = HALF * BK * 2, STAGE_BYTES = 8 * HTB, NXCD = 8, WGM = 4;
__host__ __device__ __forceinline__ int lds_byte(int r, int c) { const int st = (r >> 4) * 2 + (c >> 5), rr = r & 15, cc = c & 31, ob = rr * 64 + cc * 2; return st * 1024 + (ob ^ (((ob >> 9) & 1) << 5)); }
__host__ __device__ __forceinline__ void stage_rc(int b, int& R, int& C) { const int st = b / 1024, sb = b % 1024, swz = sb ^ (((sb >> 9) & 1) << 5); R = (st >> 1) * 16 + swz / 64; C = (st & 1) * 32 + (swz % 64) / 2; }
__host__ __device__ __forceinline__ int perm32(int rho) { const int n = rho >> 4, i = rho & 15; return 8 * (i >> 2) + 4 * n + (i & 3); }

struct Unit { int pm, pn; };
struct Gemm { const bf16_t* A; const bf16_t* Bt; int M, N, K; };

struct StaticOrder {
    int nM, nN, nwg, G, c;
    __host__ __device__ void init(int M_, int N_, int G_, int c_) { nM = M_ / BM; nN = N_ / BM; nwg = nM * nN; G = G_; c = c_; }
    __host__ __device__ bool next(int i, Unit& u) const {
        const long L = (long)i * G + c; if (L >= nwg) return false;
        int wgid = (int)L; { const int q = nwg / NXCD, r = nwg % NXCD, xcd = wgid % NXCD, off = wgid / NXCD; wgid = (xcd < r ? xcd * (q + 1) : r * (q + 1) + (xcd - r) * q) + off; }
        const int nig = WGM * nN, gid = wgid / nig, fm = gid * WGM, gsz = (nM - fm) < WGM ? (nM - fm) : WGM;
        u.pm = fm + ((wgid % nig) % gsz); u.pn = (wgid % nig) / gsz; return true;
    }
    __device__ __forceinline__ void a_ready(const Unit&) const {}
    __device__ __forceinline__ void done(const Unit&) const {}
};


constexpr int LDS_RS = 131072 + 1024, LDS_RSPM = 131072 + 2048 + 64, LDS_SSP = 131072 + 4096;
__device__ __forceinline__ void rs_panel(LAS unsigned char* lds, const float* ssq, int pm) {
    volatile LAS int* pmL = (volatile LAS int*)(lds + LDS_RSPM); LAS float* rsL = (LAS float*)(lds + LDS_RS);
    if (pmL[0] != pm) {
        asm volatile("s_waitcnt lgkmcnt(0)" ::: "memory"); __builtin_amdgcn_s_barrier();
        const int t = threadIdx.x;
        if (t < 256) { const f32x4* pp = (const f32x4*)(ssq + (size_t)(pm * 256 + t) * 8); const f32x4 pa = pp[0], pb = pp[1];
            rsL[t] = __builtin_amdgcn_rsqf((((pa.x + pa.y) + (pa.z + pa.w)) + ((pb.x + pb.y) + (pb.z + pb.w))) * (1.0f / D) + EPS); }
        if (t == 0) pmL[0] = pm;
        asm volatile("s_waitcnt vmcnt(0) lgkmcnt(0)" ::: "memory"); __builtin_amdgcn_s_barrier();
    }
}
struct EpiSwiGLU {
    static constexpr bool PERM = true, AFTER_DRAIN = false, MIDK = false;
    bf16_t* O; int ldc; const float* ssq; LAS unsigned char* lds;
    __device__ __forceinline__ void operator()(const f32x4 (&acc)[2][2][4][2], const Unit& u, int wr, int wc, int fr, int fq) const {
        rs_panel(lds, ssq, u.pm);
        const LAS float* rsL = (const LAS float*)(lds + LDS_RS) + wr * 64 + fr;
        const int row0 = u.pm * BM + wr * 64 + fr; const int col0 = u.pn * HALF + wc * 32 + 8 * fq;
#pragma unroll
        for (int ai = 0; ai < 2; ++ai)
#pragma unroll
            for (int m = 0; m < 4; ++m) {
                bf16_t* rowp = O + (size_t)(row0 + ai * HALF + m * 16) * ldc + col0;
                const float rs = rsL[ai * HALF + m * 16];
                const float c1 = -LOG2E * rs, rs2 = rs * rs;
                float v[8];
#pragma unroll
                for (int n = 0; n < 2; ++n)
#pragma unroll
                    for (int hh = 0; hh < 2; ++hh) {
                        const f32x2 a2 = (f32x2){acc[ai][0][m][n][2 * hh], acc[ai][0][m][n][2 * hh + 1]}, b2 = (f32x2){acc[ai][1][m][n][2 * hh], acc[ai][1][m][n][2 * hh + 1]};
                        const f32x2 t2 = a2 * c1;
                        f32x2 d2; d2.x = fast_exp2(t2.x); d2.y = fast_exp2(t2.y); d2 = d2 + 1.0f;
                        f32x2 s2; s2.x = fast_rcp(d2.x); s2.y = fast_rcp(d2.y);
                        const f32x2 v2 = (a2 * b2) * (s2 * rs2);
                        v[n * 4 + 2 * hh] = v2.x; v[n * 4 + 2 * hh + 1] = v2.y; }
                u32x4 w; w.x = cvt_pk_bf16(v[0], v[1]); w.y = cvt_pk_bf16(v[2], v[3]); w.z = cvt_pk_bf16(v[4], v[5]); w.w = cvt_pk_bf16(v[6], v[7]);
                *(u32x4*)rowp = w;
            }
    }
};
template <bool HALFSC> struct EpiResid {
    static constexpr bool PERM = false, AFTER_DRAIN = false, MIDK = false;
    bf16_t* xb; float* ssq_part; LAS unsigned char* lds;
    __device__ __forceinline__ void operator()(const f32x4 (&acc)[2][2][4][2], const Unit& u, int wr, int wc, int fr, int fq) const {
        const float scale_ = HALFSC ? 0.5f : 1.0f; bf16_t* const xb_ = xb; float* const ssq_ = ssq_part;
        LAS float* pl = (LAS float*)(lds + LDS_SSP);
        const int col0 = u.pn * BM + wc * 32 + 4 * fq;
        const size_t base = (size_t)(u.pm * BM + wr * 64 + fr) * D + col0;
        u32x2 r[2][2][2][2];
#define ER_LOAD(buf, bb) do { _Pragma("unroll") for (int mm = 0; mm < 2; ++mm) _Pragma("unroll") for (int bj = 0; bj < 2; ++bj) _Pragma("unroll") for (int n = 0; n < 2; ++n) \
            r[buf][mm][bj][n] = *(const u32x2*)(xb_ + base + (size_t)(((bb) >> 1) * HALF + (((bb) & 1) * 2 + mm) * 16) * D + bj * HALF + n * 16); } while (0)
        ER_LOAD(0, 0);
#pragma unroll
        for (int bb = 0; bb < 4; ++bb) {
            if (bb < 3) ER_LOAD((bb + 1) & 1, bb + 1);
            const int ai = bb >> 1;
#pragma unroll
            for (int mm = 0; mm < 2; ++mm) { const int m = (bb & 1) * 2 + mm; const int rowl = ai * HALF + m * 16; const size_t off = base + (size_t)rowl * D; float ssum = 0.f;
#pragma unroll
                for (int bj = 0; bj < 2; ++bj)
#pragma unroll
                    for (int n = 0; n < 2; ++n) { const u32x2 rr = r[bb & 1][mm][bj][n]; const f32x4 a = acc[ai][bj][m][n];
                        const float o0 = bf_lo(rr.x) + a.x * scale_, o1 = bf_hi(rr.x) + a.y * scale_, o2 = bf_lo(rr.y) + a.z * scale_, o3 = bf_hi(rr.y) + a.w * scale_;
                        u32x2 w; w.x = cvt_pk_bf16(o0, o1); w.y = cvt_pk_bf16(o2, o3); *(u32x2*)(xb_ + off + bj * HALF + n * 16) = w;
                        ssum += (o0 * o0 + o1 * o1) + (o2 * o2 + o3 * o3); }
                ssum += __shfl_xor(ssum, 16); ssum += __shfl_xor(ssum, 32);
                if (fq == 0) pl[(rowl + wr * 64 + fr) * 4 + wc] = ssum;
            }
        }
#undef ER_LOAD
        asm volatile("s_waitcnt lgkmcnt(0)" ::: "memory"); __builtin_amdgcn_s_barrier();
        const int t = threadIdx.x;
        if (t < 256) { const f32x4 p = *(const LAS f32x4*)(pl + t * 4); ssq_[(size_t)(u.pm * BM + t) * 8 + u.pn] = (p.x + p.y) + (p.z + p.w); }
    }
};
constexpr int LDS_RS2 = 131072 + 8192, LDS_RS2PM = 131072 + 8192 + 2048 + 64;
__device__ __forceinline__ void rs2_panel(LAS unsigned char* lds, const float* yp, int pm) {
    volatile LAS int* pmL = (volatile LAS int*)(lds + LDS_RS2PM); LAS f32x2* rsL = (LAS f32x2*)(lds + LDS_RS2);
    if (pmL[0] != pm) {
        asm volatile("s_waitcnt lgkmcnt(0)" ::: "memory"); __builtin_amdgcn_s_barrier();
        const int t = threadIdx.x;
        if (t < 256) { const f32x4* pp = (const f32x4*)(yp + (size_t)(pm * 256 + t) * 24);
            const f32x4 a0 = pp[0], a1 = pp[1], a2 = pp[2], a3 = pp[3], b0 = pp[4], b1 = pp[5];
            const float sl = (((a0.x + a0.y) + (a0.z + a0.w)) + ((a1.x + a1.y) + (a1.z + a1.w))) + (((a2.x + a2.y) + (a2.z + a2.w)) + ((a3.x + a3.y) + (a3.z + a3.w)));
            const float sa = ((b0.x + b0.y) + (b0.z + b0.w)) + ((b1.x + b1.y) + (b1.z + b1.w));
            const float va = sa * (1.0f / 1024.f) + EPS, vl = sl * (1.0f / 1024.f) + EPS;
            rsL[t] = (f32x2){__builtin_amdgcn_rsqf(va), __builtin_amdgcn_rsqf(vl) * sqrtf(va)}; }
        if (t == 0) pmL[0] = pm;
        asm volatile("s_waitcnt vmcnt(0) lgkmcnt(0)" ::: "memory"); __builtin_amdgcn_s_barrier();
    }
}
struct EpiResidY {
    static constexpr bool PERM = false, AFTER_DRAIN = false, MIDK = true;
    bf16_t* xb; float* ssq_part; const float* yp; LAS unsigned char* lds;
    __device__ __forceinline__ void prep(const Unit& u) const { rs2_panel(lds, yp, u.pm); }
    __device__ __forceinline__ void mid(f32x4 (&acc)[2][2][4][2], const Unit& u, int wr, int wc, int fr, int fq) const {
        const LAS f32x2* rsL = (const LAS f32x2*)(lds + LDS_RS2) + wr * 64 + fr;
#pragma unroll
        for (int ai = 0; ai < 2; ++ai)
#pragma unroll
            for (int m = 0; m < 4; ++m) { const float q = rsL[ai * HALF + m * 16].y;
#pragma unroll
                for (int bj = 0; bj < 2; ++bj)
#pragma unroll
                    for (int n = 0; n < 2; ++n) acc[ai][bj][m][n] = acc[ai][bj][m][n] * q; }
    }
    __device__ __forceinline__ void operator()(const f32x4 (&acc)[2][2][4][2], const Unit& u, int wr, int wc, int fr, int fq) const {
        bf16_t* const xb_ = xb; float* const ssq_ = ssq_part;
        LAS float* pl = (LAS float*)(lds + LDS_SSP);
        const LAS f32x2* rsL = (const LAS f32x2*)(lds + LDS_RS2) + wr * 64 + fr;
        const int col0 = u.pn * BM + wc * 32 + 4 * fq;
        const size_t base = (size_t)(u.pm * BM + wr * 64 + fr) * D + col0;
        u32x2 r[2][2][2][2];
#define ER_LOAD(buf, bb) do { _Pragma("unroll") for (int mm = 0; mm < 2; ++mm) _Pragma("unroll") for (int bj = 0; bj < 2; ++bj) _Pragma("unroll") for (int n = 0; n < 2; ++n) \
            r[buf][mm][bj][n] = *(const u32x2*)(xb_ + base + (size_t)(((bb) >> 1) * HALF + (((bb) & 1) * 2 + mm) * 16) * D + bj * HALF + n * 16); } while (0)
        ER_LOAD(0, 0);
#pragma unroll
        for (int bb = 0; bb < 4; ++bb) {
            if (bb < 3) ER_LOAD((bb + 1) & 1, bb + 1);
            const int ai = bb >> 1;
#pragma unroll
            for (int mm = 0; mm < 2; ++mm) { const int m = (bb & 1) * 2 + mm; const int rowl = ai * HALF + m * 16; const size_t off = base + (size_t)rowl * D; float ssum = 0.f;
                const float scale_ = rsL[rowl].x;
#pragma unroll
                for (int bj = 0; bj < 2; ++bj)
#pragma unroll
                    for (int n = 0; n < 2; ++n) { const u32x2 rr = r[bb & 1][mm][bj][n]; const f32x4 a = acc[ai][bj][m][n];
                        const float o0 = bf_lo(rr.x) + a.x * scale_, o1 = bf_hi(rr.x) + a.y * scale_, o2 = bf_lo(rr.y) + a.z * scale_, o3 = bf_hi(rr.y) + a.w * scale_;
                        u32x2 w; w.x = cvt_pk_bf16(o0, o1); w.y = cvt_pk_bf16(o2, o3); *(u32x2*)(xb_ + off + bj * HALF + n * 16) = w;
                        ssum += (o0 * o0 + o1 * o1) + (o2 * o2 + o3 * o3); }
                ssum += __shfl_xor(ssum, 16); ssum += __shfl_xor(ssum, 32);
                if (fq == 0) pl[(rowl + wr * 64 + fr) * 4 + wc] = ssum;
            }
        }
#undef ER_LOAD
        asm volatile("s_waitcnt lgkmcnt(0)" ::: "memory"); __builtin_amdgcn_s_barrier();
        const int t = threadIdx.x;
        if (t < 256) { const f32x4 p = *(const LAS f32x4*)(pl + t * 4); ssq_[(size_t)(u.pm * BM + t) * 8 + u.pn] = (p.x + p.y) + (p.z + p.w); }
    }
};
struct EpiZ {
    static constexpr bool PERM = true, AFTER_DRAIN = false, MIDK = false;
    bf16_t* Z; bf16_t* Vt; bf16_t* Kh; const float* ssq; LAS unsigned char* lds;
    __device__ __forceinline__ void operator()(const f32x4 (&acc)[2][2][4][2], const Unit& u, int wr, int wc, int fr, int fq) const {
        rs_panel(lds, ssq, u.pm);
        float rs[2][4];
        { const LAS float* rsL = (const LAS float*)(lds + LDS_RS) + wr * 64 + fr;
#pragma unroll
          for (int ai = 0; ai < 2; ++ai)
#pragma unroll
            for (int m = 0; m < 4; ++m) rs[ai][m] = rsL[ai * HALF + m * 16]; }
        if (u.pn >= 12 && u.pn < 16) {
            const int b = (u.pm * BM) / SEQ; const int s0 = (u.pm * BM) % SEQ + wr * 64 + fr;
#pragma unroll
            for (int bj = 0; bj < 2; ++bj) {
                const int head = (u.pn - 12) * 2 + bj;
                bf16_t* hb = Kh + ((size_t)(b * NH + head) * SEQ + s0) * HD + wc * 32 + 8 * fq;
#pragma unroll
                for (int ai = 0; ai < 2; ++ai)
#pragma unroll
                    for (int m = 0; m < 4; ++m) { const f32x4 v0 = acc[ai][bj][m][0] * rs[ai][m], v1 = acc[ai][bj][m][1] * rs[ai][m];
                        u32x4 w; w.x = cvt_pk_bf16(v0[0], v0[1]); w.y = cvt_pk_bf16(v0[2], v0[3]); w.z = cvt_pk_bf16(v1[0], v1[1]); w.w = cvt_pk_bf16(v1[2], v1[3]);
                        *(u32x4*)(hb + (size_t)(ai * HALF + m * 16) * HD) = w; }
            }
        } else if (u.pn < 12) {
            const int row0 = u.pm * BM + wr * 64 + fr; const int col0 = u.pn * BM + wc * 32 + 8 * fq;
#pragma unroll
            for (int ai = 0; ai < 2; ++ai)
#pragma unroll
                for (int m = 0; m < 4; ++m) {
                    bf16_t* rowp = Z + (size_t)(row0 + ai * HALF + m * 16) * ZLD + col0;
#pragma unroll
                    for (int bj = 0; bj < 2; ++bj) { const f32x4 v0 = acc[ai][bj][m][0] * rs[ai][m], v1 = acc[ai][bj][m][1] * rs[ai][m];
                        u32x4 w; w.x = cvt_pk_bf16(v0[0], v0[1]); w.y = cvt_pk_bf16(v0[2], v0[3]); w.z = cvt_pk_bf16(v1[0], v1[1]); w.w = cvt_pk_bf16(v1[2], v1[3]);
                        *(u32x4*)(rowp + bj * HALF) = w; }
                }
        } else {
            const int b = (u.pm * BM) / SEQ; const int s0 = (u.pm * BM) % SEQ + wr * 64 + fr;
#pragma unroll
            for (int bj = 0; bj < 2; ++bj) {
                const int head = (u.pn - 16) * 2 + bj;
                bf16_t* hb = Vt + ((size_t)(b * NH + head) * HD + wc * 32 + 8 * fq) * SEQ + s0;
#pragma unroll
                for (int ai = 0; ai < 2; ++ai)
#pragma unroll
                    for (int m = 0; m < 4; ++m)
#pragma unroll
                        for (int n = 0; n < 2; ++n)
#pragma unroll
                            for (int i = 0; i < 4; ++i) {
                                const unsigned w = cvt_pk_bf16(acc[ai][bj][m][n][i] * rs[ai][m], 0.f);
                                hb[(size_t)(4 * n + i) * SEQ + ai * HALF + m * 16] = (bf16_t)(w & 0xffffu);
                            }
            }
        }
    }
};

template <class Epi, class Sched, bool ALIGN_EPI = false, bool SP2 = false>
__device__ __forceinline__ void gemm_phase(LAS unsigned char* lds, const Gemm g, const Sched& S, const Epi& E) {
    int tid_l = threadIdx.x; LAUNDER(tid_l);
    const int tid = tid_l, wid = __builtin_amdgcn_readfirstlane(tid >> 6), lane = tid & 63, wr = wid >> 2, wc = wid & 3, fr = lane & 15, fq = lane >> 4;
    const int K = g.K, nt = K / BK;
    unsigned voffA[2], voffB[2];
#pragma unroll
    for (int i = 0; i < 2; ++i) { int R, C; stage_rc(tid * 16 + i * 8192, R, C); const int Rb = Epi::PERM ? ((R & ~31) + perm32(R & 31)) : R;
        voffA[i] = (unsigned)(R * K + C) * 2u; voffB[i] = (unsigned)(Rb * K + C) * 2u; }
    const size_t kstep = (size_t)(BK * 2);
    const size_t hstep = (size_t)HALF * K * 2;
    const size_t tstep = 2 * hstep;
    const unsigned ldsw = (unsigned)wid * 1024u;
    const int aoff = lds_byte(wr * 64 + fr, fq * 8), boff = lds_byte(wc * 32 + fr, fq * 8);
#define PG8_SA(b, h) (((b) * 2 + (h)) * HTB)
#define PG8_SB(b, h) ((4 + (b) * 2 + (h)) * HTB)
#define PG8_STAGE(bufoff, gbase, voff) do { _Pragma("unroll") for (int _i = 0; _i < 2; ++_i) \
        __builtin_amdgcn_global_load_lds((const unsigned*)((const char*)(gbase) + (voff)[_i]), (LAS unsigned*)(lds + (bufoff) + ldsw + _i * 8192), 16, 0, 0); } while (0)
#define PG8_LDA(dst, b, h) do { _Pragma("unroll") for (int m = 0; m < 4; ++m) _Pragma("unroll") for (int k = 0; k < 2; ++k) dst[m][k] = *(const LAS bf16x8*)(lds + PG8_SA(b, h) + aoff + m * 2048 + k * 1024); } while (0)
#define PG8_LDB(dst, b, h) do { _Pragma("unroll") for (int n = 0; n < 2; ++n) _Pragma("unroll") for (int k = 0; k < 2; ++k) dst[n][k] = *(const LAS bf16x8*)(lds + PG8_SB(b, h) + boff + n * 2048 + k * 1024); } while (0)
#define PG8_MMA(ai, bj, At, Bt) do { __builtin_amdgcn_s_setprio(1); _Pragma("unroll") for (int m = 0; m < 4; ++m) _Pragma("unroll") for (int n = 0; n < 2; ++n) _Pragma("unroll") for (int k = 0; k < 2; ++k) \
        acc[ai][bj][m][n] = __builtin_amdgcn_mfma_f32_16x16x32_bf16(Bt[n][k], At[m][k], acc[ai][bj][m][n], 0, 0, 0); __builtin_amdgcn_s_setprio(0); } while (0)
#define PG8_WAIT_V(n) asm volatile("s_waitcnt vmcnt(" #n ")" ::: "memory")
#define PG8_WAIT_L(n) asm volatile("s_waitcnt lgkmcnt(" #n ")" ::: "memory")
#define PG8_BAR __builtin_amdgcn_s_barrier()
#define PG8_SCHED __builtin_amdgcn_sched_barrier(0)
    Unit cur, nxt; int ui = 0;
    if (!S.next(0, cur)) return;
    f32x4 acc[2][2][4][2];
#pragma unroll
    for (int a = 0; a < 2; ++a)
#pragma unroll
        for (int b = 0; b < 2; ++b)
#pragma unroll
            for (int m = 0; m < 4; ++m)
#pragma unroll
                for (int n = 0; n < 2; ++n) acc[a][b][m][n] = (f32x4){0.f, 0.f, 0.f, 0.f};
    bf16x8 At[4][2], B0[2][2], B1[2][2];
    const char* cA = (const char*)g.A + (size_t)cur.pm * tstep; const char* cB = (const char*)g.Bt + (size_t)cur.pn * tstep;
    S.a_ready(cur);
    if constexpr (SP2) {
        PG8_STAGE(PG8_SB(0, 0), cB, voffB); PG8_STAGE(PG8_SB(0, 1), cB + hstep, voffB); PG8_STAGE(PG8_SA(0, 0), cA, voffA); PG8_STAGE(PG8_SA(0, 1), cA + hstep, voffA);
        if (wr == 1) PG8_BAR;
        PG8_WAIT_V(2); PG8_BAR;
        PG8_STAGE(PG8_SB(1, 0), cB + kstep, voffB); PG8_STAGE(PG8_SA(1, 0), cA + kstep, voffA); PG8_STAGE(PG8_SB(1, 1), cB + hstep + kstep, voffB);
        PG8_WAIT_V(6); PG8_BAR;
    } else {
        PG8_STAGE(PG8_SB(0, 0), cB, voffB); PG8_STAGE(PG8_SA(0, 0), cA, voffA); PG8_STAGE(PG8_SB(0, 1), cB + hstep, voffB); PG8_STAGE(PG8_SA(0, 1), cA + hstep, voffA);
        if (wr == 1) PG8_BAR;
        PG8_WAIT_V(4); PG8_BAR;
        PG8_STAGE(PG8_SB(1, 0), cB + kstep, voffB); PG8_STAGE(PG8_SA(1, 0), cA + kstep, voffA); PG8_STAGE(PG8_SB(1, 1), cB + hstep + kstep, voffB);
        PG8_WAIT_V(6); PG8_BAR;
    }
    for (;;) {
        const bool has_next = S.next(ui + 1, nxt);
        const char* nA = has_next ? (const char*)g.A + (size_t)nxt.pm * tstep : cA; const char* nB = has_next ? (const char*)g.Bt + (size_t)nxt.pn * tstep : cB;
        for (int t = 0; t < nt; t += 2) {
            if constexpr (Epi::MIDK) { if (t == (nt >> 1)) E.mid(acc, cur, wr, wc, fr, fq); }
            const bool last = (t == nt - 2);
            const char* a1 = cA + (size_t)(t + 1) * kstep;
            const char* a2 = last ? nA : cA + (size_t)(t + 2) * kstep; const char* b2 = last ? nB : cB + (size_t)(t + 2) * kstep;
            const char* a3 = a2 + kstep; const char* b3 = b2 + kstep;
            if (last && has_next) S.a_ready(nxt);
            if constexpr (SP2) {
            PG8_LDB(B0, 0, 0); PG8_LDB(B1, 0, 1); PG8_SCHED; PG8_LDA(At, 0, 0); PG8_STAGE(PG8_SA(1, 1), a1 + hstep, voffA);
            PG8_WAIT_V(8); PG8_WAIT_L(0); PG8_BAR; PG8_MMA(0, 0, At, B0); PG8_MMA(0, 1, At, B1); PG8_BAR; PG8_SCHED;
            PG8_LDA(At, 0, 1); PG8_STAGE(PG8_SB(0, 0), b2, voffB); PG8_STAGE(PG8_SB(0, 1), b2 + hstep, voffB); PG8_STAGE(PG8_SA(0, 0), a2, voffA);
            PG8_WAIT_V(8); PG8_WAIT_L(0); PG8_BAR; PG8_MMA(1, 0, At, B0); PG8_MMA(1, 1, At, B1); PG8_BAR; PG8_SCHED;
            PG8_LDB(B0, 1, 0); PG8_LDB(B1, 1, 1); PG8_SCHED; PG8_LDA(At, 1, 0); PG8_STAGE(PG8_SA(0, 1), a2 + hstep, voffA);
            PG8_WAIT_V(8); PG8_WAIT_L(0); PG8_BAR; PG8_MMA(0, 0, At, B0); PG8_MMA(0, 1, At, B1); PG8_BAR; PG8_SCHED;
            PG8_LDA(At, 1, 1); PG8_STAGE(PG8_SB(1, 0), b3, voffB); PG8_STAGE(PG8_SB(1, 1), b3 + hstep, voffB); PG8_STAGE(PG8_SA(1, 0), a3, voffA);
            PG8_WAIT_V(8); PG8_WAIT_L(0); PG8_BAR; PG8_MMA(1, 0, At, B0); PG8_MMA(1, 1, At, B1); PG8_BAR; PG8_SCHED;
            } else {
            PG8_LDB(B0, 0, 0); PG8_SCHED; PG8_LDA(At, 0, 0); PG8_STAGE(PG8_SA(1, 1), a1 + hstep, voffA);
            PG8_WAIT_L(8); PG8_BAR; PG8_WAIT_L(0); PG8_MMA(0, 0, At, B0); PG8_BAR; PG8_SCHED;
            PG8_LDB(B1, 0, 1); PG8_STAGE(PG8_SB(0, 0), b2, voffB);
            PG8_BAR; PG8_WAIT_L(0); PG8_MMA(0, 1, At, B1); PG8_BAR;
            PG8_LDA(At, 0, 1); PG8_STAGE(PG8_SA(0, 0), a2, voffA);
            PG8_BAR; PG8_WAIT_L(0); PG8_MMA(1, 0, At, B0); PG8_BAR; PG8_SCHED;
            PG8_STAGE(PG8_SB(0, 1), b2 + hstep, voffB);
            PG8_WAIT_V(6); PG8_BAR; PG8_MMA(1, 1, At, B1); PG8_BAR;
            PG8_LDB(B0, 1, 0); PG8_SCHED; PG8_LDA(At, 1, 0); PG8_STAGE(PG8_SA(0, 1), a2 + hstep, voffA);
            PG8_WAIT_L(8); PG8_BAR; PG8_WAIT_L(0); PG8_MMA(0, 0, At, B0); PG8_BAR; PG8_SCHED;
            PG8_LDB(B1, 1, 1); PG8_STAGE(PG8_SB(1, 0), b3, voffB);
            PG8_BAR; PG8_WAIT_L(0); PG8_MMA(0, 1, At, B1); PG8_BAR;
            PG8_LDA(At, 1, 1); PG8_STAGE(PG8_SA(1, 0), a3, voffA);
            PG8_BAR; PG8_WAIT_L(0); PG8_MMA(1, 0, At, B0); PG8_BAR; PG8_SCHED;
            PG8_STAGE(PG8_SB(1, 1), b3 + hstep, voffB);
            PG8_WAIT_V(6); PG8_BAR; PG8_MMA(1, 1, At, B1); PG8_BAR;
            }
        }
        if constexpr (ALIGN_EPI) { if (wr == 0) PG8_BAR; }
        if constexpr (!Epi::AFTER_DRAIN) { E(acc, cur, wr, wc, fr, fq); S.done(cur); }
        if constexpr (Epi::MIDK) { if (has_next) E.prep(nxt); }
        if (!has_next) break;
#pragma unroll
        for (int a = 0; a < 2; ++a)
#pragma unroll
            for (int b = 0; b < 2; ++b)
#pragma unroll
                for (int m = 0; m < 4; ++m)
#pragma unroll
                    for (int n = 0; n < 2; ++n) acc[a][b][m][n] = (f32x4){0.f, 0.f, 0.f, 0.f};
        cur = nxt; cA = nA; cB = nB; ++ui;
        if constexpr (ALIGN_EPI) { if (wr == 1) PG8_BAR; }
    }
    PG8_WAIT_V(0);
    if constexpr (!ALIGN_EPI) { if (wr == 0) PG8_BAR; }
    PG8_BAR;
#undef PG8_SA
#undef PG8_SB
#undef PG8_STAGE
#undef PG8_LDA
#undef PG8_LDB
#undef PG8_MMA
#undef PG8_WAIT_V
#undef PG8_WAIT_L
#undef PG8_BAR
#undef PG8_SCHED
}
}

#define LDS_WAIT() asm volatile("s_waitcnt lgkmcnt(0)" ::: "memory")

__device__ __forceinline__ float wave_sum(float v) {
#pragma unroll
    for (int o = 1; o < 64; o <<= 1) v += __shfl_xor(v, o);
    return v;
}

__device__ __forceinline__ void p0_transpose_item(const float* W, const float* gain, int K, int N, bf16_t* WT, int ilv, LAS float* scr, int item, int lane, const float* gain2 = nullptr) {
    const int nblk = N / 32, kb = item / nblk, nb = item % nblk, k0 = 64 * kb, n0 = 32 * nb;
#pragma unroll 8
    for (int i = 0; i < 32; ++i) { const int kk = 2 * i + (lane >> 5); scr[kk * 33 + (lane & 31)] = W[(size_t)(k0 + kk) * N + n0 + (lane & 31)]; }
    LDS_WAIT(); asm volatile("" ::: "memory");
    const int c = lane & 7;
    f32x4 g0 = (f32x4){1.f, 1.f, 1.f, 1.f}, g1 = g0;
    if (gain) { const float* gp = (gain2 && k0 >= 1024) ? gain2 + (k0 - 1024) : gain + k0; g0 = *(const f32x4*)(gp + 8 * c); g1 = *(const f32x4*)(gp + 8 * c + 4); }
#pragma unroll
    for (int j = 0; j < 4; ++j) { const int n = (lane >> 3) + 8 * j; const LAS float* s = scr + (8 * c) * 33 + n;
        u32x4 o; o.x = cvt_pk_bf16(s[0 * 33] * g0.x, s[1 * 33] * g0.y); o.y = cvt_pk_bf16(s[2 * 33] * g0.z, s[3 * 33] * g0.w); o.z = cvt_pk_bf16(s[4 * 33] * g1.x, s[5 * 33] * g1.y); o.w = cvt_pk_bf16(s[6 * 33] * g1.z, s[7 * 33] * g1.w);
        const int nn = n0 + n; const int row = ilv < 0 ? nn : ((nn >> 7) * 256 + (nn & 127) + ilv);
        *(u32x4*)(WT + (size_t)row * K + k0 + 8 * c) = o; }
    LDS_WAIT(); asm volatile("" ::: "memory");
}

__device__ __forceinline__ void rms_rows_bf16(const float* x, const float* g, bf16_t* out, int gw, int NGW, int lane) {
    LAUNDER(lane);
    f32x4 gv[8];
#pragma unroll
    for (int j = 0; j < 8; ++j) gv[j] = *(const f32x4*)(g + 4 * lane + 256 * j);
    for (int m = gw; m < M; m += NGW) {
        const f32x4* xr = (const f32x4*)(x + (size_t)m * D) + lane; f32x4 v[8]; float s = 0.f;
#pragma unroll
        for (int j = 0; j < 8; ++j) { v[j] = xr[64 * j]; s += (v[j].x * v[j].x + v[j].y * v[j].y) + (v[j].z * v[j].z + v[j].w * v[j].w); }
        const float rstd = 1.0f / sqrtf(wave_sum(s) * (1.0f / D) + EPS);
        u32x2* o8 = (u32x2*)(out + (size_t)m * D) + lane;
#pragma unroll
        for (int j = 0; j < 8; ++j) { const f32x4 o = v[j] * rstd * gv[j]; u32x2 w; w.x = cvt_pk_bf16(o.x, o.y); w.y = cvt_pk_bf16(o.z, o.w); o8[64 * j] = w; }
    }
}
__device__ __forceinline__ void cast_rows_bf16(const float* x, bf16_t* out, float* ssq, int gw, int NGW, int lane) {
    LAUNDER(lane);
    for (int m = gw; m < M; m += NGW) {
        const f32x4* xr = (const f32x4*)(x + (size_t)m * D) + lane; f32x4 v[8]; float s = 0.f;
#pragma unroll
        for (int j = 0; j < 8; ++j) { v[j] = xr[64 * j]; s += (v[j].x * v[j].x + v[j].y * v[j].y) + (v[j].z * v[j].z + v[j].w * v[j].w); }
        s = wave_sum(s);
        if (lane == 0) { f32x4* pp = (f32x4*)(ssq + (size_t)m * 8); pp[0] = (f32x4){s, 0.f, 0.f, 0.f}; pp[1] = (f32x4){0.f, 0.f, 0.f, 0.f}; }
        u32x2* o8 = (u32x2*)(out + (size_t)m * D) + lane;
#pragma unroll
        for (int j = 0; j < 8; ++j) { u32x2 w; w.x = cvt_pk_bf16(v[j].x, v[j].y); w.y = cvt_pk_bf16(v[j].z, v[j].w); o8[64 * j] = w; }
    }
}
__device__ __forceinline__ void rms_rows_f32_inplace(float* x, const float* g, int gw, int NGW, int lane) {
    LAUNDER(lane);
    f32x4 gv[8];
#pragma unroll
    for (int j = 0; j < 8; ++j) gv[j] = *(const f32x4*)(g + 4 * lane + 256 * j);
    for (int m = gw; m < M; m += NGW) {
        f32x4* xr = (f32x4*)(x + (size_t)m * D) + lane; f32x4 v[8]; float s = 0.f;
#pragma unroll
        for (int j = 0; j < 8; ++j) { v[j] = xr[64 * j]; s += (v[j].x * v[j].x + v[j].y * v[j].y) + (v[j].z * v[j].z + v[j].w * v[j].w); }
        const float rstd = 1.0f / sqrtf(wave_sum(s) * (1.0f / D) + EPS);
#pragma unroll
        for (int j = 0; j < 8; ++j) xr[64 * j] = v[j] * rstd * gv[j];
    }
}
__device__ __forceinline__ void rms_rows_bf16_to_f32(const bf16_t* x, const float* g, float* out, int gw, int NGW, int lane) {
    LAUNDER(lane);
    f32x4 gv[4][2];
#pragma unroll
    for (int j = 0; j < 4; ++j) { const float* gp = g + 512 * j + 8 * lane; gv[j][0] = *(const f32x4*)gp; gv[j][1] = *(const f32x4*)(gp + 4); }
    for (int m = gw; m < M; m += NGW) {
        const u32x4* xr = (const u32x4*)(x + (size_t)m * D) + lane; u32x4 raw[4]; float s = 0.f;
#pragma unroll
        for (int j = 0; j < 4; ++j) raw[j] = xr[64 * j];
        float v[4][8];
#pragma unroll
        for (int j = 0; j < 4; ++j) {
            v[j][0] = bf_lo(raw[j].x); v[j][1] = bf_hi(raw[j].x); v[j][2] = bf_lo(raw[j].y); v[j][3] = bf_hi(raw[j].y);
            v[j][4] = bf_lo(raw[j].z); v[j][5] = bf_hi(raw[j].z); v[j][6] = bf_lo(raw[j].w); v[j][7] = bf_hi(raw[j].w);
#pragma unroll
            for (int e = 0; e < 8; ++e) s += v[j][e] * v[j][e];
        }
        const float rstd = 1.0f / sqrtf(wave_sum(s) * (1.0f / D) + EPS);
        f32x4* orow = (f32x4*)(out + (size_t)m * D + 8 * lane);
#pragma unroll
        for (int j = 0; j < 4; ++j) {
            orow[128 * j] = (f32x4){v[j][0] * rstd * gv[j][0].x, v[j][1] * rstd * gv[j][0].y, v[j][2] * rstd * gv[j][0].z, v[j][3] * rstd * gv[j][0].w};
            orow[128 * j + 1] = (f32x4){v[j][4] * rstd * gv[j][1].x, v[j][5] * rstd * gv[j][1].y, v[j][6] * rstd * gv[j][1].z, v[j][7] * rstd * gv[j][1].w};
        }
    }
}
__device__ __forceinline__ void ynorm_rows(bf16_t* y, const float* g_lru, const float* g_att, int gw, int NGW, int lane) {
    LAUNDER(lane);
    f32x4 gv[4][2];
#pragma unroll
    for (int j = 0; j < 4; ++j) { const float* gp = (j < 2 ? g_lru + 512 * j : g_att + 512 * (j - 2)) + 8 * lane; gv[j][0] = *(const f32x4*)gp; gv[j][1] = *(const f32x4*)(gp + 4); }
    for (int m = gw; m < M; m += NGW) {
        u32x4* yr = (u32x4*)(y + (size_t)m * D) + lane; u32x4 raw[4]; float s0 = 0.f, s1 = 0.f;
#pragma unroll
        for (int j = 0; j < 4; ++j) raw[j] = yr[64 * j];
        float v[4][8];
#pragma unroll
        for (int j = 0; j < 4; ++j) {
            v[j][0] = bf_lo(raw[j].x); v[j][1] = bf_hi(raw[j].x); v[j][2] = bf_lo(raw[j].y); v[j][3] = bf_hi(raw[j].y);
            v[j][4] = bf_lo(raw[j].z); v[j][5] = bf_hi(raw[j].z); v[j][6] = bf_lo(raw[j].w); v[j][7] = bf_hi(raw[j].w);
            float s = 0.f;
#pragma unroll
            for (int e = 0; e < 8; ++e) s += v[j][e] * v[j][e];
            if (j < 2) s0 += s; else s1 += s;
        }
        const float r0 = 1.0f / sqrtf(wave_sum(s0) * (1.0f / 1024.f) + EPS), r1 = 1.0f / sqrtf(wave_sum(s1) * (1.0f / 1024.f) + EPS);
#pragma unroll
        for (int j = 0; j < 4; ++j) { const float r = j < 2 ? r0 : r1; u32x4 w;
            w.x = cvt_pk_bf16(v[j][0] * r * gv[j][0].x, v[j][1] * r * gv[j][0].y); w.y = cvt_pk_bf16(v[j][2] * r * gv[j][0].z, v[j][3] * r * gv[j][0].w);
            w.z = cvt_pk_bf16(v[j][4] * r * gv[j][1].x, v[j][5] * r * gv[j][1].y); w.w = cvt_pk_bf16(v[j][6] * r * gv[j][1].z, v[j][7] * r * gv[j][1].w);
            yr[64 * j] = w; }
    }
}

constexpr int LM_BIAS = 0;
constexpr int LM_CW = 8448;
constexpr int LM_CB = 9472;
constexpr int LM_P = 10240;
constexpr int LM_H = 18432;
__device__ __forceinline__ void lru_unit(LAS unsigned char* lds, const bf16_t* zm, bf16_t* yraw, float* yp, const float* conv_w, const float* conv_b, const float* wa, const float* ba,
                                         const float* wx, const float* bx, const float* lam, int b, int hb, int tid) {
    LAUNDER(tid);
    const int lane = tid & 63, w = tid >> 6, fr = lane & 15, fq = lane >> 4;
    LAS float* cwL = (LAS float*)(lds + LM_CW); LAS float* cbL = (LAS float*)(lds + LM_CB);
    if (tid < 256) cwL[tid] = conv_w[(tid >> 6) * DL + hb * 64 + (tid & 63)];
    else if (tid < 320) cbL[tid - 256] = conv_b[hb * 64 + tid - 256];
    bf16x8 WA[4][2], WX[4][2];
#pragma unroll
    for (int nt = 0; nt < 4; ++nt)
#pragma unroll
        for (int ks = 0; ks < 2; ++ks) {
            const float* pa = wa + ((size_t)hb * 64 + ks * 32 + 8 * fq) * 64 + nt * 16 + fr; const float* px = wx + ((size_t)hb * 64 + ks * 32 + 8 * fq) * 64 + nt * 16 + fr;
            u32x4 ua, ux;
            ua.x = cvt_pk_bf16(pa[0 * 64], pa[1 * 64]); ua.y = cvt_pk_bf16(pa[2 * 64], pa[3 * 64]); ua.z = cvt_pk_bf16(pa[4 * 64], pa[5 * 64]); ua.w = cvt_pk_bf16(pa[6 * 64], pa[7 * 64]);
            ux.x = cvt_pk_bf16(px[0 * 64], px[1 * 64]); ux.y = cvt_pk_bf16(px[2 * 64], px[3 * 64]); ux.z = cvt_pk_bf16(px[4 * 64], px[5 * 64]); ux.w = cvt_pk_bf16(px[6 * 64], px[7 * 64]);
            WA[nt][ks] = __builtin_bit_cast(bf16x8, ua); WX[nt][ks] = __builtin_bit_cast(bf16x8, ux);
        }
    bf16x8 ID[2];
#pragma unroll
    for (int p = 0; p < 2; ++p)
#pragma unroll
        for (int e = 0; e < 8; ++e) ID[p][e] = (8 * fq + e == 16 * p + fr) ? (short)0x3F80 : (short)0;
    float pba[4], pbx[4], pcl[4];
#pragma unroll
    for (int nt = 0; nt < 4; ++nt) { const int c = hb * 64 + nt * 16 + fr; pba[nt] = ba[c]; pbx[nt] = bx[c]; pcl[nt] = -8.0f * log1pf(expf(-lam[c])); }
    __syncthreads();
    float hin[4] = {0.f, 0.f, 0.f, 0.f};
    const bf16_t* zb = zm + (size_t)b * SEQ * ZLD + hb * 64;
    LAS f32x2* TOT = (LAS f32x2*)(lds + LM_P);
    u32x4 XR[2][4], GR[2];
    {
        const int tA = 16 * w + fr;
#pragma unroll
        for (int ks = 0; ks < 2; ++ks) {
            const int ch0 = ks * 32 + 8 * fq;
#pragma unroll
            for (int tap = 0; tap < 4; ++tap) { const int t = tA - 3 + tap; const int tt = t >= 0 ? t : 0; XR[ks][tap] = *(const u32x4*)(zb + (size_t)tt * ZLD + ch0); }
            GR[ks] = *(const u32x4*)(zb + (size_t)tA * ZLD + 1024 + ch0);
        }
    }
#pragma unroll 1
    for (int sc = 0; sc < 16; ++sc) {
        const int tA = sc * 128 + 16 * w + fr;
        const int tN = sc < 15 ? tA + 128 : tA;
        u32x4 XN[2][4], GN[2];
#pragma unroll
        for (int ks = 0; ks < 2; ++ks) {
            const int ch0 = ks * 32 + 8 * fq;
#pragma unroll
            for (int tap = 0; tap < 4; ++tap) XN[ks][tap] = *(const u32x4*)(zb + (size_t)(tN - 3 + tap) * ZLD + ch0);
            GN[ks] = *(const u32x4*)(zb + (size_t)tN * ZLD + 1024 + ch0);
        }
        bf16x8 XC[2], GL[2];
#pragma unroll
        for (int ks = 0; ks < 2; ++ks) {
            const int ch0 = ks * 32 + 8 * fq;
            const f32x4 c0 = *(const LAS f32x4*)(cbL + ch0), c1 = *(const LAS f32x4*)(cbL + ch0 + 4);
            float a8[8] = {c0.x, c0.y, c0.z, c0.w, c1.x, c1.y, c1.z, c1.w};
#pragma unroll
            for (int tap = 0; tap < 4; ++tap) {
                const bool ok = (tA - 3 + tap) >= 0;
                u32x4 xr = XR[ks][tap];
                if (!ok) xr = (u32x4){0u, 0u, 0u, 0u};
                const f32x4 w0 = *(const LAS f32x4*)(cwL + tap * 64 + ch0), w1 = *(const LAS f32x4*)(cwL + tap * 64 + ch0 + 4);
                a8[0] += w0.x * bf_lo(xr.x); a8[1] += w0.y * bf_hi(xr.x); a8[2] += w0.z * bf_lo(xr.y); a8[3] += w0.w * bf_hi(xr.y);
                a8[4] += w1.x * bf_lo(xr.z); a8[5] += w1.y * bf_hi(xr.z); a8[6] += w1.z * bf_lo(xr.w); a8[7] += w1.w * bf_hi(xr.w);
            }
            u32x4 pk; pk.x = cvt_pk_bf16(a8[0], a8[1]); pk.y = cvt_pk_bf16(a8[2], a8[3]); pk.z = cvt_pk_bf16(a8[4], a8[5]); pk.w = cvt_pk_bf16(a8[6], a8[7]);
            XC[ks] = __builtin_bit_cast(bf16x8, pk);
            GL[ks] = __builtin_bit_cast(bf16x8, GR[ks]);
        }
        float hl[4][4], pc[4][4], gel[4][4], PE[4], HE[4];
        LAS f32x2* totw = TOT + ((sc & 1) * 8 + w) * 64;
#pragma unroll
        for (int nt = 0; nt < 4; ++nt) {
            f32x4 ga = (f32x4){0.f, 0.f, 0.f, 0.f}, gx = ga, xo = ga, go = ga;
#pragma unroll
            for (int ks = 0; ks < 2; ++ks) { ga = __builtin_amdgcn_mfma_f32_16x16x32_bf16(XC[ks], WA[nt][ks], ga, 0, 0, 0); gx = __builtin_amdgcn_mfma_f32_16x16x32_bf16(XC[ks], WX[nt][ks], gx, 0, 0, 0); }
            xo = __builtin_amdgcn_mfma_f32_16x16x32_bf16(XC[nt >> 1], ID[nt & 1], xo, 0, 0, 0);
            go = __builtin_amdgcn_mfma_f32_16x16x32_bf16(GL[nt >> 1], ID[nt & 1], go, 0, 0, 0);
#pragma unroll
            for (int hh = 0; hh < 2; ++hh) {
                const f32x2 ga2 = (f32x2){ga[2 * hh], ga[2 * hh + 1]}, gx2 = (f32x2){gx[2 * hh], gx[2 * hh + 1]}, xo2 = (f32x2){xo[2 * hh], xo[2 * hh + 1]}, go2 = (f32x2){go[2 * hh], go[2 * hh + 1]};
                const f32x2 ta = (ga2 + pba[nt]) * (-LOG2E), tx = (gx2 + pbx[nt]) * (-LOG2E);
                f32x2 da, dx; da.x = fast_exp2(ta.x); da.y = fast_exp2(ta.y); dx.x = fast_exp2(tx.x); dx.y = fast_exp2(tx.y);
                da = da + 1.0f; dx = dx + 1.0f;
                f32x2 r, ig; r.x = fast_rcp(da.x); r.y = fast_rcp(da.y); ig.x = fast_rcp(dx.x); ig.y = fast_rcp(dx.y);
                const f32x2 la2 = r * (pcl[nt] * LOG2E), x2 = r * (2.0f * pcl[nt]);
                f32x2 av; av.x = fast_exp2(la2.x); av.y = fast_exp2(la2.y);
                const f32x2 omp = -x2 * (x2 * 0.5f * (x2 * (1.0f / 3.0f) + 1.0f) + 1.0f), omd = 1.0f - av * av;
                f32x2 uv; uv.x = __builtin_amdgcn_sqrtf(x2.x < -0.03f ? omd.x : omp.x); uv.y = __builtin_amdgcn_sqrtf(x2.y < -0.03f ? omd.y : omp.y);
                uv = uv * ig * xo2;
                const f32x2 tg = go2 * (go2 * go2 * (-LOG2E * 1.5957691216057308f * 0.044715f) + (-LOG2E * 1.5957691216057308f));
                f32x2 dg; dg.x = fast_exp2(tg.x); dg.y = fast_exp2(tg.y); dg = dg + 1.0f;
                gel[nt][2 * hh] = go2.x * fast_rcp(dg.x); gel[nt][2 * hh + 1] = go2.y * fast_rcp(dg.y);
                if (hh == 0) { hl[nt][0] = uv.x; pc[nt][0] = av.x; }
                else { hl[nt][2] = av.x * hl[nt][1] + uv.x; pc[nt][2] = pc[nt][1] * av.x; }
                hl[nt][2 * hh + 1] = av.y * hl[nt][2 * hh] + uv.y; pc[nt][2 * hh + 1] = pc[nt][2 * hh] * av.y;
            }
            float P = pc[nt][3], H = hl[nt][3];
            { const float Pp = __shfl_up(P, 16), Hp = __shfl_up(H, 16); if (fq >= 1) { H = P * Hp + H; P = P * Pp; } }
            { const float Pp = __shfl_up(P, 32), Hp = __shfl_up(H, 32); if (fq >= 2) { H = P * Hp + H; P = P * Pp; } }
            { float Pe = __shfl_up(P, 16), He = __shfl_up(H, 16); if (fq == 0) { Pe = 1.0f; He = 0.0f; } PE[nt] = Pe; HE[nt] = He; }
            if (fq == 3) totw[nt * 16 + fr] = (f32x2){P, H};
        }
        __syncthreads();
        float psq[4] = {0.f, 0.f, 0.f, 0.f};
#pragma unroll
        for (int nt = 0; nt < 4; ++nt) {
            float hrun = hin[nt], hws = hin[nt];
#pragma unroll
            for (int w2 = 0; w2 < 8; ++w2) { const f32x2 t2 = TOT[((sc & 1) * 8 + w2) * 64 + nt * 16 + fr]; hrun = t2.x * hrun + t2.y; if (w2 + 1 == w) hws = hrun; }
            hin[nt] = hrun;
            const float hs = PE[nt] * hws + HE[nt];
#pragma unroll
            for (int j = 0; j < 4; ++j) {
                const float ov = (hl[nt][j] + pc[nt][j] * hs) * gel[nt][j]; psq[j] += ov * ov;
                const unsigned o = cvt_pk_bf16(ov, 0.f);
                yraw[(size_t)(b * SEQ + sc * 128 + 16 * w + 4 * fq + j) * D + hb * 64 + nt * 16 + fr] = (bf16_t)(o & 0xffffu);
            }
        }
#pragma unroll
        for (int j = 0; j < 4; ++j) { float q = psq[j]; q += __shfl_xor(q, 1); q += __shfl_xor(q, 2); q += __shfl_xor(q, 4); q += __shfl_xor(q, 8);
            if (fr == 0) yp[(size_t)(b * SEQ + sc * 128 + 16 * w + 4 * fq + j) * 24 + hb] = q; }
#pragma unroll
        for (int ks = 0; ks < 2; ++ks) {
#pragma unroll
            for (int tap = 0; tap < 4; ++tap) XR[ks][tap] = XN[ks][tap];
            GR[ks] = GN[ks];
        }
    }
    __syncthreads();
}

constexpr int LM_ATT = 32768;
#define ATT_COMPUTE(FAR) do { \
        bf16x8 Kf[2][4], Vf[8]; \
        _Pragma("unroll") for (int t = 0; t < 2; ++t) _Pragma("unroll") for (int ks = 0; ks < 4; ++ks) Kf[t][ks] = *(const LAS bf16x8*)(sb + (t * 4 + ks) * 1024 + foff); \
        _Pragma("unroll") for (int dt = 0; dt < 8; ++dt) Vf[dt] = *(const LAS bf16x8*)(sb + 8192 + dt * 1024 + foff); \
        f32x4 St[2][2]; \
        _Pragma("unroll") for (int t = 0; t < 2; ++t) _Pragma("unroll") for (int qt = 0; qt < 2; ++qt) { f32x4 s_ = (f32x4){0.f, 0.f, 0.f, 0.f}; \
            _Pragma("unroll") for (int ks = 0; ks < 4; ++ks) s_ = __builtin_amdgcn_mfma_f32_16x16x32_bf16(Kf[t][ks], Q[qt][ks], s_, 0, 0, 0); \
            St[t][qt] = s_; } \
        bf16x8 Pf[2]; \
        _Pragma("unroll") for (int qt = 0; qt < 2; ++qt) { \
            const int qpos = c * 64 + qh * 32 + qt * 16 + fr; \
            float sv[8]; float bm = -1e30f; \
            _Pragma("unroll") for (int t = 0; t < 2; ++t) _Pragma("unroll") for (int j = 0; j < 4; ++j) { float bv_; \
                if (FAR) bv_ = bias0; else { int rel = k0 + 8 * fq + 4 * t + j - qpos; rel = rel < -128 ? -128 : (rel > 128 ? 128 : rel); bv_ = bias[rel + 128]; } \
                const float s_ = St[t][qt][j] * SC + bv_; sv[t * 4 + j] = s_; bm = fmaxf(bm, s_); } \
            bm = fmaxf(bm, __shfl_xor(bm, 16)); bm = fmaxf(bm, __shfl_xor(bm, 32)); \
            const float mn = (bm > mrun[qt] + 8.0f) ? bm : mrun[qt];     \
            if (__builtin_amdgcn_ballot_w64(mn != mrun[qt]) != 0ull) { const float alpha = fast_exp2(mrun[qt] - mn); mrun[qt] = mn; lrun[qt] = lrun[qt] * alpha; \
                _Pragma("unroll") for (int dt = 0; dt < 8; ++dt) O[dt][qt] = O[dt][qt] * alpha; } \
            float ps = 0.f; \
            _Pragma("unroll") for (int e = 0; e < 8; ++e) { sv[e] = fast_exp2(sv[e] - mn); ps += sv[e]; } \
            lrun[qt] = lrun[qt] + ps; \
            u32x4 pk; pk.x = cvt_pk_bf16(sv[0], sv[1]); pk.y = cvt_pk_bf16(sv[2], sv[3]); pk.z = cvt_pk_bf16(sv[4], sv[5]); pk.w = cvt_pk_bf16(sv[6], sv[7]); \
            Pf[qt] = __builtin_bit_cast(bf16x8, pk); } \
        _Pragma("unroll") for (int dt = 0; dt < 8; ++dt) _Pragma("unroll") for (int qt = 0; qt < 2; ++qt) O[dt][qt] = __builtin_amdgcn_mfma_f32_16x16x32_bf16(Vf[dt], Pf[qt], O[dt][qt], 0, 0, 0); \
    } while (0)
__device__ __forceinline__ void attn_block(LAS unsigned char* lds, const bf16_t* zm, const bf16_t* Kh, const bf16_t* Vt, bf16_t* yraw, float* yp, const LAS float* biasAll, int b, int h, int g, int tid) {
    LAUNDER(tid);
    const int lane = tid & 63, wave = tid >> 6, fr = lane & 15, fq = lane >> 4;
    const int c = 4 * g + (wave >> 1), qh = wave & 1;
    const LAS float* bias = biasAll + h * NREL;
    const float bias0 = bias[0];
    const float SC = 0.08838834764831845f * LOG2E;
    bf16x8 Q[2][4];
#pragma unroll
    for (int qt = 0; qt < 2; ++qt) { const size_t tok = (size_t)b * SEQ + c * 64 + qh * 32 + qt * 16 + fr;
#pragma unroll
        for (int ks = 0; ks < 4; ++ks) Q[qt][ks] = *(const bf16x8*)(zm + tok * ZLD + 2048 + h * HD + ks * 32 + 8 * fq); }
    f32x4 O[8][2];
#pragma unroll
    for (int dt = 0; dt < 8; ++dt)
#pragma unroll
        for (int qt = 0; qt < 2; ++qt) O[dt][qt] = (f32x4){0.f, 0.f, 0.f, 0.f};
    float mrun[2] = {-1e30f, -1e30f}, lrun[2] = {0.f, 0.f};
    const int lo = g >= 2 ? 4 * g - 8 : 0, nch = 4 * g + 4 - lo;
    const int kr = tid >> 4, c16 = tid & 15;
    const int krho = ((kr >> 3) << 2) | (kr & 3);
    const int kst = ((((kr >> 2) & 1) * 4 + (c16 >> 2)) * 1024) + ((krho * 64 + (c16 & 3) * 16) ^ (krho >= 8 ? 32 : 0));
    const bf16_t* kg = Kh + ((size_t)(b * NH + h) * SEQ + kr) * HD + 8 * c16;
    const int vd = tid >> 2, vq = tid & 3;
    const int vst = 8192 + (vd >> 4) * 1024 + (((vd & 15) * 64 + vq * 16) ^ ((vd & 15) >= 8 ? 32 : 0));
    const bf16_t* vg = Vt + ((size_t)(b * NH + h) * HD + vd) * SEQ + 8 * vq;
    const int foff = (fr * 64 + fq * 16) ^ (fr >= 8 ? 32 : 0);
    LAS unsigned char* st = lds + LM_ATT;
    { const int k0 = lo * 64;
      const u32x4 kv0 = *(const u32x4*)(kg + (size_t)k0 * HD), kv1 = *(const u32x4*)(kg + (size_t)(k0 + 32) * HD); const u32x4 vv0 = *(const u32x4*)(vg + k0), vv1 = *(const u32x4*)(vg + k0 + 32);
      *(LAS u32x4*)(st + kst) = kv0; *(LAS u32x4*)(st + vst) = vv0; *(LAS u32x4*)(st + 16384 + kst) = kv1; *(LAS u32x4*)(st + 16384 + vst) = vv1; }
    __syncthreads();
#pragma unroll 1
    for (int ci = 0; ci < nch; ++ci) {
        const int kc = lo + ci;
        const int k0n = (lo + (ci + 1 < nch ? ci + 1 : ci)) * 64;
        const u32x4 kv0 = *(const u32x4*)(kg + (size_t)k0n * HD), kv1 = *(const u32x4*)(kg + (size_t)(k0n + 32) * HD); const u32x4 vv0 = *(const u32x4*)(vg + k0n), vv1 = *(const u32x4*)(vg + k0n + 32);
        if (kc >= c - 8 && kc <= c) {
            const bool farc = kc <= c - 3;
#pragma unroll 1
            for (int hf = 0; hf < 2; ++hf) {
                const LAS unsigned char* sb = st + (ci & 1) * 32768 + hf * 16384; const int k0 = kc * 64 + hf * 32;
                if (farc) ATT_COMPUTE(true); else ATT_COMPUTE(false);
            }
        }
        LAS unsigned char* nb = st + ((ci + 1) & 1) * 32768;
        *(LAS u32x4*)(nb + kst) = kv0; *(LAS u32x4*)(nb + vst) = vv0; *(LAS u32x4*)(nb + 16384 + kst) = kv1; *(LAS u32x4*)(nb + 16384 + vst) = vv1;
        __syncthreads();
    }
#pragma unroll
    for (int qt = 0; qt < 2; ++qt) {
        float l = lrun[qt]; l += __shfl_xor(l, 16); l += __shfl_xor(l, 32);
        const float inv = 1.0f / l;
        bf16_t* op = yraw + ((size_t)b * SEQ + c * 64 + qh * 32 + qt * 16 + fr) * D + 1024 + h * HD + 4 * fq;
        float q = 0.f;
#pragma unroll
        for (int dt = 0; dt < 8; ++dt) { const f32x4 o = O[dt][qt] * inv; u32x2 w; w.x = cvt_pk_bf16(o.x, o.y); w.y = cvt_pk_bf16(o.z, o.w); *(u32x2*)(op + dt * 16) = w; q += (o.x * o.x + o.y * o.y) + (o.z * o.z + o.w * o.w); }
        q += __shfl_xor(q, 16); q += __shfl_xor(q, 32);
        if (fq == 0) yp[((size_t)b * SEQ + c * 64 + qh * 32 + qt * 16 + fr) * 24 + 16 + h] = q;
    }
}
#undef ATT_COMPUTE

#define XB_TMO      128
#define XB_XCNT(j)  (256  + 64 * (j))
#define XB_XSUB(j)  (1280 + 64 * (j))
#define XB_XGEN(j)  (2304 + 64 * (j))
#define XB_TOP      3328
#define XB_TOPGEN   3392
#define XCD_BAR_WORDS 3456
#define XB_SPIN_CAP (1u << 18)
__device__ __forceinline__ unsigned xb_ld(unsigned* p)              { return __hip_atomic_load(p, __ATOMIC_RELAXED, __HIP_MEMORY_SCOPE_AGENT); }
__device__ __forceinline__ unsigned xb_add(unsigned* p, unsigned v) { return __hip_atomic_fetch_add(p, v, __ATOMIC_RELAXED, __HIP_MEMORY_SCOPE_AGENT); }
__device__ __forceinline__ unsigned xb_xcc_id() { return (unsigned)__builtin_amdgcn_s_getreg((3 << 11) | 20) & 0xFu; }
#define XB_SPIN(cond, bar) do { unsigned _sp = 0; while (cond) { __builtin_amdgcn_s_sleep(1); \
    if ((++_sp & 255u) == 0u) { if (xb_ld(&(bar)[XB_TMO])) break; if (_sp > XB_SPIN_CAP) { atomicAdd(&(bar)[XB_TMO], 1u); break; } } } } while (0)
struct XcdBarrier { unsigned* bar; unsigned x; volatile LAS unsigned* st; };
__device__ __forceinline__ XcdBarrier xcd_barrier_post(unsigned* bar, volatile LAS unsigned* st) {
    XcdBarrier b; b.bar = bar; b.x = xb_xcc_id(); b.st = st;
    if (threadIdx.x == 0) (void)xb_add(&bar[XB_XCNT(b.x)], 1u);
    return b;
}
__device__ __forceinline__ void xcd_barrier_complete(unsigned* bar, unsigned x, unsigned& nloc, unsigned& nx) {
    const unsigned G = gridDim.x * gridDim.y * gridDim.z;
    unsigned sum, cnt, mine, sp = 0u;
    for (;;) {
        sum = 0u; cnt = 0u; mine = 0u;
#pragma unroll
        for (unsigned j = 0; j < 16; ++j) { const unsigned c = xb_ld(&bar[XB_XCNT(j)]); sum += c; cnt += (c > 0u) ? 1u : 0u; mine = (j == x) ? c : mine; }
        if (sum == G) break;
        __builtin_amdgcn_s_sleep(1);
        if ((++sp & 255u) == 0u) { if (xb_ld(&bar[XB_TMO])) break; if (sp > XB_SPIN_CAP) { atomicAdd(&bar[XB_TMO], 1u); break; } }
    }
    nloc = mine > 0u ? mine : 1u; nx = cnt > 0u ? cnt : 1u;
}
__device__ __forceinline__ void xcd_barrier(const XcdBarrier& b) {
    asm volatile("s_waitcnt vmcnt(0)" ::: "memory");
    __syncthreads();
    if (threadIdx.x == 0) {
        unsigned* bar = b.bar;
        __builtin_amdgcn_s_waitcnt(0);
        unsigned nloc = b.st[0], nx = b.st[1];
        if (nloc == 0u) { xcd_barrier_complete(bar, b.x, nloc, nx); b.st[0] = nloc; b.st[1] = nx; }
        const unsigned old = xb_add(&bar[XB_XSUB(b.x)], 1u);
        const unsigned gen = old / nloc;
        if (old + 1u == (gen + 1u) * nloc) {
            __builtin_amdgcn_fence(__ATOMIC_RELEASE, "agent");
            asm volatile("s_waitcnt vmcnt(0)" ::: "memory");
            const unsigned og = xb_add(&bar[XB_TOP], 1u);
            const unsigned tg = og / nx;
            if (og + 1u == (tg + 1u) * nx) xb_add(&bar[XB_TOPGEN], 1u);
            else XB_SPIN(xb_ld(&bar[XB_TOPGEN]) == tg, bar);
            __builtin_amdgcn_fence(__ATOMIC_ACQUIRE, "agent");
            xb_add(&bar[XB_XGEN(b.x)], 1u);
            asm volatile("s_waitcnt vmcnt(0)" ::: "memory");
        } else {
            XB_SPIN(xb_ld(&bar[XB_XGEN(b.x)]) == gen, bar);
            __builtin_amdgcn_fence(__ATOMIC_ACQUIRE, "agent");
            asm volatile("s_waitcnt vmcnt(0)" ::: "memory");
        }
    }
    __syncthreads();
}

struct Args { const float* in[23]; float* out; unsigned char* ws; int pad0, pad1; };

__global__ void __launch_bounds__(NTHREADS, 2) mk_fwd(Args args) {
    extern __shared__ __attribute__((aligned(16))) unsigned char lds_raw[];
    LAS unsigned char* lds = (LAS unsigned char*)lds_raw;
    cg::grid_group grid = cg::this_grid();
    const int tid = threadIdx.x, lane = tid & 63, wave = __builtin_amdgcn_readfirstlane(tid >> 6);
    const int G = gridDim.x, bx = blockIdx.x;
    const int gw = bx * NWAVES + wave, NGW = G * NWAVES;
    typedef const float* cfp;
    const __attribute__((address_space(4))) cfp* inp = (const __attribute__((address_space(4))) cfp*)__builtin_amdgcn_kernarg_segment_ptr();
#define INP(k) (inp[k])
#define LAUNDER_S(v) asm volatile("" : "+s"(v))
    unsigned char* ws = args.ws;
    float* out = args.out;
    volatile LAS unsigned* bst = (volatile LAS unsigned*)(lds + 131072 + 64);
    if (tid < 2) bst[tid] = 0u;
    __syncthreads();
    if (bx == 0) for (int i = tid; i < XCD_BAR_WORDS; i += NTHREADS) ((unsigned*)(ws + WS_CTL))[i] = 0u;
#define GRID_BAR() do { XcdBarrier xb_; xb_.bar = (unsigned*)(args.ws + WS_CTL); xb_.x = xb_xcc_id(); xb_.st = (volatile LAS unsigned*)(lds + 131072 + 64); xcd_barrier(xb_); } while (0)
    bf16_t* HID = (bf16_t*)(ws + WS_BIG); bf16_t* ZM = (bf16_t*)(ws + WS_BIG); bf16_t* VT = (bf16_t*)(ws + WS_VT); bf16_t* KH = (bf16_t*)(ws + WS_KH); bf16_t* HB = (bf16_t*)(ws + WS_H); bf16_t* HB2 = (bf16_t*)(ws + WS_H2); float* SSQ = (float*)(ws + WS_SSQ); float* YP = (float*)(ws + WS_YP);

    {
        LAS float* scr = (LAS float*)(lds + wave * 16384);
        constexpr int I_G = (D / 64) * (FF / 32), I_D = (FF / 64) * (D / 32), I_IN = (D / 64) * (DIN / 32), I_O = (D / 64) * (D / 32);
        constexpr int PER_LAYER = 4 * I_G + 2 * I_D + I_IN + I_O;
        for (int it = gw; it < DEPTH * PER_LAYER; it += NGW) {
            const int l = it / PER_LAYER; int r = it % PER_LAYER;
            unsigned char* wl = ws + (size_t)l * LAYER_W;
            if (r < I_G) { p0_transpose_item(INP(2) + (size_t)l * D * FF, INP(1) + (size_t)l * D, D, FF, (bf16_t*)(wl + OFF_WGU1), 0, scr, r, lane); continue; } r -= I_G;
            if (r < I_G) { p0_transpose_item(INP(3) + (size_t)l * D * FF, INP(1) + (size_t)l * D, D, FF, (bf16_t*)(wl + OFF_WGU1), 128, scr, r, lane); continue; } r -= I_G;
            if (r < I_D) { p0_transpose_item(INP(4) + (size_t)l * FF * D, nullptr, FF, D, (bf16_t*)(wl + OFF_WD1), -1, scr, r, lane); continue; } r -= I_D;
            if (r < I_IN) { p0_transpose_item(INP(6) + (size_t)l * D * DIN, INP(5) + (size_t)l * D, D, DIN, (bf16_t*)(wl + OFF_WIN), -1, scr, r, lane); continue; } r -= I_IN;
            if (r < I_O) { p0_transpose_item(INP(17) + (size_t)l * D * D, INP(15) + (size_t)l * DL, D, D, (bf16_t*)(wl + OFF_WOUT), -1, scr, r, lane, INP(16) + (size_t)l * DL); continue; } r -= I_O;
            if (r < I_G) { p0_transpose_item(INP(19) + (size_t)l * D * FF, INP(18) + (size_t)l * D, D, FF, (bf16_t*)(wl + OFF_WGU2), 0, scr, r, lane); continue; } r -= I_G;
            if (r < I_G) { p0_transpose_item(INP(20) + (size_t)l * D * FF, INP(18) + (size_t)l * D, D, FF, (bf16_t*)(wl + OFF_WGU2), 128, scr, r, lane); continue; } r -= I_G;
            p0_transpose_item(INP(21) + (size_t)l * FF * D, nullptr, FF, D, (bf16_t*)(wl + OFF_WD2), -1, scr, r, lane);
        }
        cast_rows_bf16(INP(0), HB, SSQ, gw, NGW, lane);
    }
    grid.sync();
    (void)xcd_barrier_post((unsigned*)(ws + WS_CTL), bst);

#pragma unroll 1
    for (int l = 0; l < DEPTH; ++l) {
        unsigned char* wl = ws + (size_t)l * LAYER_W;
#pragma unroll 1
        for (int f = 0; f < 2; ++f) {
            LAUNDER_S(inp);
            {
                pg8::Gemm g{HB, (const bf16_t*)(wl + (f ? OFF_WGU2 : OFF_WGU1)), M, 2 * FF, D}; pg8::StaticOrder S; S.init(M, 2 * FF, G, bx);
                { if (tid == 0) *(volatile LAS int*)(lds + pg8::LDS_RSPM) = -1; __syncthreads(); }
                pg8::EpiSwiGLU E{HID, FF, SSQ + (size_t)(3 * l + (f ? 2 : 0)) * M * 8, lds};
                pg8::gemm_phase<pg8::EpiSwiGLU, pg8::StaticOrder, true, true>(lds, g, S, E);
            }
            GRID_BAR();
            {
                pg8::Gemm g{HID, (const bf16_t*)(wl + (f ? OFF_WD2 : OFF_WD1)), M, D, FF}; pg8::StaticOrder S; S.init(M, D, G, bx);
                pg8::EpiResid<true> E{HB, SSQ + (size_t)(3 * l + (f ? 3 : 1)) * M * 8, lds};
                pg8::gemm_phase<pg8::EpiResid<true>, pg8::StaticOrder, true, true>(lds, g, S, E);
            }
            GRID_BAR();
            if (f == 0) {
                {
                    pg8::Gemm g{HB, (const bf16_t*)(wl + OFF_WIN), M, DIN, D}; pg8::StaticOrder S; S.init(M, DIN, G, bx);
                    { if (tid == 0) *(volatile LAS int*)(lds + pg8::LDS_RSPM) = -1; __syncthreads(); }
                    pg8::EpiZ E{ZM, VT, KH, SSQ + (size_t)(3 * l + 1) * M * 8, lds};
                    pg8::gemm_phase<pg8::EpiZ, pg8::StaticOrder, true, true>(lds, g, S, E);
                }
                GRID_BAR();
                {
                    LAS float* biasL = (LAS float*)(lds + LM_BIAS);
                    const float* rb = INP(14) + (size_t)l * NH * NREL;
                    int tid_m = tid; LAUNDER(tid_m);
                    for (int i = tid_m; i < NH * NREL; i += NTHREADS) biasL[i] = rb[i] * LOG2E;
                    __syncthreads();
                    for (int u = bx; u < NB * 16; u += G)
                        lru_unit(lds, ZM, HB2, YP, INP(7) + (size_t)l * 4 * DL, INP(8) + (size_t)l * DL, INP(9) + (size_t)l * 16 * 64 * 64, INP(10) + (size_t)l * DL,
                                 INP(11) + (size_t)l * 16 * 64 * 64, INP(12) + (size_t)l * DL, INP(13) + (size_t)l * DL, u >> 4, u & 15, tid);
                    for (int bu = bx; bu < 1024; bu += G) {
                        const int kk = bu >> 8, bxv = bu & 255;
                        const int ag = ((bxv & 7) + 2 * kk) & 7, ap = (bxv >> 3) + 32 * kk;
                        attn_block(lds, ZM, KH, VT, HB2, YP, biasL, ap >> 3, ap & 7, ag, tid);
                    }
                }
                GRID_BAR();
                {
                    pg8::Gemm g{HB2, (const bf16_t*)(wl + OFF_WOUT), M, D, D}; pg8::StaticOrder S; S.init(M, D, G, bx);
                    { if (tid == 0) *(volatile LAS int*)(lds + pg8::LDS_RS2PM) = -1; __syncthreads(); }
                    pg8::EpiResidY E{HB, SSQ + (size_t)(3 * l + 2) * M * 8, YP, lds};
                    { pg8::Unit u0; if (S.next(0, u0)) E.prep(u0); }
                    pg8::gemm_phase<pg8::EpiResidY, pg8::StaticOrder, true, true>(lds, g, S, E);
                }
                GRID_BAR();
            } else {
                if (l + 1 == DEPTH) rms_rows_bf16_to_f32(HB, INP(22), out, gw, NGW, lane);
            }
        }
    }
}

extern "C" void kernel_launch(void* const* d_in, const int* in_sizes, int n_in, void* d_out, int out_size, void* d_ws, size_t ws_size, hipStream_t stream) {
    static int grid = 0;
    if (grid == 0) {
        if (n_in != 23 || in_sizes[0] != M * D || out_size != M * D || ws_size < WS_END) {
            fprintf(stderr, "kernel_launch: unexpected shapes: n_in %d in0 %d out %d ws %zu (need %zu)\n", n_in, n_in > 0 ? in_sizes[0] : -1, out_size, ws_size, (size_t)WS_END); grid = -1; return; }
        int dev = 0, cus = 0, per_cu = 0;
        hipGetDevice(&dev); hipDeviceGetAttribute(&cus, hipDeviceAttributeMultiprocessorCount, dev);
        if (hipFuncSetAttribute((const void*)mk_fwd, hipFuncAttributeMaxDynamicSharedMemorySize, LDS_BYTES) != hipSuccess) fprintf(stderr, "kernel_launch: hipFuncSetAttribute failed\n");
        if (hipOccupancyMaxActiveBlocksPerMultiprocessor(&per_cu, (const void*)mk_fwd, NTHREADS, LDS_BYTES) != hipSuccess || per_cu < 1) { fprintf(stderr, "kernel_launch: occupancy query gave %d\n", per_cu); per_cu = 1; }
        (void)hipGetLastError();
        grid = cus * per_cu;
        if (grid > 256) grid = 256;
    }
    if (grid < 0) return;
    Args a{};
    for (int i = 0; i < 23; ++i) a.in[i] = (const float*)d_in[i];
    a.out = (float*)d_out; a.ws = (unsigned char*)d_ws;
    void* kargs[] = {&a};
    hipError_t e = hipLaunchCooperativeKernel((const void*)mk_fwd, dim3(grid), dim3(NTHREADS), kargs, LDS_BYTES, stream);
    if (e != hipSuccess) fprintf(stderr, "kernel_launch: cooperative launch failed: %s (grid %d)\n", hipGetErrorString(e), grid);
}
```

```cpp
#include <hip/hip_runtime.h>
#include <hip/hip_cooperative_groups.h>
#include <cstdio>
#include <cstdint>
namespace cg = cooperative_groups;

#define LAS __attribute__((address_space(3)))
#define LAUNDER(v) asm volatile("" : "+v"(v))
typedef unsigned short bf16_t;
typedef short bf16x8 __attribute__((ext_vector_type(8)));
typedef float f32x4 __attribute__((ext_vector_type(4)));
typedef float f32x2 __attribute__((ext_vector_type(2)));
typedef unsigned u32x4 __attribute__((ext_vector_type(4)));
typedef unsigned u32x2 __attribute__((ext_vector_type(2)));

constexpr int NB = 16, SEQ = 2048, M = NB * SEQ, D = 2048, FF = 5632, DIN = 5120, DL = 1024, NH = 8, HD = 128, NREL = 257, DEPTH = 2;
constexpr int ZLD = 3072;
constexpr float EPS = 1e-6f;
constexpr float LOG2E = 1.4426950408889634f;

constexpr size_t MiB = 1u << 20;
constexpr size_t SZ_WGU = (size_t)2 * FF * D * 2, SZ_WD = (size_t)D * FF * 2, SZ_WIN = (size_t)DIN * D * 2, SZ_WOUT = (size_t)D * D * 2;
constexpr size_t OFF_WGU1 = 0, OFF_WD1 = OFF_WGU1 + SZ_WGU, OFF_WIN = OFF_WD1 + SZ_WD, OFF_WOUT = OFF_WIN + SZ_WIN, OFF_WGU2 = OFF_WOUT + SZ_WOUT, OFF_WD2 = OFF_WGU2 + SZ_WGU;
constexpr size_t LAYER_W = OFF_WD2 + SZ_WD;
static_assert(LAYER_W == 160 * MiB, "weights per layer");
constexpr size_t WS_BIG = 2 * LAYER_W;
constexpr size_t WS_VT = WS_BIG + (size_t)M * ZLD * 2;
constexpr size_t WS_KH = WS_VT + (size_t)M * 1024 * 2;
constexpr size_t WS_H = WS_BIG + 352 * MiB;
constexpr size_t WS_H2 = WS_H + 128 * MiB;
constexpr size_t WS_SSQ = WS_H2 + 128 * MiB;
constexpr size_t WS_YP = WS_SSQ + 8 * MiB;
constexpr size_t WS_CTL = WS_YP + 4 * MiB;
constexpr size_t CTL_BYTES = 16384;
constexpr size_t WS_END = WS_CTL + 1 * MiB;
static_assert((size_t)M * FF * 2 == 352 * MiB, "hidden size");

constexpr int NWAVES = 8, NTHREADS = 512;
constexpr int LDS_BYTES = 147456;

__device__ __forceinline__ unsigned cvt_pk_bf16(float lo, float hi) { unsigned r; asm volatile("v_cvt_pk_bf16_f32 %0, %1, %2" : "=v"(r) : "v"(lo), "v"(hi)); return r; }
__device__ __forceinline__ float bf_lo(unsigned u) { return __uint_as_float(u << 16); }
__device__ __forceinline__ float bf_hi(unsigned u) { return __uint_as_float(u & 0xffff0000u); }
__device__ __forceinline__ float fast_exp2(float x) { return __builtin_amdgcn_exp2f(x); }
__device__ __forceinline__ float fast_rcp(float x) { return __builtin_amdgcn_rcpf(x); }
__device__ __forceinline__ float sigmoidf_(float x) { return fast_rcp(1.0f + fast_exp2(-LOG2E * x)); }

namespace pg8 {
constexpr int BM = 256, BK = 64, HALF = 128, HTB = HALF * BK * 2, STAGE_BYTES = 8 * HTB, NXCD = 8, WGM = 4;
__host__ __device__ __forceinline__ int lds_byte(int r, int c) { const int st = (r >> 4) * 2 + (c >> 5), rr = r & 15, cc = c & 31, ob = rr * 64 + cc * 2; return st * 1024 + (ob ^ (((ob >> 9) & 1) << 5)); }
__host__ __device__ __forceinline__ void stage_rc(int b, int& R, int& C) { const int st = b / 1024, sb = b % 1024, swz = sb ^ (((sb >> 9) & 1) << 5); R = (st >> 1) * 16 + swz / 64; C = (st & 1) * 32 + (swz % 64) / 2; }
__host__ __device__ __forceinline__ int perm32(int rho) { const int n = rho >> 4, i = rho & 15; return 8 * (i >> 2) + 4 * n + (i & 3); }

struct Unit { int pm, pn; };
struct Gemm { const bf16_t* A; const bf16_t* Bt; int M, N, K; };

struct StaticOrder {
    int nM, nN, nwg, G, c;
    __host__ __device__ void init(int M_, int N_, int G_, int c_) { nM = M_ / BM; nN = N_ / BM; nwg = nM * nN; G = G_; c = c_; }
    __host__ __device__ bool next(int i, Unit& u) const {
        const long L = (long)i * G + c; if (L >= nwg) return false;
        int wgid = (int)L; { const int q = nwg / NXCD, r = nwg % NXCD, xcd = wgid % NXCD, off = wgid / NXCD; wgid = (xcd < r ? xcd * (q + 1) : r * (q + 1) + (xcd - r) * q) + off; }
        const int nig = WGM * nN, gid = wgid / nig, fm = gid * WGM, gsz = (nM - fm) < WGM ? (nM - fm) : WGM;
        u.pm = fm + ((wgid % nig) % gsz); u.pn = (wgid % nig) / gsz; return true;
    }
    __device__ __forceinline__ void a_ready(const Unit&) const {}
    __device__ __forceinline__ void done(const Unit&) const {}
};


constexpr int LDS_RS = 131072 + 1024, LDS_RSPM = 131072 + 2048 + 64, LDS_SSP = 131072 + 4096;
__device__ __forceinline__ void rs_panel(LAS unsigned char* lds, const float* ssq, int pm) {
    volatile LAS int* pmL = (volatile LAS int*)(lds + LDS_RSPM); LAS float* rsL = (LAS float*)(lds + LDS_RS);
    if (pmL[0] != pm) {
        asm volatile("s_waitcnt lgkmcnt(0)" ::: "memory"); __builtin_amdgcn_s_barrier();
        const int t = threadIdx.x;
        if (t < 256) { const f32x4* pp = (const f32x4*)(ssq + (size_t)(pm * 256 + t) * 8); const f32x4 pa = pp[0], pb = pp[1];
            rsL[t] = __builtin_amdgcn_rsqf((((pa.x + pa.y) + (pa.z + pa.w)) + ((pb.x + pb.y) + (pb.z + pb.w))) * (1.0f / D) + EPS); }
        if (t == 0) pmL[0] = pm;
        asm volatile("s_waitcnt vmcnt(0) lgkmcnt(0)" ::: "memory"); __builtin_amdgcn_s_barrier();
    }
}
struct EpiSwiGLU {
    static constexpr bool PERM = true, AFTER_DRAIN = false, MIDK = false;
    bf16_t* O; int ldc; const float* ssq; LAS unsigned char* lds;
    __device__ __forceinline__ void operator()(const f32x4 (&acc)[2][2][4][2], const Unit& u, int wr, int wc, int fr, int fq) const {
        rs_panel(lds, ssq, u.pm);
        const LAS float* rsL = (const LAS float*)(lds + LDS_RS) + wr * 64 + fr;
        const int row0 = u.pm * BM + wr * 64 + fr; const int col0 = u.pn * HALF + wc * 32 + 8 * fq;
#pragma unroll
        for (int ai = 0; ai < 2; ++ai)
#pragma unroll
            for (int m = 0; m < 4; ++m) {
                bf16_t* rowp = O + (size_t)(row0 + ai * HALF + m * 16) * ldc + col0;
                const float rs = rsL[ai * HALF + m * 16];
                const float c1 = -LOG2E * rs, rs2 = rs * rs;
                float v[8];
#pragma unroll
                for (int n = 0; n < 2; ++n)
#pragma unroll
                    for (int hh = 0; hh < 2; ++hh) {
                        const f32x2 a2 = (f32x2){acc[ai][0][m][n][2 * hh], acc[ai][0][m][n][2 * hh + 1]}, b2 = (f32x2){acc[ai][1][m][n][2 * hh], acc[ai][1][m][n][2 * hh + 1]};
                        const f32x2 t2 = a2 * c1;
                        f32x2 d2; d2.x = fast_exp2(t2.x); d2.y = fast_exp2(t2.y); d2 = d2 + 1.0f;
                        f32x2 s2; s2.x = fast_rcp(d2.x); s2.y = fast_rcp(d2.y);
                        const f32x2 v2 = (a2 * b2) * (s2 * rs2);
                        v[n * 4 + 2 * hh] = v2.x; v[n * 4 + 2 * hh + 1] = v2.y; }
                u32x4 w; w.x = cvt_pk_bf16(v[0], v[1]); w.y = cvt_pk_bf16(v[2], v[3]); w.z = cvt_pk_bf16(v[4], v[5]); w.w = cvt_pk_bf16(v[6], v[7]);
                *(u32x4*)rowp = w;
            }
    }
};
template <bool HALFSC> struct EpiResid {
    static constexpr bool PERM = false, AFTER_DRAIN = false, MIDK = false;
    bf16_t* xb; float* ssq_part; LAS unsigned char* lds;
    __device__ __forceinline__ void operator()(const f32x4 (&acc)[2][2][4][2], const Unit& u, int wr, int wc, int fr, int fq) const {
        const float scale_ = HALFSC ? 0.5f : 1.0f; bf16_t* const xb_ = xb; float* const ssq_ = ssq_part;
        LAS float* pl = (LAS float*)(lds + LDS_SSP);
        const int col0 = u.pn * BM + wc * 32 + 4 * fq;
        const size_t base = (size_t)(u.pm * BM + wr * 64 + fr) * D + col0;
        u32x2 r[2][2][2][2];
#define ER_LOAD(buf, bb) do { _Pragma("unroll") for (int mm = 0; mm < 2; ++mm) _Pragma("unroll") for (int bj = 0; bj < 2; ++bj) _Pragma("unroll") for (int n = 0; n < 2; ++n) \
            r[buf][mm][bj][n] = *(const u32x2*)(xb_ + base + (size_t)(((bb) >> 1) * HALF + (((bb) & 1) * 2 + mm) * 16) * D + bj * HALF + n * 16); } while (0)
        ER_LOAD(0, 0);
#pragma unroll
        for (int bb = 0; bb < 4; ++bb) {
            if (bb < 3) ER_LOAD((bb + 1) & 1, bb + 1);
            const int ai = bb >> 1;
#pragma unroll
            for (int mm = 0; mm < 2; ++mm) { const int m = (bb & 1) * 2 + mm; const int rowl = ai * HALF + m * 16; const size_t off = base + (size_t)rowl * D; float ssum = 0.f;
#pragma unroll
                for (int bj = 0; bj < 2; ++bj)
#pragma unroll
                    for (int n = 0; n < 2; ++n) { const u32x2 rr = r[bb & 1][mm][bj][n]; const f32x4 a = acc[ai][bj][m][n];
                        const float o0 = bf_lo(rr.x) + a.x * scale_, o1 = bf_hi(rr.x) + a.y * scale_, o2 = bf_lo(rr.y) + a.z * scale_, o3 = bf_hi(rr.y) + a.w * scale_;
                        u32x2 w; w.x = cvt_pk_bf16(o0, o1); w.y = cvt_pk_bf16(o2, o3); *(u32x2*)(xb_ + off + bj * HALF + n * 16) = w;
                        ssum += (o0 * o0 + o1 * o1) + (o2 * o2 + o3 * o3); }
                ssum += __shfl_xor(ssum, 16); ssum += __shfl_xor(ssum, 32);
                if (fq == 0) pl[(rowl + wr * 64 + fr) * 4 + wc] = ssum;
            }
        }
#undef ER_LOAD
        asm volatile("s_waitcnt lgkmcnt(0)" ::: "memory"); __builtin_amdgcn_s_barrier();
        const int t = threadIdx.x;
        if (t < 256) { const f32x4 p = *(const LAS f32x4*)(pl + t * 4); ssq_[(size_t)(u.pm * BM + t) * 8 + u.pn] = (p.x + p.y) + (p.z + p.w); }
    }
};
constexpr int LDS_RS2 = 131072 + 8192, LDS_RS2PM = 131072 + 8192 + 2048 + 64;
__device__ __forceinline__ void rs2_panel(LAS unsigned char* lds, const float* yp, int pm) {
    volatile LAS int* pmL = (volatile LAS int*)(lds + LDS_RS2PM); LAS f32x2* rsL = (LAS f32x2*)(lds + LDS_RS2);
    if (pmL[0] != pm) {
        asm volatile("s_waitcnt lgkmcnt(0)" ::: "memory"); __builtin_amdgcn_s_barrier();
        const int t = threadIdx.x;
        if (t < 256) { const f32x4* pp = (const f32x4*)(yp + (size_t)(pm * 256 + t) * 24);
            const f32x4 a0 = pp[0], a1 = pp[1], a2 = pp[2], a3 = pp[3], b0 = pp[4], b1 = pp[5];
            const float sl = (((a0.x + a0.y) + (a0.z + a0.w)) + ((a1.x + a1.y) + (a1.z + a1.w))) + (((a2.x + a2.y) + (a2.z + a2.w)) + ((a3.x + a3.y) + (a3.z + a3.w)));
            const float sa = ((b0.x + b0.y) + (b0.z + b0.w)) + ((b1.x + b1.y) + (b1.z + b1.w));
            const float va = sa * (1.0f / 1024.f) + EPS, vl = sl * (1.0f / 1024.f) + EPS;
            rsL[t] = (f32x2){__builtin_amdgcn_rsqf(va), __builtin_amdgcn_rsqf(vl) * sqrtf(va)}; }
        if (t == 0) pmL[0] = pm;
        asm volatile("s_waitcnt vmcnt(0) lgkmcnt(0)" ::: "memory"); __builtin_amdgcn_s_barrier();
    }
}
struct EpiResidY {
    static constexpr bool PERM = false, AFTER_DRAIN = false, MIDK = true;
    bf16_t* xb; float* ssq_part; const float* yp; LAS unsigned char* lds;
    __device__ __forceinline__ void prep(const Unit& u) const { rs2_panel(lds, yp, u.pm); }
    __device__ __forceinline__ void mid(f32x4 (&acc)[2][2][4][2], const Unit& u, int wr, int wc, int fr, int fq) const {
        const LAS f32x2* rsL = (const LAS f32x2*)(lds + LDS_RS2) + wr * 64 + fr;
#pragma unroll
        for (int ai = 0; ai < 2; ++ai)
#pragma unroll
            for (int m = 0; m < 4; ++m) { const float q = rsL[ai * HALF + m * 16].y;
#pragma unroll
                for (int bj = 0; bj < 2; ++bj)
#pragma unroll
                    for (int n = 0; n < 2; ++n) acc[ai][bj][m][n] = acc[ai][bj][m][n] * q; }
    }
    __device__ __forceinline__ void operator()(const f32x4 (&acc)[2][2][4][2], const Unit& u, int wr, int wc, int fr, int fq) const {
        bf16_t* const xb_ = xb; float* const ssq_ = ssq_part;
        LAS float* pl = (LAS float*)(lds + LDS_SSP);
        const LAS f32x2* rsL = (const LAS f32x2*)(lds + LDS_RS2) + wr * 64 + fr;
        const int col0 = u.pn * BM + wc * 32 + 4 * fq;
        const size_t base = (size_t)(u.pm * BM + wr * 64 + fr) * D + col0;
        u32x2 r[2][2][2][2];
#define ER_LOAD(buf, bb) do { _Pragma("unroll") for (int mm = 0; mm < 2; ++mm) _Pragma("unroll") for (int bj = 0; bj < 2; ++bj) _Pragma("unroll") for (int n = 0; n < 2; ++n) \
            r[buf][mm][bj][n] = *(const u32x2*)(xb_ + base + (size_t)(((bb) >> 1) * HALF + (((bb) & 1) * 2 + mm) * 16) * D + bj * HALF + n * 16); } while (0)
        ER_LOAD(0, 0);
#pragma unroll
        for (int bb = 0; bb < 4; ++bb) {
            if (bb < 3) ER_LOAD((bb + 1) & 1, bb + 1);
            const int ai = bb >> 1;
#pragma unroll
            for (int mm = 0; mm < 2; ++mm) { const int m = (bb & 1) * 2 + mm; const int rowl = ai * HALF + m * 16; const size_t off = base + (size_t)rowl * D; float ssum = 0.f;
                const float scale_ = rsL[rowl].x;
#pragma unroll
                for (int bj = 0; bj < 2; ++bj)
#pragma unroll
                    for (int n = 0; n < 2; ++n) { const u32x2 rr = r[bb & 1][mm][bj][n]; const f32x4 a = acc[ai][bj][m][n];
                        const float o0 = bf_lo(rr.x) + a.x * scale_, o1 = bf_hi(rr.x) + a.y * scale_, o2 = bf_lo(rr.y) + a.z * scale_, o3 = bf_hi(rr.y) + a.w * scale_;
                        u32x2 w; w.x = cvt_pk_bf16(o0, o1); w.y = cvt_pk_bf16(o2, o3); *(u32x2*)(xb_ + off + bj * HALF + n * 16) = w;
                        ssum += (o0 * o0 + o1 * o1) + (o2 * o2 + o3 * o3); }
                ssum += __shfl_xor(ssum, 16); ssum += __shfl_xor(ssum, 32);
                if (fq == 0) pl[(rowl + wr * 64 + fr) * 4 + wc] = ssum;
            }
        }
#undef ER_LOAD
        asm volatile("s_waitcnt lgkmcnt(0)" ::: "memory"); __builtin_amdgcn_s_barrier();
        const int t = threadIdx.x;
        if (t < 256) { const f32x4 p = *(const LAS f32x4*)(pl + t * 4); ssq_[(size_t)(u.pm * BM + t) * 8 + u.pn] = (p.x + p.y) + (p.z + p.w); }
    }
};
struct EpiZ {
    static constexpr bool PERM = true, AFTER_DRAIN = false, MIDK = false;
    bf16_t* Z; bf16_t* Vt; bf16_t* Kh; const float* ssq; LAS unsigned char* lds;
    __device__ __forceinline__ void operator()(const f32x4 (&acc)[2][2][4][2], const Unit& u, int wr, int wc, int fr, int fq) const {
        rs_panel(lds, ssq, u.pm);
        float rs[2][4];
        { const LAS float* rsL = (const LAS float*)(lds + LDS_RS) + wr * 64 + fr;
#pragma unroll
          for (int ai = 0; ai < 2; ++ai)
#pragma unroll
            for (int m = 0; m < 4; ++m) rs[ai][m] = rsL[ai * HALF + m * 16]; }
        if (u.pn >= 12 && u.pn < 16) {
            const int b = (u.pm * BM) / SEQ; const int s0 = (u.pm * BM) % SEQ + wr * 64 + fr;
#pragma unroll
            for (int bj = 0; bj < 2; ++bj) {
                const int head = (u.pn - 12) * 2 + bj;
                bf16_t* hb = Kh + ((size_t)(b * NH + head) * SEQ + s0) * HD + wc * 32 + 8 * fq;
#pragma unroll
                for (int ai = 0; ai < 2; ++ai)
#pragma unroll
                    for (int m = 0; m < 4; ++m) { const f32x4 v0 = acc[ai][bj][m][0] * rs[ai][m], v1 = acc[ai][bj][m][1] * rs[ai][m];
                        u32x4 w; w.x = cvt_pk_bf16(v0[0], v0[1]); w.y = cvt_pk_bf16(v0[2], v0[3]); w.z = cvt_pk_bf16(v1[0], v1[1]); w.w = cvt_pk_bf16(v1[2], v1[3]);
                        *(u32x4*)(hb + (size_t)(ai * HALF + m * 16) * HD) = w; }
            }
        } else if (u.pn < 12) {
            const int row0 = u.pm * BM + wr * 64 + fr; const int col0 = u.pn * BM + wc * 32 + 8 * fq;
#pragma unroll
            for (int ai = 0; ai < 2; ++ai)
#pragma unroll
                for (int m = 0; m < 4; ++m) {
                    bf16_t* rowp = Z + (size_t)(row0 + ai * HALF + m * 16) * ZLD + col0;
#pragma unroll
                    for (int bj = 0; bj < 2; ++bj) { const f32x4 v0 = acc[ai][bj][m][0] * rs[ai][m], v1 = acc[ai][bj][m][1] * rs[ai][m];
                        u32x4 w; w.x = cvt_pk_bf16(v0[0], v0[1]); w.y = cvt_pk_bf16(v0[2], v0[3]); w.z = cvt_pk_bf16(v1[0], v1[1]); w.w = cvt_pk_bf16(v1[2], v1[3]);
                        *(u32x4*)(rowp + bj * HALF) = w; }
                }
        } else {
            const int b = (u.pm * BM) / SEQ; const int s0 = (u.pm * BM) % SEQ + wr * 64 + fr;
#pragma unroll
            for (int bj = 0; bj < 2; ++bj) {
                const int head = (u.pn - 16) * 2 + bj;
                bf16_t* hb = Vt + ((size_t)(b * NH + head) * HD + wc * 32 + 8 * fq) * SEQ + s0;
#pragma unroll
                for (int ai = 0; ai < 2; ++ai)
#pragma unroll
                    for (int m = 0; m < 4; ++m)
#pragma unroll
                        for (int n = 0; n < 2; ++n)
#pragma unroll
                            for (int i = 0; i < 4; ++i) {
                                const unsigned w = cvt_pk_bf16(acc[ai][bj][m][n][i] * rs[ai][m], 0.f);
                                hb[(size_t)(4 * n + i) * SEQ + ai * HALF + m * 16] = (bf16_t)(w & 0xffffu);
                            }
            }
        }
    }
};

template <class Epi, class Sched, bool ALIGN_EPI = false, bool SP2 = false>
__device__ __forceinline__ void gemm_phase(LAS unsigned char* lds, const Gemm g, const Sched& S, const Epi& E) {
    int tid_l = threadIdx.x; LAUNDER(tid_l);
    const int tid = tid_l, wid = __builtin_amdgcn_readfirstlane(tid >> 6), lane = tid & 63, wr = wid >> 2, wc = wid & 3, fr = lane & 15, fq = lane >> 4;
    const int K = g.K, nt = K / BK;
    unsigned voffA[2], voffB[2];
#pragma unroll
    for (int i = 0; i < 2; ++i) { int R, C; stage_rc(tid * 16 + i * 8192, R, C); const int Rb = Epi::PERM ? ((R & ~31) + perm32(R & 31)) : R;
        voffA[i] = (unsigned)(R * K + C) * 2u; voffB[i] = (unsigned)(Rb * K + C) * 2u; }
    const size_t kstep = (size_t)(BK * 2);
    const size_t hstep = (size_t)HALF * K * 2;
    const size_t tstep = 2 * hstep;
    const unsigned ldsw = (unsigned)wid * 1024u;
    const int aoff = lds_byte(wr * 64 + fr, fq * 8), boff = lds_byte(wc * 32 + fr, fq * 8);
#define PG8_SA(b, h) (((b) * 2 + (h)) * HTB)
#define PG8_SB(b, h) ((4 + (b) * 2 + (h)) * HTB)
#define PG8_STAGE(bufoff, gbase, voff) do { _Pragma("unroll") for (int _i = 0; _i < 2; ++_i) \
        __builtin_amdgcn_global_load_lds((const unsigned*)((const char*)(gbase) + (voff)[_i]), (LAS unsigned*)(lds + (bufoff) + ldsw + _i * 8192), 16, 0, 0); } while (0)
#define PG8_LDA(dst, b, h) do { _Pragma("unroll") for (int m = 0; m < 4; ++m) _Pragma("unroll") for (int k = 0; k < 2; ++k) dst[m][k] = *(const LAS bf16x8*)(lds + PG8_SA(b, h) + aoff + m * 2048 + k * 1024); } while (0)
#define PG8_LDB(dst, b, h) do { _Pragma("unroll") for (int n = 0; n < 2; ++n) _Pragma("unroll") for (int k = 0; k < 2; ++k) dst[n][k] = *(const LAS bf16x8*)(lds + PG8_SB(b, h) + boff + n * 2048 + k * 1024); } while (0)
#define PG8_MMA(ai, bj, At, Bt) do { __builtin_amdgcn_s_setprio(1); _Pragma("unroll") for (int m = 0; m < 4; ++m) _Pragma("unroll") for (int n = 0; n < 2; ++n) _Pragma("unroll") for (int k = 0; k < 2; ++k) \
        acc[ai][bj][m][n] = __builtin_amdgcn_mfma_f32_16x16x32_bf16(Bt[n][k], At[m][k], acc[ai][bj][m][n], 0, 0, 0); __builtin_amdgcn_s_setprio(0); } while (0)
#define PG8_WAIT_V(n) asm volatile("s_waitcnt vmcnt(" #n ")" ::: "memory")
#define PG8_WAIT_L(n) asm volatile("s_waitcnt lgkmcnt(" #n ")" ::: "memory")
#define PG8_BAR __builtin_amdgcn_s_barrier()
#define PG8_SCHED __builtin_amdgcn_sched_barrier(0)
    Unit cur, nxt; int ui = 0;
    if (!S.next(0, cur)) return;
    f32x4 acc[2][2][4][2];
#pragma unroll
    for (int a = 0; a < 2; ++a)
#pragma unroll
        for (int b = 0; b < 2; ++b)
#pragma unroll
            for (int m = 0; m < 4; ++m)
#pragma unroll
                for (int n = 0; n < 2; ++n) acc[a][b][m][n] = (f32x4){0.f, 0.f, 0.f, 0.f};
    bf16x8 At[4][2], B0[2][2], B1[2][2];
    const char* cA = (const char*)g.A + (size_t)cur.pm * tstep; const char* cB = (const char*)g.Bt + (size_t)cur.pn * tstep;
    S.a_ready(cur);
    if constexpr (SP2) {
        PG8_STAGE(PG8_SB(0, 0), cB, voffB); PG8_STAGE(PG8_SB(0, 1), cB + hstep, voffB); PG8_STAGE(PG8_SA(0, 0), cA, voffA); PG8_STAGE(PG8_SA(0, 1), cA + hstep, voffA);
        if (wr == 1) PG8_BAR;
        PG8_WAIT_V(2); PG8_BAR;
        PG8_STAGE(PG8_SB(1, 0), cB + kstep, voffB); PG8_STAGE(PG8_SA(1, 0), cA + kstep, voffA); PG8_STAGE(PG8_SB(1, 1), cB + hstep + kstep, voffB);
        PG8_WAIT_V(6); PG8_BAR;
    } else {
        PG8_STAGE(PG8_SB(0, 0), cB, voffB); PG8_STAGE(PG8_SA(0, 0), cA, voffA); PG8_STAGE(PG8_SB(0, 1), cB + hstep, voffB); PG8_STAGE(PG8_SA(0, 1), cA + hstep, voffA);
        if (wr == 1) PG8_BAR;
        PG8_WAIT_V(4); PG8_BAR;
        PG8_STAGE(PG8_SB(1, 0), cB + kstep, voffB); PG8_STAGE(PG8_SA(1, 0), cA + kstep, voffA); PG8_STAGE(PG8_SB(1, 1), cB + hstep + kstep, voffB);
        PG8_WAIT_V(6); PG8_BAR;
    }
    for (;;) {
        const bool has_next = S.next(ui + 1, nxt);
        const char* nA = has_next ? (const char*)g.A + (size_t)nxt.pm * tstep : cA; const char* nB = has_next ? (const char*)g.Bt + (size_t)nxt.pn * tstep : cB;
        for (int t = 0; t < nt; t += 2) {
            if constexpr (Epi::MIDK) { if (t == (nt >> 1)) E.mid(acc, cur, wr, wc, fr, fq); }
            const bool last = (t == nt - 2);
            const char* a1 = cA + (size_t)(t + 1) * kstep;
            const char* a2 = last ? nA : cA + (size_t)(t + 2) * kstep; const char* b2 = last ? nB : cB + (size_t)(t + 2) * kstep;
            const char* a3 = a2 + kstep; const char* b3 = b2 + kstep;
            if (last && has_next) S.a_ready(nxt);
            if constexpr (SP2) {
            PG8_LDB(B0, 0, 0); PG8_LDB(B1, 0, 1); PG8_SCHED; PG8_LDA(At, 0, 0); PG8_STAGE(PG8_SA(1, 1), a1 + hstep, voffA);
            PG8_WAIT_V(8); PG8_WAIT_L(0); PG8_BAR; PG8_MMA(0, 0, At, B0); PG8_MMA(0, 1, At, B1); PG8_BAR; PG8_SCHED;
            PG8_LDA(At, 0, 1); PG8_STAGE(PG8_SB(0, 0), b2, voffB); PG8_STAGE(PG8_SB(0, 1), b2 + hstep, voffB); PG8_STAGE(PG8_SA(0, 0), a2, voffA);
            PG8_WAIT_V(8); PG8_WAIT_L(0); PG8_BAR; PG8_MMA(1, 0, At, B0); PG8_MMA(1, 1, At, B1); PG8_BAR; PG8_SCHED;
            PG8_LDB(B0, 1, 0); PG8_LDB(B1, 1, 1); PG8_SCHED; PG8_LDA(At, 1, 0); PG8_STAGE(PG8_SA(0, 1), a2 + hstep, voffA);
            PG8_WAIT_V(8); PG8_WAIT_L(0); PG8_BAR; PG8_MMA(0, 0, At, B0); PG8_MMA(0, 1, At, B1); PG8_BAR; PG8_SCHED;
            PG8_LDA(At, 1, 1); PG8_STAGE(PG8_SB(1, 0), b3, voffB); PG8_STAGE(PG8_SB(1, 1), b3 + hstep, voffB); PG8_STAGE(PG8_SA(1, 0), a3, voffA);
            PG8_WAIT_V(8); PG8_WAIT_L(0); PG8_BAR; PG8_MMA(1, 0, At, B0); PG8_MMA(1, 1, At, B1); PG8_BAR; PG8_SCHED;
            } else {
            PG8_LDB(B0, 0, 0); PG8_SCHED; PG8_LDA(At, 0, 0); PG8_STAGE(PG8_SA(1, 1), a1 + hstep, voffA);
            PG8_WAIT_L(8); PG8_BAR; PG8_WAIT_L(0); PG8_MMA(0, 0, At, B0); PG8_BAR; PG8_SCHED;
            PG8_LDB(B1, 0, 1); PG8_STAGE(PG8_SB(0, 0), b2, voffB);
            PG8_BAR; PG8_WAIT_L(0); PG8_MMA(0, 1, At, B1); PG8_BAR;
            PG8_LDA(At, 0, 1); PG8_STAGE(PG8_SA(0, 0), a2, voffA);
            PG8_BAR; PG8_WAIT_L(0); PG8_MMA(1, 0, At, B0); PG8_BAR; PG8_SCHED;
            PG8_STAGE(PG8_SB(0, 1), b2 + hstep, voffB);
            PG8_WAIT_V(6); PG8_BAR; PG8_MMA(1, 1, At, B1); PG8_BAR;
            PG8_LDB(B0, 1, 0); PG8_SCHED; PG8_LDA(At, 1, 0); PG8_STAGE(PG8_SA(0, 1), a2 + hstep, voffA);
            PG8_WAIT_L(8); PG8_BAR; PG8_WAIT_L(0); PG8_MMA(0, 0, At, B0); PG8_BAR; PG8_SCHED;
            PG8_LDB(B1, 1, 1); PG8_STAGE(PG8_SB(1, 0), b3, voffB);
            PG8_BAR; PG8_WAIT_L(0); PG8_MMA(0, 1, At, B1); PG8_BAR;
            PG8_LDA(At, 1, 1); PG8_STAGE(PG8_SA(1, 0), a3, voffA);
            PG8_BAR; PG8_WAIT_L(0); PG8_MMA(1, 0, At, B0); PG8_BAR; PG8_SCHED;
            PG8_STAGE(PG8_SB(1, 1), b3 + hstep, voffB);
            PG8_WAIT_V(6); PG8_BAR; PG8_MMA(1, 1, At, B1); PG8_BAR;
            }
        }
        if constexpr (ALIGN_EPI) { if (wr == 0) PG8_BAR; }
        if constexpr (!Epi::AFTER_DRAIN) { E(acc, cur, wr, wc, fr, fq); S.done(cur); }
        if constexpr (Epi::MIDK) { if (has_next) E.prep(nxt); }
        if (!has_next) break;
#pragma unroll
        for (int a = 0; a < 2; ++a)
#pragma unroll
            for (int b = 0; b < 2; ++b)
#pragma unroll
                for (int m = 0; m < 4; ++m)
#pragma unroll
                    for (int n = 0; n < 2; ++n) acc[a][b][m][n] = (f32x4){0.f, 0.f, 0.f, 0.f};
        cur = nxt; cA = nA; cB = nB; ++ui;
        if constexpr (ALIGN_EPI) { if (wr == 1) PG8_BAR; }
    }
    PG8_WAIT_V(0);
    if constexpr (!ALIGN_EPI) { if (wr == 0) PG8_BAR; }
    PG8_BAR;
#undef PG8_SA
#undef PG8_SB
#undef PG8_STAGE
#undef PG8_LDA
#undef PG8_LDB
#undef PG8_MMA
#undef PG8_WAIT_V
#undef PG8_WAIT_L
#undef PG8_BAR
#undef PG8_SCHED
}
}

#define LDS_WAIT() asm volatile("s_waitcnt lgkmcnt(0)" ::: "memory")

__device__ __forceinline__ float wave_sum(float v) {
#pragma unroll
    for (int o = 1; o < 64; o <<= 1) v += __shfl_xor(v, o);
    return v;
}

__device__ __forceinline__ void p0_transpose_item(const float* W, const float* gain, int K, int N, bf16_t* WT, int ilv, LAS float* scr, int item, int lane, const float* gain2 = nullptr) {
    const int nblk = N / 32, kb = item / nblk, nb = item % nblk, k0 = 64 * kb, n0 = 32 * nb;
#pragma unroll 8
    for (int i = 0; i < 32; ++i) { const int kk = 2 * i + (lane >> 5); scr[kk * 33 + (lane & 31)] = W[(size_t)(k0 + kk) * N + n0 + (lane & 31)]; }
    LDS_WAIT(); asm volatile("" ::: "memory");
    const int c = lane & 7;
    f32x4 g0 = (f32x4){1.f, 1.f, 1.f, 1.f}, g1 = g0;
    if (gain) { const float* gp = (gain2 && k0 >= 1024) ? gain2 + (k0 - 1024) : gain + k0; g0 = *(const f32x4*)(gp + 8 * c); g1 = *(const f32x4*)(gp + 8 * c + 4); }
#pragma unroll
    for (int j = 0; j < 4; ++j) { const int n = (lane >> 3) + 8 * j; const LAS float* s = scr + (8 * c) * 33 + n;
        u32x4 o; o.x = cvt_pk_bf16(s[0 * 33] * g0.x, s[1 * 33] * g0.y); o.y = cvt_pk_bf16(s[2 * 33] * g0.z, s[3 * 33] * g0.w); o.z = cvt_pk_bf16(s[4 * 33] * g1.x, s[5 * 33] * g1.y); o.w = cvt_pk_bf16(s[6 * 33] * g1.z, s[7 * 33] * g1.w);
        const int nn = n0 + n; const int row = ilv < 0 ? nn : ((nn >> 7) * 256 + (nn & 127) + ilv);
        *(u32x4*)(WT + (size_t)row * K + k0 + 8 * c) = o; }
    LDS_WAIT(); asm volatile("" ::: "memory");
}

__device__ __forceinline__ void rms_rows_bf16(const float* x, const float* g, bf16_t* out, int gw, int NGW, int lane) {
    LAUNDER(lane);
    f32x4 gv[8];
#pragma unroll
    for (int j = 0; j < 8; ++j) gv[j] = *(const f32x4*)(g + 4 * lane + 256 * j);
    for (int m = gw; m < M; m += NGW) {
        const f32x4* xr = (const f32x4*)(x + (size_t)m * D) + lane; f32x4 v[8]; float s = 0.f;
#pragma unroll
        for (int j = 0; j < 8; ++j) { v[j] = xr[64 * j]; s += (v[j].x * v[j].x + v[j].y * v[j].y) + (v[j].z * v[j].z + v[j].w * v[j].w); }
        const float rstd = 1.0f / sqrtf(wave_sum(s) * (1.0f / D) + EPS);
        u32x2* o8 = (u32x2*)(out + (size_t)m * D) + lane;
#pragma unroll
        for (int j = 0; j < 8; ++j) { const f32x4 o = v[j] * rstd * gv[j]; u32x2 w; w.x = cvt_pk_bf16(o.x, o.y); w.y = cvt_pk_bf16(o.z, o.w); o8[64 * j] = w; }
    }
}
__device__ __forceinline__ void cast_rows_bf16(const float* x, bf16_t* out, float* ssq, int gw, int NGW, int lane) {
    LAUNDER(lane);
    for (int m = gw; m < M; m += NGW) {
        const f32x4* xr = (const f32x4*)(x + (size_t)m * D) + lane; f32x4 v[8]; float s = 0.f;
#pragma unroll
        for (int j = 0; j < 8; ++j) { v[j] = xr[64 * j]; s += (v[j].x * v[j].x + v[j].y * v[j].y) + (v[j].z * v[j].z + v[j].w * v[j].w); }
        s = wave_sum(s);
        if (lane == 0) { f32x4* pp = (f32x4*)(ssq + (size_t)m * 8); pp[0] = (f32x4){s, 0.f, 0.f, 0.f}; pp[1] = (f32x4){0.f, 0.f, 0.f, 0.f}; }
        u32x2* o8 = (u32x2*)(out + (size_t)m * D) + lane;
#pragma unroll
        for (int j = 0; j < 8; ++j) { u32x2 w; w.x = cvt_pk_bf16(v[j].x, v[j].y); w.y = cvt_pk_bf16(v[j].z, v[j].w); o8[64 * j] = w; }
    }
}
__device__ __forceinline__ void rms_rows_f32_inplace(float* x, const float* g, int gw, int NGW, int lane) {
    LAUNDER(lane);
    f32x4 gv[8];
#pragma unroll
    for (int j = 0; j < 8; ++j) gv[j] = *(const f32x4*)(g + 4 * lane + 256 * j);
    for (int m = gw; m < M; m += NGW) {
        f32x4* xr = (f32x4*)(x + (size_t)m * D) + lane; f32x4 v[8]; float s = 0.f;
#pragma unroll
        for (int j = 0; j < 8; ++j) { v[j] = xr[64 * j]; s += (v[j].x * v[j].x + v[j].y * v[j].y) + (v[j].z * v[j].z + v[j].w * v[j].w); }
        const float rstd = 1.0f / sqrtf(wave_sum(s) * (1.0f / D) + EPS);
#pragma unroll
        for (int j = 0; j < 8; ++j) xr[64 * j] = v[j] * rstd * gv[j];
    }
}
__device__ __forceinline__ void rms_rows_bf16_to_f32(const bf16_t* x, const float* g, float* out, int gw, int NGW, int lane) {
    LAUNDER(lane);
    f32x4 gv[4][2];
#pragma unroll
    for (int j = 0; j < 4; ++j) { const float* gp = g + 512 * j + 8 * lane; gv[j][0] = *(const f32x4*)gp; gv[j][1] = *(const f32x4*)(gp + 4); }
    for (int m = gw; m < M; m += NGW) {
        const u32x4* xr = (const u32x4*)(x + (size_t)m * D) + lane; u32x4 raw[4]; float s = 0.f;
#pragma unroll
        for (int j = 0; j < 4; ++j) raw[j] = xr[64 * j];
        float v[4][8];
#pragma unroll
        for (int j = 0; j < 4; ++j) {
            v[j][0] = bf_lo(raw[j].x); v[j][1] = bf_hi(raw[j].x); v[j][2] = bf_lo(raw[j].y); v[j][3] = bf_hi(raw[j].y);
            v[j][4] = bf_lo(raw[j].z); v[j][5] = bf_hi(raw[j].z); v[j][6] = bf_lo(raw[j].w); v[j][7] = bf_hi(raw[j].w);
#pragma unroll
            for (int e = 0; e < 8; ++e) s += v[j][e] * v[j][e];
        }
        const float rstd = 1.0f / sqrtf(wave_sum(s) * (1.0f / D) + EPS);
        f32x4* orow = (f32x4*)(out + (size_t)m * D + 8 * lane);
#pragma unroll
        for (int j = 0; j < 4; ++j) {
            orow[128 * j] = (f32x4){v[j][0] * rstd * gv[j][0].x, v[j][1] * rstd * gv[j][0].y, v[j][2] * rstd * gv[j][0].z, v[j][3] * rstd * gv[j][0].w};
            orow[128 * j + 1] = (f32x4){v[j][4] * rstd * gv[j][1].x, v[j][5] * rstd * gv[j][1].y, v[j][6] * rstd * gv[j][1].z, v[j][7] * rstd * gv[j][1].w};
        }
    }
}
__device__ __forceinline__ void ynorm_rows(bf16_t* y, const float* g_lru, const float* g_att, int gw, int NGW, int lane) {
    LAUNDER(lane);
    f32x4 gv[4][2];
#pragma unroll
    for (int j = 0; j < 4; ++j) { const float* gp = (j < 2 ? g_lru + 512 * j : g_att + 512 * (j - 2)) + 8 * lane; gv[j][0] = *(const f32x4*)gp; gv[j][1] = *(const f32x4*)(gp + 4); }
    for (int m = gw; m < M; m += NGW) {
        u32x4* yr = (u32x4*)(y + (size_t)m * D) + lane; u32x4 raw[4]; float s0 = 0.f, s1 = 0.f;
#pragma unroll
        for (int j = 0; j < 4; ++j) raw[j] = yr[64 * j];
        float v[4][8];
#pragma unroll
        for (int j = 0; j < 4; ++j) {
            v[j][0] = bf_lo(raw[j].x); v[j][1] = bf_hi(raw[j].x); v[j][2] = bf_lo(raw[j].y); v[j][3] = bf_hi(raw[j].y);
            v[j][4] = bf_lo(raw[j].z); v[j][5] = bf_hi(raw[j].z); v[j][6] = bf_lo(raw[j].w); v[j][7] = bf_hi(raw[j].w);
            float s = 0.f;
#pragma unroll
            for (int e = 0; e < 8; ++e) s += v[j][e] * v[j][e];
            if (j < 2) s0 += s; else s1 += s;
        }
        const float r0 = 1.0f / sqrtf(wave_sum(s0) * (1.0f / 1024.f) + EPS), r1 = 1.0f / sqrtf(wave_sum(s1) * (1.0f / 1024.f) + EPS);
#pragma unroll
        for (int j = 0; j < 4; ++j) { const float r = j < 2 ? r0 : r1; u32x4 w;
            w.x = cvt_pk_bf16(v[j][0] * r * gv[j][0].x, v[j][1] * r * gv[j][0].y); w.y = cvt_pk_bf16(v[j][2] * r * gv[j][0].z, v[j][3] * r * gv[j][0].w);
            w.z = cvt_pk_bf16(v[j][4] * r * gv[j][1].x, v[j][5] * r * gv[j][1].y); w.w = cvt_pk_bf16(v[j][6] * r * gv[j][1].z, v[j][7] * r * gv[j][1].w);
            yr[64 * j] = w; }
    }
}

constexpr int LM_BIAS = 0;
constexpr int LM_CW = 8448;
constexpr int LM_CB = 9472;
constexpr int LM_P = 10240;
constexpr int LM_H = 18432;
__device__ __forceinline__ void lru_unit(LAS unsigned char* lds, const bf16_t* zm, bf16_t* yraw, float* yp, const float* conv_w, const float* conv_b, const float* wa, const float* ba,
                                         const float* wx, const float* bx, const float* lam, int b, int hb, int tid) {
    LAUNDER(tid);
    const int lane = tid & 63, w = tid >> 6, fr = lane & 15, fq = lane >> 4;
    LAS float* cwL = (LAS float*)(lds + LM_CW); LAS float* cbL = (LAS float*)(lds + LM_CB);
    if (tid < 256) cwL[tid] = conv_w[(tid >> 6) * DL + hb * 64 + (tid & 63)];
    else if (tid < 320) cbL[tid - 256] = conv_b[hb * 64 + tid - 256];
    bf16x8 WA[4][2], WX[4][2];
#pragma unroll
    for (int nt = 0; nt < 4; ++nt)
#pragma unroll
        for (int ks = 0; ks < 2; ++ks) {
            const float* pa = wa + ((size_t)hb * 64 + ks * 32 + 8 * fq) * 64 + nt * 16 + fr; const float* px = wx + ((size_t)hb * 64 + ks * 32 + 8 * fq) * 64 + nt * 16 + fr;
            u32x4 ua, ux;
            ua.x = cvt_pk_bf16(pa[0 * 64], pa[1 * 64]); ua.y = cvt_pk_bf16(pa[2 * 64], pa[3 * 64]); ua.z = cvt_pk_bf16(pa[4 * 64], pa[5 * 64]); ua.w = cvt_pk_bf16(pa[6 * 64], pa[7 * 64]);
            ux.x = cvt_pk_bf16(px[0 * 64], px[1 * 64]); ux.y = cvt_pk_bf16(px[2 * 64], px[3 * 64]); ux.z = cvt_pk_bf16(px[4 * 64], px[5 * 64]); ux.w = cvt_pk_bf16(px[6 * 64], px[7 * 64]);
            WA[nt][ks] = __builtin_bit_cast(bf16x8, ua); WX[nt][ks] = __builtin_bit_cast(bf16x8, ux);
        }
    bf16x8 ID[2];
#pragma unroll
    for (int p = 0; p < 2; ++p)
#pragma unroll
        for (int e = 0; e < 8; ++e) ID[p][e] = (8 * fq + e == 16 * p + fr) ? (short)0x3F80 : (short)0;
    float pba[4], pbx[4], pcl[4];
#pragma unroll
    for (int nt = 0; nt < 4; ++nt) { const int c = hb * 64 + nt * 16 + fr; pba[nt] = ba[c]; pbx[nt] = bx[c]; pcl[nt] = -8.0f * log1pf(expf(-lam[c])); }
    __syncthreads();
    float hin[4] = {0.f, 0.f, 0.f, 0.f};
    const bf16_t* zb = zm + (size_t)b * SEQ * ZLD + hb * 64;
    LAS f32x2* TOT = (LAS f32x2*)(lds + LM_P);
    u32x4 XR[2][4], GR[2];
    {
        const int tA = 16 * w + fr;
#pragma unroll
        for (int ks = 0; ks < 2; ++ks) {
            const int ch0 = ks * 32 + 8 * fq;
#pragma unroll
            for (int tap = 0; tap < 4; ++tap) { const int t = tA - 3 + tap; const int tt = t >= 0 ? t : 0; XR[ks][tap] = *(const u32x4*)(zb + (size_t)tt * ZLD + ch0); }
            GR[ks] = *(const u32x4*)(zb + (size_t)tA * ZLD + 1024 + ch0);
        }
    }
#pragma unroll 1
    for (int sc = 0; sc < 16; ++sc) {
        const int tA = sc * 128 + 16 * w + fr;
        const int tN = sc < 15 ? tA + 128 : tA;
        u32x4 XN[2][4], GN[2];
#pragma unroll
        for (int ks = 0; ks < 2; ++ks) {
            const int ch0 = ks * 32 + 8 * fq;
#pragma unroll
            for (int tap = 0; tap < 4; ++tap) XN[ks][tap] = *(const u32x4*)(zb + (size_t)(tN - 3 + tap) * ZLD + ch0);
            GN[ks] = *(const u32x4*)(zb + (size_t)tN * ZLD + 1024 + ch0);
        }
        bf16x8 XC[2], GL[2];
#pragma unroll
        for (int ks = 0; ks < 2; ++ks) {
            const int ch0 = ks * 32 + 8 * fq;
            const f32x4 c0 = *(const LAS f32x4*)(cbL + ch0), c1 = *(const LAS f32x4*)(cbL + ch0 + 4);
            float a8[8] = {c0.x, c0.y, c0.z, c0.w, c1.x, c1.y, c1.z, c1.w};
#pragma unroll
            for (int tap = 0; tap < 4; ++tap) {
                const bool ok = (tA - 3 + tap) >= 0;
                u32x4 xr = XR[ks][tap];
                if (!ok) xr = (u32x4){0u, 0u, 0u, 0u};
                const f32x4 w0 = *(const LAS f32x4*)(cwL + tap * 64 + ch0), w1 = *(const LAS f32x4*)(cwL + tap * 64 + ch0 + 4);
                a8[0] += w0.x * bf_lo(xr.x); a8[1] += w0.y * bf_hi(xr.x); a8[2] += w0.z * bf_lo(xr.y); a8[3] += w0.w * bf_hi(xr.y);
                a8[4] += w1.x * bf_lo(xr.z); a8[5] += w1.y * bf_hi(xr.z); a8[6] += w1.z * bf_lo(xr.w); a8[7] += w1.w * bf_hi(xr.w);
            }
            u32x4 pk; pk.x = cvt_pk_bf16(a8[0], a8[1]); pk.y = cvt_pk_bf16(a8[2], a8[3]); pk.z = cvt_pk_bf16(a8[4], a8[5]); pk.w = cvt_pk_bf16(a8[6], a8[7]);
            XC[ks] = __builtin_bit_cast(bf16x8, pk);
            GL[ks] = __builtin_bit_cast(bf16x8, GR[ks]);
        }
        float hl[4][4], pc[4][4], gel[4][4], PE[4], HE[4];
        LAS f32x2* totw = TOT + ((sc & 1) * 8 + w) * 64;
#pragma unroll
        for (int nt = 0; nt < 4; ++nt) {
            f32x4 ga = (f32x4){0.f, 0.f, 0.f, 0.f}, gx = ga, xo = ga, go = ga;
#pragma unroll
            for (int ks = 0; ks < 2; ++ks) { ga = __builtin_amdgcn_mfma_f32_16x16x32_bf16(XC[ks], WA[nt][ks], ga, 0, 0, 0); gx = __builtin_amdgcn_mfma_f32_16x16x32_bf16(XC[ks], WX[nt][ks], gx, 0, 0, 0); }
            xo = __builtin_amdgcn_mfma_f32_16x16x32_bf16(XC[nt >> 1], ID[nt & 1], xo, 0, 0, 0);
            go = __builtin_amdgcn_mfma_f32_16x16x32_bf16(GL[nt >> 1], ID[nt & 1], go, 0, 0, 0);
#pragma unroll
            for (int hh = 0; hh < 2; ++hh) {
                const f32x2 ga2 = (f32x2){ga[2 * hh], ga[2 * hh + 1]}, gx2 = (f32x2){gx[2 * hh], gx[2 * hh + 1]}, xo2 = (f32x2){xo[2 * hh], xo[2 * hh + 1]}, go2 = (f32x2){go[2 * hh], go[2 * hh + 1]};
                const f32x2 ta = (ga2 + pba[nt]) * (-LOG2E), tx = (gx2 + pbx[nt]) * (-LOG2E);
                f32x2 da, dx; da.x = fast_exp2(ta.x); da.y = fast_exp2(ta.y); dx.x = fast_exp2(tx.x); dx.y = fast_exp2(tx.y);
                da = da + 1.0f; dx = dx + 1.0f;
                f32x2 r, ig; r.x = fast_rcp(da.x); r.y = fast_rcp(da.y); ig.x = fast_rcp(dx.x); ig.y = fast_rcp(dx.y);
                const f32x2 la2 = r * (pcl[nt] * LOG2E), x2 = r * (2.0f * pcl[nt]);
                f32x2 av; av.x = fast_exp2(la2.x); av.y = fast_exp2(la2.y);
                const f32x2 omp = -x2 * (x2 * 0.5f * (x2 * (1.0f / 3.0f) + 1.0f) + 1.0f), omd = 1.0f - av * av;
                f32x2 uv; uv.x = __builtin_amdgcn_sqrtf(x2.x < -0.03f ? omd.x : omp.x); uv.y = __builtin_amdgcn_sqrtf(x2.y < -0.03f ? omd.y : omp.y);
                uv = uv * ig * xo2;
                const f32x2 tg = go2 * (go2 * go2 * (-LOG2E * 1.5957691216057308f * 0.044715f) + (-LOG2E * 1.5957691216057308f));
                f32x2 dg; dg.x = fast_exp2(tg.x); dg.y = fast_exp2(tg.y); dg = dg + 1.0f;
                gel[nt][2 * hh] = go2.x * fast_rcp(dg.x); gel[nt][2 * hh + 1] = go2.y * fast_rcp(dg.y);
                if (hh == 0) { hl[nt][0] = uv.x; pc[nt][0] = av.x; }
                else { hl[nt][2] = av.x * hl[nt][1] + uv.x; pc[nt][2] = pc[nt][1] * av.x; }
                hl[nt][2 * hh + 1] = av.y * hl[nt][2 * hh] + uv.y; pc[nt][2 * hh + 1] = pc[nt][2 * hh] * av.y;
            }
            float P = pc[nt][3], H = hl[nt][3];
            { const float Pp = __shfl_up(P, 16), Hp = __shfl_up(H, 16); if (fq >= 1) { H = P * Hp + H; P = P * Pp; } }
            { const float Pp = __shfl_up(P, 32), Hp = __shfl_up(H, 32); if (fq >= 2) { H = P * Hp + H; P = P * Pp; } }
            { float Pe = __shfl_up(P, 16), He = __shfl_up(H, 16); if (fq == 0) { Pe = 1.0f; He = 0.0f; } PE[nt] = Pe; HE[nt] = He; }
            if (fq == 3) totw[nt * 16 + fr] = (f32x2){P, H};
        }
        asm volatile("s_waitcnt lgkmcnt(0)" ::: "memory"); __builtin_amdgcn_s_barrier(); asm volatile("" ::: "memory");
        float psq[4] = {0.f, 0.f, 0.f, 0.f};
#pragma unroll
        for (int nt = 0; nt < 4; ++nt) {
            float hrun = hin[nt], hws = hin[nt];
#pragma unroll
            for (int w2 = 0; w2 < 8; ++w2) { const f32x2 t2 = TOT[((sc & 1) * 8 + w2) * 64 + nt * 16 + fr]; hrun = t2.x * hrun + t2.y; if (w2 + 1 == w) hws = hrun; }
            hin[nt] = hrun;
            const float hs = PE[nt] * hws + HE[nt];
#pragma unroll
            for (int j = 0; j < 4; ++j) {
                const float ov = (hl[nt][j] + pc[nt][j] * hs) * gel[nt][j]; psq[j] += ov * ov;
                const unsigned o = cvt_pk_bf16(ov, 0.f);
                yraw[(size_t)(b * SEQ + sc * 128 + 16 * w + 4 * fq + j) * D + hb * 64 + nt * 16 + fr] = (bf16_t)(o & 0xffffu);
            }
        }
#pragma unroll
        for (int j = 0; j < 4; ++j) { float q = psq[j]; q += __shfl_xor(q, 1); q += __shfl_xor(q, 2); q += __shfl_xor(q, 4); q += __shfl_xor(q, 8);
            if (fr == 0) yp[(size_t)(b * SEQ + sc * 128 + 16 * w + 4 * fq + j) * 24 + hb] = q; }
#pragma unroll
        for (int ks = 0; ks < 2; ++ks) {
#pragma unroll
            for (int tap = 0; tap < 4; ++tap) XR[ks][tap] = XN[ks][tap];
            GR[ks] = GN[ks];
        }
    }
    __syncthreads();
}

constexpr int LM_ATT = 32768;
#define ATT_COMPUTE(FAR) do { \
        bf16x8 Kf[2][4], Vf[8]; \
        _Pragma("unroll") for (int t = 0; t < 2; ++t) _Pragma("unroll") for (int ks = 0; ks < 4; ++ks) Kf[t][ks] = *(const LAS bf16x8*)(sb + (t * 4 + ks) * 1024 + foff); \
        _Pragma("unroll") for (int dt = 0; dt < 8; ++dt) Vf[dt] = *(const LAS bf16x8*)(sb + 8192 + dt * 1024 + foff); \
        f32x4 St[2][2]; \
        _Pragma("unroll") for (int t = 0; t < 2; ++t) _Pragma("unroll") for (int qt = 0; qt < 2; ++qt) { f32x4 s_ = (f32x4){0.f, 0.f, 0.f, 0.f}; \
            _Pragma("unroll") for (int ks = 0; ks < 4; ++ks) s_ = __builtin_amdgcn_mfma_f32_16x16x32_bf16(Kf[t][ks], Q[qt][ks], s_, 0, 0, 0); \
            St[t][qt] = s_; } \
        bf16x8 Pf[2]; \
        _Pragma("unroll") for (int qt = 0; qt < 2; ++qt) { \
            const int qpos = c * 64 + qh * 32 + qt * 16 + fr; \
            float sv[8]; float bm = -1e30f; \
            _Pragma("unroll") for (int t = 0; t < 2; ++t) _Pragma("unroll") for (int j = 0; j < 4; ++j) { float bv_; \
                if (FAR) bv_ = bias0; else { int rel = k0 + 8 * fq + 4 * t + j - qpos; rel = rel < -128 ? -128 : (rel > 128 ? 128 : rel); bv_ = bias[rel + 128]; } \
                const float s_ = St[t][qt][j] * SC + bv_; sv[t * 4 + j] = s_; bm = fmaxf(bm, s_); } \
            bm = fmaxf(bm, __shfl_xor(bm, 16)); bm = fmaxf(bm, __shfl_xor(bm, 32)); \
            const float mn = (bm > mrun[qt] + 8.0f) ? bm : mrun[qt];     \
            if (__builtin_amdgcn_ballot_w64(mn != mrun[qt]) != 0ull) { const float alpha = fast_exp2(mrun[qt] - mn); mrun[qt] = mn; lrun[qt] = lrun[qt] * alpha; \
                _Pragma("unroll") for (int dt = 0; dt < 8; ++dt) O[dt][qt] = O[dt][qt] * alpha; } \
            float ps = 0.f; \
            _Pragma("unroll") for (int e = 0; e < 8; ++e) { sv[e] = fast_exp2(sv[e] - mn); ps += sv[e]; } \
            lrun[qt] = lrun[qt] + ps; \
            u32x4 pk; pk.x = cvt_pk_bf16(sv[0], sv[1]); pk.y = cvt_pk_bf16(sv[2], sv[3]); pk.z = cvt_pk_bf16(sv[4], sv[5]); pk.w = cvt_pk_bf16(sv[6], sv[7]); \
            Pf[qt] = __builtin_bit_cast(bf16x8, pk); } \
        _Pragma("unroll") for (int dt = 0; dt < 8; ++dt) _Pragma("unroll") for (int qt = 0; qt < 2; ++qt) O[dt][qt] = __builtin_amdgcn_mfma_f32_16x16x32_bf16(Vf[dt], Pf[qt], O[dt][qt], 0, 0, 0); \
    } while (0)
__device__ __forceinline__ void attn_block(LAS unsigned char* lds, const bf16_t* zm, const bf16_t* Kh, const bf16_t* Vt, bf16_t* yraw, float* yp, const LAS float* biasAll, int b, int h, int g, int tid) {
    LAUNDER(tid);
    const int lane = tid & 63, wave = tid >> 6, fr = lane & 15, fq = lane >> 4;
    const int c = 4 * g + (wave >> 1), qh = wave & 1;
    const LAS float* bias = biasAll + h * NREL;
    const float bias0 = bias[0];
    const float SC = 0.08838834764831845f * LOG2E;
    bf16x8 Q[2][4];
#pragma unroll
    for (int qt = 0; qt < 2; ++qt) { const size_t tok = (size_t)b * SEQ + c * 64 + qh * 32 + qt * 16 + fr;
#pragma unroll
        for (int ks = 0; ks < 4; ++ks) Q[qt][ks] = *(const bf16x8*)(zm + tok * ZLD + 2048 + h * HD + ks * 32 + 8 * fq); }
    f32x4 O[8][2];
#pragma unroll
    for (int dt = 0; dt < 8; ++dt)
#pragma unroll
        for (int qt = 0; qt < 2; ++qt) O[dt][qt] = (f32x4){0.f, 0.f, 0.f, 0.f};
    float mrun[2] = {-1e30f, -1e30f}, lrun[2] = {0.f, 0.f};
    const int lo = g >= 2 ? 4 * g - 8 : 0, nch = 4 * g + 4 - lo;
    const int kr = tid >> 4, c16 = tid & 15;
    const int krho = ((kr >> 3) << 2) | (kr & 3);
    const int kst = ((((kr >> 2) & 1) * 4 + (c16 >> 2)) * 1024) + ((krho * 64 + (c16 & 3) * 16) ^ (krho >= 8 ? 32 : 0));
    const bf16_t* kg = Kh + ((size_t)(b * NH + h) * SEQ + kr) * HD + 8 * c16;
    const int vd = tid >> 2, vq = tid & 3;
    const int vst = 8192 + (vd >> 4) * 1024 + (((vd & 15) * 64 + vq * 16) ^ ((vd & 15) >= 8 ? 32 : 0));
    const bf16_t* vg = Vt + ((size_t)(b * NH + h) * HD + vd) * SEQ + 8 * vq;
    const int foff = (fr * 64 + fq * 16) ^ (fr >= 8 ? 32 : 0);
    LAS unsigned char* st = lds + LM_ATT;
    { const int k0 = lo * 64;
      const u32x4 kv0 = *(const u32x4*)(kg + (size_t)k0 * HD), kv1 = *(const u32x4*)(kg + (size_t)(k0 + 32) * HD); const u32x4 vv0 = *(const u32x4*)(vg + k0), vv1 = *(const u32x4*)(vg + k0 + 32);
      *(LAS u32x4*)(st + kst) = kv0; *(LAS u32x4*)(st + vst) = vv0; *(LAS u32x4*)(st + 16384 + kst) = kv1; *(LAS u32x4*)(st + 16384 + vst) = vv1; }
    __syncthreads();
#pragma unroll 1
    for (int ci = 0; ci < nch; ++ci) {
        const int kc = lo + ci;
        const int k0n = (lo + (ci + 1 < nch ? ci + 1 : ci)) * 64;
        const u32x4 kv0 = *(const u32x4*)(kg + (size_t)k0n * HD), kv1 = *(const u32x4*)(kg + (size_t)(k0n + 32) * HD); const u32x4 vv0 = *(const u32x4*)(vg + k0n), vv1 = *(const u32x4*)(vg + k0n + 32);
        if (kc >= c - 8 && kc <= c) {
            const bool farc = kc <= c - 3;
#pragma unroll 1
            for (int hf = 0; hf < 2; ++hf) {
                const LAS unsigned char* sb = st + (ci & 1) * 32768 + hf * 16384; const int k0 = kc * 64 + hf * 32;
                if (farc) ATT_COMPUTE(true); else ATT_COMPUTE(false);
            }
        }
        LAS unsigned char* nb = st + ((ci + 1) & 1) * 32768;
        *(LAS u32x4*)(nb + kst) = kv0; *(LAS u32x4*)(nb + vst) = vv0; *(LAS u32x4*)(nb + 16384 + kst) = kv1; *(LAS u32x4*)(nb + 16384 + vst) = vv1;
        __syncthreads();
    }
#pragma unroll
    for (int qt = 0; qt < 2; ++qt) {
        float l = lrun[qt]; l += __shfl_xor(l, 16); l += __shfl_xor(l, 32);
        const float inv = 1.0f / l;
        bf16_t* op = yraw + ((size_t)b * SEQ + c * 64 + qh * 32 + qt * 16 + fr) * D + 1024 + h * HD + 4 * fq;
        float q = 0.f;
#pragma unroll
        for (int dt = 0; dt < 8; ++dt) { const f32x4 o = O[dt][qt] * inv; u32x2 w; w.x = cvt_pk_bf16(o.x, o.y); w.y = cvt_pk_bf16(o.z, o.w); *(u32x2*)(op + dt * 16) = w; q += (o.x * o.x + o.y * o.y) + (o.z * o.z + o.w * o.w); }
        q += __shfl_xor(q, 16); q += __shfl_xor(q, 32);
        if (fq == 0) yp[((size_t)b * SEQ + c * 64 + qh * 32 + qt * 16 + fr) * 24 + 16 + h] = q;
    }
}
#undef ATT_COMPUTE

#define XB_TMO      128
#define XB_XCNT(j)  (256  + 64 * (j))
#define XB_XSUB(j)  (1280 + 64 * (j))
#define XB_XGEN(j)  (2304 + 64 * (j))
#define XB_TOP      3328
#define XB_TOPGEN   3392
#define XCD_BAR_WORDS 3456
#define XB_SPIN_CAP (1u << 18)
__device__ __forceinline__ unsigned xb_ld(unsigned* p)              { return __hip_atomic_load(p, __ATOMIC_RELAXED, __HIP_MEMORY_SCOPE_AGENT); }
__device__ __forceinline__ unsigned xb_add(unsigned* p, unsigned v) { return __hip_atomic_fetch_add(p, v, __ATOMIC_RELAXED, __HIP_MEMORY_SCOPE_AGENT); }
__device__ __forceinline__ unsigned xb_xcc_id() { return (unsigned)__builtin_amdgcn_s_getreg((3 << 11) | 20) & 0xFu; }
#define XB_SPIN(cond, bar) do { unsigned _sp = 0; while (cond) { __builtin_amdgcn_s_sleep(1); \
    if ((++_sp & 255u) == 0u) { if (xb_ld(&(bar)[XB_TMO])) break; if (_sp > XB_SPIN_CAP) { atomicAdd(&(bar)[XB_TMO], 1u); break; } } } } while (0)
struct XcdBarrier { unsigned* bar; unsigned x; volatile LAS unsigned* st; };
__device__ __forceinline__ XcdBarrier xcd_barrier_post(unsigned* bar, volatile LAS unsigned* st) {
    XcdBarrier b; b.bar = bar; b.x = xb_xcc_id(); b.st = st;
    if (threadIdx.x == 0) (void)xb_add(&bar[XB_XCNT(b.x)], 1u);
    return b;
}
__device__ __forceinline__ void xcd_barrier_complete(unsigned* bar, unsigned x, unsigned& nloc, unsigned& nx) {
    const unsigned G = gridDim.x * gridDim.y * gridDim.z;
    unsigned sum, cnt, mine, sp = 0u;
    for (;;) {
        sum = 0u; cnt = 0u; mine = 0u;
#pragma unroll
        for (unsigned j = 0; j < 16; ++j) { const unsigned c = xb_ld(&bar[XB_XCNT(j)]); sum += c; cnt += (c > 0u) ? 1u : 0u; mine = (j == x) ? c : mine; }
        if (sum == G) break;
        __builtin_amdgcn_s_sleep(1);
        if ((++sp & 255u) == 0u) { if (xb_ld(&bar[XB_TMO])) break; if (sp > XB_SPIN_CAP) { atomicAdd(&bar[XB_TMO], 1u); break; } }
    }
    nloc = mine > 0u ? mine : 1u; nx = cnt > 0u ? cnt : 1u;
}
__device__ __forceinline__ void xcd_barrier(const XcdBarrier& b) {
    asm volatile("s_waitcnt vmcnt(0)" ::: "memory");
    __syncthreads();
    if (threadIdx.x == 0) {
        unsigned* bar = b.bar;
        __builtin_amdgcn_s_waitcnt(0);
        unsigned nloc = b.st[0], nx = b.st[1];
        if (nloc == 0u) { xcd_barrier_complete(bar, b.x, nloc, nx); b.st[0] = nloc; b.st[1] = nx; }
        const unsigned old = xb_add(&bar[XB_XSUB(b.x)], 1u);
        const unsigned gen = old / nloc;
        if (old + 1u == (gen + 1u) * nloc) {
            __builtin_amdgcn_fence(__ATOMIC_RELEASE, "agent");
            asm volatile("s_waitcnt vmcnt(0)" ::: "memory");
            const unsigned og = xb_add(&bar[XB_TOP], 1u);
            const unsigned tg = og / nx;
            if (og + 1u == (tg + 1u) * nx) xb_add(&bar[XB_TOPGEN], 1u);
            else XB_SPIN(xb_ld(&bar[XB_TOPGEN]) == tg, bar);
            __builtin_amdgcn_fence(__ATOMIC_ACQUIRE, "agent");
            xb_add(&bar[XB_XGEN(b.x)], 1u);
            asm volatile("s_waitcnt vmcnt(0)" ::: "memory");
        } else {
            XB_SPIN(xb_ld(&bar[XB_XGEN(b.x)]) == gen, bar);
            __builtin_amdgcn_fence(__ATOMIC_ACQUIRE, "agent");
            asm volatile("s_waitcnt vmcnt(0)" ::: "memory");
        }
    }
    __syncthreads();
}

struct Args { const float* in[23]; float* out; unsigned char* ws; int pad0, pad1; };

__global__ void __launch_bounds__(NTHREADS, 2) mk_fwd(Args args) {
    extern __shared__ __attribute__((aligned(16))) unsigned char lds_raw[];
    LAS unsigned char* lds = (LAS unsigned char*)lds_raw;
    cg::grid_group grid = cg::this_grid();
    const int tid = threadIdx.x, lane = tid & 63, wave = __builtin_amdgcn_readfirstlane(tid >> 6);
    const int G = gridDim.x, bx = blockIdx.x;
    const int gw = bx * NWAVES + wave, NGW = G * NWAVES;
    typedef const float* cfp;
    const __attribute__((address_space(4))) cfp* inp = (const __attribute__((address_space(4))) cfp*)__builtin_amdgcn_kernarg_segment_ptr();
#define INP(k) (inp[k])
#define LAUNDER_S(v) asm volatile("" : "+s"(v))
    unsigned char* ws = args.ws;
    float* out = args.out;
    volatile LAS unsigned* bst = (volatile LAS unsigned*)(lds + 131072 + 64);
    if (tid < 2) bst[tid] = 0u;
    __syncthreads();
    if (bx == 0) for (int i = tid; i < XCD_BAR_WORDS; i += NTHREADS) ((unsigned*)(ws + WS_CTL))[i] = 0u;
#define GRID_BAR() do { XcdBarrier xb_; xb_.bar = (unsigned*)(args.ws + WS_CTL); xb_.x = xb_xcc_id(); xb_.st = (volatile LAS unsigned*)(lds + 131072 + 64); xcd_barrier(xb_); } while (0)
    bf16_t* HID = (bf16_t*)(ws + WS_BIG); bf16_t* ZM = (bf16_t*)(ws + WS_BIG); bf16_t* VT = (bf16_t*)(ws + WS_VT); bf16_t* KH = (bf16_t*)(ws + WS_KH); bf16_t* HB = (bf16_t*)(ws + WS_H); bf16_t* HB2 = (bf16_t*)(ws + WS_H2); float* SSQ = (float*)(ws + WS_SSQ); float* YP = (float*)(ws + WS_YP);

    {
        LAS float* scr = (LAS float*)(lds + wave * 16384);
        constexpr int I_G = (D / 64) * (FF / 32), I_D = (FF / 64) * (D / 32), I_IN = (D / 64) * (DIN / 32), I_O = (D / 64) * (D / 32);
        constexpr int PER_LAYER = 4 * I_G + 2 * I_D + I_IN + I_O;
        for (int it = gw; it < DEPTH * PER_LAYER; it += NGW) {
            const int l = it / PER_LAYER; int r = it % PER_LAYER;
            unsigned char* wl = ws + (size_t)l * LAYER_W;
            if (r < I_G) { p0_transpose_item(INP(2) + (size_t)l * D * FF, INP(1) + (size_t)l * D, D, FF, (bf16_t*)(wl + OFF_WGU1), 0, scr, r, lane); continue; } r -= I_G;
            if (r < I_G) { p0_transpose_item(INP(3) + (size_t)l * D * FF, INP(1) + (size_t)l * D, D, FF, (bf16_t*)(wl + OFF_WGU1), 128, scr, r, lane); continue; } r -= I_G;
            if (r < I_D) { p0_transpose_item(INP(4) + (size_t)l * FF * D, nullptr, FF, D, (bf16_t*)(wl + OFF_WD1), -1, scr, r, lane); continue; } r -= I_D;
            if (r < I_IN) { p0_transpose_item(INP(6) + (size_t)l * D * DIN, INP(5) + (size_t)l * D, D, DIN, (bf16_t*)(wl + OFF_WIN), -1, scr, r, lane); continue; } r -= I_IN;
            if (r < I_O) { p0_transpose_item(INP(17) + (size_t)l * D * D, INP(15) + (size_t)l * DL, D, D, (bf16_t*)(wl + OFF_WOUT), -1, scr, r, lane, INP(16) + (size_t)l * DL); continue; } r -= I_O;
            if (r < I_G) { p0_transpose_item(INP(19) + (size_t)l * D * FF, INP(18) + (size_t)l * D, D, FF, (bf16_t*)(wl + OFF_WGU2), 0, scr, r, lane); continue; } r -= I_G;
            if (r < I_G) { p0_transpose_item(INP(20) + (size_t)l * D * FF, INP(18) + (size_t)l * D, D, FF, (bf16_t*)(wl + OFF_WGU2), 128, scr, r, lane); continue; } r -= I_G;
            p0_transpose_item(INP(21) + (size_t)l * FF * D, nullptr, FF, D, (bf16_t*)(wl + OFF_WD2), -1, scr, r, lane);
        }
        cast_rows_bf16(INP(0), HB, SSQ, gw, NGW, lane);
    }
    grid.sync();
    (void)xcd_barrier_post((unsigned*)(ws + WS_CTL), bst);

#pragma unroll 1
    for (int l = 0; l < DEPTH; ++l) {
        unsigned char* wl = ws + (size_t)l * LAYER_W;
#pragma unroll 1
        for (int f = 0; f < 2; ++f) {
            LAUNDER_S(inp);
            {
                pg8::Gemm g{HB, (const bf16_t*)(wl + (f ? OFF_WGU2 : OFF_WGU1)), M, 2 * FF, D}; pg8::StaticOrder S; S.init(M, 2 * FF, G, bx);
                { if (tid == 0) *(volatile LAS int*)(lds + pg8::LDS_RSPM) = -1; __syncthreads(); }
                pg8::EpiSwiGLU E{HID, FF, SSQ + (size_t)(3 * l + (f ? 2 : 0)) * M * 8, lds};
                pg8::gemm_phase<pg8::EpiSwiGLU, pg8::StaticOrder, true, true>(lds, g, S, E);
            }
            GRID_BAR();
            {
                pg8::Gemm g{HID, (const bf16_t*)(wl + (f ? OFF_WD2 : OFF_WD1)), M, D, FF}; pg8::StaticOrder S; S.init(M, D, G, bx);
                pg8::EpiResid<true> E{HB, SSQ + (size_t)(3 * l + (f ? 3 : 1)) * M * 8, lds};
                pg8::gemm_phase<pg8::EpiResid<true>, pg8::StaticOrder, true, true>(lds, g, S, E);
            }
            GRID_BAR();
            if (f == 0) {
                {
                    pg8::Gemm g{HB, (const bf16_t*)(wl + OFF_WIN), M, DIN, D}; pg8::StaticOrder S; S.init(M, DIN, G, bx);
                    { if (tid == 0) *(volatile LAS int*)(lds + pg8::LDS_RSPM) = -1; __syncthreads(); }
                    pg8::EpiZ E{ZM, VT, KH, SSQ + (size_t)(3 * l + 1) * M * 8, lds};
                    pg8::gemm_phase<pg8::EpiZ, pg8::StaticOrder, true, true>(lds, g, S, E);
                }
                GRID_BAR();
                {
                    LAS float* biasL = (LAS float*)(lds + LM_BIAS);
                    const float* rb = INP(14) + (size_t)l * NH * NREL;
                    int tid_m = tid; LAUNDER(tid_m);
                    for (int i = tid_m; i < NH * NREL; i += NTHREADS) biasL[i] = rb[i] * LOG2E;
                    __syncthreads();
                    for (int u = bx; u < NB * 16; u += G)
                        lru_unit(lds, ZM, HB2, YP, INP(7) + (size_t)l * 4 * DL, INP(8) + (size_t)l * DL, INP(9) + (size_t)l * 16 * 64 * 64, INP(10) + (size_t)l * DL,
                                 INP(11) + (size_t)l * 16 * 64 * 64, INP(12) + (size_t)l * DL, INP(13) + (size_t)l * DL, u >> 4, u & 15, tid);
                    for (int bu = bx; bu < 1024; bu += G) {
                        const int kk = bu >> 8, bxv = bu & 255;
                        const int ag = ((bxv & 7) + 2 * kk) & 7, ap = (bxv >> 3) + 32 * kk;
                        attn_block(lds, ZM, KH, VT, HB2, YP, biasL, ap >> 3, ap & 7, ag, tid);
                    }
                }
                GRID_BAR();
                {
                    pg8::Gemm g{HB2, (const bf16_t*)(wl + OFF_WOUT), M, D, D}; pg8::StaticOrder S; S.init(M, D, G, bx);
                    { if (tid == 0) *(volatile LAS int*)(lds + pg8::LDS_RS2PM) = -1; __syncthreads(); }
                    pg8::EpiResidY E{HB, SSQ + (size_t)(3 * l + 2) * M * 8, YP, lds};
                    { pg8::Unit u0; if (S.next(0, u0)) E.prep(u0); }
                    pg8::gemm_phase<pg8::EpiResidY, pg8::StaticOrder, true, true>(lds, g, S, E);
                }
                GRID_BAR();
            } else {
                if (l + 1 == DEPTH) rms_rows_bf16_to_f32(HB, INP(22), out, gw, NGW, lane);
            }
        }
    }
}

extern "C" void kernel_launch(void* const* d_in, const int* in_sizes, int n_in, void* d_out, int out_size, void* d_ws, size_t ws_size, hipStream_t stream) {
    static int grid = 0;
    if (grid == 0) {
        if (n_in != 23 || in_sizes[0] != M * D || out_size != M * D || ws_size < WS_END) {
            fprintf(stderr, "kernel_launch: unexpected shapes: n_in %d in0 %d out %d ws %zu (need %zu)\n", n_in, n_in > 0 ? in_sizes[0] : -1, out_size, ws_size, (size_t)WS_END); grid = -1; return; }
        int dev = 0, cus = 0, per_cu = 0;
        hipGetDevice(&dev); hipDeviceGetAttribute(&cus, hipDeviceAttributeMultiprocessorCount, dev);
        if (hipFuncSetAttribute((const void*)mk_fwd, hipFuncAttributeMaxDynamicSharedMemorySize, LDS_BYTES) != hipSuccess) fprintf(stderr, "kernel_launch: hipFuncSetAttribute failed\n");
        if (hipOccupancyMaxActiveBlocksPerMultiprocessor(&per_cu, (const void*)mk_fwd, NTHREADS, LDS_BYTES) != hipSuccess || per_cu < 1) { fprintf(stderr, "kernel_launch: occupancy query gave %d\n", per_cu); per_cu = 1; }
        (void)hipGetLastError();
        grid = cus * per_cu;
        if (grid > 256) grid = 256;
    }
    if (grid < 0) return;
    Args a{};
    for (int i = 0; i < 23; ++i) a.in[i] = (const float*)d_in[i];
    a.out = (float*)d_out; a.ws = (unsigned char*)d_ws;
    void* kargs[] = {&a};
    hipError_t e = hipLaunchCooperativeKernel((const void*)mk_fwd, dim3(grid), dim3(NTHREADS), kargs, LDS_BYTES, stream);
    if (e != hipSuccess) fprintf(stderr, "kernel_launch: cooperative launch failed: %s (grid %d)\n", hipGetErrorString(e), grid);
}
```

```cpp
#include <hip/hip_runtime.h>
#include <hip/hip_cooperative_groups.h>
#include <cstdio>
#include <cstdint>
namespace cg = cooperative_groups;

#define LAS __attribute__((address_space(3)))
#define LAUNDER(v) asm volatile("" : "+v"(v))
typedef unsigned short bf16_t;
typedef short bf16x8 __attribute__((ext_vector_type(8)));
typedef float f32x4 __attribute__((ext_vector_type(4)));
typedef float f32x2 __attribute__((ext_vector_type(2)));
typedef unsigned u32x4 __attribute__((ext_vector_type(4)));
typedef unsigned u32x2 __attribute__((ext_vector_type(2)));

constexpr int NB = 16, SEQ = 2048, M = NB * SEQ, D = 2048, FF = 5632, DIN = 5120, DL = 1024, NH = 8, HD = 128, NREL = 257, DEPTH = 2;
constexpr int ZLD = 3072;
constexpr float EPS = 1e-6f;
constexpr float LOG2E = 1.4426950408889634f;

constexpr size_t MiB = 1u << 20;
constexpr size_t SZ_WGU = (size_t)2 * FF * D * 2, SZ_WD = (size_t)D * FF * 2, SZ_WIN = (size_t)DIN * D * 2, SZ_WOUT = (size_t)D * D * 2;
constexpr size_t OFF_WGU1 = 0, OFF_WD1 = OFF_WGU1 + SZ_WGU, OFF_WIN = OFF_WD1 + SZ_WD, OFF_WOUT = OFF_WIN + SZ_WIN, OFF_WGU2 = OFF_WOUT + SZ_WOUT, OFF_WD2 = OFF_WGU2 + SZ_WGU;
constexpr size_t LAYER_W = OFF_WD2 + SZ_WD;
static_assert(LAYER_W == 160 * MiB, "weights per layer");
constexpr size_t WS_BIG = 2 * LAYER_W;
constexpr size_t WS_VT = WS_BIG + (size_t)M * ZLD * 2;
constexpr size_t WS_KH = WS_VT + (size_t)M * 1024 * 2;
constexpr size_t WS_H = WS_BIG + 352 * MiB;
constexpr size_t WS_H2 = WS_H + 128 * MiB;
constexpr size_t WS_SSQ = WS_H2 + 128 * MiB;
constexpr size_t WS_YP = WS_SSQ + 8 * MiB;
constexpr size_t WS_CTL = WS_YP + 4 * MiB;
constexpr size_t CTL_BYTES = 16384;
constexpr size_t WS_END = WS_CTL + 1 * MiB;
static_assert((size_t)M * FF * 2 == 352 * MiB, "hidden size");

constexpr int NWAVES = 8, NTHREADS = 512;
constexpr int LDS_BYTES = 147456;

__device__ __forceinline__ unsigned cvt_pk_bf16(float lo, float hi) { unsigned r; asm volatile("v_cvt_pk_bf16_f32 %0, %1, %2" : "=v"(r) : "v"(lo), "v"(hi)); return r; }
__device__ __forceinline__ float bf_lo(unsigned u) { return __uint_as_float(u << 16); }
__device__ __forceinline__ float bf_hi(unsigned u) { return __uint_as_float(u & 0xffff0000u); }
__device__ __forceinline__ float fast_exp2(float x) { return __builtin_amdgcn_exp2f(x); }
__device__ __forceinline__ float fast_rcp(float x) { return __builtin_amdgcn_rcpf(x); }
__device__ __forceinline__ float sigmoidf_(float x) { return fast_rcp(1.0f + fast_exp2(-LOG2E * x)); }

namespace pg8 {
constexpr int BM = 256, BK = 64, HALF = 128, HTB = HALF * BK * 2, STAGE_BYTES = 8 * HTB, NXCD = 8, WGM = 4;
__host__ __device__ __forceinline__ int lds_byte(int r, int c) { const int st = (r >> 4) * 2 + (c >> 5), rr = r & 15, cc = c & 31, ob = rr * 64 + cc * 2; return st * 1024 + (ob ^ (((ob >> 9) & 1) << 5)); }
__host__ __device__ __forceinline__ void stage_rc(int b, int& R, int& C) { const int st = b / 1024, sb = b % 1024, swz = sb ^ (((sb >> 9) & 1) << 5); R = (st >> 1) * 16 + swz / 64; C = (st & 1) * 32 + (swz % 64) / 2; }
__host__ __device__ __forceinline__ int perm32(int rho) { const int n = rho >> 4, i = rho & 15; return 8 * (i >> 2) + 4 * n + (i & 3); }

struct Unit { int pm, pn; };
struct Gemm { const bf16_t* A; const bf16_t* Bt; int M, N, K; };

struct StaticOrder {
    int nM, nN, nwg, G, c;
    __host__ __device__ void init(int M_, int N_, int G_, int c_) { nM = M_ / BM; nN = N_ / BM; nwg = nM * nN; G = G_; c = c_; }
    __host__ __device__ bool next(int i, Unit& u) const {
        const long L = (long)i * G + c; if (L >= nwg) return false;
        int wgid = (int)L; { const int q = nwg / NXCD, r = nwg % NXCD, xcd = wgid % NXCD, off = wgid / NXCD; wgid = (xcd < r ? xcd * (q + 1) : r * (q + 1) + (xcd - r) * q) + off; }
        const int nig = WGM * nN, gid = wgid / nig, fm = gid * WGM, gsz = (nM - fm) < WGM ? (nM - fm) : WGM;
        u.pm = fm + ((wgid % nig) % gsz); u.pn = (wgid % nig) / gsz; return true;
    }
    __device__ __forceinline__ void a_ready(const Unit&) const {}
    __device__ __forceinline__ void done(const Unit&) const {}
};


constexpr int LDS_RS = 131072 + 1024, LDS_RSPM = 131072 + 2048 + 64, LDS_SSP = 131072 + 4096;
__device__ __forceinline__ void rs_panel(LAS unsigned char* lds, const float* ssq, int pm) {
    volatile LAS int* pmL = (volatile LAS int*)(lds + LDS_RSPM); LAS float* rsL = (LAS float*)(lds + LDS_RS);
    if (pmL[0] != pm) {
        asm volatile("s_waitcnt lgkmcnt(0)" ::: "memory"); __builtin_amdgcn_s_barrier();
        const int t = threadIdx.x;
        if (t < 256) { const f32x4* pp = (const f32x4*)(ssq + (size_t)(pm * 256 + t) * 8); const f32x4 pa = pp[0], pb = pp[1];
            rsL[t] = __builtin_amdgcn_rsqf((((pa.x + pa.y) + (pa.z + pa.w)) + ((pb.x + pb.y) + (pb.z + pb.w))) * (1.0f / D) + EPS); }
        if (t == 0) pmL[0] = pm;
        asm volatile("s_waitcnt vmcnt(0) lgkmcnt(0)" ::: "memory"); __builtin_amdgcn_s_barrier();
    }
}
struct EpiSwiGLU {
    static constexpr bool PERM = true, AFTER_DRAIN = false, MIDK = false;
    bf16_t* O; int ldc; const float* ssq; LAS unsigned char* lds;
    __device__ __forceinline__ void operator()(const f32x4 (&acc)[2][2][4][2], const Unit& u, int wr, int wc, int fr, int fq) const {
        rs_panel(lds, ssq, u.pm);
        const LAS float* rsL = (const LAS float*)(lds + LDS_RS) + wr * 64 + fr;
        const int row0 = u.pm * BM + wr * 64 + fr; const int col0 = u.pn * HALF + wc * 32 + 8 * fq;
#pragma unroll
        for (int ai = 0; ai < 2; ++ai)
#pragma unroll
            for (int m = 0; m < 4; ++m) {
                bf16_t* rowp = O + (size_t)(row0 + ai * HALF + m * 16) * ldc + col0;
                const float rs = rsL[ai * HALF + m * 16];
                const float c1 = -LOG2E * rs, rs2 = rs * rs;
                float v[8];
#pragma unroll
                for (int n = 0; n < 2; ++n)
#pragma unroll
                    for (int hh = 0; hh < 2; ++hh) {
                        const f32x2 a2 = (f32x2){acc[ai][0][m][n][2 * hh], acc[ai][0][m][n][2 * hh + 1]}, b2 = (f32x2){acc[ai][1][m][n][2 * hh], acc[ai][1][m][n][2 * hh + 1]};
                        const f32x2 t2 = a2 * c1;
                        f32x2 d2; d2.x = fast_exp2(t2.x); d2.y = fast_exp2(t2.y); d2 = d2 + 1.0f;
                        f32x2 s2; s2.x = fast_rcp(d2.x); s2.y = fast_rcp(d2.y);
                        const f32x2 v2 = (a2 * b2) * (s2 * rs2);
                        v[n * 4 + 2 * hh] = v2.x; v[n * 4 + 2 * hh + 1] = v2.y; }
                u32x4 w; w.x = cvt_pk_bf16(v[0], v[1]); w.y = cvt_pk_bf16(v[2], v[3]); w.z = cvt_pk_bf16(v[4], v[5]); w.w = cvt_pk_bf16(v[6], v[7]);
                *(u32x4*)rowp = w;
            }
    }
};
template <bool HALFSC> struct EpiResid {
    static constexpr bool PERM = false, AFTER_DRAIN = false, MIDK = false;
    bf16_t* xb; float* ssq_part; LAS unsigned char* lds;
    __device__ __forceinline__ void operator()(const f32x4 (&acc)[2][2][4][2], const Unit& u, int wr, int wc, int fr, int fq) const {
        const float scale_ = HALFSC ? 0.5f : 1.0f; bf16_t* const xb_ = xb; float* const ssq_ = ssq_part;
        LAS float* pl = (LAS float*)(lds + LDS_SSP);
        const int col0 = u.pn * BM + wc * 32 + 4 * fq;
        const size_t base = (size_t)(u.pm * BM + wr * 64 + fr) * D + col0;
        u32x2 r[2][2][2][2];
#define ER_LOAD(buf, bb) do { _Pragma("unroll") for (int mm = 0; mm < 2; ++mm) _Pragma("unroll") for (int bj = 0; bj < 2; ++bj) _Pragma("unroll") for (int n = 0; n < 2; ++n) \
            r[buf][mm][bj][n] = *(const u32x2*)(xb_ + base + (size_t)(((bb) >> 1) * HALF + (((bb) & 1) * 2 + mm) * 16) * D + bj * HALF + n * 16); } while (0)
        ER_LOAD(0, 0);
#pragma unroll
        for (int bb = 0; bb < 4; ++bb) {
            if (bb < 3) ER_LOAD((bb + 1) & 1, bb + 1);
            const int ai = bb >> 1;
#pragma unroll
            for (int mm = 0; mm < 2; ++mm) { const int m = (bb & 1) * 2 + mm; const int rowl = ai * HALF + m * 16; const size_t off = base + (size_t)rowl * D; float ssum = 0.f;
#pragma unroll
                for (int bj = 0; bj < 2; ++bj)
#pragma unroll
                    for (int n = 0; n < 2; ++n) { const u32x2 rr = r[bb & 1][mm][bj][n]; const f32x4 a = acc[ai][bj][m][n];
                        const float o0 = bf_lo(rr.x) + a.x * scale_, o1 = bf_hi(rr.x) + a.y * scale_, o2 = bf_lo(rr.y) + a.z * scale_, o3 = bf_hi(rr.y) + a.w * scale_;
                        u32x2 w; w.x = cvt_pk_bf16(o0, o1); w.y = cvt_pk_bf16(o2, o3); *(u32x2*)(xb_ + off + bj * HALF + n * 16) = w;
                        ssum += (o0 * o0 + o1 * o1) + (o2 * o2 + o3 * o3); }
                ssum += __shfl_xor(ssum, 16); ssum += __shfl_xor(ssum, 32);
                if (fq == 0) pl[(rowl + wr * 64 + fr) * 4 + wc] = ssum;
            }
        }
#undef ER_LOAD
        asm volatile("s_waitcnt lgkmcnt(0)" ::: "memory"); __builtin_amdgcn_s_barrier();
        const int t = threadIdx.x;
        if (t < 256) { const f32x4 p = *(const LAS f32x4*)(pl + t * 4); ssq_[(size_t)(u.pm * BM + t) * 8 + u.pn] = (p.x + p.y) + (p.z + p.w); }
    }
};
constexpr int LDS_RS2 = 131072 + 8192, LDS_RS2PM = 131072 + 8192 + 2048 + 64;
__device__ __forceinline__ void rs2_panel(LAS unsigned char* lds, const float* yp, int pm) {
    volatile LAS int* pmL = (volatile LAS int*)(lds + LDS_RS2PM); LAS f32x2* rsL = (LAS f32x2*)(lds + LDS_RS2);
    if (pmL[0] != pm) {
        asm volatile("s_waitcnt lgkmcnt(0)" ::: "memory"); __builtin_amdgcn_s_barrier();
        const int t = threadIdx.x;
        if (t < 256) { const f32x4* pp = (const f32x4*)(yp + (size_t)(pm * 256 + t) * 24);
            const f32x4 a0 = pp[0], a1 = pp[1], a2 = pp[2], a3 = pp[3], b0 = pp[4], b1 = pp[5];
            const float sl = (((a0.x + a0.y) + (a0.z + a0.w)) + ((a1.x + a1.y) + (a1.z + a1.w))) + (((a2.x + a2.y) + (a2.z + a2.w)) + ((a3.x + a3.y) + (a3.z + a3.w)));
            const float sa = ((b0.x + b0.y) + (b0.z + b0.w)) + ((b1.x + b1.y) + (b1.z + b1.w));
            const float va = sa * (1.0f / 1024.f) + EPS, vl = sl * (1.0f / 1024.f) + EPS;
            rsL[t] = (f32x2){__builtin_amdgcn_rsqf(va), __builtin_amdgcn_rsqf(vl) * sqrtf(va)}; }
        if (t == 0) pmL[0] = pm;
        asm volatile("s_waitcnt vmcnt(0) lgkmcnt(0)" ::: "memory"); __builtin_amdgcn_s_barrier();
    }
}
struct EpiResidY {
    static constexpr bool PERM = false, AFTER_DRAIN = false, MIDK = true;
    bf16_t* xb; float* ssq_part; const float* yp; LAS unsigned char* lds;
    __device__ __forceinline__ void prep(const Unit& u) const { rs2_panel(lds, yp, u.pm); }
    __device__ __forceinline__ void mid(f32x4 (&acc)[2][2][4][2], const Unit& u, int wr, int wc, int fr, int fq) const {
        const LAS f32x2* rsL = (const LAS f32x2*)(lds + LDS_RS2) + wr * 64 + fr;
#pragma unroll
        for (int ai = 0; ai < 2; ++ai)
#pragma unroll
            for (int m = 0; m < 4; ++m) { const float q = rsL[ai * HALF + m * 16].y;
#pragma unroll
                for (int bj = 0; bj < 2; ++bj)
#pragma unroll
                    for (int n = 0; n < 2; ++n) acc[ai][bj][m][n] = acc[ai][bj][m][n] * q; }
    }
    __device__ __forceinline__ void operator()(const f32x4 (&acc)[2][2][4][2], const Unit& u, int wr, int wc, int fr, int fq) const {
        bf16_t* const xb_ = xb; float* const ssq_ = ssq_part;
        LAS float* pl = (LAS float*)(lds + LDS_SSP);
        const LAS f32x2* rsL = (const LAS f32x2*)(lds + LDS_RS2) + wr * 64 + fr;
        const int col0 = u.pn * BM + wc * 32 + 4 * fq;
        const size_t base = (size_t)(u.pm * BM + wr * 64 + fr) * D + col0;
        u32x2 r[2][2][2][2];
#define ER_LOAD(buf, bb) do { _Pragma("unroll") for (int mm = 0; mm < 2; ++mm) _Pragma("unroll") for (int bj = 0; bj < 2; ++bj) _Pragma("unroll") for (int n = 0; n < 2; ++n) \
            r[buf][mm][bj][n] = *(const u32x2*)(xb_ + base + (size_t)(((bb) >> 1) * HALF + (((bb) & 1) * 2 + mm) * 16) * D + bj * HALF + n * 16); } while (0)
        ER_LOAD(0, 0);
#pragma unroll
        for (int bb = 0; bb < 4; ++bb) {
            if (bb < 3) ER_LOAD((bb + 1) & 1, bb + 1);
            const int ai = bb >> 1;
#pragma unroll
            for (int mm = 0; mm < 2; ++mm) { const int m = (bb & 1) * 2 + mm; const int rowl = ai * HALF + m * 16; const size_t off = base + (size_t)rowl * D; float ssum = 0.f;
                const float scale_ = rsL[rowl].x;
#pragma unroll
                for (int bj = 0; bj < 2; ++bj)
#pragma unroll
                    for (int n = 0; n < 2; ++n) { const u32x2 rr = r[bb & 1][mm][bj][n]; const f32x4 a = acc[ai][bj][m][n];
                        const float o0 = bf_lo(rr.x) + a.x * scale_, o1 = bf_hi(rr.x) + a.y * scale_, o2 = bf_lo(rr.y) + a.z * scale_, o3 = bf_hi(rr.y) + a.w * scale_;
                        u32x2 w; w.x = cvt_pk_bf16(o0, o1); w.y = cvt_pk_bf16(o2, o3); *(u32x2*)(xb_ + off + bj * HALF + n * 16) = w;
                        ssum += (o0 * o0 + o1 * o1) + (o2 * o2 + o3 * o3); }
                ssum += __shfl_xor(ssum, 16); ssum += __shfl_xor(ssum, 32);
                if (fq == 0) pl[(rowl + wr * 64 + fr) * 4 + wc] = ssum;
            }
        }
#undef ER_LOAD
        asm volatile("s_waitcnt lgkmcnt(0)" ::: "memory"); __builtin_amdgcn_s_barrier();
        const int t = threadIdx.x;
        if (t < 256) { const f32x4 p = *(const LAS f32x4*)(pl + t * 4); ssq_[(size_t)(u.pm * BM + t) * 8 + u.pn] = (p.x + p.y) + (p.z + p.w); }
    }
};
struct EpiZ {
    static constexpr bool PERM = true, AFTER_DRAIN = false, MIDK = false;
    bf16_t* Z; bf16_t* Vt; bf16_t* Kh; const float* ssq; LAS unsigned char* lds;
    __device__ __forceinline__ void operator()(const f32x4 (&acc)[2][2][4][2], const Unit& u, int wr, int wc, int fr, int fq) const {
        rs_panel(lds, ssq, u.pm);
        float rs[2][4];
        { const LAS float* rsL = (const LAS float*)(lds + LDS_RS) + wr * 64 + fr;
#pragma unroll
          for (int ai = 0; ai < 2; ++ai)
#pragma unroll
            for (int m = 0; m < 4; ++m) rs[ai][m] = rsL[ai * HALF + m * 16]; }
        if (u.pn >= 12 && u.pn < 16) {
            const int b = (u.pm * BM) / SEQ; const int s0 = (u.pm * BM) % SEQ + wr * 64 + fr;
#pragma unroll
            for (int bj = 0; bj < 2; ++bj) {
                const int head = (u.pn - 12) * 2 + bj;
                bf16_t* hb = Kh + ((size_t)(b * NH + head) * SEQ + s0) * HD + wc * 32 + 8 * fq;
#pragma unroll
                for (int ai = 0; ai < 2; ++ai)
#pragma unroll
                    for (int m = 0; m < 4; ++m) { const f32x4 v0 = acc[ai][bj][m][0] * rs[ai][m], v1 = acc[ai][bj][m][1] * rs[ai][m];
                        u32x4 w; w.x = cvt_pk_bf16(v0[0], v0[1]); w.y = cvt_pk_bf16(v0[2], v0[3]); w.z = cvt_pk_bf16(v1[0], v1[1]); w.w = cvt_pk_bf16(v1[2], v1[3]);
                        *(u32x4*)(hb + (size_t)(ai * HALF + m * 16) * HD) = w; }
            }
        } else if (u.pn < 12) {
            const int row0 = u.pm * BM + wr * 64 + fr; const int col0 = u.pn * BM + wc * 32 + 8 * fq;
#pragma unroll
            for (int ai = 0; ai < 2; ++ai)
#pragma unroll
                for (int m = 0; m < 4; ++m) {
                    bf16_t* rowp = Z + (size_t)(row0 + ai * HALF + m * 16) * ZLD + col0;
#pragma unroll
                    for (int bj = 0; bj < 2; ++bj) { const f32x4 v0 = acc[ai][bj][m][0] * rs[ai][m], v1 = acc[ai][bj][m][1] * rs[ai][m];
                        u32x4 w; w.x = cvt_pk_bf16(v0[0], v0[1]); w.y = cvt_pk_bf16(v0[2], v0[3]); w.z = cvt_pk_bf16(v1[0], v1[1]); w.w = cvt_pk_bf16(v1[2], v1[3]);
                        *(u32x4*)(rowp + bj * HALF) = w; }
                }
        } else {
            const int b = (u.pm * BM) / SEQ; const int s0 = (u.pm * BM) % SEQ + wr * 64 + fr;
#pragma unroll
            for (int bj = 0; bj < 2; ++bj) {
                const int head = (u.pn - 16) * 2 + bj;
                bf16_t* hb = Vt + ((size_t)(b * NH + head) * HD + wc * 32 + 8 * fq) * SEQ + s0;
#pragma unroll
                for (int ai = 0; ai < 2; ++ai)
#pragma unroll
                    for (int m = 0; m < 4; ++m)
#pragma unroll
                        for (int n = 0; n < 2; ++n)
#pragma unroll
                            for (int i = 0; i < 4; ++i) {
                                const unsigned w = cvt_pk_bf16(acc[ai][bj][m][n][i] * rs[ai][m], 0.f);
                                hb[(size_t)(4 * n + i) * SEQ + ai * HALF + m * 16] = (bf16_t)(w & 0xffffu);
                            }
            }
        }
    }
};

template <class Epi, class Sched, bool ALIGN_EPI = false, bool SP2 = false>
__device__ __forceinline__ void gemm_phase(LAS unsigned char* lds, const Gemm g, const Sched& S, const Epi& E) {
    int tid_l = threadIdx.x; LAUNDER(tid_l);
    const int tid = tid_l, wid = __builtin_amdgcn_readfirstlane(tid >> 6), lane = tid & 63, wr = wid >> 2, wc = wid & 3, fr = lane & 15, fq = lane >> 4;
    const int K = g.K, nt = K / BK;
    unsigned voffA[2], voffB[2];
#pragma unroll
    for (int i = 0; i < 2; ++i) { int R, C; stage_rc(tid * 16 + i * 8192, R, C); const int Rb = Epi::PERM ? ((R & ~31) + perm32(R & 31)) : R;
        voffA[i] = (unsigned)(R * K + C) * 2u; voffB[i] = (unsigned)(Rb * K + C) * 2u; }
    const size_t kstep = (size_t)(BK * 2);
    const size_t hstep = (size_t)HALF * K * 2;
    const size_t tstep = 2 * hstep;
    const unsigned ldsw = (unsigned)wid * 1024u;
    const int aoff = lds_byte(wr * 64 + fr, fq * 8), boff = lds_byte(wc * 32 + fr, fq * 8);
#define PG8_SA(b, h) (((b) * 2 + (h)) * HTB)
#define PG8_SB(b, h) ((4 + (b) * 2 + (h)) * HTB)
#define PG8_STAGE(bufoff, gbase, voff) do { _Pragma("unroll") for (int _i = 0; _i < 2; ++_i) \
        __builtin_amdgcn_global_load_lds((const unsigned*)((const char*)(gbase) + (voff)[_i]), (LAS unsigned*)(lds + (bufoff) + ldsw + _i * 8192), 16, 0, 0); } while (0)
#define PG8_LDA(dst, b, h) do { _Pragma("unroll") for (int m = 0; m < 4; ++m) _Pragma("unroll") for (int k = 0; k < 2; ++k) dst[m][k] = *(const LAS bf16x8*)(lds + PG8_SA(b, h) + aoff + m * 2048 + k * 1024); } while (0)
#define PG8_LDB(dst, b, h) do { _Pragma("unroll") for (int n = 0; n < 2; ++n) _Pragma("unroll") for (int k = 0; k < 2; ++k) dst[n][k] = *(const LAS bf16x8*)(lds + PG8_SB(b, h) + boff + n * 2048 + k * 1024); } while (0)
#define PG8_MMA(ai, bj, At, Bt) do { __builtin_amdgcn_s_setprio(1); _Pragma("unroll") for (int m = 0; m < 4; ++m) _Pragma("unroll") for (int n = 0; n < 2; ++n) _Pragma("unroll") for (int k = 0; k < 2; ++k) \
        acc[ai][bj][m][n] = __builtin_amdgcn_mfma_f32_16x16x32_bf16(Bt[n][k], At[m][k], acc[ai][bj][m][n], 0, 0, 0); __builtin_amdgcn_s_setprio(0); } while (0)
#define PG8_MMA_NP(ai, bj, At, Bt) do { _Pragma("unroll") for (int m = 0; m < 4; ++m) _Pragma("unroll") for (int n = 0; n < 2; ++n) _Pragma("unroll") for (int k = 0; k < 2; ++k) \
        acc[ai][bj][m][n] = __builtin_amdgcn_mfma_f32_16x16x32_bf16(Bt[n][k], At[m][k], acc[ai][bj][m][n], 0, 0, 0); } while (0)
#define PG8_MMA2(ai, At, Ba, Bb) do { __builtin_amdgcn_s_setprio(1); PG8_MMA_NP(ai, 0, At, Ba); PG8_MMA_NP(ai, 1, At, Bb); __builtin_amdgcn_s_setprio(0); } while (0)
#define PG8_WAIT_V(n) asm volatile("s_waitcnt vmcnt(" #n ")" ::: "memory")
#define PG8_WAIT_L(n) asm volatile("s_waitcnt lgkmcnt(" #n ")" ::: "memory")
#define PG8_BAR __builtin_amdgcn_s_barrier()
#define PG8_SCHED __builtin_amdgcn_sched_barrier(0)
    Unit cur, nxt; int ui = 0;
    if (!S.next(0, cur)) return;
    f32x4 acc[2][2][4][2];
#pragma unroll
    for (int a = 0; a < 2; ++a)
#pragma unroll
        for (int b = 0; b < 2; ++b)
#pragma unroll
            for (int m = 0; m < 4; ++m)
#pragma unroll
                for (int n = 0; n < 2; ++n) acc[a][b][m][n] = (f32x4){0.f, 0.f, 0.f, 0.f};
    bf16x8 At[4][2], B0[2][2], B1[2][2];
    const char* cA = (const char*)g.A + (size_t)cur.pm * tstep; const char* cB = (const char*)g.Bt + (size_t)cur.pn * tstep;
    S.a_ready(cur);
    if constexpr (SP2) {
        PG8_STAGE(PG8_SB(0, 0), cB, voffB); PG8_STAGE(PG8_SB(0, 1), cB + hstep, voffB); PG8_STAGE(PG8_SA(0, 0), cA, voffA); PG8_STAGE(PG8_SA(0, 1), cA + hstep, voffA);
        if (wr == 1) PG8_BAR;
        PG8_WAIT_V(2); PG8_BAR;
        PG8_STAGE(PG8_SB(1, 0), cB + kstep, voffB); PG8_STAGE(PG8_SA(1, 0), cA + kstep, voffA); PG8_STAGE(PG8_SB(1, 1), cB + hstep + kstep, voffB);
        PG8_WAIT_V(6); PG8_BAR;
    } else {
        PG8_STAGE(PG8_SB(0, 0), cB, voffB); PG8_STAGE(PG8_SA(0, 0), cA, voffA); PG8_STAGE(PG8_SB(0, 1), cB + hstep, voffB); PG8_STAGE(PG8_SA(0, 1), cA + hstep, voffA);
        if (wr == 1) PG8_BAR;
        PG8_WAIT_V(4); PG8_BAR;
        PG8_STAGE(PG8_SB(1, 0), cB + kstep, voffB); PG8_STAGE(PG8_SA(1, 0), cA + kstep, voffA); PG8_STAGE(PG8_SB(1, 1), cB + hstep + kstep, voffB);
        PG8_WAIT_V(6); PG8_BAR;
    }
    for (;;) {
        const bool has_next = S.next(ui + 1, nxt);
        const char* nA = has_next ? (const char*)g.A + (size_t)nxt.pm * tstep : cA; const char* nB = has_next ? (const char*)g.Bt + (size_t)nxt.pn * tstep : cB;
        for (int t = 0; t < nt; t += 2) {
            if constexpr (Epi::MIDK) { if (t == (nt >> 1)) E.mid(acc, cur, wr, wc, fr, fq); }
            const bool last = (t == nt - 2);
            const char* a1 = cA + (size_t)(t + 1) * kstep;
            const char* a2 = last ? nA : cA + (size_t)(t + 2) * kstep; const char* b2 = last ? nB : cB + (size_t)(t + 2) * kstep;
            const char* a3 = a2 + kstep; const char* b3 = b2 + kstep;
            if (last && has_next) S.a_ready(nxt);
            if constexpr (SP2) {
            PG8_LDB(B0, 0, 0); PG8_LDB(B1, 0, 1); PG8_SCHED; PG8_LDA(At, 0, 0); PG8_STAGE(PG8_SA(1, 1), a1 + hstep, voffA);
            PG8_WAIT_V(8); PG8_WAIT_L(0); PG8_BAR; PG8_MMA2(0, At, B0, B1); PG8_BAR; PG8_SCHED;
            PG8_LDA(At, 0, 1); PG8_STAGE(PG8_SB(0, 0), b2, voffB); PG8_STAGE(PG8_SB(0, 1), b2 + hstep, voffB); PG8_STAGE(PG8_SA(0, 0), a2, voffA);
            PG8_WAIT_V(8); PG8_WAIT_L(0); PG8_BAR; PG8_MMA2(1, At, B0, B1); PG8_BAR; PG8_SCHED;
            PG8_LDB(B0, 1, 0); PG8_LDB(B1, 1, 1); PG8_SCHED; PG8_LDA(At, 1, 0); PG8_STAGE(PG8_SA(0, 1), a2 + hstep, voffA);
            PG8_WAIT_V(8); PG8_WAIT_L(0); PG8_BAR; PG8_MMA2(0, At, B0, B1); PG8_BAR; PG8_SCHED;
            PG8_LDA(At, 1, 1); PG8_STAGE(PG8_SB(1, 0), b3, voffB); PG8_STAGE(PG8_SB(1, 1), b3 + hstep, voffB); PG8_STAGE(PG8_SA(1, 0), a3, voffA);
            PG8_WAIT_V(8); PG8_WAIT_L(0); PG8_BAR; PG8_MMA2(1, At, B0, B1); PG8_BAR; PG8_SCHED;
            } else {
            PG8_LDB(B0, 0, 0); PG8_SCHED; PG8_LDA(At, 0, 0); PG8_STAGE(PG8_SA(1, 1), a1 + hstep, voffA);
            PG8_WAIT_L(8); PG8_BAR; PG8_WAIT_L(0); PG8_MMA(0, 0, At, B0); PG8_BAR; PG8_SCHED;
            PG8_LDB(B1, 0, 1); PG8_STAGE(PG8_SB(0, 0), b2, voffB);
            PG8_BAR; PG8_WAIT_L(0); PG8_MMA(0, 1, At, B1); PG8_BAR;
            PG8_LDA(At, 0, 1); PG8_STAGE(PG8_SA(0, 0), a2, voffA);
            PG8_BAR; PG8_WAIT_L(0); PG8_MMA(1, 0, At, B0); PG8_BAR; PG8_SCHED;
            PG8_STAGE(PG8_SB(0, 1), b2 + hstep, voffB);
            PG8_WAIT_V(6); PG8_BAR; PG8_MMA(1, 1, At, B1); PG8_BAR;
            PG8_LDB(B0, 1, 0); PG8_SCHED; PG8_LDA(At, 1, 0); PG8_STAGE(PG8_SA(0, 1), a2 + hstep, voffA);
            PG8_WAIT_L(8); PG8_BAR; PG8_WAIT_L(0); PG8_MMA(0, 0, At, B0); PG8_BAR; PG8_SCHED;
            PG8_LDB(B1, 1, 1); PG8_STAGE(PG8_SB(1, 0), b3, voffB);
            PG8_BAR; PG8_WAIT_L(0); PG8_MMA(0, 1, At, B1); PG8_BAR;
            PG8_LDA(At, 1, 1); PG8_STAGE(PG8_SA(1, 0), a3, voffA);
            PG8_BAR; PG8_WAIT_L(0); PG8_MMA(1, 0, At, B0); PG8_BAR; PG8_SCHED;
            PG8_STAGE(PG8_SB(1, 1), b3 + hstep, voffB);
            PG8_WAIT_V(6); PG8_BAR; PG8_MMA(1, 1, At, B1); PG8_BAR;
            }
        }
        if constexpr (ALIGN_EPI) { if (wr == 0) PG8_BAR; }
        if constexpr (!Epi::AFTER_DRAIN) { E(acc, cur, wr, wc, fr, fq); S.done(cur); }
        if constexpr (Epi::MIDK) { if (has_next) E.prep(nxt); }
        if (!has_next) break;
#pragma unroll
        for (int a = 0; a < 2; ++a)
#pragma unroll
            for (int b = 0; b < 2; ++b)
#pragma unroll
                for (int m = 0; m < 4; ++m)
#pragma unroll
                    for (int n = 0; n < 2; ++n) acc[a][b][m][n] = (f32x4){0.f, 0.f, 0.f, 0.f};
        cur = nxt; cA = nA; cB = nB; ++ui;
        if constexpr (ALIGN_EPI) { if (wr == 1) PG8_BAR; }
    }
    PG8_WAIT_V(0);
    if constexpr (!ALIGN_EPI) { if (wr == 0) PG8_BAR; }
    PG8_BAR;
#undef PG8_SA
#undef PG8_SB
#undef PG8_STAGE
#undef PG8_LDA
#undef PG8_LDB
#undef PG8_MMA
#undef PG8_MMA_NP
#undef PG8_MMA2
#undef PG8_WAIT_V
#undef PG8_WAIT_L
#undef PG8_BAR
#undef PG8_SCHED
}
}

#define LDS_WAIT() asm volatile("s_waitcnt lgkmcnt(0)" ::: "memory")

__device__ __forceinline__ float wave_sum(float v) {
#pragma unroll
    for (int o = 1; o < 64; o <<= 1) v += __shfl_xor(v, o);
    return v;
}

__device__ __forceinline__ void p0_transpose_item(const float* W, const float* gain, int K, int N, bf16_t* WT, int ilv, LAS float* scr, int item, int lane, const float* gain2 = nullptr) {
    const int nblk = N / 32, kb = item / nblk, nb = item % nblk, k0 = 64 * kb, n0 = 32 * nb;
#pragma unroll 8
    for (int i = 0; i < 32; ++i) { const int kk = 2 * i + (lane >> 5); scr[kk * 33 + (lane & 31)] = W[(size_t)(k0 + kk) * N + n0 + (lane & 31)]; }
    LDS_WAIT(); asm volatile("" ::: "memory");
    const int c = lane & 7;
    f32x4 g0 = (f32x4){1.f, 1.f, 1.f, 1.f}, g1 = g0;
    if (gain) { const float* gp = (gain2 && k0 >= 1024) ? gain2 + (k0 - 1024) : gain + k0; g0 = *(const f32x4*)(gp + 8 * c); g1 = *(const f32x4*)(gp + 8 * c + 4); }
#pragma unroll
    for (int j = 0; j < 4; ++j) { const int n = (lane >> 3) + 8 * j; const LAS float* s = scr + (8 * c) * 33 + n;
        u32x4 o; o.x = cvt_pk_bf16(s[0 * 33] * g0.x, s[1 * 33] * g0.y); o.y = cvt_pk_bf16(s[2 * 33] * g0.z, s[3 * 33] * g0.w); o.z = cvt_pk_bf16(s[4 * 33] * g1.x, s[5 * 33] * g1.y); o.w = cvt_pk_bf16(s[6 * 33] * g1.z, s[7 * 33] * g1.w);
        const int nn = n0 + n; const int row = ilv < 0 ? nn : ((nn >> 7) * 256 + (nn & 127) + ilv);
        *(u32x4*)(WT + (size_t)row * K + k0 + 8 * c) = o; }
    LDS_WAIT(); asm volatile("" ::: "memory");
}

__device__ __forceinline__ void rms_rows_bf16(const float* x, const float* g, bf16_t* out, int gw, int NGW, int lane) {
    LAUNDER(lane);
    f32x4 gv[8];
#pragma unroll
    for (int j = 0; j < 8; ++j) gv[j] = *(const f32x4*)(g + 4 * lane + 256 * j);
    for (int m = gw; m < M; m += NGW) {
        const f32x4* xr = (const f32x4*)(x + (size_t)m * D) + lane; f32x4 v[8]; float s = 0.f;
#pragma unroll
        for (int j = 0; j < 8; ++j) { v[j] = xr[64 * j]; s += (v[j].x * v[j].x + v[j].y * v[j].y) + (v[j].z * v[j].z + v[j].w * v[j].w); }
        const float rstd = 1.0f / sqrtf(wave_sum(s) * (1.0f / D) + EPS);
        u32x2* o8 = (u32x2*)(out + (size_t)m * D) + lane;
#pragma unroll
        for (int j = 0; j < 8; ++j) { const f32x4 o = v[j] * rstd * gv[j]; u32x2 w; w.x = cvt_pk_bf16(o.x, o.y); w.y = cvt_pk_bf16(o.z, o.w); o8[64 * j] = w; }
    }
}
__device__ __forceinline__ void cast_rows_bf16(const float* x, bf16_t* out, float* ssq, int gw, int NGW, int lane) {
    LAUNDER(lane);
    for (int m = gw; m < M; m += NGW) {
        const f32x4* xr = (const f32x4*)(x + (size_t)m * D) + lane; f32x4 v[8]; float s = 0.f;
#pragma unroll
        for (int j = 0; j < 8; ++j) { v[j] = xr[64 * j]; s += (v[j].x * v[j].x + v[j].y * v[j].y) + (v[j].z * v[j].z + v[j].w * v[j].w); }
        s = wave_sum(s);
        if (lane == 0) { f32x4* pp = (f32x4*)(ssq + (size_t)m * 8); pp[0] = (f32x4){s, 0.f, 0.f, 0.f}; pp[1] = (f32x4){0.f, 0.f, 0.f, 0.f}; }
        u32x2* o8 = (u32x2*)(out + (size_t)m * D) + lane;
#pragma unroll
        for (int j = 0; j < 8; ++j) { u32x2 w; w.x = cvt_pk_bf16(v[j].x, v[j].y); w.y = cvt_pk_bf16(v[j].z, v[j].w); o8[64 * j] = w; }
    }
}
__device__ __forceinline__ void rms_rows_f32_inplace(float* x, const float* g, int gw, int NGW, int lane) {
    LAUNDER(lane);
    f32x4 gv[8];
#pragma unroll
    for (int j = 0; j < 8; ++j) gv[j] = *(const f32x4*)(g + 4 * lane + 256 * j);
    for (int m = gw; m < M; m += NGW) {
        f32x4* xr = (f32x4*)(x + (size_t)m * D) + lane; f32x4 v[8]; float s = 0.f;
#pragma unroll
        for (int j = 0; j < 8; ++j) { v[j] = xr[64 * j]; s += (v[j].x * v[j].x + v[j].y * v[j].y) + (v[j].z * v[j].z + v[j].w * v[j].w); }
        const float rstd = 1.0f / sqrtf(wave_sum(s) * (1.0f / D) + EPS);
#pragma unroll
        for (int j = 0; j < 8; ++j) xr[64 * j] = v[j] * rstd * gv[j];
    }
}
__device__ __forceinline__ void rms_rows_bf16_to_f32(const bf16_t* x, const float* g, float* out, int gw, int NGW, int lane) {
    LAUNDER(lane);
    f32x4 gv[4][2];
#pragma unroll
    for (int j = 0; j < 4; ++j) { const float* gp = g + 512 * j + 8 * lane; gv[j][0] = *(const f32x4*)gp; gv[j][1] = *(const f32x4*)(gp + 4); }
    for (int m = gw; m < M; m += NGW) {
        const u32x4* xr = (const u32x4*)(x + (size_t)m * D) + lane; u32x4 raw[4]; float s = 0.f;
#pragma unroll
        for (int j = 0; j < 4; ++j) raw[j] = xr[64 * j];
        float v[4][8];
#pragma unroll
        for (int j = 0; j < 4; ++j) {
            v[j][0] = bf_lo(raw[j].x); v[j][1] = bf_hi(raw[j].x); v[j][2] = bf_lo(raw[j].y); v[j][3] = bf_hi(raw[j].y);
            v[j][4] = bf_lo(raw[j].z); v[j][5] = bf_hi(raw[j].z); v[j][6] = bf_lo(raw[j].w); v[j][7] = bf_hi(raw[j].w);
#pragma unroll
            for (int e = 0; e < 8; ++e) s += v[j][e] * v[j][e];
        }
        const float rstd = 1.0f / sqrtf(wave_sum(s) * (1.0f / D) + EPS);
        f32x4* orow = (f32x4*)(out + (size_t)m * D + 8 * lane);
#pragma unroll
        for (int j = 0; j < 4; ++j) {
            orow[128 * j] = (f32x4){v[j][0] * rstd * gv[j][0].x, v[j][1] * rstd * gv[j][0].y, v[j][2] * rstd * gv[j][0].z, v[j][3] * rstd * gv[j][0].w};
            orow[128 * j + 1] = (f32x4){v[j][4] * rstd * gv[j][1].x, v[j][5] * rstd * gv[j][1].y, v[j][6] * rstd * gv[j][1].z, v[j][7] * rstd * gv[j][1].w};
        }
    }
}
__device__ __forceinline__ void ynorm_rows(bf16_t* y, const float* g_lru, const float* g_att, int gw, int NGW, int lane) {
    LAUNDER(lane);
    f32x4 gv[4][2];
#pragma unroll
    for (int j = 0; j < 4; ++j) { const float* gp = (j < 2 ? g_lru + 512 * j : g_att + 512 * (j - 2)) + 8 * lane; gv[j][0] = *(const f32x4*)gp; gv[j][1] = *(const f32x4*)(gp + 4); }
    for (int m = gw; m < M; m += NGW) {
        u32x4* yr = (u32x4*)(y + (size_t)m * D) + lane; u32x4 raw[4]; float s0 = 0.f, s1 = 0.f;
#pragma unroll
        for (int j = 0; j < 4; ++j) raw[j] = yr[64 * j];
        float v[4][8];
#pragma unroll
        for (int j = 0; j < 4; ++j) {
            v[j][0] = bf_lo(raw[j].x); v[j][1] = bf_hi(raw[j].x); v[j][2] = bf_lo(raw[j].y); v[j][3] = bf_hi(raw[j].y);
            v[j][4] = bf_lo(raw[j].z); v[j][5] = bf_hi(raw[j].z); v[j][6] = bf_lo(raw[j].w); v[j][7] = bf_hi(raw[j].w);
            float s = 0.f;
#pragma unroll
            for (int e = 0; e < 8; ++e) s += v[j][e] * v[j][e];
            if (j < 2) s0 += s; else s1 += s;
        }
        const float r0 = 1.0f / sqrtf(wave_sum(s0) * (1.0f / 1024.f) + EPS), r1 = 1.0f / sqrtf(wave_sum(s1) * (1.0f / 1024.f) + EPS);
#pragma unroll
        for (int j = 0; j < 4; ++j) { const float r = j < 2 ? r0 : r1; u32x4 w;
            w.x = cvt_pk_bf16(v[j][0] * r * gv[j][0].x, v[j][1] * r * gv[j][0].y); w.y = cvt_pk_bf16(v[j][2] * r * gv[j][0].z, v[j][3] * r * gv[j][0].w);
            w.z = cvt_pk_bf16(v[j][4] * r * gv[j][1].x, v[j][5] * r * gv[j][1].y); w.w = cvt_pk_bf16(v[j][6] * r * gv[j][1].z, v[j][7] * r * gv[j][1].w);
            yr[64 * j] = w; }
    }
}

constexpr int LM_BIAS = 0;
constexpr int LM_CW = 8448;
constexpr int LM_CB = 9472;
constexpr int LM_P = 10240;
constexpr int LM_H = 18432;
__device__ __forceinline__ void lru_unit(LAS unsigned char* lds, const bf16_t* zm, bf16_t* yraw, float* yp, const float* conv_w, const float* conv_b, const float* wa, const float* ba,
                                         const float* wx, const float* bx, const float* lam, int b, int hb, int tid) {
    LAUNDER(tid);
    const int lane = tid & 63, w = tid >> 6, fr = lane & 15, fq = lane >> 4;
    LAS float* cwL = (LAS float*)(lds + LM_CW); LAS float* cbL = (LAS float*)(lds + LM_CB);
    if (tid < 256) cwL[tid] = conv_w[(tid >> 6) * DL + hb * 64 + (tid & 63)];
    else if (tid < 320) cbL[tid - 256] = conv_b[hb * 64 + tid - 256];
    bf16x8 WA[4][2], WX[4][2];
#pragma unroll
    for (int nt = 0; nt < 4; ++nt)
#pragma unroll
        for (int ks = 0; ks < 2; ++ks) {
            const float* pa = wa + ((size_t)hb * 64 + ks * 32 + 8 * fq) * 64 + nt * 16 + fr; const float* px = wx + ((size_t)hb * 64 + ks * 32 + 8 * fq) * 64 + nt * 16 + fr;
            u32x4 ua, ux;
            ua.x = cvt_pk_bf16(pa[0 * 64], pa[1 * 64]); ua.y = cvt_pk_bf16(pa[2 * 64], pa[3 * 64]); ua.z = cvt_pk_bf16(pa[4 * 64], pa[5 * 64]); ua.w = cvt_pk_bf16(pa[6 * 64], pa[7 * 64]);
            ux.x = cvt_pk_bf16(px[0 * 64], px[1 * 64]); ux.y = cvt_pk_bf16(px[2 * 64], px[3 * 64]); ux.z = cvt_pk_bf16(px[4 * 64], px[5 * 64]); ux.w = cvt_pk_bf16(px[6 * 64], px[7 * 64]);
            WA[nt][ks] = __builtin_bit_cast(bf16x8, ua); WX[nt][ks] = __builtin_bit_cast(bf16x8, ux);
        }
    bf16x8 ID[2];
#pragma unroll
    for (int p = 0; p < 2; ++p)
#pragma unroll
        for (int e = 0; e < 8; ++e) ID[p][e] = (8 * fq + e == 16 * p + fr) ? (short)0x3F80 : (short)0;
    float pba[4], pbx[4], pcl[4];
#pragma unroll
    for (int nt = 0; nt < 4; ++nt) { const int c = hb * 64 + nt * 16 + fr; pba[nt] = ba[c]; pbx[nt] = bx[c]; pcl[nt] = -8.0f * log1pf(expf(-lam[c])); }
    __syncthreads();
    float hin[4] = {0.f, 0.f, 0.f, 0.f};
    const bf16_t* zb = zm + (size_t)b * SEQ * ZLD + hb * 64;
    LAS f32x2* TOT = (LAS f32x2*)(lds + LM_P);
    u32x4 XR[2][4], GR[2];
    {
        const int tA = 16 * w + fr;
#pragma unroll
        for (int ks = 0; ks < 2; ++ks) {
            const int ch0 = ks * 32 + 8 * fq;
#pragma unroll
            for (int tap = 0; tap < 4; ++tap) { const int t = tA - 3 + tap; const int tt = t >= 0 ? t : 0; XR[ks][tap] = *(const u32x4*)(zb + (size_t)tt * ZLD + ch0); }
            GR[ks] = *(const u32x4*)(zb + (size_t)tA * ZLD + 1024 + ch0);
        }
    }
#pragma unroll 1
    for (int sc = 0; sc < 16; ++sc) {
        const int tA = sc * 128 + 16 * w + fr;
        const int tN = sc < 15 ? tA + 128 : tA;
        u32x4 XN[2][4], GN[2];
#pragma unroll
        for (int ks = 0; ks < 2; ++ks) {
            const int ch0 = ks * 32 + 8 * fq;
#pragma unroll
            for (int tap = 0; tap < 4; ++tap) XN[ks][tap] = *(const u32x4*)(zb + (size_t)(tN - 3 + tap) * ZLD + ch0);
            GN[ks] = *(const u32x4*)(zb + (size_t)tN * ZLD + 1024 + ch0);
        }
        bf16x8 XC[2], GL[2];
#pragma unroll
        for (int ks = 0; ks < 2; ++ks) {
            const int ch0 = ks * 32 + 8 * fq;
            const f32x4 c0 = *(const LAS f32x4*)(cbL + ch0), c1 = *(const LAS f32x4*)(cbL + ch0 + 4);
            float a8[8] = {c0.x, c0.y, c0.z, c0.w, c1.x, c1.y, c1.z, c1.w};
#pragma unroll
            for (int tap = 0; tap < 4; ++tap) {
                const bool ok = (tA - 3 + tap) >= 0;
                u32x4 xr = XR[ks][tap];
                if (!ok) xr = (u32x4){0u, 0u, 0u, 0u};
                const f32x4 w0 = *(const LAS f32x4*)(cwL + tap * 64 + ch0), w1 = *(const LAS f32x4*)(cwL + tap * 64 + ch0 + 4);
                a8[0] += w0.x * bf_lo(xr.x); a8[1] += w0.y * bf_hi(xr.x); a8[2] += w0.z * bf_lo(xr.y); a8[3] += w0.w * bf_hi(xr.y);
                a8[4] += w1.x * bf_lo(xr.z); a8[5] += w1.y * bf_hi(xr.z); a8[6] += w1.z * bf_lo(xr.w); a8[7] += w1.w * bf_hi(xr.w);
            }
            u32x4 pk; pk.x = cvt_pk_bf16(a8[0], a8[1]); pk.y = cvt_pk_bf16(a8[2], a8[3]); pk.z = cvt_pk_bf16(a8[4], a8[5]); pk.w = cvt_pk_bf16(a8[6], a8[7]);
            XC[ks] = __builtin_bit_cast(bf16x8, pk);
            GL[ks] = __builtin_bit_cast(bf16x8, GR[ks]);
        }
        float hl[4][4], pc[4][4], gel[4][4], PE[4], HE[4];
        LAS f32x2* totw = TOT + ((sc & 1) * 8 + w) * 64;
#pragma unroll
        for (int nt = 0; nt < 4; ++nt) {
            f32x4 ga = (f32x4){0.f, 0.f, 0.f, 0.f}, gx = ga, xo = ga, go = ga;
#pragma unroll
            for (int ks = 0; ks < 2; ++ks) { ga = __builtin_amdgcn_mfma_f32_16x16x32_bf16(XC[ks], WA[nt][ks], ga, 0, 0, 0); gx = __builtin_amdgcn_mfma_f32_16x16x32_bf16(XC[ks], WX[nt][ks], gx, 0, 0, 0); }
            xo = __builtin_amdgcn_mfma_f32_16x16x32_bf16(XC[nt >> 1], ID[nt & 1], xo, 0, 0, 0);
            go = __builtin_amdgcn_mfma_f32_16x16x32_bf16(GL[nt >> 1], ID[nt & 1], go, 0, 0, 0);
#pragma unroll
            for (int hh = 0; hh < 2; ++hh) {
                const f32x2 ga2 = (f32x2){ga[2 * hh], ga[2 * hh + 1]}, gx2 = (f32x2){gx[2 * hh], gx[2 * hh + 1]}, xo2 = (f32x2){xo[2 * hh], xo[2 * hh + 1]}, go2 = (f32x2){go[2 * hh], go[2 * hh + 1]};
                const f32x2 ta = (ga2 + pba[nt]) * (-LOG2E), tx = (gx2 + pbx[nt]) * (-LOG2E);
                f32x2 da, dx; da.x = fast_exp2(ta.x); da.y = fast_exp2(ta.y); dx.x = fast_exp2(tx.x); dx.y = fast_exp2(tx.y);
                da = da + 1.0f; dx = dx + 1.0f;
                f32x2 r, ig; r.x = fast_rcp(da.x); r.y = fast_rcp(da.y); ig.x = fast_rcp(dx.x); ig.y = fast_rcp(dx.y);
                const f32x2 la2 = r * (pcl[nt] * LOG2E), x2 = r * (2.0f * pcl[nt]);
                f32x2 av; av.x = fast_exp2(la2.x); av.y = fast_exp2(la2.y);
                const f32x2 omp = -x2 * (x2 * 0.5f * (x2 * (1.0f / 3.0f) + 1.0f) + 1.0f), omd = 1.0f - av * av;
                f32x2 uv; uv.x = __builtin_amdgcn_sqrtf(x2.x < -0.03f ? omd.x : omp.x); uv.y = __builtin_amdgcn_sqrtf(x2.y < -0.03f ? omd.y : omp.y);
                uv = uv * ig * xo2;
                const f32x2 tg = go2 * (go2 * go2 * (-LOG2E * 1.5957691216057308f * 0.044715f) + (-LOG2E * 1.5957691216057308f));
                f32x2 dg; dg.x = fast_exp2(tg.x); dg.y = fast_exp2(tg.y); dg = dg + 1.0f;
                gel[nt][2 * hh] = go2.x * fast_rcp(dg.x); gel[nt][2 * hh + 1] = go2.y * fast_rcp(dg.y);
                if (hh == 0) { hl[nt][0] = uv.x; pc[nt][0] = av.x; }
                else { hl[nt][2] = av.x * hl[nt][1] + uv.x; pc[nt][2] = pc[nt][1] * av.x; }
                hl[nt][2 * hh + 1] = av.y * hl[nt][2 * hh] + uv.y; pc[nt][2 * hh + 1] = pc[nt][2 * hh] * av.y;
            }
            float P = pc[nt][3], H = hl[nt][3];
            { const float Pp = __shfl_up(P, 16), Hp = __shfl_up(H, 16); if (fq >= 1) { H = P * Hp + H; P = P * Pp; } }
            { const float Pp = __shfl_up(P, 32), Hp = __shfl_up(H, 32); if (fq >= 2) { H = P * Hp + H; P = P * Pp; } }
            { float Pe = __shfl_up(P, 16), He = __shfl_up(H, 16); if (fq == 0) { Pe = 1.0f; He = 0.0f; } PE[nt] = Pe; HE[nt] = He; }
            if (fq == 3) totw[nt * 16 + fr] = (f32x2){P, H};
        }
        asm volatile("s_waitcnt lgkmcnt(0)" ::: "memory"); __builtin_amdgcn_s_barrier(); asm volatile("" ::: "memory");
        float psq[4] = {0.f, 0.f, 0.f, 0.f};
#pragma unroll
        for (int nt = 0; nt < 4; ++nt) {
            float hrun = hin[nt], hws = hin[nt];
#pragma unroll
            for (int w2 = 0; w2 < 8; ++w2) { const f32x2 t2 = TOT[((sc & 1) * 8 + w2) * 64 + nt * 16 + fr]; hrun = t2.x * hrun + t2.y; if (w2 + 1 == w) hws = hrun; }
            hin[nt] = hrun;
            const float hs = PE[nt] * hws + HE[nt];
#pragma unroll
            for (int j = 0; j < 4; ++j) {
                const float ov = (hl[nt][j] + pc[nt][j] * hs) * gel[nt][j]; psq[j] += ov * ov;
                const unsigned o = cvt_pk_bf16(ov, 0.f);
                yraw[(size_t)(b * SEQ + sc * 128 + 16 * w + 4 * fq + j) * D + hb * 64 + nt * 16 + fr] = (bf16_t)(o & 0xffffu);
            }
        }
#pragma unroll
        for (int j = 0; j < 4; ++j) { float q = psq[j]; q += __shfl_xor(q, 1); q += __shfl_xor(q, 2); q += __shfl_xor(q, 4); q += __shfl_xor(q, 8);
            if (fr == 0) yp[(size_t)(b * SEQ + sc * 128 + 16 * w + 4 * fq + j) * 24 + hb] = q; }
#pragma unroll
        for (int ks = 0; ks < 2; ++ks) {
#pragma unroll
            for (int tap = 0; tap < 4; ++tap) XR[ks][tap] = XN[ks][tap];
            GR[ks] = GN[ks];
        }
    }
    __syncthreads();
}

constexpr int LM_ATT = 32768;
#define ATT_COMPUTE(FAR) do { \
        bf16x8 Kf[2][4], Vf[8]; \
        _Pragma("unroll") for (int t = 0; t < 2; ++t) _Pragma("unroll") for (int ks = 0; ks < 4; ++ks) Kf[t][ks] = *(const LAS bf16x8*)(sb + (t * 4 + ks) * 1024 + foff); \
        _Pragma("unroll") for (int dt = 0; dt < 8; ++dt) Vf[dt] = *(const LAS bf16x8*)(sb + 8192 + dt * 1024 + foff); \
        f32x4 St[2][2]; \
        _Pragma("unroll") for (int t = 0; t < 2; ++t) _Pragma("unroll") for (int qt = 0; qt < 2; ++qt) { f32x4 s_ = (f32x4){0.f, 0.f, 0.f, 0.f}; \
            _Pragma("unroll") for (int ks = 0; ks < 4; ++ks) s_ = __builtin_amdgcn_mfma_f32_16x16x32_bf16(Kf[t][ks], Q[qt][ks], s_, 0, 0, 0); \
            St[t][qt] = s_; } \
        bf16x8 Pf[2]; \
        _Pragma("unroll") for (int qt = 0; qt < 2; ++qt) { \
            const int qpos = c * 64 + qh * 32 + qt * 16 + fr; \
            float sv[8]; float bm = -1e30f; \
            _Pragma("unroll") for (int t = 0; t < 2; ++t) _Pragma("unroll") for (int j = 0; j < 4; ++j) { float bv_; \
                if (FAR) bv_ = bias0; else { int rel = k0 + 8 * fq + 4 * t + j - qpos; rel = rel < -128 ? -128 : (rel > 128 ? 128 : rel); bv_ = bias[rel + 128]; } \
                const float s_ = St[t][qt][j] * SC + bv_; sv[t * 4 + j] = s_; bm = fmaxf(bm, s_); } \
            bm = fmaxf(bm, __shfl_xor(bm, 16)); bm = fmaxf(bm, __shfl_xor(bm, 32)); \
            const float mn = (bm > mrun[qt] + 8.0f) ? bm : mrun[qt];     \
            if (__builtin_amdgcn_ballot_w64(mn != mrun[qt]) != 0ull) { const float alpha = fast_exp2(mrun[qt] - mn); mrun[qt] = mn; lrun[qt] = lrun[qt] * alpha; \
                _Pragma("unroll") for (int dt = 0; dt < 8; ++dt) O[dt][qt] = O[dt][qt] * alpha; } \
            float ps = 0.f; \
            _Pragma("unroll") for (int e = 0; e < 8; ++e) { sv[e] = fast_exp2(sv[e] - mn); ps += sv[e]; } \
            lrun[qt] = lrun[qt] + ps; \
            u32x4 pk; pk.x = cvt_pk_bf16(sv[0], sv[1]); pk.y = cvt_pk_bf16(sv[2], sv[3]); pk.z = cvt_pk_bf16(sv[4], sv[5]); pk.w = cvt_pk_bf16(sv[6], sv[7]); \
            Pf[qt] = __builtin_bit_cast(bf16x8, pk); } \
        _Pragma("unroll") for (int dt = 0; dt < 8; ++dt) _Pragma("unroll") for (int qt = 0; qt < 2; ++qt) O[dt][qt] = __builtin_amdgcn_mfma_f32_16x16x32_bf16(Vf[dt], Pf[qt], O[dt][qt], 0, 0, 0); \
    } while (0)
__device__ __forceinline__ void attn_block(LAS unsigned char* lds, const bf16_t* zm, const bf16_t* Kh, const bf16_t* Vt, bf16_t* yraw, float* yp, const LAS float* biasAll, int b, int h, int g, int tid) {
    LAUNDER(tid);
    const int lane = tid & 63, wave = tid >> 6, fr = lane & 15, fq = lane >> 4;
    const int c = 4 * g + (wave >> 1), qh = wave & 1;
    const LAS float* bias = biasAll + h * NREL;
    const float bias0 = bias[0];
    const float SC = 0.08838834764831845f * LOG2E;
    bf16x8 Q[2][4];
#pragma unroll
    for (int qt = 0; qt < 2; ++qt) { const size_t tok = (size_t)b * SEQ + c * 64 + qh * 32 + qt * 16 + fr;
#pragma unroll
        for (int ks = 0; ks < 4; ++ks) Q[qt][ks] = *(const bf16x8*)(zm + tok * ZLD + 2048 + h * HD + ks * 32 + 8 * fq); }
    f32x4 O[8][2];
#pragma unroll
    for (int dt = 0; dt < 8; ++dt)
#pragma unroll
        for (int qt = 0; qt < 2; ++qt) O[dt][qt] = (f32x4){0.f, 0.f, 0.f, 0.f};
    float mrun[2] = {-1e30f, -1e30f}, lrun[2] = {0.f, 0.f};
    const int lo = g >= 2 ? 4 * g - 8 : 0, nch = 4 * g + 4 - lo;
    const int kr = tid >> 4, c16 = tid & 15;
    const int krho = ((kr >> 3) << 2) | (kr & 3);
    const int kst = ((((kr >> 2) & 1) * 4 + (c16 >> 2)) * 1024) + ((krho * 64 + (c16 & 3) * 16) ^ (krho >= 8 ? 32 : 0));
    const bf16_t* kg = Kh + ((size_t)(b * NH + h) * SEQ + kr) * HD + 8 * c16;
    const int vd = tid >> 2, vq = tid & 3;
    const int vst = 8192 + (vd >> 4) * 1024 + (((vd & 15) * 64 + vq * 16) ^ ((vd & 15) >= 8 ? 32 : 0));
    const bf16_t* vg = Vt + ((size_t)(b * NH + h) * HD + vd) * SEQ + 8 * vq;
    const int foff = (fr * 64 + fq * 16) ^ (fr >= 8 ? 32 : 0);
    LAS unsigned char* st = lds + LM_ATT;
    { const int k0 = lo * 64;
      const u32x4 kv0 = *(const u32x4*)(kg + (size_t)k0 * HD), kv1 = *(const u32x4*)(kg + (size_t)(k0 + 32) * HD); const u32x4 vv0 = *(const u32x4*)(vg + k0), vv1 = *(const u32x4*)(vg + k0 + 32);
      *(LAS u32x4*)(st + kst) = kv0; *(LAS u32x4*)(st + vst) = vv0; *(LAS u32x4*)(st + 16384 + kst) = kv1; *(LAS u32x4*)(st + 16384 + vst) = vv1; }
    __syncthreads();
#pragma unroll 1
    for (int ci = 0; ci < nch; ++ci) {
        const int kc = lo + ci;
        const int k0n = (lo + (ci + 1 < nch ? ci + 1 : ci)) * 64;
        const u32x4 kv0 = *(const u32x4*)(kg + (size_t)k0n * HD), kv1 = *(const u32x4*)(kg + (size_t)(k0n + 32) * HD); const u32x4 vv0 = *(const u32x4*)(vg + k0n), vv1 = *(const u32x4*)(vg + k0n + 32);
        if (kc >= c - 8 && kc <= c) {
            const bool farc = kc <= c - 3;
#pragma unroll 1
            for (int hf = 0; hf < 2; ++hf) {
                const LAS unsigned char* sb = st + (ci & 1) * 32768 + hf * 16384; const int k0 = kc * 64 + hf * 32;
                if (farc) ATT_COMPUTE(true); else ATT_COMPUTE(false);
            }
        }
        LAS unsigned char* nb = st + ((ci + 1) & 1) * 32768;
        *(LAS u32x4*)(nb + kst) = kv0; *(LAS u32x4*)(nb + vst) = vv0; *(LAS u32x4*)(nb + 16384 + kst) = kv1; *(LAS u32x4*)(nb + 16384 + vst) = vv1;
        __syncthreads();
    }
#pragma unroll
    for (int qt = 0; qt < 2; ++qt) {
        float l = lrun[qt]; l += __shfl_xor(l, 16); l += __shfl_xor(l, 32);
        const float inv = 1.0f / l;
        bf16_t* op = yraw + ((size_t)b * SEQ + c * 64 + qh * 32 + qt * 16 + fr) * D + 1024 + h * HD + 4 * fq;
        float q = 0.f;
#pragma unroll
        for (int dt = 0; dt < 8; ++dt) { const f32x4 o = O[dt][qt] * inv; u32x2 w; w.x = cvt_pk_bf16(o.x, o.y); w.y = cvt_pk_bf16(o.z, o.w); *(u32x2*)(op + dt * 16) = w; q += (o.x * o.x + o.y * o.y) + (o.z * o.z + o.w * o.w); }
        q += __shfl_xor(q, 16); q += __shfl_xor(q, 32);
        if (fq == 0) yp[((size_t)b * SEQ + c * 64 + qh * 32 + qt * 16 + fr) * 24 + 16 + h] = q;
    }
}
#undef ATT_COMPUTE

#define XB_TMO      128
#define XB_XCNT(j)  (256  + 64 * (j))
#define XB_XSUB(j)  (1280 + 64 * (j))
#define XB_XGEN(j)  (2304 + 64 * (j))
#define XB_TOP      3328
#define XB_TOPGEN   3392
#define XCD_BAR_WORDS 3456
#define XB_SPIN_CAP (1u << 18)
__device__ __forceinline__ unsigned xb_ld(unsigned* p)              { return __hip_atomic_load(p, __ATOMIC_RELAXED, __HIP_MEMORY_SCOPE_AGENT); }
__device__ __forceinline__ unsigned xb_add(unsigned* p, unsigned v) { return __hip_atomic_fetch_add(p, v, __ATOMIC_RELAXED, __HIP_MEMORY_SCOPE_AGENT); }
__device__ __forceinline__ unsigned xb_xcc_id() { return (unsigned)__builtin_amdgcn_s_getreg((3 << 11) | 20) & 0xFu; }
#define XB_SPIN(cond, bar) do { unsigned _sp = 0; while (cond) { __builtin_amdgcn_s_sleep(1); \
    if ((++_sp & 255u) == 0u) { if (xb_ld(&(bar)[XB_TMO])) break; if (_sp > XB_SPIN_CAP) { atomicAdd(&(bar)[XB_TMO], 1u); break; } } } } while (0)
struct XcdBarrier { unsigned* bar; unsigned x; volatile LAS unsigned* st; };
__device__ __forceinline__ XcdBarrier xcd_barrier_post(unsigned* bar, volatile LAS unsigned* st) {
    XcdBarrier b; b.bar = bar; b.x = xb_xcc_id(); b.st = st;
    if (threadIdx.x == 0) (void)xb_add(&bar[XB_XCNT(b.x)], 1u);
    return b;
}
__device__ __forceinline__ void xcd_barrier_complete(unsigned* bar, unsigned x, unsigned& nloc, unsigned& nx) {
    const unsigned G = gridDim.x * gridDim.y * gridDim.z;
    unsigned sum, cnt, mine, sp = 0u;
    for (;;) {
        sum = 0u; cnt = 0u; mine = 0u;
#pragma unroll
        for (unsigned j = 0; j < 16; ++j) { const unsigned c = xb_ld(&bar[XB_XCNT(j)]); sum += c; cnt += (c > 0u) ? 1u : 0u; mine = (j == x) ? c : mine; }
        if (sum == G) break;
        __builtin_amdgcn_s_sleep(1);
        if ((++sp & 255u) == 0u) { if (xb_ld(&bar[XB_TMO])) break; if (sp > XB_SPIN_CAP) { atomicAdd(&bar[XB_TMO], 1u); break; } }
    }
    nloc = mine > 0u ? mine : 1u; nx = cnt > 0u ? cnt : 1u;
}
__device__ __forceinline__ void xcd_barrier(const XcdBarrier& b) {
    asm volatile("s_waitcnt vmcnt(0)" ::: "memory");
    __syncthreads();
    if (threadIdx.x == 0) {
        unsigned* bar = b.bar;
        __builtin_amdgcn_s_waitcnt(0);
        unsigned nloc = b.st[0], nx = b.st[1];
        if (nloc == 0u) { xcd_barrier_complete(bar, b.x, nloc, nx); b.st[0] = nloc; b.st[1] = nx; }
        const unsigned old = xb_add(&bar[XB_XSUB(b.x)], 1u);
        const unsigned gen = old / nloc;
        if (old + 1u == (gen + 1u) * nloc) {
            __builtin_amdgcn_fence(__ATOMIC_RELEASE, "agent");
            asm volatile("s_waitcnt vmcnt(0)" ::: "memory");
            const unsigned og = xb_add(&bar[XB_TOP], 1u);
            const unsigned tg = og / nx;
            if (og + 1u == (tg + 1u) * nx) xb_add(&bar[XB_TOPGEN], 1u);
            else XB_SPIN(xb_ld(&bar[XB_TOPGEN]) == tg, bar);
            __builtin_amdgcn_fence(__ATOMIC_ACQUIRE, "agent");
            xb_add(&bar[XB_XGEN(b.x)], 1u);
            asm volatile("s_waitcnt vmcnt(0)" ::: "memory");
        } else {
            XB_SPIN(xb_ld(&bar[XB_XGEN(b.x)]) == gen, bar);
            __builtin_amdgcn_fence(__ATOMIC_ACQUIRE, "agent");
            asm volatile("s_waitcnt vmcnt(0)" ::: "memory");
        }
    }
    __syncthreads();
}

struct Args { const float* in[23]; float* out; unsigned char* ws; int pad0, pad1; };

__global__ void __launch_bounds__(NTHREADS, 2) mk_fwd(Args args) {
    extern __shared__ __attribute__((aligned(16))) unsigned char lds_raw[];
    LAS unsigned char* lds = (LAS unsigned char*)lds_raw;
    cg::grid_group grid = cg::this_grid();
    const int tid = threadIdx.x, lane = tid & 63, wave = __builtin_amdgcn_readfirstlane(tid >> 6);
    const int G = gridDim.x, bx = blockIdx.x;
    const int gw = bx * NWAVES + wave, NGW = G * NWAVES;
    typedef const float* cfp;
    const __attribute__((address_space(4))) cfp* inp = (const __attribute__((address_space(4))) cfp*)__builtin_amdgcn_kernarg_segment_ptr();
#define INP(k) (inp[k])
#define LAUNDER_S(v) asm volatile("" : "+s"(v))
    unsigned char* ws = args.ws;
    float* out = args.out;
    volatile LAS unsigned* bst = (volatile LAS unsigned*)(lds + 131072 + 64);
    if (tid < 2) bst[tid] = 0u;
    __syncthreads();
    if (bx == 0) for (int i = tid; i < XCD_BAR_WORDS; i += NTHREADS) ((unsigned*)(ws + WS_CTL))[i] = 0u;
#define GRID_BAR() do { XcdBarrier xb_; xb_.bar = (unsigned*)(args.ws + WS_CTL); xb_.x = xb_xcc_id(); xb_.st = (volatile LAS unsigned*)(lds + 131072 + 64); xcd_barrier(xb_); } while (0)
    bf16_t* HID = (bf16_t*)(ws + WS_BIG); bf16_t* ZM = (bf16_t*)(ws + WS_BIG); bf16_t* VT = (bf16_t*)(ws + WS_VT); bf16_t* KH = (bf16_t*)(ws + WS_KH); bf16_t* HB = (bf16_t*)(ws + WS_H); bf16_t* HB2 = (bf16_t*)(ws + WS_H2); float* SSQ = (float*)(ws + WS_SSQ); float* YP = (float*)(ws + WS_YP);

    {
        LAS float* scr = (LAS float*)(lds + wave * 16384);
        constexpr int I_G = (D / 64) * (FF / 32), I_D = (FF / 64) * (D / 32), I_IN = (D / 64) * (DIN / 32), I_O = (D / 64) * (D / 32);
        constexpr int PER_LAYER = 4 * I_G + 2 * I_D + I_IN + I_O;
        for (int it = gw; it < DEPTH * PER_LAYER; it += NGW) {
            const int l = it / PER_LAYER; int r = it % PER_LAYER;
            unsigned char* wl = ws + (size_t)l * LAYER_W;
            if (r < I_G) { p0_transpose_item(INP(2) + (size_t)l * D * FF, INP(1) + (size_t)l * D, D, FF, (bf16_t*)(wl + OFF_WGU1), 0, scr, r, lane); continue; } r -= I_G;
            if (r < I_G) { p0_transpose_item(INP(3) + (size_t)l * D * FF, INP(1) + (size_t)l * D, D, FF, (bf16_t*)(wl + OFF_WGU1), 128, scr, r, lane); continue; } r -= I_G;
            if (r < I_D) { p0_transpose_item(INP(4) + (size_t)l * FF * D, nullptr, FF, D, (bf16_t*)(wl + OFF_WD1), -1, scr, r, lane); continue; } r -= I_D;
            if (r < I_IN) { p0_transpose_item(INP(6) + (size_t)l * D * DIN, INP(5) + (size_t)l * D, D, DIN, (bf16_t*)(wl + OFF_WIN), -1, scr, r, lane); continue; } r -= I_IN;
            if (r < I_O) { p0_transpose_item(INP(17) + (size_t)l * D * D, INP(15) + (size_t)l * DL, D, D, (bf16_t*)(wl + OFF_WOUT), -1, scr, r, lane, INP(16) + (size_t)l * DL); continue; } r -= I_O;
            if (r < I_G) { p0_transpose_item(INP(19) + (size_t)l * D * FF, INP(18) + (size_t)l * D, D, FF, (bf16_t*)(wl + OFF_WGU2), 0, scr, r, lane); continue; } r -= I_G;
            if (r < I_G) { p0_transpose_item(INP(20) + (size_t)l * D * FF, INP(18) + (size_t)l * D, D, FF, (bf16_t*)(wl + OFF_WGU2), 128, scr, r, lane); continue; } r -= I_G;
            p0_transpose_item(INP(21) + (size_t)l * FF * D, nullptr, FF, D, (bf16_t*)(wl + OFF_WD2), -1, scr, r, lane);
        }
        cast_rows_bf16(INP(0), HB, SSQ, gw, NGW, lane);
    }
    grid.sync();
    (void)xcd_barrier_post((unsigned*)(ws + WS_CTL), bst);

#pragma unroll 1
    for (int l = 0; l < DEPTH; ++l) {
        unsigned char* wl = ws + (size_t)l * LAYER_W;
#pragma unroll 1
        for (int f = 0; f < 2; ++f) {
            LAUNDER_S(inp);
            {
                pg8::Gemm g{HB, (const bf16_t*)(wl + (f ? OFF_WGU2 : OFF_WGU1)), M, 2 * FF, D}; pg8::StaticOrder S; S.init(M, 2 * FF, G, bx);
                { if (tid == 0) *(volatile LAS int*)(lds + pg8::LDS_RSPM) = -1; __syncthreads(); }
                pg8::EpiSwiGLU E{HID, FF, SSQ + (size_t)(3 * l + (f ? 2 : 0)) * M * 8, lds};
                pg8::gemm_phase<pg8::EpiSwiGLU, pg8::StaticOrder, true, true>(lds, g, S, E);
            }
            GRID_BAR();
            {
                pg8::Gemm g{HID, (const bf16_t*)(wl + (f ? OFF_WD2 : OFF_WD1)), M, D, FF}; pg8::StaticOrder S; S.init(M, D, G, bx);
                pg8::EpiResid<true> E{HB, SSQ + (size_t)(3 * l + (f ? 3 : 1)) * M * 8, lds};
                pg8::gemm_phase<pg8::EpiResid<true>, pg8::StaticOrder, true, true>(lds, g, S, E);
            }
            GRID_BAR();
            if (f == 0) {
                {
                    pg8::Gemm g{HB, (const bf16_t*)(wl + OFF_WIN), M, DIN, D}; pg8::StaticOrder S; S.init(M, DIN, G, bx);
                    { if (tid == 0) *(volatile LAS int*)(lds + pg8::LDS_RSPM) = -1; __syncthreads(); }
                    pg8::EpiZ E{ZM, VT, KH, SSQ + (size_t)(3 * l + 1) * M * 8, lds};
                    pg8::gemm_phase<pg8::EpiZ, pg8::StaticOrder, true, true>(lds, g, S, E);
                }
                GRID_BAR();
                {
                    LAS float* biasL = (LAS float*)(lds + LM_BIAS);
                    const float* rb = INP(14) + (size_t)l * NH * NREL;
                    int tid_m = tid; LAUNDER(tid_m);
                    for (int i = tid_m; i < NH * NREL; i += NTHREADS) biasL[i] = rb[i] * LOG2E;
                    __syncthreads();
                    for (int u = bx; u < NB * 16; u += G)
                        lru_unit(lds, ZM, HB2, YP, INP(7) + (size_t)l * 4 * DL, INP(8) + (size_t)l * DL, INP(9) + (size_t)l * 16 * 64 * 64, INP(10) + (size_t)l * DL,
                                 INP(11) + (size_t)l * 16 * 64 * 64, INP(12) + (size_t)l * DL, INP(13) + (size_t)l * DL, u >> 4, u & 15, tid);
                    for (int bu = bx; bu < 1024; bu += G) {
                        const int kk = bu >> 8, bxv = bu & 255;
                        const int ag = ((bxv & 7) + 2 * kk) & 7, ap = (bxv >> 3) + 32 * kk;
                        attn_block(lds, ZM, KH, VT, HB2, YP, biasL, ap >> 3, ap & 7, ag, tid);
                    }
                }
                GRID_BAR();
                {
                    pg8::Gemm g{HB2, (const bf16_t*)(wl + OFF_WOUT), M, D, D}; pg8::StaticOrder S; S.init(M, D, G, bx);
                    { if (tid == 0) *(volatile LAS int*)(lds + pg8::LDS_RS2PM) = -1; __syncthreads(); }
                    pg8::EpiResidY E{HB, SSQ + (size_t)(3 * l + 2) * M * 8, YP, lds};
                    { pg8::Unit u0; if (S.next(0, u0)) E.prep(u0); }
                    pg8::gemm_phase<pg8::EpiResidY, pg8::StaticOrder, true, true>(lds, g, S, E);
                }
                GRID_BAR();
            } else {
                if (l + 1 == DEPTH) rms_rows_bf16_to_f32(HB, INP(22), out, gw, NGW, lane);
            }
        }
    }
}

extern "C" void kernel_launch(void* const* d_in, const int* in_sizes, int n_in, void* d_out, int out_size, void* d_ws, size_t ws_size, hipStream_t stream) {
    static int grid = 0;
    if (grid == 0) {
        if (n_in != 23 || in_sizes[0] != M * D || out_size != M * D || ws_size < WS_END) {
            fprintf(stderr, "kernel_launch: unexpected shapes: n_in %d in0 %d out %d ws %zu (need %zu)\n", n_in, n_in > 0 ? in_sizes[0] : -1, out_size, ws_size, (size_t)WS_END); grid = -1; return; }
        int dev = 0, cus = 0, per_cu = 0;
        hipGetDevice(&dev); hipDeviceGetAttribute(&cus, hipDeviceAttributeMultiprocessorCount, dev);
        if (hipFuncSetAttribute((const void*)mk_fwd, hipFuncAttributeMaxDynamicSharedMemorySize, LDS_BYTES) != hipSuccess) fprintf(stderr, "kernel_launch: hipFuncSetAttribute failed\n");
        if (hipOccupancyMaxActiveBlocksPerMultiprocessor(&per_cu, (const void*)mk_fwd, NTHREADS, LDS_BYTES) != hipSuccess || per_cu < 1) { fprintf(stderr, "kernel_launch: occupancy query gave %d\n", per_cu); per_cu = 1; }
        (void)hipGetLastError();
        grid = cus * per_cu;
        if (grid > 256) grid = 256;
    }
    if (grid < 0) return;
    Args a{};
    for (int i = 0; i < 23; ++i) a.in[i] = (const float*)d_in[i];
    a.out = (float*)d_out; a.ws = (unsigned char*)d_ws;
    void* kargs[] = {&a};
    hipError_t e = hipLaunchCooperativeKernel((const void*)mk_fwd, dim3(grid), dim3(NTHREADS), kargs, LDS_BYTES, stream);
    if (e != hipSuccess) fprintf(stderr, "kernel_launch: cooperative launch failed: %s (grid %d)\n", hipGetErrorString(e), grid);
}
```

```cpp
#include <hip/hip_runtime.h>
#include <hip/hip_cooperative_groups.h>
#include <cstdio>
#include <cstdint>
namespace cg = cooperative_groups;

#define LAS __attribute__((address_space(3)))
#define LAUNDER(v) asm volatile("" : "+v"(v))
typedef unsigned short bf16_t;
typedef short bf16x8 __attribute__((ext_vector_type(8)));
typedef float f32x4 __attribute__((ext_vector_type(4)));
typedef float f32x2 __attribute__((ext_vector_type(2)));
typedef unsigned u32x4 __attribute__((ext_vector_type(4)));
typedef unsigned u32x2 __attribute__((ext_vector_type(2)));

constexpr int NB = 16, SEQ = 2048, M = NB * SEQ, D = 2048, FF = 5632, DIN = 5120, DL = 1024, NH = 8, HD = 128, NREL = 257, DEPTH = 2;
constexpr int ZLD = 3072;
constexpr float EPS = 1e-6f;
constexpr float LOG2E = 1.4426950408889634f;

constexpr size_t MiB = 1u << 20;
constexpr size_t SZ_WGU = (size_t)2 * FF * D * 2, SZ_WD = (size_t)D * FF * 2, SZ_WIN = (size_t)DIN * D * 2, SZ_WOUT = (size_t)D * D * 2;
constexpr size_t OFF_WGU1 = 0, OFF_WD1 = OFF_WGU1 + SZ_WGU, OFF_WIN = OFF_WD1 + SZ_WD, OFF_WOUT = OFF_WIN + SZ_WIN, OFF_WGU2 = OFF_WOUT + SZ_WOUT, OFF_WD2 = OFF_WGU2 + SZ_WGU;
constexpr size_t LAYER_W = OFF_WD2 + SZ_WD;
static_assert(LAYER_W == 160 * MiB, "weights per layer");
constexpr size_t WS_BIG = 2 * LAYER_W;
constexpr size_t WS_VT = WS_BIG + (size_t)M * ZLD * 2;
constexpr size_t WS_KH = WS_VT + (size_t)M * 1024 * 2;
constexpr size_t WS_H = WS_BIG + 352 * MiB;
constexpr size_t WS_H2 = WS_H + 128 * MiB;
constexpr size_t WS_SSQ = WS_H2 + 128 * MiB;
constexpr size_t WS_YP = WS_SSQ + 8 * MiB;
constexpr size_t WS_CTL = WS_YP + 4 * MiB;
constexpr size_t CTL_BYTES = 16384;
constexpr size_t WS_END = WS_CTL + 1 * MiB;
static_assert((size_t)M * FF * 2 == 352 * MiB, "hidden size");

constexpr int NWAVES = 8, NTHREADS = 512;
constexpr int LDS_BYTES = 147456;

__device__ __forceinline__ unsigned cvt_pk_bf16(float lo, float hi) { unsigned r; asm volatile("v_cvt_pk_bf16_f32 %0, %1, %2" : "=v"(r) : "v"(lo), "v"(hi)); return r; }
__device__ __forceinline__ float bf_lo(unsigned u) { return __uint_as_float(u << 16); }
__device__ __forceinline__ float bf_hi(unsigned u) { return __uint_as_float(u & 0xffff0000u); }
__device__ __forceinline__ float fast_exp2(float x) { return __builtin_amdgcn_exp2f(x); }
__device__ __forceinline__ float fast_rcp(float x) { return __builtin_amdgcn_rcpf(x); }
__device__ __forceinline__ float sigmoidf_(float x) { return fast_rcp(1.0f + fast_exp2(-LOG2E * x)); }

namespace pg8 {
constexpr int BM = 256, BK = 64, HALF = 128, HTB = HALF * BK * 2, STAGE_BYTES = 8 * HTB, NXCD = 8, WGM = 4;
__host__ __device__ __forceinline__ int lds_byte(int r, int c) { const int st = (r >> 4) * 2 + (c >> 5), rr = r & 15, cc = c & 31, ob = rr * 64 + cc * 2; return st * 1024 + (ob ^ (((ob >> 9) & 1) << 5)); }
__host__ __device__ __forceinline__ void stage_rc(int b, int& R, int& C) { const int st = b / 1024, sb = b % 1024, swz = sb ^ (((sb >> 9) & 1) << 5); R = (st >> 1) * 16 + swz / 64; C = (st & 1) * 32 + (swz % 64) / 2; }
__host__ __device__ __forceinline__ int perm32(int rho) { const int n = rho >> 4, i = rho & 15; return 8 * (i >> 2) + 4 * n + (i & 3); }

struct Unit { int pm, pn; };
struct Gemm { const bf16_t* A; const bf16_t* Bt; int M, N, K; };

struct StaticOrder {
    int nM, nN, nwg, G, c;
    __host__ __device__ void init(int M_, int N_, int G_, int c_) { nM = M_ / BM; nN = N_ / BM; nwg = nM * nN; G = G_; c = c_; }
    __host__ __device__ bool next(int i, Unit& u) const {
        const long L = (long)i * G + c; if (L >= nwg) return false;
        int wgid = (int)L; { const int q = nwg / NXCD, r = nwg % NXCD, xcd = wgid % NXCD, off = wgid / NXCD; wgid = (xcd < r ? xcd * (q + 1) : r * (q + 1) + (xcd - r) * q) + off; }
        const int nig = WGM * nN, gid = wgid / nig, fm = gid * WGM, gsz = (nM - fm) < WGM ? (nM - fm) : WGM;
        u.pm = fm + ((wgid % nig) % gsz); u.pn = (wgid % nig) / gsz; return true;
    }
    __device__ __forceinline__ void a_ready(const Unit&) const {}
    __device__ __forceinline__ void done(const Unit&) const {}
};


constexpr int LDS_RS = 131072 + 1024, LDS_RSPM = 131072 + 2048 + 64, LDS_SSP = 131072 + 4096;
__device__ __forceinline__ void rs_panel(LAS unsigned char* lds, const float* ssq, int pm) {
    volatile LAS int* pmL = (volatile LAS int*)(lds + LDS_RSPM); LAS float* rsL = (LAS float*)(lds + LDS_RS);
    if (pmL[0] != pm) {
        asm volatile("s_waitcnt lgkmcnt(0)" ::: "memory"); __builtin_amdgcn_s_barrier();
        const int t = threadIdx.x;
        if (t < 256) { const f32x4* pp = (const f32x4*)(ssq + (size_t)(pm * 256 + t) * 8); const f32x4 pa = pp[0], pb = pp[1];
            rsL[t] = __builtin_amdgcn_rsqf((((pa.x + pa.y) + (pa.z + pa.w)) + ((pb.x + pb.y) + (pb.z + pb.w))) * (1.0f / D) + EPS); }
        if (t == 0) pmL[0] = pm;
        asm volatile("s_waitcnt vmcnt(0) lgkmcnt(0)" ::: "memory"); __builtin_amdgcn_s_barrier();
    }
}
struct EpiSwiGLU {
    static constexpr bool PERM = true, AFTER_DRAIN = false, MIDK = false;
    bf16_t* O; int ldc; const float* ssq; LAS unsigned char* lds;
    __device__ __forceinline__ void operator()(const f32x4 (&acc)[2][2][4][2], const Unit& u, int wr, int wc, int fr, int fq) const {
        rs_panel(lds, ssq, u.pm);
        const LAS float* rsL = (const LAS float*)(lds + LDS_RS) + wr * 64 + fr;
        const int row0 = u.pm * BM + wr * 64 + fr; const int col0 = u.pn * HALF + wc * 32 + 8 * fq;
#pragma unroll
        for (int ai = 0; ai < 2; ++ai)
#pragma unroll
            for (int m = 0; m < 4; ++m) {
                bf16_t* rowp = O + (size_t)(row0 + ai * HALF + m * 16) * ldc + col0;
                const float rs = rsL[ai * HALF + m * 16];
                const float c1 = -LOG2E * rs, rs2 = rs * rs;
                float v[8];
#pragma unroll
                for (int n = 0; n < 2; ++n)
#pragma unroll
                    for (int hh = 0; hh < 2; ++hh) {
                        const f32x2 a2 = (f32x2){acc[ai][0][m][n][2 * hh], acc[ai][0][m][n][2 * hh + 1]}, b2 = (f32x2){acc[ai][1][m][n][2 * hh], acc[ai][1][m][n][2 * hh + 1]};
                        const f32x2 t2 = a2 * c1;
                        f32x2 d2; d2.x = fast_exp2(t2.x); d2.y = fast_exp2(t2.y); d2 = d2 + 1.0f;
                        f32x2 s2; s2.x = fast_rcp(d2.x); s2.y = fast_rcp(d2.y);
                        const f32x2 v2 = (a2 * b2) * (s2 * rs2);
                        v[n * 4 + 2 * hh] = v2.x; v[n * 4 + 2 * hh + 1] = v2.y; }
                u32x4 w; w.x = cvt_pk_bf16(v[0], v[1]); w.y = cvt_pk_bf16(v[2], v[3]); w.z = cvt_pk_bf16(v[4], v[5]); w.w = cvt_pk_bf16(v[6], v[7]);
                *(u32x4*)rowp = w;
            }
    }
};
template <bool HALFSC> struct EpiResid {
    static constexpr bool PERM = false, AFTER_DRAIN = false, MIDK = false;
    bf16_t* xb; float* ssq_part; LAS unsigned char* lds;
    __device__ __forceinline__ void operator()(const f32x4 (&acc)[2][2][4][2], const Unit& u, int wr, int wc, int fr, int fq) const {
        const float scale_ = HALFSC ? 0.5f : 1.0f; bf16_t* const xb_ = xb; float* const ssq_ = ssq_part;
        LAS float* pl = (LAS float*)(lds + LDS_SSP);
        const int col0 = u.pn * BM + wc * 32 + 4 * fq;
        const size_t base = (size_t)(u.pm * BM + wr * 64 + fr) * D + col0;
        u32x2 r[2][2][2][2];
#define ER_LOAD(buf, bb) do { _Pragma("unroll") for (int mm = 0; mm < 2; ++mm) _Pragma("unroll") for (int bj = 0; bj < 2; ++bj) _Pragma("unroll") for (int n = 0; n < 2; ++n) \
            r[buf][mm][bj][n] = *(const u32x2*)(xb_ + base + (size_t)(((bb) >> 1) * HALF + (((bb) & 1) * 2 + mm) * 16) * D + bj * HALF + n * 16); } while (0)
        ER_LOAD(0, 0);
#pragma unroll
        for (int bb = 0; bb < 4; ++bb) {
            if (bb < 3) ER_LOAD((bb + 1) & 1, bb + 1);
            const int ai = bb >> 1;
#pragma unroll
            for (int mm = 0; mm < 2; ++mm) { const int m = (bb & 1) * 2 + mm; const int rowl = ai * HALF + m * 16; const size_t off = base + (size_t)rowl * D; float ssum = 0.f;
#pragma unroll
                for (int bj = 0; bj < 2; ++bj)
#pragma unroll
                    for (int n = 0; n < 2; ++n) { const u32x2 rr = r[bb & 1][mm][bj][n]; const f32x4 a = acc[ai][bj][m][n];
                        const float o0 = bf_lo(rr.x) + a.x * scale_, o1 = bf_hi(rr.x) + a.y * scale_, o2 = bf_lo(rr.y) + a.z * scale_, o3 = bf_hi(rr.y) + a.w * scale_;
                        u32x2 w; w.x = cvt_pk_bf16(o0, o1); w.y = cvt_pk_bf16(o2, o3); *(u32x2*)(xb_ + off + bj * HALF + n * 16) = w;
                        ssum += (o0 * o0 + o1 * o1) + (o2 * o2 + o3 * o3); }
                ssum += __shfl_xor(ssum, 16); ssum += __shfl_xor(ssum, 32);
                if (fq == 0) pl[(rowl + wr * 64 + fr) * 4 + wc] = ssum;
            }
        }
#undef ER_LOAD
        asm volatile("s_waitcnt lgkmcnt(0)" ::: "memory"); __builtin_amdgcn_s_barrier();
        const int t = threadIdx.x;
        if (t < 256) { const f32x4 p = *(const LAS f32x4*)(pl + t * 4); ssq_[(size_t)(u.pm * BM + t) * 8 + u.pn] = (p.x + p.y) + (p.z + p.w); }
    }
};
struct EpiResidFinal {
    static constexpr bool PERM = false, AFTER_DRAIN = false, MIDK = false;
    const bf16_t* xb; float* out; const float* gfin; float* part; unsigned* cnt; LAS unsigned char* lds;
    __device__ __forceinline__ void operator()(f32x4 (&acc)[2][2][4][2], const Unit& u, int wr, int wc, int fr, int fq) const {
        const bf16_t* const xb_ = xb; float* const out_ = out; const float* const g_ = gfin; float* const part_ = part; unsigned* const cnt_ = cnt + 64 * u.pm;
        LAS float* pl = (LAS float*)(lds + LDS_SSP); LAS float* rsL = (LAS float*)(lds + LDS_RS);
        const int col0 = u.pn * BM + wc * 32 + 4 * fq;
        const size_t base = (size_t)(u.pm * BM + wr * 64 + fr) * D + col0;
        u32x2 r[2][2][2][2];
#define ER_LOAD(buf, bb) do { _Pragma("unroll") for (int mm = 0; mm < 2; ++mm) _Pragma("unroll") for (int bj = 0; bj < 2; ++bj) _Pragma("unroll") for (int n = 0; n < 2; ++n) \
            r[buf][mm][bj][n] = *(const u32x2*)(xb_ + base + (size_t)(((bb) >> 1) * HALF + (((bb) & 1) * 2 + mm) * 16) * D + bj * HALF + n * 16); } while (0)
        ER_LOAD(0, 0);
#pragma unroll
        for (int bb = 0; bb < 4; ++bb) {
            if (bb < 3) ER_LOAD((bb + 1) & 1, bb + 1);
            const int ai = bb >> 1;
#pragma unroll
            for (int mm = 0; mm < 2; ++mm) { const int m = (bb & 1) * 2 + mm; const int rowl = ai * HALF + m * 16; float ssum = 0.f;
#pragma unroll
                for (int bj = 0; bj < 2; ++bj)
#pragma unroll
                    for (int n = 0; n < 2; ++n) { const u32x2 rr = r[bb & 1][mm][bj][n]; const f32x4 a = acc[ai][bj][m][n];
                        const float o0 = bf_lo(rr.x) + a.x * 0.5f, o1 = bf_hi(rr.x) + a.y * 0.5f, o2 = bf_lo(rr.y) + a.z * 0.5f, o3 = bf_hi(rr.y) + a.w * 0.5f;
                        acc[ai][bj][m][n] = (f32x4){o0, o1, o2, o3};
                        ssum += (o0 * o0 + o1 * o1) + (o2 * o2 + o3 * o3); }
                ssum += __shfl_xor(ssum, 16); ssum += __shfl_xor(ssum, 32);
                if (fq == 0) pl[(rowl + wr * 64 + fr) * 4 + wc] = ssum;
            }
        }
#undef ER_LOAD
        asm volatile("s_waitcnt lgkmcnt(0)" ::: "memory"); __builtin_amdgcn_s_barrier(); asm volatile("" ::: "memory");
        const int t = threadIdx.x;
        if (t < 256) { const f32x4 p = *(const LAS f32x4*)(pl + t * 4); __hip_atomic_store(part_ + (size_t)(u.pm * BM + t) * 8 + u.pn, (p.x + p.y) + (p.z + p.w), __ATOMIC_RELAXED, __HIP_MEMORY_SCOPE_AGENT); }
        asm volatile("s_waitcnt vmcnt(0)" ::: "memory");
        if (t < 256 && (t & 63) == 0) (void)__hip_atomic_fetch_add(cnt_, 1u, __ATOMIC_RELAXED, __HIP_MEMORY_SCOPE_AGENT);
        if (t < 64) {
            unsigned spins = 0u;
            while ((unsigned)__builtin_amdgcn_readfirstlane((int)__hip_atomic_load(cnt_, __ATOMIC_RELAXED, __HIP_MEMORY_SCOPE_AGENT)) < 32u) { __builtin_amdgcn_s_sleep(2); if (++spins > (1u << 20)) break; }
            __builtin_amdgcn_fence(__ATOMIC_ACQUIRE, "agent");
        }
        asm volatile("s_waitcnt vmcnt(0) lgkmcnt(0)" ::: "memory"); __builtin_amdgcn_s_barrier(); asm volatile("" ::: "memory");
        if (t < 256) { const float* pp = part_ + (size_t)(u.pm * BM + t) * 8; float sq = 0.f;
#pragma unroll
            for (int j = 0; j < 8; ++j) sq += __hip_atomic_load(pp + j, __ATOMIC_RELAXED, __HIP_MEMORY_SCOPE_AGENT);
            rsL[t] = __builtin_amdgcn_rsqf(sq * (1.0f / D) + EPS); }
        asm volatile("s_waitcnt vmcnt(0) lgkmcnt(0)" ::: "memory"); __builtin_amdgcn_s_barrier(); asm volatile("" ::: "memory");
        f32x4 g4[2][2];
#pragma unroll
        for (int bj = 0; bj < 2; ++bj)
#pragma unroll
            for (int n = 0; n < 2; ++n) g4[bj][n] = *(const f32x4*)(g_ + col0 + bj * HALF + n * 16);
#pragma unroll
        for (int ai = 0; ai < 2; ++ai)
#pragma unroll
            for (int m = 0; m < 4; ++m) { const int rowl = ai * HALF + m * 16; const float rs = rsL[rowl + wr * 64 + fr]; const size_t off = base + (size_t)rowl * D;
#pragma unroll
                for (int bj = 0; bj < 2; ++bj)
#pragma unroll
                    for (int n = 0; n < 2; ++n) *(f32x4*)(out_ + off + bj * HALF + n * 16) = acc[ai][bj][m][n] * rs * g4[bj][n]; }
    }
};
constexpr int LDS_RS2 = 131072 + 8192, LDS_RS2PM = 131072 + 8192 + 2048 + 64;
__device__ __forceinline__ void rs2_panel(LAS unsigned char* lds, const float* yp, int pm) {
    volatile LAS int* pmL = (volatile LAS int*)(lds + LDS_RS2PM); LAS f32x2* rsL = (LAS f32x2*)(lds + LDS_RS2);
    if (pmL[0] != pm) {
        asm volatile("s_waitcnt lgkmcnt(0)" ::: "memory"); __builtin_amdgcn_s_barrier();
        const int t = threadIdx.x;
        if (t < 256) { const f32x4* pp = (const f32x4*)(yp + (size_t)(pm * 256 + t) * 24);
            const f32x4 a0 = pp[0], a1 = pp[1], a2 = pp[2], a3 = pp[3], b0 = pp[4], b1 = pp[5];
            const float sl = (((a0.x + a0.y) + (a0.z + a0.w)) + ((a1.x + a1.y) + (a1.z + a1.w))) + (((a2.x + a2.y) + (a2.z + a2.w)) + ((a3.x + a3.y) + (a3.z + a3.w)));
            const float sa = ((b0.x + b0.y) + (b0.z + b0.w)) + ((b1.x + b1.y) + (b1.z + b1.w));
            const float va = sa * (1.0f / 1024.f) + EPS, vl = sl * (1.0f / 1024.f) + EPS;
            rsL[t] = (f32x2){__builtin_amdgcn_rsqf(va), __builtin_amdgcn_rsqf(vl) * sqrtf(va)}; }
        if (t == 0) pmL[0] = pm;
        asm volatile("s_waitcnt vmcnt(0) lgkmcnt(0)" ::: "memory"); __builtin_amdgcn_s_barrier();
    }
}
struct EpiResidY {
    static constexpr bool PERM = false, AFTER_DRAIN = false, MIDK = true;
    bf16_t* xb; float* ssq_part; const float* yp; LAS unsigned char* lds;
    __device__ __forceinline__ void prep(const Unit& u) const { rs2_panel(lds, yp, u.pm); }
    __device__ __forceinline__ void mid(f32x4 (&acc)[2][2][4][2], const Unit& u, int wr, int wc, int fr, int fq) const {
        const LAS f32x2* rsL = (const LAS f32x2*)(lds + LDS_RS2) + wr * 64 + fr;
#pragma unroll
        for (int ai = 0; ai < 2; ++ai)
#pragma unroll
            for (int m = 0; m < 4; ++m) { const float q = rsL[ai * HALF + m * 16].y;
#pragma unroll
                for (int bj = 0; bj < 2; ++bj)
#pragma unroll
                    for (int n = 0; n < 2; ++n) acc[ai][bj][m][n] = acc[ai][bj][m][n] * q; }
    }
    __device__ __forceinline__ void operator()(const f32x4 (&acc)[2][2][4][2], const Unit& u, int wr, int wc, int fr, int fq) const {
        bf16_t* const xb_ = xb; float* const ssq_ = ssq_part;
        LAS float* pl = (LAS float*)(lds + LDS_SSP);
        const LAS f32x2* rsL = (const LAS f32x2*)(lds + LDS_RS2) + wr * 64 + fr;
        const int col0 = u.pn * BM + wc * 32 + 4 * fq;
        const size_t base = (size_t)(u.pm * BM + wr * 64 + fr) * D + col0;
        u32x2 r[2][2][2][2];
#define ER_LOAD(buf, bb) do { _Pragma("unroll") for (int mm = 0; mm < 2; ++mm) _Pragma("unroll") for (int bj = 0; bj < 2; ++bj) _Pragma("unroll") for (int n = 0; n < 2; ++n) \
            r[buf][mm][bj][n] = *(const u32x2*)(xb_ + base + (size_t)(((bb) >> 1) * HALF + (((bb) & 1) * 2 + mm) * 16) * D + bj * HALF + n * 16); } while (0)
        ER_LOAD(0, 0);
#pragma unroll
        for (int bb = 0; bb < 4; ++bb) {
            if (bb < 3) ER_LOAD((bb + 1) & 1, bb + 1);
            const int ai = bb >> 1;
#pragma unroll
            for (int mm = 0; mm < 2; ++mm) { const int m = (bb & 1) * 2 + mm; const int rowl = ai * HALF + m * 16; const size_t off = base + (size_t)rowl * D; float ssum = 0.f;
                const float scale_ = rsL[rowl].x;
#pragma unroll
                for (int bj = 0; bj < 2; ++bj)
#pragma unroll
                    for (int n = 0; n < 2; ++n) { const u32x2 rr = r[bb & 1][mm][bj][n]; const f32x4 a = acc[ai][bj][m][n];
                        const float o0 = bf_lo(rr.x) + a.x * scale_, o1 = bf_hi(rr.x) + a.y * scale_, o2 = bf_lo(rr.y) + a.z * scale_, o3 = bf_hi(rr.y) + a.w * scale_;
                        u32x2 w; w.x = cvt_pk_bf16(o0, o1); w.y = cvt_pk_bf16(o2, o3); *(u32x2*)(xb_ + off + bj * HALF + n * 16) = w;
                        ssum += (o0 * o0 + o1 * o1) + (o2 * o2 + o3 * o3); }
                ssum += __shfl_xor(ssum, 16); ssum += __shfl_xor(ssum, 32);
                if (fq == 0) pl[(rowl + wr * 64 + fr) * 4 + wc] = ssum;
            }
        }
#undef ER_LOAD
        asm volatile("s_waitcnt lgkmcnt(0)" ::: "memory"); __builtin_amdgcn_s_barrier();
        const int t = threadIdx.x;
        if (t < 256) { const f32x4 p = *(const LAS f32x4*)(pl + t * 4); ssq_[(size_t)(u.pm * BM + t) * 8 + u.pn] = (p.x + p.y) + (p.z + p.w); }
    }
};
struct EpiZ {
    static constexpr bool PERM = true, AFTER_DRAIN = false, MIDK = false;
    bf16_t* Z; bf16_t* Vt; bf16_t* Kh; const float* ssq; LAS unsigned char* lds;
    __device__ __forceinline__ void operator()(const f32x4 (&acc)[2][2][4][2], const Unit& u, int wr, int wc, int fr, int fq) const {
        rs_panel(lds, ssq, u.pm);
        float rs[2][4];
        { const LAS float* rsL = (const LAS float*)(lds + LDS_RS) + wr * 64 + fr;
#pragma unroll
          for (int ai = 0; ai < 2; ++ai)
#pragma unroll
            for (int m = 0; m < 4; ++m) rs[ai][m] = rsL[ai * HALF + m * 16]; }
        if (u.pn >= 12 && u.pn < 16) {
            const int b = (u.pm * BM) / SEQ; const int s0 = (u.pm * BM) % SEQ + wr * 64 + fr;
#pragma unroll
            for (int bj = 0; bj < 2; ++bj) {
                const int head = (u.pn - 12) * 2 + bj;
                bf16_t* hb = Kh + ((size_t)(b * NH + head) * SEQ + s0) * HD + wc * 32 + 8 * fq;
#pragma unroll
                for (int ai = 0; ai < 2; ++ai)
#pragma unroll
                    for (int m = 0; m < 4; ++m) { const f32x4 v0 = acc[ai][bj][m][0] * rs[ai][m], v1 = acc[ai][bj][m][1] * rs[ai][m];
                        u32x4 w; w.x = cvt_pk_bf16(v0[0], v0[1]); w.y = cvt_pk_bf16(v0[2], v0[3]); w.z = cvt_pk_bf16(v1[0], v1[1]); w.w = cvt_pk_bf16(v1[2], v1[3]);
                        *(u32x4*)(hb + (size_t)(ai * HALF + m * 16) * HD) = w; }
            }
        } else if (u.pn < 12) {
            const int row0 = u.pm * BM + wr * 64 + fr; const int col0 = u.pn * BM + wc * 32 + 8 * fq;
#pragma unroll
            for (int ai = 0; ai < 2; ++ai)
#pragma unroll
                for (int m = 0; m < 4; ++m) {
                    bf16_t* rowp = Z + (size_t)(row0 + ai * HALF + m * 16) * ZLD + col0;
#pragma unroll
                    for (int bj = 0; bj < 2; ++bj) { const f32x4 v0 = acc[ai][bj][m][0] * rs[ai][m], v1 = acc[ai][bj][m][1] * rs[ai][m];
                        u32x4 w; w.x = cvt_pk_bf16(v0[0], v0[1]); w.y = cvt_pk_bf16(v0[2], v0[3]); w.z = cvt_pk_bf16(v1[0], v1[1]); w.w = cvt_pk_bf16(v1[2], v1[3]);
                        *(u32x4*)(rowp + bj * HALF) = w; }
                }
        } else {
            const int b = (u.pm * BM) / SEQ; const int s0 = (u.pm * BM) % SEQ + wr * 64 + fr;
#pragma unroll
            for (int bj = 0; bj < 2; ++bj) {
                const int head = (u.pn - 16) * 2 + bj;
                bf16_t* hb = Vt + ((size_t)(b * NH + head) * HD + wc * 32 + 8 * fq) * SEQ + s0;
#pragma unroll
                for (int ai = 0; ai < 2; ++ai)
#pragma unroll
                    for (int m = 0; m < 4; ++m)
#pragma unroll
                        for (int n = 0; n < 2; ++n)
#pragma unroll
                            for (int i = 0; i < 4; ++i) {
                                const unsigned w = cvt_pk_bf16(acc[ai][bj][m][n][i] * rs[ai][m], 0.f);
                                hb[(size_t)(4 * n + i) * SEQ + ai * HALF + m * 16] = (bf16_t)(w & 0xffffu);
                            }
            }
        }
    }
};

template <class Epi, class Sched, bool ALIGN_EPI = false, bool SP2 = false>
__device__ __forceinline__ void gemm_phase(LAS unsigned char* lds, const Gemm g, const Sched& S, const Epi& E) {
    int tid_l = threadIdx.x; LAUNDER(tid_l);
    const int tid = tid_l, wid = __builtin_amdgcn_readfirstlane(tid >> 6), lane = tid & 63, wr = wid >> 2, wc = wid & 3, fr = lane & 15, fq = lane >> 4;
    const int K = g.K, nt = K / BK;
    unsigned voffA[2], voffB[2];
#pragma unroll
    for (int i = 0; i < 2; ++i) { int R, C; stage_rc(tid * 16 + i * 8192, R, C); const int Rb = Epi::PERM ? ((R & ~31) + perm32(R & 31)) : R;
        voffA[i] = (unsigned)(R * K + C) * 2u; voffB[i] = (unsigned)(Rb * K + C) * 2u; }
    const size_t kstep = (size_t)(BK * 2);
    const size_t hstep = (size_t)HALF * K * 2;
    const size_t tstep = 2 * hstep;
    const unsigned ldsw = (unsigned)wid * 1024u;
    const int aoff = lds_byte(wr * 64 + fr, fq * 8), boff = lds_byte(wc * 32 + fr, fq * 8);
#define PG8_SA(b, h) (((b) * 2 + (h)) * HTB)
#define PG8_SB(b, h) ((4 + (b) * 2 + (h)) * HTB)
#define PG8_STAGE(bufoff, gbase, voff) do { _Pragma("unroll") for (int _i = 0; _i < 2; ++_i) \
        __builtin_amdgcn_global_load_lds((const unsigned*)((const char*)(gbase) + (voff)[_i]), (LAS unsigned*)(lds + (bufoff) + ldsw + _i * 8192), 16, 0, 0); } while (0)
#define PG8_LDA(dst, b, h) do { _Pragma("unroll") for (int m = 0; m < 4; ++m) _Pragma("unroll") for (int k = 0; k < 2; ++k) dst[m][k] = *(const LAS bf16x8*)(lds + PG8_SA(b, h) + aoff + m * 2048 + k * 1024); } while (0)
#define PG8_LDB(dst, b, h) do { _Pragma("unroll") for (int n = 0; n < 2; ++n) _Pragma("unroll") for (int k = 0; k < 2; ++k) dst[n][k] = *(const LAS bf16x8*)(lds + PG8_SB(b, h) + boff + n * 2048 + k * 1024); } while (0)
#define PG8_MMA(ai, bj, At, Bt) do { __builtin_amdgcn_s_setprio(1); _Pragma("unroll") for (int m = 0; m < 4; ++m) _Pragma("unroll") for (int n = 0; n < 2; ++n) _Pragma("unroll") for (int k = 0; k < 2; ++k) \
        acc[ai][bj][m][n] = __builtin_amdgcn_mfma_f32_16x16x32_bf16(Bt[n][k], At[m][k], acc[ai][bj][m][n], 0, 0, 0); __builtin_amdgcn_s_setprio(0); } while (0)
#define PG8_MMA_NP(ai, bj, At, Bt) do { _Pragma("unroll") for (int m = 0; m < 4; ++m) _Pragma("unroll") for (int n = 0; n < 2; ++n) _Pragma("unroll") for (int k = 0; k < 2; ++k) \
        acc[ai][bj][m][n] = __builtin_amdgcn_mfma_f32_16x16x32_bf16(Bt[n][k], At[m][k], acc[ai][bj][m][n], 0, 0, 0); } while (0)
#define PG8_MMA2(ai, At, Ba, Bb) do { __builtin_amdgcn_s_setprio(1); PG8_MMA_NP(ai, 0, At, Ba); PG8_MMA_NP(ai, 1, At, Bb); __builtin_amdgcn_s_setprio(0); } while (0)
#define PG8_WAIT_V(n) asm volatile("s_waitcnt vmcnt(" #n ")" ::: "memory")
#define PG8_WAIT_L(n) asm volatile("s_waitcnt lgkmcnt(" #n ")" ::: "memory")
#define PG8_BAR __builtin_amdgcn_s_barrier()
#define PG8_SCHED __builtin_amdgcn_sched_barrier(0)
    Unit cur, nxt; int ui = 0;
    if (!S.next(0, cur)) return;
    f32x4 acc[2][2][4][2];
#pragma unroll
    for (int a = 0; a < 2; ++a)
#pragma unroll
        for (int b = 0; b < 2; ++b)
#pragma unroll
            for (int m = 0; m < 4; ++m)
#pragma unroll
                for (int n = 0; n < 2; ++n) acc[a][b][m][n] = (f32x4){0.f, 0.f, 0.f, 0.f};
    bf16x8 At[4][2], B0[2][2], B1[2][2];
    const char* cA = (const char*)g.A + (size_t)cur.pm * tstep; const char* cB = (const char*)g.Bt + (size_t)cur.pn * tstep;
    S.a_ready(cur);
    if constexpr (SP2) {
        PG8_STAGE(PG8_SB(0, 0), cB, voffB); PG8_STAGE(PG8_SB(0, 1), cB + hstep, voffB); PG8_STAGE(PG8_SA(0, 0), cA, voffA); PG8_STAGE(PG8_SA(0, 1), cA + hstep, voffA);
        if (wr == 1) PG8_BAR;
        PG8_WAIT_V(2); PG8_BAR;
        PG8_STAGE(PG8_SB(1, 0), cB + kstep, voffB); PG8_STAGE(PG8_SA(1, 0), cA + kstep, voffA); PG8_STAGE(PG8_SB(1, 1), cB + hstep + kstep, voffB);
        PG8_WAIT_V(6); PG8_BAR;
    } else {
        PG8_STAGE(PG8_SB(0, 0), cB, voffB); PG8_STAGE(PG8_SA(0, 0), cA, voffA); PG8_STAGE(PG8_SB(0, 1), cB + hstep, voffB); PG8_STAGE(PG8_SA(0, 1), cA + hstep, voffA);
        if (wr == 1) PG8_BAR;
        PG8_WAIT_V(4); PG8_BAR;
        PG8_STAGE(PG8_SB(1, 0), cB + kstep, voffB); PG8_STAGE(PG8_SA(1, 0), cA + kstep, voffA); PG8_STAGE(PG8_SB(1, 1), cB + hstep + kstep, voffB);
        PG8_WAIT_V(6); PG8_BAR;
    }
    for (;;) {
        const bool has_next = S.next(ui + 1, nxt);
        const char* nA = has_next ? (const char*)g.A + (size_t)nxt.pm * tstep : cA; const char* nB = has_next ? (const char*)g.Bt + (size_t)nxt.pn * tstep : cB;
        for (int t = 0; t < nt; t += 2) {
            if constexpr (Epi::MIDK) { if (t == (nt >> 1)) E.mid(acc, cur, wr, wc, fr, fq); }
            const bool last = (t == nt - 2);
            const char* a1 = cA + (size_t)(t + 1) * kstep;
            const char* a2 = last ? nA : cA + (size_t)(t + 2) * kstep; const char* b2 = last ? nB : cB + (size_t)(t + 2) * kstep;
            const char* a3 = a2 + kstep; const char* b3 = b2 + kstep;
            if (last && has_next) S.a_ready(nxt);
            if constexpr (SP2) {
            PG8_LDB(B0, 0, 0); PG8_LDB(B1, 0, 1); PG8_SCHED; PG8_LDA(At, 0, 0); PG8_STAGE(PG8_SA(1, 1), a1 + hstep, voffA);
            PG8_WAIT_V(8); PG8_WAIT_L(0); PG8_BAR; PG8_MMA2(0, At, B0, B1); PG8_BAR; PG8_SCHED;
            PG8_LDA(At, 0, 1); PG8_STAGE(PG8_SB(0, 0), b2, voffB); PG8_STAGE(PG8_SB(0, 1), b2 + hstep, voffB); PG8_STAGE(PG8_SA(0, 0), a2, voffA);
            PG8_WAIT_V(8); PG8_WAIT_L(0); PG8_BAR; PG8_MMA2(1, At, B0, B1); PG8_BAR; PG8_SCHED;
            PG8_LDB(B0, 1, 0); PG8_LDB(B1, 1, 1); PG8_SCHED; PG8_LDA(At, 1, 0); PG8_STAGE(PG8_SA(0, 1), a2 + hstep, voffA);
            PG8_WAIT_V(8); PG8_WAIT_L(0); PG8_BAR; PG8_MMA2(0, At, B0, B1); PG8_BAR; PG8_SCHED;
            PG8_LDA(At, 1, 1); PG8_STAGE(PG8_SB(1, 0), b3, voffB); PG8_STAGE(PG8_SB(1, 1), b3 + hstep, voffB); PG8_STAGE(PG8_SA(1, 0), a3, voffA);
            PG8_WAIT_V(8); PG8_WAIT_L(0); PG8_BAR; PG8_MMA2(1, At, B0, B1); PG8_BAR; PG8_SCHED;
            } else {
            PG8_LDB(B0, 0, 0); PG8_SCHED; PG8_LDA(At, 0, 0); PG8_STAGE(PG8_SA(1, 1), a1 + hstep, voffA);
            PG8_WAIT_L(8); PG8_BAR; PG8_WAIT_L(0); PG8_MMA(0, 0, At, B0); PG8_BAR; PG8_SCHED;
            PG8_LDB(B1, 0, 1); PG8_STAGE(PG8_SB(0, 0), b2, voffB);
            PG8_BAR; PG8_WAIT_L(0); PG8_MMA(0, 1, At, B1); PG8_BAR;
            PG8_LDA(At, 0, 1); PG8_STAGE(PG8_SA(0, 0), a2, voffA);
            PG8_BAR; PG8_WAIT_L(0); PG8_MMA(1, 0, At, B0); PG8_BAR; PG8_SCHED;
            PG8_STAGE(PG8_SB(0, 1), b2 + hstep, voffB);
            PG8_WAIT_V(6); PG8_BAR; PG8_MMA(1, 1, At, B1); PG8_BAR;
            PG8_LDB(B0, 1, 0); PG8_SCHED; PG8_LDA(At, 1, 0); PG8_STAGE(PG8_SA(0, 1), a2 + hstep, voffA);
            PG8_WAIT_L(8); PG8_BAR; PG8_WAIT_L(0); PG8_MMA(0, 0, At, B0); PG8_BAR; PG8_SCHED;
            PG8_LDB(B1, 1, 1); PG8_STAGE(PG8_SB(1, 0), b3, voffB);
            PG8_BAR; PG8_WAIT_L(0); PG8_MMA(0, 1, At, B1); PG8_BAR;
            PG8_LDA(At, 1, 1); PG8_STAGE(PG8_SA(1, 0), a3, voffA);
            PG8_BAR; PG8_WAIT_L(0); PG8_MMA(1, 0, At, B0); PG8_BAR; PG8_SCHED;
            PG8_STAGE(PG8_SB(1, 1), b3 + hstep, voffB);
            PG8_WAIT_V(6); PG8_BAR; PG8_MMA(1, 1, At, B1); PG8_BAR;
            }
        }
        if constexpr (ALIGN_EPI) { if (wr == 0) PG8_BAR; }
        if constexpr (!Epi::AFTER_DRAIN) { E(acc, cur, wr, wc, fr, fq); S.done(cur); }
        if constexpr (Epi::MIDK) { if (has_next) E.prep(nxt); }
        if (!has_next) break;
#pragma unroll
        for (int a = 0; a < 2; ++a)
#pragma unroll
            for (int b = 0; b < 2; ++b)
#pragma unroll
                for (int m = 0; m < 4; ++m)
#pragma unroll
                    for (int n = 0; n < 2; ++n) acc[a][b][m][n] = (f32x4){0.f, 0.f, 0.f, 0.f};
        cur = nxt; cA = nA; cB = nB; ++ui;
        if constexpr (ALIGN_EPI) { if (wr == 1) PG8_BAR; }
    }
    PG8_WAIT_V(0);
    if constexpr (!ALIGN_EPI) { if (wr == 0) PG8_BAR; }
    PG8_BAR;
#undef PG8_SA
#undef PG8_SB
#undef PG8_STAGE
#undef PG8_LDA
#undef PG8_LDB
#undef PG8_MMA
#undef PG8_MMA_NP
#undef PG8_MMA2
#undef PG8_WAIT_V
#undef PG8_WAIT_L
#undef PG8_BAR
#undef PG8_SCHED
}
}

#define LDS_WAIT() asm volatile("s_waitcnt lgkmcnt(0)" ::: "memory")

__device__ __forceinline__ float wave_sum(float v) {
#pragma unroll
    for (int o = 1; o < 64; o <<= 1) v += __shfl_xor(v, o);
    return v;
}

__device__ __forceinline__ void p0_transpose_item(const float* W, const float* gain, int K, int N, bf16_t* WT, int ilv, LAS float* scr, int item, int lane, const float* gain2 = nullptr) {
    const int nblk = N / 32, kb = item / nblk, nb = item % nblk, k0 = 64 * kb, n0 = 32 * nb;
#pragma unroll 8
    for (int i = 0; i < 32; ++i) { const int kk = 2 * i + (lane >> 5); scr[kk * 33 + (lane & 31)] = W[(size_t)(k0 + kk) * N + n0 + (lane & 31)]; }
    LDS_WAIT(); asm volatile("" ::: "memory");
    const int c = lane & 7;
    f32x4 g0 = (f32x4){1.f, 1.f, 1.f, 1.f}, g1 = g0;
    if (gain) { const float* gp = (gain2 && k0 >= 1024) ? gain2 + (k0 - 1024) : gain + k0; g0 = *(const f32x4*)(gp + 8 * c); g1 = *(const f32x4*)(gp + 8 * c + 4); }
#pragma unroll
    for (int j = 0; j < 4; ++j) { const int n = (lane >> 3) + 8 * j; const LAS float* s = scr + (8 * c) * 33 + n;
        u32x4 o; o.x = cvt_pk_bf16(s[0 * 33] * g0.x, s[1 * 33] * g0.y); o.y = cvt_pk_bf16(s[2 * 33] * g0.z, s[3 * 33] * g0.w); o.z = cvt_pk_bf16(s[4 * 33] * g1.x, s[5 * 33] * g1.y); o.w = cvt_pk_bf16(s[6 * 33] * g1.z, s[7 * 33] * g1.w);
        const int nn = n0 + n; const int row = ilv < 0 ? nn : ((nn >> 7) * 256 + (nn & 127) + ilv);
        *(u32x4*)(WT + (size_t)row * K + k0 + 8 * c) = o; }
    LDS_WAIT(); asm volatile("" ::: "memory");
}

__device__ __forceinline__ void rms_rows_bf16(const float* x, const float* g, bf16_t* out, int gw, int NGW, int lane) {
    LAUNDER(lane);
    f32x4 gv[8];
#pragma unroll
    for (int j = 0; j < 8; ++j) gv[j] = *(const f32x4*)(g + 4 * lane + 256 * j);
    for (int m = gw; m < M; m += NGW) {
        const f32x4* xr = (const f32x4*)(x + (size_t)m * D) + lane; f32x4 v[8]; float s = 0.f;
#pragma unroll
        for (int j = 0; j < 8; ++j) { v[j] = xr[64 * j]; s += (v[j].x * v[j].x + v[j].y * v[j].y) + (v[j].z * v[j].z + v[j].w * v[j].w); }
        const float rstd = 1.0f / sqrtf(wave_sum(s) * (1.0f / D) + EPS);
        u32x2* o8 = (u32x2*)(out + (size_t)m * D) + lane;
#pragma unroll
        for (int j = 0; j < 8; ++j) { const f32x4 o = v[j] * rstd * gv[j]; u32x2 w; w.x = cvt_pk_bf16(o.x, o.y); w.y = cvt_pk_bf16(o.z, o.w); o8[64 * j] = w; }
    }
}
__device__ __forceinline__ void cast_rows_bf16(const float* x, bf16_t* out, float* ssq, int gw, int NGW, int lane) {
    LAUNDER(lane);
    for (int m = gw; m < M; m += NGW) {
        const f32x4* xr = (const f32x4*)(x + (size_t)m * D) + lane; f32x4 v[8]; float s = 0.f;
#pragma unroll
        for (int j = 0; j < 8; ++j) { v[j] = xr[64 * j]; s += (v[j].x * v[j].x + v[j].y * v[j].y) + (v[j].z * v[j].z + v[j].w * v[j].w); }
        s = wave_sum(s);
        if (lane == 0) { f32x4* pp = (f32x4*)(ssq + (size_t)m * 8); pp[0] = (f32x4){s, 0.f, 0.f, 0.f}; pp[1] = (f32x4){0.f, 0.f, 0.f, 0.f}; }
        u32x2* o8 = (u32x2*)(out + (size_t)m * D) + lane;
#pragma unroll
        for (int j = 0; j < 8; ++j) { u32x2 w; w.x = cvt_pk_bf16(v[j].x, v[j].y); w.y = cvt_pk_bf16(v[j].z, v[j].w); o8[64 * j] = w; }
    }
}
__device__ __forceinline__ void rms_rows_f32_inplace(float* x, const float* g, int gw, int NGW, int lane) {
    LAUNDER(lane);
    f32x4 gv[8];
#pragma unroll
    for (int j = 0; j < 8; ++j) gv[j] = *(const f32x4*)(g + 4 * lane + 256 * j);
    for (int m = gw; m < M; m += NGW) {
        f32x4* xr = (f32x4*)(x + (size_t)m * D) + lane; f32x4 v[8]; float s = 0.f;
#pragma unroll
        for (int j = 0; j < 8; ++j) { v[j] = xr[64 * j]; s += (v[j].x * v[j].x + v[j].y * v[j].y) + (v[j].z * v[j].z + v[j].w * v[j].w); }
        const float rstd = 1.0f / sqrtf(wave_sum(s) * (1.0f / D) + EPS);
#pragma unroll
        for (int j = 0; j < 8; ++j) xr[64 * j] = v[j] * rstd * gv[j];
    }
}
__device__ __forceinline__ void rms_rows_bf16_to_f32(const bf16_t* x, const float* g, float* out, int gw, int NGW, int lane) {
    LAUNDER(lane);
    f32x4 gv[4][2];
#pragma unroll
    for (int j = 0; j < 4; ++j) { const float* gp = g + 512 * j + 8 * lane; gv[j][0] = *(const f32x4*)gp; gv[j][1] = *(const f32x4*)(gp + 4); }
    for (int m = gw; m < M; m += NGW) {
        const u32x4* xr = (const u32x4*)(x + (size_t)m * D) + lane; u32x4 raw[4]; float s = 0.f;
#pragma unroll
        for (int j = 0; j < 4; ++j) raw[j] = xr[64 * j];
        float v[4][8];
#pragma unroll
        for (int j = 0; j < 4; ++j) {
            v[j][0] = bf_lo(raw[j].x); v[j][1] = bf_hi(raw[j].x); v[j][2] = bf_lo(raw[j].y); v[j][3] = bf_hi(raw[j].y);
            v[j][4] = bf_lo(raw[j].z); v[j][5] = bf_hi(raw[j].z); v[j][6] = bf_lo(raw[j].w); v[j][7] = bf_hi(raw[j].w);
#pragma unroll
            for (int e = 0; e < 8; ++e) s += v[j][e] * v[j][e];
        }
        const float rstd = 1.0f / sqrtf(wave_sum(s) * (1.0f / D) + EPS);
        f32x4* orow = (f32x4*)(out + (size_t)m * D + 8 * lane);
#pragma unroll
        for (int j = 0; j < 4; ++j) {
            orow[128 * j] = (f32x4){v[j][0] * rstd * gv[j][0].x, v[j][1] * rstd * gv[j][0].y, v[j][2] * rstd * gv[j][0].z, v[j][3] * rstd * gv[j][0].w};
            orow[128 * j + 1] = (f32x4){v[j][4] * rstd * gv[j][1].x, v[j][5] * rstd * gv[j][1].y, v[j][6] * rstd * gv[j][1].z, v[j][7] * rstd * gv[j][1].w};
        }
    }
}
__device__ __forceinline__ void ynorm_rows(bf16_t* y, const float* g_lru, const float* g_att, int gw, int NGW, int lane) {
    LAUNDER(lane);
    f32x4 gv[4][2];
#pragma unroll
    for (int j = 0; j < 4; ++j) { const float* gp = (j < 2 ? g_lru + 512 * j : g_att + 512 * (j - 2)) + 8 * lane; gv[j][0] = *(const f32x4*)gp; gv[j][1] = *(const f32x4*)(gp + 4); }
    for (int m = gw; m < M; m += NGW) {
        u32x4* yr = (u32x4*)(y + (size_t)m * D) + lane; u32x4 raw[4]; float s0 = 0.f, s1 = 0.f;
#pragma unroll
        for (int j = 0; j < 4; ++j) raw[j] = yr[64 * j];
        float v[4][8];
#pragma unroll
        for (int j = 0; j < 4; ++j) {
            v[j][0] = bf_lo(raw[j].x); v[j][1] = bf_hi(raw[j].x); v[j][2] = bf_lo(raw[j].y); v[j][3] = bf_hi(raw[j].y);
            v[j][4] = bf_lo(raw[j].z); v[j][5] = bf_hi(raw[j].z); v[j][6] = bf_lo(raw[j].w); v[j][7] = bf_hi(raw[j].w);
            float s = 0.f;
#pragma unroll
            for (int e = 0; e < 8; ++e) s += v[j][e] * v[j][e];
            if (j < 2) s0 += s; else s1 += s;
        }
        const float r0 = 1.0f / sqrtf(wave_sum(s0) * (1.0f / 1024.f) + EPS), r1 = 1.0f / sqrtf(wave_sum(s1) * (1.0f / 1024.f) + EPS);
#pragma unroll
        for (int j = 0; j < 4; ++j) { const float r = j < 2 ? r0 : r1; u32x4 w;
            w.x = cvt_pk_bf16(v[j][0] * r * gv[j][0].x, v[j][1] * r * gv[j][0].y); w.y = cvt_pk_bf16(v[j][2] * r * gv[j][0].z, v[j][3] * r * gv[j][0].w);
            w.z = cvt_pk_bf16(v[j][4] * r * gv[j][1].x, v[j][5] * r * gv[j][1].y); w.w = cvt_pk_bf16(v[j][6] * r * gv[j][1].z, v[j][7] * r * gv[j][1].w);
            yr[64 * j] = w; }
    }
}

constexpr int LM_BIAS = 0;
constexpr int LM_CW = 8448;
constexpr int LM_CB = 9472;
constexpr int LM_P = 10240;
constexpr int LM_H = 18432;
__device__ __forceinline__ void lru_unit(LAS unsigned char* lds, const bf16_t* zm, bf16_t* yraw, float* yp, const float* conv_w, const float* conv_b, const float* wa, const float* ba,
                                         const float* wx, const float* bx, const float* lam, int b, int hb, int tid) {
    LAUNDER(tid);
    const int lane = tid & 63, w = tid >> 6, fr = lane & 15, fq = lane >> 4;
    LAS float* cwL = (LAS float*)(lds + LM_CW); LAS float* cbL = (LAS float*)(lds + LM_CB);
    if (tid < 256) cwL[tid] = conv_w[(tid >> 6) * DL + hb * 64 + (tid & 63)];
    else if (tid < 320) cbL[tid - 256] = conv_b[hb * 64 + tid - 256];
    bf16x8 WA[4][2], WX[4][2];
#pragma unroll
    for (int nt = 0; nt < 4; ++nt)
#pragma unroll
        for (int ks = 0; ks < 2; ++ks) {
            const float* pa = wa + ((size_t)hb * 64 + ks * 32 + 8 * fq) * 64 + nt * 16 + fr; const float* px = wx + ((size_t)hb * 64 + ks * 32 + 8 * fq) * 64 + nt * 16 + fr;
            u32x4 ua, ux;
            ua.x = cvt_pk_bf16(pa[0 * 64], pa[1 * 64]); ua.y = cvt_pk_bf16(pa[2 * 64], pa[3 * 64]); ua.z = cvt_pk_bf16(pa[4 * 64], pa[5 * 64]); ua.w = cvt_pk_bf16(pa[6 * 64], pa[7 * 64]);
            ux.x = cvt_pk_bf16(px[0 * 64], px[1 * 64]); ux.y = cvt_pk_bf16(px[2 * 64], px[3 * 64]); ux.z = cvt_pk_bf16(px[4 * 64], px[5 * 64]); ux.w = cvt_pk_bf16(px[6 * 64], px[7 * 64]);
            WA[nt][ks] = __builtin_bit_cast(bf16x8, ua); WX[nt][ks] = __builtin_bit_cast(bf16x8, ux);
        }
    bf16x8 ID[2];
#pragma unroll
    for (int p = 0; p < 2; ++p)
#pragma unroll
        for (int e = 0; e < 8; ++e) ID[p][e] = (8 * fq + e == 16 * p + fr) ? (short)0x3F80 : (short)0;
    float pba[4], pbx[4], pcl[4];
#pragma unroll
    for (int nt = 0; nt < 4; ++nt) { const int c = hb * 64 + nt * 16 + fr; pba[nt] = ba[c]; pbx[nt] = bx[c]; pcl[nt] = -8.0f * log1pf(expf(-lam[c])); }
    __syncthreads();
    float hin[4] = {0.f, 0.f, 0.f, 0.f};
    const bf16_t* zb = zm + (size_t)b * SEQ * ZLD + hb * 64;
    LAS f32x2* TOT = (LAS f32x2*)(lds + LM_P);
    u32x4 XR[2][4], GR[2];
    {
        const int tA = 16 * w + fr;
#pragma unroll
        for (int ks = 0; ks < 2; ++ks) {
            const int ch0 = ks * 32 + 8 * fq;
#pragma unroll
            for (int tap = 0; tap < 4; ++tap) { const int t = tA - 3 + tap; const int tt = t >= 0 ? t : 0; XR[ks][tap] = *(const u32x4*)(zb + (size_t)tt * ZLD + ch0); }
            GR[ks] = *(const u32x4*)(zb + (size_t)tA * ZLD + 1024 + ch0);
        }
    }
#pragma unroll 1
    for (int sc = 0; sc < 16; ++sc) {
        const int tA = sc * 128 + 16 * w + fr;
        const int tN = sc < 15 ? tA + 128 : tA;
        u32x4 XN[2][4], GN[2];
#pragma unroll
        for (int ks = 0; ks < 2; ++ks) {
            const int ch0 = ks * 32 + 8 * fq;
#pragma unroll
            for (int tap = 0; tap < 4; ++tap) XN[ks][tap] = *(const u32x4*)(zb + (size_t)(tN - 3 + tap) * ZLD + ch0);
            GN[ks] = *(const u32x4*)(zb + (size_t)tN * ZLD + 1024 + ch0);
        }
        bf16x8 XC[2], GL[2];
#pragma unroll
        for (int ks = 0; ks < 2; ++ks) {
            const int ch0 = ks * 32 + 8 * fq;
            const f32x4 c0 = *(const LAS f32x4*)(cbL + ch0), c1 = *(const LAS f32x4*)(cbL + ch0 + 4);
            float a8[8] = {c0.x, c0.y, c0.z, c0.w, c1.x, c1.y, c1.z, c1.w};
#pragma unroll
            for (int tap = 0; tap < 4; ++tap) {
                const bool ok = (tA - 3 + tap) >= 0;
                u32x4 xr = XR[ks][tap];
                if (!ok) xr = (u32x4){0u, 0u, 0u, 0u};
                const f32x4 w0 = *(const LAS f32x4*)(cwL + tap * 64 + ch0), w1 = *(const LAS f32x4*)(cwL + tap * 64 + ch0 + 4);
                a8[0] += w0.x * bf_lo(xr.x); a8[1] += w0.y * bf_hi(xr.x); a8[2] += w0.z * bf_lo(xr.y); a8[3] += w0.w * bf_hi(xr.y);
                a8[4] += w1.x * bf_lo(xr.z); a8[5] += w1.y * bf_hi(xr.z); a8[6] += w1.z * bf_lo(xr.w); a8[7] += w1.w * bf_hi(xr.w);
            }
            u32x4 pk; pk.x = cvt_pk_bf16(a8[0], a8[1]); pk.y = cvt_pk_bf16(a8[2], a8[3]); pk.z = cvt_pk_bf16(a8[4], a8[5]); pk.w = cvt_pk_bf16(a8[6], a8[7]);
            XC[ks] = __builtin_bit_cast(bf16x8, pk);
            GL[ks] = __builtin_bit_cast(bf16x8, GR[ks]);
        }
        float hl[4][4], pc[4][4], gel[4][4], PE[4], HE[4];
        LAS f32x2* totw = TOT + ((sc & 1) * 8 + w) * 64;
#pragma unroll
        for (int nt = 0; nt < 4; ++nt) {
            f32x4 ga = (f32x4){0.f, 0.f, 0.f, 0.f}, gx = ga, xo = ga, go = ga;
#pragma unroll
            for (int ks = 0; ks < 2; ++ks) { ga = __builtin_amdgcn_mfma_f32_16x16x32_bf16(XC[ks], WA[nt][ks], ga, 0, 0, 0); gx = __builtin_amdgcn_mfma_f32_16x16x32_bf16(XC[ks], WX[nt][ks], gx, 0, 0, 0); }
            xo = __builtin_amdgcn_mfma_f32_16x16x32_bf16(XC[nt >> 1], ID[nt & 1], xo, 0, 0, 0);
            go = __builtin_amdgcn_mfma_f32_16x16x32_bf16(GL[nt >> 1], ID[nt & 1], go, 0, 0, 0);
#pragma unroll
            for (int hh = 0; hh < 2; ++hh) {
                const f32x2 ga2 = (f32x2){ga[2 * hh], ga[2 * hh + 1]}, gx2 = (f32x2){gx[2 * hh], gx[2 * hh + 1]}, xo2 = (f32x2){xo[2 * hh], xo[2 * hh + 1]}, go2 = (f32x2){go[2 * hh], go[2 * hh + 1]};
                const f32x2 ta = (ga2 + pba[nt]) * (-LOG2E), tx = (gx2 + pbx[nt]) * (-LOG2E);
                f32x2 da, dx; da.x = fast_exp2(ta.x); da.y = fast_exp2(ta.y); dx.x = fast_exp2(tx.x); dx.y = fast_exp2(tx.y);
                da = da + 1.0f; dx = dx + 1.0f;
                f32x2 r, ig; r.x = fast_rcp(da.x); r.y = fast_rcp(da.y); ig.x = fast_rcp(dx.x); ig.y = fast_rcp(dx.y);
                const f32x2 la2 = r * (pcl[nt] * LOG2E), x2 = r * (2.0f * pcl[nt]);
                f32x2 av; av.x = fast_exp2(la2.x); av.y = fast_exp2(la2.y);
                const f32x2 omp = -x2 * (x2 * 0.5f * (x2 * (1.0f / 3.0f) + 1.0f) + 1.0f), omd = 1.0f - av * av;
                f32x2 uv; uv.x = __builtin_amdgcn_sqrtf(x2.x < -0.03f ? omd.x : omp.x); uv.y = __builtin_amdgcn_sqrtf(x2.y < -0.03f ? omd.y : omp.y);
                uv = uv * ig * xo2;
                const f32x2 tg = go2 * (go2 * go2 * (-LOG2E * 1.5957691216057308f * 0.044715f) + (-LOG2E * 1.5957691216057308f));
                f32x2 dg; dg.x = fast_exp2(tg.x); dg.y = fast_exp2(tg.y); dg = dg + 1.0f;
                gel[nt][2 * hh] = go2.x * fast_rcp(dg.x); gel[nt][2 * hh + 1] = go2.y * fast_rcp(dg.y);
                if (hh == 0) { hl[nt][0] = uv.x; pc[nt][0] = av.x; }
                else { hl[nt][2] = av.x * hl[nt][1] + uv.x; pc[nt][2] = pc[nt][1] * av.x; }
                hl[nt][2 * hh + 1] = av.y * hl[nt][2 * hh] + uv.y; pc[nt][2 * hh + 1] = pc[nt][2 * hh] * av.y;
            }
            float P = pc[nt][3], H = hl[nt][3];
            { const float Pp = __shfl_up(P, 16), Hp = __shfl_up(H, 16); if (fq >= 1) { H = P * Hp + H; P = P * Pp; } }
            { const float Pp = __shfl_up(P, 32), Hp = __shfl_up(H, 32); if (fq >= 2) { H = P * Hp + H; P = P * Pp; } }
            { float Pe = __shfl_up(P, 16), He = __shfl_up(H, 16); if (fq == 0) { Pe = 1.0f; He = 0.0f; } PE[nt] = Pe; HE[nt] = He; }
            if (fq == 3) totw[nt * 16 + fr] = (f32x2){P, H};
        }
        asm volatile("s_waitcnt lgkmcnt(0)" ::: "memory"); __builtin_amdgcn_s_barrier(); asm volatile("" ::: "memory");
        float psq[4] = {0.f, 0.f, 0.f, 0.f};
#pragma unroll
        for (int nt = 0; nt < 4; ++nt) {
            float hrun = hin[nt], hws = hin[nt];
#pragma unroll
            for (int w2 = 0; w2 < 8; ++w2) { const f32x2 t2 = TOT[((sc & 1) * 8 + w2) * 64 + nt * 16 + fr]; hrun = t2.x * hrun + t2.y; if (w2 + 1 == w) hws = hrun; }
            hin[nt] = hrun;
            const float hs = PE[nt] * hws + HE[nt];
#pragma unroll
            for (int j = 0; j < 4; ++j) {
                const float ov = (hl[nt][j] + pc[nt][j] * hs) * gel[nt][j]; psq[j] += ov * ov;
                const unsigned o = cvt_pk_bf16(ov, 0.f);
                yraw[(size_t)(b * SEQ + sc * 128 + 16 * w + 4 * fq + j) * D + hb * 64 + nt * 16 + fr] = (bf16_t)(o & 0xffffu);
            }
        }
#pragma unroll
        for (int j = 0; j < 4; ++j) { float q = psq[j]; q += __shfl_xor(q, 1); q += __shfl_xor(q, 2); q += __shfl_xor(q, 4); q += __shfl_xor(q, 8);
            if (fr == 0) yp[(size_t)(b * SEQ + sc * 128 + 16 * w + 4 * fq + j) * 24 + hb] = q; }
#pragma unroll
        for (int ks = 0; ks < 2; ++ks) {
#pragma unroll
            for (int tap = 0; tap < 4; ++tap) XR[ks][tap] = XN[ks][tap];
            GR[ks] = GN[ks];
        }
    }
    __syncthreads();
}

constexpr int LM_ATT = 32768;
#define ATT_COMPUTE(FAR) do { \
        bf16x8 Kf[2][4], Vf[8]; \
        _Pragma("unroll") for (int t = 0; t < 2; ++t) _Pragma("unroll") for (int ks = 0; ks < 4; ++ks) Kf[t][ks] = *(const LAS bf16x8*)(sb + (t * 4 + ks) * 1024 + foff); \
        _Pragma("unroll") for (int dt = 0; dt < 8; ++dt) Vf[dt] = *(const LAS bf16x8*)(sb + 8192 + dt * 1024 + foff); \
        f32x4 St[2][2]; \
        _Pragma("unroll") for (int t = 0; t < 2; ++t) _Pragma("unroll") for (int qt = 0; qt < 2; ++qt) { f32x4 s_ = (f32x4){0.f, 0.f, 0.f, 0.f}; \
            _Pragma("unroll") for (int ks = 0; ks < 4; ++ks) s_ = __builtin_amdgcn_mfma_f32_16x16x32_bf16(Kf[t][ks], Q[qt][ks], s_, 0, 0, 0); \
            St[t][qt] = s_; } \
        bf16x8 Pf[2]; \
        _Pragma("unroll") for (int qt = 0; qt < 2; ++qt) { \
            const int qpos = c * 64 + qh * 32 + qt * 16 + fr; \
            float sv[8]; float bm = -1e30f; \
            _Pragma("unroll") for (int t = 0; t < 2; ++t) _Pragma("unroll") for (int j = 0; j < 4; ++j) { float bv_; \
                if (FAR) bv_ = bias0; else { int rel = k0 + 8 * fq + 4 * t + j - qpos; rel = rel < -128 ? -128 : (rel > 128 ? 128 : rel); bv_ = bias[rel + 128]; } \
                const float s_ = St[t][qt][j] * SC + bv_; sv[t * 4 + j] = s_; bm = fmaxf(bm, s_); } \
            bm = fmaxf(bm, __shfl_xor(bm, 16)); bm = fmaxf(bm, __shfl_xor(bm, 32)); \
            const float mn = (bm > mrun[qt] + 8.0f) ? bm : mrun[qt];     \
            if (__builtin_amdgcn_ballot_w64(mn != mrun[qt]) != 0ull) { const float alpha = fast_exp2(mrun[qt] - mn); mrun[qt] = mn; lrun[qt] = lrun[qt] * alpha; \
                _Pragma("unroll") for (int dt = 0; dt < 8; ++dt) O[dt][qt] = O[dt][qt] * alpha; } \
            float ps = 0.f; \
            _Pragma("unroll") for (int e = 0; e < 8; ++e) { sv[e] = fast_exp2(sv[e] - mn); ps += sv[e]; } \
            lrun[qt] = lrun[qt] + ps; \
            u32x4 pk; pk.x = cvt_pk_bf16(sv[0], sv[1]); pk.y = cvt_pk_bf16(sv[2], sv[3]); pk.z = cvt_pk_bf16(sv[4], sv[5]); pk.w = cvt_pk_bf16(sv[6], sv[7]); \
            Pf[qt] = __builtin_bit_cast(bf16x8, pk); } \
        _Pragma("unroll") for (int dt = 0; dt < 8; ++dt) _Pragma("unroll") for (int qt = 0; qt < 2; ++qt) O[dt][qt] = __builtin_amdgcn_mfma_f32_16x16x32_bf16(Vf[dt], Pf[qt], O[dt][qt], 0, 0, 0); \
    } while (0)
__device__ __forceinline__ void attn_block(LAS unsigned char* lds, const bf16_t* zm, const bf16_t* Kh, const bf16_t* Vt, bf16_t* yraw, float* yp, const LAS float* biasAll, int b, int h, int g, int tid) {
    LAUNDER(tid);
    const int lane = tid & 63, wave = tid >> 6, fr = lane & 15, fq = lane >> 4;
    const int c = 4 * g + (wave >> 1), qh = wave & 1;
    const LAS float* bias = biasAll + h * NREL;
    const float bias0 = bias[0];
    const float SC = 0.08838834764831845f * LOG2E;
    bf16x8 Q[2][4];
#pragma unroll
    for (int qt = 0; qt < 2; ++qt) { const size_t tok = (size_t)b * SEQ + c * 64 + qh * 32 + qt * 16 + fr;
#pragma unroll
        for (int ks = 0; ks < 4; ++ks) Q[qt][ks] = *(const bf16x8*)(zm + tok * ZLD + 2048 + h * HD + ks * 32 + 8 * fq); }
    f32x4 O[8][2];
#pragma unroll
    for (int dt = 0; dt < 8; ++dt)
#pragma unroll
        for (int qt = 0; qt < 2; ++qt) O[dt][qt] = (f32x4){0.f, 0.f, 0.f, 0.f};
    float mrun[2] = {-1e30f, -1e30f}, lrun[2] = {0.f, 0.f};
    const int lo = g >= 2 ? 4 * g - 8 : 0, nch = 4 * g + 4 - lo;
    const int kr = tid >> 4, c16 = tid & 15;
    const int krho = ((kr >> 3) << 2) | (kr & 3);
    const int kst = ((((kr >> 2) & 1) * 4 + (c16 >> 2)) * 1024) + ((krho * 64 + (c16 & 3) * 16) ^ (krho >= 8 ? 32 : 0));
    const bf16_t* kg = Kh + ((size_t)(b * NH + h) * SEQ + kr) * HD + 8 * c16;
    const int vd = tid >> 2, vq = tid & 3;
    const int vst = 8192 + (vd >> 4) * 1024 + (((vd & 15) * 64 + vq * 16) ^ ((vd & 15) >= 8 ? 32 : 0));
    const bf16_t* vg = Vt + ((size_t)(b * NH + h) * HD + vd) * SEQ + 8 * vq;
    const int foff = (fr * 64 + fq * 16) ^ (fr >= 8 ? 32 : 0);
    LAS unsigned char* st = lds + LM_ATT;
    { const int k0 = lo * 64;
      const u32x4 kv0 = *(const u32x4*)(kg + (size_t)k0 * HD), kv1 = *(const u32x4*)(kg + (size_t)(k0 + 32) * HD); const u32x4 vv0 = *(const u32x4*)(vg + k0), vv1 = *(const u32x4*)(vg + k0 + 32);
      *(LAS u32x4*)(st + kst) = kv0; *(LAS u32x4*)(st + vst) = vv0; *(LAS u32x4*)(st + 16384 + kst) = kv1; *(LAS u32x4*)(st + 16384 + vst) = vv1; }
    __syncthreads();
#pragma unroll 1
    for (int ci = 0; ci < nch; ++ci) {
        const int kc = lo + ci;
        const int k0n = (lo + (ci + 1 < nch ? ci + 1 : ci)) * 64;
        const u32x4 kv0 = *(const u32x4*)(kg + (size_t)k0n * HD), kv1 = *(const u32x4*)(kg + (size_t)(k0n + 32) * HD); const u32x4 vv0 = *(const u32x4*)(vg + k0n), vv1 = *(const u32x4*)(vg + k0n + 32);
        if (kc >= c - 8 && kc <= c) {
            const bool farc = kc <= c - 3;
#pragma unroll 1
            for (int hf = 0; hf < 2; ++hf) {
                const LAS unsigned char* sb = st + (ci & 1) * 32768 + hf * 16384; const int k0 = kc * 64 + hf * 32;
                if (farc) ATT_COMPUTE(true); else ATT_COMPUTE(false);
            }
        }
        LAS unsigned char* nb = st + ((ci + 1) & 1) * 32768;
        *(LAS u32x4*)(nb + kst) = kv0; *(LAS u32x4*)(nb + vst) = vv0; *(LAS u32x4*)(nb + 16384 + kst) = kv1; *(LAS u32x4*)(nb + 16384 + vst) = vv1;
        __syncthreads();
    }
#pragma unroll
    for (int qt = 0; qt < 2; ++qt) {
        float l = lrun[qt]; l += __shfl_xor(l, 16); l += __shfl_xor(l, 32);
        const float inv = 1.0f / l;
        bf16_t* op = yraw + ((size_t)b * SEQ + c * 64 + qh * 32 + qt * 16 + fr) * D + 1024 + h * HD + 4 * fq;
        float q = 0.f;
#pragma unroll
        for (int dt = 0; dt < 8; ++dt) { const f32x4 o = O[dt][qt] * inv; u32x2 w; w.x = cvt_pk_bf16(o.x, o.y); w.y = cvt_pk_bf16(o.z, o.w); *(u32x2*)(op + dt * 16) = w; q += (o.x * o.x + o.y * o.y) + (o.z * o.z + o.w * o.w); }
        q += __shfl_xor(q, 16); q += __shfl_xor(q, 32);
        if (fq == 0) yp[((size_t)b * SEQ + c * 64 + qh * 32 + qt * 16 + fr) * 24 + 16 + h] = q;
    }
}
#undef ATT_COMPUTE

#define XB_TMO      128
#define XB_XCNT(j)  (256  + 64 * (j))
#define XB_XSUB(j)  (1280 + 64 * (j))
#define XB_XGEN(j)  (2304 + 64 * (j))
#define XB_TOP      3328
#define XB_TOPGEN   3392
#define XCD_BAR_WORDS 3456
#define XB_SPIN_CAP (1u << 18)
__device__ __forceinline__ unsigned xb_ld(unsigned* p)              { return __hip_atomic_load(p, __ATOMIC_RELAXED, __HIP_MEMORY_SCOPE_AGENT); }
__device__ __forceinline__ unsigned xb_add(unsigned* p, unsigned v) { return __hip_atomic_fetch_add(p, v, __ATOMIC_RELAXED, __HIP_MEMORY_SCOPE_AGENT); }
__device__ __forceinline__ unsigned xb_xcc_id() { return (unsigned)__builtin_amdgcn_s_getreg((3 << 11) | 20) & 0xFu; }
#define XB_SPIN(cond, bar) do { unsigned _sp = 0; while (cond) { __builtin_amdgcn_s_sleep(1); \
    if ((++_sp & 255u) == 0u) { if (xb_ld(&(bar)[XB_TMO])) break; if (_sp > XB_SPIN_CAP) { atomicAdd(&(bar)[XB_TMO], 1u); break; } } } } while (0)
struct XcdBarrier { unsigned* bar; unsigned x; volatile LAS unsigned* st; };
__device__ __forceinline__ XcdBarrier xcd_barrier_post(unsigned* bar, volatile LAS unsigned* st) {
    XcdBarrier b; b.bar = bar; b.x = xb_xcc_id(); b.st = st;
    if (threadIdx.x == 0) (void)xb_add(&bar[XB_XCNT(b.x)], 1u);
    return b;
}
__device__ __forceinline__ void xcd_barrier_complete(unsigned* bar, unsigned x, unsigned& nloc, unsigned& nx) {
    const unsigned G = gridDim.x * gridDim.y * gridDim.z;
    unsigned sum, cnt, mine, sp = 0u;
    for (;;) {
        sum = 0u; cnt = 0u; mine = 0u;
#pragma unroll
        for (unsigned j = 0; j < 16; ++j) { const unsigned c = xb_ld(&bar[XB_XCNT(j)]); sum += c; cnt += (c > 0u) ? 1u : 0u; mine = (j == x) ? c : mine; }
        if (sum == G) break;
        __builtin_amdgcn_s_sleep(1);
        if ((++sp & 255u) == 0u) { if (xb_ld(&bar[XB_TMO])) break; if (sp > XB_SPIN_CAP) { atomicAdd(&bar[XB_TMO], 1u); break; } }
    }
    nloc = mine > 0u ? mine : 1u; nx = cnt > 0u ? cnt : 1u;
}
__device__ __forceinline__ void xcd_barrier(const XcdBarrier& b) {
    asm volatile("s_waitcnt vmcnt(0)" ::: "memory");
    __syncthreads();
    if (threadIdx.x == 0) {
        unsigned* bar = b.bar;
        __builtin_amdgcn_s_waitcnt(0);
        unsigned nloc = b.st[0], nx = b.st[1];
        if (nloc == 0u) { xcd_barrier_complete(bar, b.x, nloc, nx); b.st[0] = nloc; b.st[1] = nx; }
        const unsigned old = xb_add(&bar[XB_XSUB(b.x)], 1u);
        const unsigned gen = old / nloc;
        if (old + 1u == (gen + 1u) * nloc) {
            __builtin_amdgcn_fence(__ATOMIC_RELEASE, "agent");
            asm volatile("s_waitcnt vmcnt(0)" ::: "memory");
            const unsigned og = xb_add(&bar[XB_TOP], 1u);
            const unsigned tg = og / nx;
            if (og + 1u == (tg + 1u) * nx) xb_add(&bar[XB_TOPGEN], 1u);
            else XB_SPIN(xb_ld(&bar[XB_TOPGEN]) == tg, bar);
            __builtin_amdgcn_fence(__ATOMIC_ACQUIRE, "agent");
            xb_add(&bar[XB_XGEN(b.x)], 1u);
            asm volatile("s_waitcnt vmcnt(0)" ::: "memory");
        } else {
            XB_SPIN(xb_ld(&bar[XB_XGEN(b.x)]) == gen, bar);
            __builtin_amdgcn_fence(__ATOMIC_ACQUIRE, "agent");
            asm volatile("s_waitcnt vmcnt(0)" ::: "memory");
        }
    }
    __syncthreads();
}

struct Args { const float* in[23]; float* out; unsigned char* ws; int pad0, pad1; };

__global__ void __launch_bounds__(NTHREADS, 2) mk_fwd(Args args) {
    extern __shared__ __attribute__((aligned(16))) unsigned char lds_raw[];
    LAS unsigned char* lds = (LAS unsigned char*)lds_raw;
    cg::grid_group grid = cg::this_grid();
    const int tid = threadIdx.x, lane = tid & 63, wave = __builtin_amdgcn_readfirstlane(tid >> 6);
    const int G = gridDim.x, bx = blockIdx.x;
    const int gw = bx * NWAVES + wave, NGW = G * NWAVES;
    typedef const float* cfp;
    const __attribute__((address_space(4))) cfp* inp = (const __attribute__((address_space(4))) cfp*)__builtin_amdgcn_kernarg_segment_ptr();
#define INP(k) (inp[k])
#define LAUNDER_S(v) asm volatile("" : "+s"(v))
    unsigned char* ws = args.ws;
    float* out = args.out;
    volatile LAS unsigned* bst = (volatile LAS unsigned*)(lds + 131072 + 64);
    if (tid < 2) bst[tid] = 0u;
    __syncthreads();
    if (bx == 0) for (int i = tid; i < 12288; i += NTHREADS) ((unsigned*)(ws + WS_CTL))[i] = 0u;
#define GRID_BAR() do { XcdBarrier xb_; xb_.bar = (unsigned*)(args.ws + WS_CTL); xb_.x = xb_xcc_id(); xb_.st = (volatile LAS unsigned*)(lds + 131072 + 64); xcd_barrier(xb_); } while (0)
    bf16_t* HID = (bf16_t*)(ws + WS_BIG); bf16_t* ZM = (bf16_t*)(ws + WS_BIG); bf16_t* VT = (bf16_t*)(ws + WS_VT); bf16_t* KH = (bf16_t*)(ws + WS_KH); bf16_t* HB = (bf16_t*)(ws + WS_H); bf16_t* HB2 = (bf16_t*)(ws + WS_H2); float* SSQ = (float*)(ws + WS_SSQ); float* YP = (float*)(ws + WS_YP);

    {
        LAS float* scr = (LAS float*)(lds + wave * 16384);
        constexpr int I_G = (D / 64) * (FF / 32), I_D = (FF / 64) * (D / 32), I_IN = (D / 64) * (DIN / 32), I_O = (D / 64) * (D / 32);
        constexpr int PER_LAYER = 4 * I_G + 2 * I_D + I_IN + I_O;
        for (int it = gw; it < DEPTH * PER_LAYER; it += NGW) {
            const int l = it / PER_LAYER; int r = it % PER_LAYER;
            unsigned char* wl = ws + (size_t)l * LAYER_W;
            if (r < I_G) { p0_transpose_item(INP(2) + (size_t)l * D * FF, INP(1) + (size_t)l * D, D, FF, (bf16_t*)(wl + OFF_WGU1), 0, scr, r, lane); continue; } r -= I_G;
            if (r < I_G) { p0_transpose_item(INP(3) + (size_t)l * D * FF, INP(1) + (size_t)l * D, D, FF, (bf16_t*)(wl + OFF_WGU1), 128, scr, r, lane); continue; } r -= I_G;
            if (r < I_D) { p0_transpose_item(INP(4) + (size_t)l * FF * D, nullptr, FF, D, (bf16_t*)(wl + OFF_WD1), -1, scr, r, lane); continue; } r -= I_D;
            if (r < I_IN) { p0_transpose_item(INP(6) + (size_t)l * D * DIN, INP(5) + (size_t)l * D, D, DIN, (bf16_t*)(wl + OFF_WIN), -1, scr, r, lane); continue; } r -= I_IN;
            if (r < I_O) { p0_transpose_item(INP(17) + (size_t)l * D * D, INP(15) + (size_t)l * DL, D, D, (bf16_t*)(wl + OFF_WOUT), -1, scr, r, lane, INP(16) + (size_t)l * DL); continue; } r -= I_O;
            if (r < I_G) { p0_transpose_item(INP(19) + (size_t)l * D * FF, INP(18) + (size_t)l * D, D, FF, (bf16_t*)(wl + OFF_WGU2), 0, scr, r, lane); continue; } r -= I_G;
            if (r < I_G) { p0_transpose_item(INP(20) + (size_t)l * D * FF, INP(18) + (size_t)l * D, D, FF, (bf16_t*)(wl + OFF_WGU2), 128, scr, r, lane); continue; } r -= I_G;
            p0_transpose_item(INP(21) + (size_t)l * FF * D, nullptr, FF, D, (bf16_t*)(wl + OFF_WD2), -1, scr, r, lane);
        }
        cast_rows_bf16(INP(0), HB, SSQ, gw, NGW, lane);
    }
    grid.sync();
    (void)xcd_barrier_post((unsigned*)(ws + WS_CTL), bst);

#pragma unroll 1
    for (int l = 0; l < DEPTH; ++l) {
        unsigned char* wl = ws + (size_t)l * LAYER_W;
#pragma unroll 1
        for (int f = 0; f < 2; ++f) {
            LAUNDER_S(inp);
            {
                pg8::Gemm g{HB, (const bf16_t*)(wl + (f ? OFF_WGU2 : OFF_WGU1)), M, 2 * FF, D}; pg8::StaticOrder S; S.init(M, 2 * FF, G, bx);
                { if (tid == 0) *(volatile LAS int*)(lds + pg8::LDS_RSPM) = -1; __syncthreads(); }
                pg8::EpiSwiGLU E{HID, FF, SSQ + (size_t)(3 * l + (f ? 2 : 0)) * M * 8, lds};
                pg8::gemm_phase<pg8::EpiSwiGLU, pg8::StaticOrder, true, true>(lds, g, S, E);
            }
            GRID_BAR();
            {
                pg8::Gemm g{HID, (const bf16_t*)(wl + (f ? OFF_WD2 : OFF_WD1)), M, D, FF}; pg8::StaticOrder S; S.init(M, D, G, bx);
                if (l + 1 == DEPTH && f == 1) {
                    pg8::EpiResidFinal E{HB, out, INP(22), SSQ + (size_t)6 * M * 8, (unsigned*)(ws + WS_CTL) + 4096, lds};
                    pg8::gemm_phase<pg8::EpiResidFinal, pg8::StaticOrder, true, true>(lds, g, S, E);
                } else {
                    pg8::EpiResid<true> E{HB, SSQ + (size_t)(3 * l + (f ? 3 : 1)) * M * 8, lds};
                    pg8::gemm_phase<pg8::EpiResid<true>, pg8::StaticOrder, true, true>(lds, g, S, E);
                }
            }
            if (!(l + 1 == DEPTH && f == 1)) GRID_BAR();
            if (f == 0) {
                {
                    pg8::Gemm g{HB, (const bf16_t*)(wl + OFF_WIN), M, DIN, D}; pg8::StaticOrder S; S.init(M, DIN, G, bx);
                    { if (tid == 0) *(volatile LAS int*)(lds + pg8::LDS_RSPM) = -1; __syncthreads(); }
                    pg8::EpiZ E{ZM, VT, KH, SSQ + (size_t)(3 * l + 1) * M * 8, lds};
                    pg8::gemm_phase<pg8::EpiZ, pg8::StaticOrder, true, true>(lds, g, S, E);
                }
                GRID_BAR();
                {
                    LAS float* biasL = (LAS float*)(lds + LM_BIAS);
                    const float* rb = INP(14) + (size_t)l * NH * NREL;
                    int tid_m = tid; LAUNDER(tid_m);
                    for (int i = tid_m; i < NH * NREL; i += NTHREADS) biasL[i] = rb[i] * LOG2E;
                    __syncthreads();
                    for (int u = bx; u < NB * 16; u += G)
                        lru_unit(lds, ZM, HB2, YP, INP(7) + (size_t)l * 4 * DL, INP(8) + (size_t)l * DL, INP(9) + (size_t)l * 16 * 64 * 64, INP(10) + (size_t)l * DL,
                                 INP(11) + (size_t)l * 16 * 64 * 64, INP(12) + (size_t)l * DL, INP(13) + (size_t)l * DL, u >> 4, u & 15, tid);
                    for (int bu = bx; bu < 1024; bu += G) {
                        const int kk = bu >> 8, bxv = bu & 255;
                        const int ag = ((bxv & 7) + 2 * kk) & 7, ap = (bxv >> 3) + 32 * kk;
                        attn_block(lds, ZM, KH, VT, HB2, YP, biasL, ap >> 3, ap & 7, ag, tid);
                    }
                }
                GRID_BAR();
                {
                    pg8::Gemm g{HB2, (const bf16_t*)(wl + OFF_WOUT), M, D, D}; pg8::StaticOrder S; S.init(M, D, G, bx);
                    { if (tid == 0) *(volatile LAS int*)(lds + pg8::LDS_RS2PM) = -1; __syncthreads(); }
                    pg8::EpiResidY E{HB, SSQ + (size_t)(3 * l + 2) * M * 8, YP, lds};
                    { pg8::Unit u0; if (S.next(0, u0)) E.prep(u0); }
                    pg8::gemm_phase<pg8::EpiResidY, pg8::StaticOrder, true, true>(lds, g, S, E);
                }
                GRID_BAR();
            } else {
            }
        }
    }
}

extern "C" void kernel_launch(void* const* d_in, const int* in_sizes, int n_in, void* d_out, int out_size, void* d_ws, size_t ws_size, hipStream_t stream) {
    static int grid = 0;
    if (grid == 0) {
        if (n_in != 23 || in_sizes[0] != M * D || out_size != M * D || ws_size < WS_END) {
            fprintf(stderr, "kernel_launch: unexpected shapes: n_in %d in0 %d out %d ws %zu (need %zu)\n", n_in, n_in > 0 ? in_sizes[0] : -1, out_size, ws_size, (size_t)WS_END); grid = -1; return; }
        int dev = 0, cus = 0, per_cu = 0;
        hipGetDevice(&dev); hipDeviceGetAttribute(&cus, hipDeviceAttributeMultiprocessorCount, dev);
        if (hipFuncSetAttribute((const void*)mk_fwd, hipFuncAttributeMaxDynamicSharedMemorySize, LDS_BYTES) != hipSuccess) fprintf(stderr, "kernel_launch: hipFuncSetAttribute failed\n");
        if (hipOccupancyMaxActiveBlocksPerMultiprocessor(&per_cu, (const void*)mk_fwd, NTHREADS, LDS_BYTES) != hipSuccess || per_cu < 1) { fprintf(stderr, "kernel_launch: occupancy query gave %d\n", per_cu); per_cu = 1; }
        (void)hipGetLastError();
        grid = cus * per_cu;
        if (grid > 256) grid = 256;
    }
    if (grid < 0) return;
    Args a{};
    for (int i = 0; i < 23; ++i) a.in[i] = (const float*)d_in[i];
    a.out = (float*)d_out; a.ws = (unsigned char*)d_ws;
    void* kargs[] = {&a};
    hipError_t e = hipLaunchCooperativeKernel((const void*)mk_fwd, dim3(grid), dim3(NTHREADS), kargs, LDS_BYTES, stream);
    if (e != hipSuccess) fprintf(stderr, "kernel_launch: cooperative launch failed: %s (grid %d)\n", hipGetErrorString(e), grid);
}
```

```cpp
#include <hip/hip_runtime.h>
#include <hip/hip_cooperative_groups.h>
#include <cstdio>
#include <cstdint>
namespace cg = cooperative_groups;

#define LAS __attribute__((address_space(3)))
#define LAUNDER(v) asm volatile("" : "+v"(v))
typedef unsigned short bf16_t;
typedef short bf16x8 __attribute__((ext_vector_type(8)));
typedef float f32x4 __attribute__((ext_vector_type(4)));
typedef float f32x2 __attribute__((ext_vector_type(2)));
typedef unsigned u32x4 __attribute__((ext_vector_type(4)));
typedef unsigned u32x2 __attribute__((ext_vector_type(2)));

constexpr int NB = 16, SEQ = 2048, M = NB * SEQ, D = 2048, FF = 5632, DIN = 5120, DL = 1024, NH = 8, HD = 128, NREL = 257, DEPTH = 2;
constexpr int ZLD = 3072;
constexpr float EPS = 1e-6f;
constexpr float LOG2E = 1.4426950408889634f;

constexpr size_t MiB = 1u << 20;
constexpr size_t SZ_WGU = (size_t)2 * FF * D * 2, SZ_WD = (size_t)D * FF * 2, SZ_WIN = (size_t)DIN * D * 2, SZ_WOUT = (size_t)D * D * 2;
constexpr size_t OFF_WGU1 = 0, OFF_WD1 = OFF_WGU1 + SZ_WGU, OFF_WIN = OFF_WD1 + SZ_WD, OFF_WOUT = OFF_WIN + SZ_WIN, OFF_WGU2 = OFF_WOUT + SZ_WOUT, OFF_WD2 = OFF_WGU2 + SZ_WGU;
constexpr size_t LAYER_W = OFF_WD2 + SZ_WD;
static_assert(LAYER_W == 160 * MiB, "weights per layer");
constexpr size_t WS_BIG = 2 * LAYER_W;
constexpr size_t WS_VT = WS_BIG + (size_t)M * ZLD * 2;
constexpr size_t WS_KH = WS_VT + (size_t)M * 1024 * 2;
constexpr size_t WS_H = WS_BIG + 352 * MiB;
constexpr size_t WS_H2 = WS_H + 128 * MiB;
constexpr size_t WS_SSQ = WS_H2 + 128 * MiB;
constexpr size_t WS_YP = WS_SSQ + 8 * MiB;
constexpr size_t WS_CTL = WS_YP + 4 * MiB;
constexpr size_t CTL_BYTES = 16384;
constexpr size_t WS_END = WS_CTL + 1 * MiB;
static_assert((size_t)M * FF * 2 == 352 * MiB, "hidden size");

constexpr int NWAVES = 8, NTHREADS = 512;
constexpr int LDS_BYTES = 147456;

__device__ __forceinline__ unsigned cvt_pk_bf16(float lo, float hi) { unsigned r; asm volatile("v_cvt_pk_bf16_f32 %0, %1, %2" : "=v"(r) : "v"(lo), "v"(hi)); return r; }
__device__ __forceinline__ float bf_lo(unsigned u) { return __uint_as_float(u << 16); }
__device__ __forceinline__ float bf_hi(unsigned u) { return __uint_as_float(u & 0xffff0000u); }
__device__ __forceinline__ float fast_exp2(float x) { return __builtin_amdgcn_exp2f(x); }
__device__ __forceinline__ float fast_rcp(float x) { return __builtin_amdgcn_rcpf(x); }
__device__ __forceinline__ float sigmoidf_(float x) { return fast_rcp(1.0f + fast_exp2(-LOG2E * x)); }

namespace pg8 {
constexpr int BM = 256, BK = 64, HALF = 128, HTB = HALF * BK * 2, STAGE_BYTES = 8 * HTB, NXCD = 8, WGM = 4;
__host__ __device__ __forceinline__ int lds_byte(int r, int c) { const int st = (r >> 4) * 2 + (c >> 5), rr = r & 15, cc = c & 31, ob = rr * 64 + cc * 2; return st * 1024 + (ob ^ (((ob >> 9) & 1) << 5)); }
__host__ __device__ __forceinline__ void stage_rc(int b, int& R, int& C) { const int st = b / 1024, sb = b % 1024, swz = sb ^ (((sb >> 9) & 1) << 5); R = (st >> 1) * 16 + swz / 64; C = (st & 1) * 32 + (swz % 64) / 2; }
__host__ __device__ __forceinline__ int perm32(int rho) { const int n = rho >> 4, i = rho & 15; return 8 * (i >> 2) + 4 * n + (i & 3); }

struct Unit { int pm, pn; };
struct Gemm { const bf16_t* A; const bf16_t* Bt; int M, N, K; };

struct StaticOrder {
    int nM, nN, nwg, G, c;
    __host__ __device__ void init(int M_, int N_, int G_, int c_) { nM = M_ / BM; nN = N_ / BM; nwg = nM * nN; G = G_; c = c_; }
    __host__ __device__ bool next(int i, Unit& u) const {
        const long L = (long)i * G + c; if (L >= nwg) return false;
        int wgid = (int)L; { const int q = nwg / NXCD, r = nwg % NXCD, xcd = wgid % NXCD, off = wgid / NXCD; wgid = (xcd < r ? xcd * (q + 1) : r * (q + 1) + (xcd - r) * q) + off; }
        const int nig = WGM * nN, gid = wgid / nig, fm = gid * WGM, gsz = (nM - fm) < WGM ? (nM - fm) : WGM;
        u.pm = fm + ((wgid % nig) % gsz); u.pn = (wgid % nig) / gsz; return true;
    }
    __device__ __forceinline__ void a_ready(const Unit&) const {}
    __device__ __forceinline__ void done(const Unit&) const {}
};


constexpr int LDS_RS = 131072 + 1024, LDS_RSPM = 131072 + 2048 + 64, LDS_SSP = 131072 + 4096;
__device__ __forceinline__ void rs_panel(LAS unsigned char* lds, const float* ssq, int pm) {
    volatile LAS int* pmL = (volatile LAS int*)(lds + LDS_RSPM); LAS float* rsL = (LAS float*)(lds + LDS_RS);
    if (pmL[0] != pm) {
        asm volatile("s_waitcnt lgkmcnt(0)" ::: "memory"); __builtin_amdgcn_s_barrier();
        const int t = threadIdx.x;
        if (t < 256) { const f32x4* pp = (const f32x4*)(ssq + (size_t)(pm * 256 + t) * 8); const f32x4 pa = pp[0], pb = pp[1];
            rsL[t] = __builtin_amdgcn_rsqf((((pa.x + pa.y) + (pa.z + pa.w)) + ((pb.x + pb.y) + (pb.z + pb.w))) * (1.0f / D) + EPS); }
        if (t == 0) pmL[0] = pm;
        asm volatile("s_waitcnt vmcnt(0) lgkmcnt(0)" ::: "memory"); __builtin_amdgcn_s_barrier();
    }
}
struct EpiSwiGLU {
    static constexpr bool PERM = true, AFTER_DRAIN = false, MIDK = false;
    bf16_t* O; int ldc; const float* ssq; LAS unsigned char* lds;
    __device__ __forceinline__ void operator()(const f32x4 (&acc)[2][2][4][2], const Unit& u, int wr, int wc, int fr, int fq) const {
        rs_panel(lds, ssq, u.pm);
        const LAS float* rsL = (const LAS float*)(lds + LDS_RS) + wr * 64 + fr;
        const int row0 = u.pm * BM + wr * 64 + fr; const int col0 = u.pn * HALF + wc * 32 + 8 * fq;
#pragma unroll
        for (int ai = 0; ai < 2; ++ai)
#pragma unroll
            for (int m = 0; m < 4; ++m) {
                bf16_t* rowp = O + (size_t)(row0 + ai * HALF + m * 16) * ldc + col0;
                const float rs = rsL[ai * HALF + m * 16];
                const float c1 = -LOG2E * rs, rs2 = rs * rs;
                float v[8];
#pragma unroll
                for (int n = 0; n < 2; ++n)
#pragma unroll
                    for (int hh = 0; hh < 2; ++hh) {
                        const f32x2 a2 = (f32x2){acc[ai][0][m][n][2 * hh], acc[ai][0][m][n][2 * hh + 1]}, b2 = (f32x2){acc[ai][1][m][n][2 * hh], acc[ai][1][m][n][2 * hh + 1]};
                        const f32x2 t2 = a2 * c1;
                        f32x2 d2; d2.x = fast_exp2(t2.x); d2.y = fast_exp2(t2.y); d2 = d2 + 1.0f;
                        f32x2 s2; s2.x = fast_rcp(d2.x); s2.y = fast_rcp(d2.y);
                        const f32x2 v2 = (a2 * b2) * (s2 * rs2);
                        v[n * 4 + 2 * hh] = v2.x; v[n * 4 + 2 * hh + 1] = v2.y; }
                u32x4 w; w.x = cvt_pk_bf16(v[0], v[1]); w.y = cvt_pk_bf16(v[2], v[3]); w.z = cvt_pk_bf16(v[4], v[5]); w.w = cvt_pk_bf16(v[6], v[7]);
                *(u32x4*)rowp = w;
            }
    }
};
template <bool HALFSC> struct EpiResid {
    static constexpr bool PERM = true, AFTER_DRAIN = false, MIDK = false;
    bf16_t* xb; float* ssq_part; LAS unsigned char* lds;
    __device__ __forceinline__ void operator()(const f32x4 (&acc)[2][2][4][2], const Unit& u, int wr, int wc, int fr, int fq) const {
        const float scale_ = HALFSC ? 0.5f : 1.0f; bf16_t* const xb_ = xb; float* const ssq_ = ssq_part;
        LAS float* pl = (LAS float*)(lds + LDS_SSP);
        const int col0 = u.pn * BM + wc * 32 + 8 * fq;
        const size_t base = (size_t)(u.pm * BM + wr * 64 + fr) * D + col0;
        u32x4 r[2][2][2];
#define ER_LOAD(buf, bb) do { _Pragma("unroll") for (int mm = 0; mm < 2; ++mm) _Pragma("unroll") for (int bj = 0; bj < 2; ++bj) \
            r[buf][mm][bj] = *(const u32x4*)(xb_ + base + (size_t)(((bb) >> 1) * HALF + (((bb) & 1) * 2 + mm) * 16) * D + bj * HALF); } while (0)
        ER_LOAD(0, 0);
#pragma unroll
        for (int bb = 0; bb < 4; ++bb) {
            if (bb < 3) ER_LOAD((bb + 1) & 1, bb + 1);
            const int ai = bb >> 1;
#pragma unroll
            for (int mm = 0; mm < 2; ++mm) { const int m = (bb & 1) * 2 + mm; const int rowl = ai * HALF + m * 16; const size_t off = base + (size_t)rowl * D; float ssum = 0.f;
#pragma unroll
                for (int bj = 0; bj < 2; ++bj) { const u32x4 rr = r[bb & 1][mm][bj]; const f32x4 a = acc[ai][bj][m][0], c = acc[ai][bj][m][1];
                        const float o0 = bf_lo(rr.x) + a.x * scale_, o1 = bf_hi(rr.x) + a.y * scale_, o2 = bf_lo(rr.y) + a.z * scale_, o3 = bf_hi(rr.y) + a.w * scale_;
                        const float o4 = bf_lo(rr.z) + c.x * scale_, o5 = bf_hi(rr.z) + c.y * scale_, o6 = bf_lo(rr.w) + c.z * scale_, o7 = bf_hi(rr.w) + c.w * scale_;
                        u32x4 w; w.x = cvt_pk_bf16(o0, o1); w.y = cvt_pk_bf16(o2, o3); w.z = cvt_pk_bf16(o4, o5); w.w = cvt_pk_bf16(o6, o7); *(u32x4*)(xb_ + off + bj * HALF) = w;
                        ssum += ((o0 * o0 + o1 * o1) + (o2 * o2 + o3 * o3)) + ((o4 * o4 + o5 * o5) + (o6 * o6 + o7 * o7)); }
                ssum += __shfl_xor(ssum, 16); ssum += __shfl_xor(ssum, 32);
                if (fq == 0) pl[(rowl + wr * 64 + fr) * 4 + wc] = ssum;
            }
        }
#undef ER_LOAD
        asm volatile("s_waitcnt lgkmcnt(0)" ::: "memory"); __builtin_amdgcn_s_barrier();
        const int t = threadIdx.x;
        if (t < 256) { const f32x4 p = *(const LAS f32x4*)(pl + t * 4); ssq_[(size_t)(u.pm * BM + t) * 8 + u.pn] = (p.x + p.y) + (p.z + p.w); }
    }
};
struct EpiResidFinal {
    static constexpr bool PERM = true, AFTER_DRAIN = false, MIDK = false;
    const bf16_t* xb; float* out; const float* gfin; float* part; unsigned* cnt; LAS unsigned char* lds;
    __device__ __forceinline__ void operator()(f32x4 (&acc)[2][2][4][2], const Unit& u, int wr, int wc, int fr, int fq) const {
        const bf16_t* const xb_ = xb; float* const out_ = out; const float* const g_ = gfin; float* const part_ = part; unsigned* const cnt_ = cnt + 64 * u.pm;
        LAS float* pl = (LAS float*)(lds + LDS_SSP); LAS float* rsL = (LAS float*)(lds + LDS_RS);
        const int col0 = u.pn * BM + wc * 32 + 8 * fq;
        const size_t base = (size_t)(u.pm * BM + wr * 64 + fr) * D + col0;
        u32x4 r[2][2][2];
#define ER_LOAD(buf, bb) do { _Pragma("unroll") for (int mm = 0; mm < 2; ++mm) _Pragma("unroll") for (int bj = 0; bj < 2; ++bj) \
            r[buf][mm][bj] = *(const u32x4*)(xb_ + base + (size_t)(((bb) >> 1) * HALF + (((bb) & 1) * 2 + mm) * 16) * D + bj * HALF); } while (0)
        ER_LOAD(0, 0);
#pragma unroll
        for (int bb = 0; bb < 4; ++bb) {
            if (bb < 3) ER_LOAD((bb + 1) & 1, bb + 1);
            const int ai = bb >> 1;
#pragma unroll
            for (int mm = 0; mm < 2; ++mm) { const int m = (bb & 1) * 2 + mm; const int rowl = ai * HALF + m * 16; float ssum = 0.f;
#pragma unroll
                for (int bj = 0; bj < 2; ++bj) { const u32x4 rr = r[bb & 1][mm][bj]; const f32x4 a = acc[ai][bj][m][0], c = acc[ai][bj][m][1];
                        const float o0 = bf_lo(rr.x) + a.x * 0.5f, o1 = bf_hi(rr.x) + a.y * 0.5f, o2 = bf_lo(rr.y) + a.z * 0.5f, o3 = bf_hi(rr.y) + a.w * 0.5f;
                        const float o4 = bf_lo(rr.z) + c.x * 0.5f, o5 = bf_hi(rr.z) + c.y * 0.5f, o6 = bf_lo(rr.w) + c.z * 0.5f, o7 = bf_hi(rr.w) + c.w * 0.5f;
                        acc[ai][bj][m][0] = (f32x4){o0, o1, o2, o3}; acc[ai][bj][m][1] = (f32x4){o4, o5, o6, o7};
                        ssum += ((o0 * o0 + o1 * o1) + (o2 * o2 + o3 * o3)) + ((o4 * o4 + o5 * o5) + (o6 * o6 + o7 * o7)); }
                ssum += __shfl_xor(ssum, 16); ssum += __shfl_xor(ssum, 32);
                if (fq == 0) pl[(rowl + wr * 64 + fr) * 4 + wc] = ssum;
            }
        }
#undef ER_LOAD
        asm volatile("s_waitcnt lgkmcnt(0)" ::: "memory"); __builtin_amdgcn_s_barrier(); asm volatile("" ::: "memory");
        const int t = threadIdx.x;
        if (t < 256) { const f32x4 p = *(const LAS f32x4*)(pl + t * 4); __hip_atomic_store(part_ + (size_t)(u.pm * BM + t) * 8 + u.pn, (p.x + p.y) + (p.z + p.w), __ATOMIC_RELAXED, __HIP_MEMORY_SCOPE_AGENT); }
        asm volatile("s_waitcnt vmcnt(0)" ::: "memory");
        if (t < 256 && (t & 63) == 0) (void)__hip_atomic_fetch_add(cnt_, 1u, __ATOMIC_RELAXED, __HIP_MEMORY_SCOPE_AGENT);
        if (t < 64) {
            unsigned spins = 0u;
            while ((unsigned)__builtin_amdgcn_readfirstlane((int)__hip_atomic_load(cnt_, __ATOMIC_RELAXED, __HIP_MEMORY_SCOPE_AGENT)) < 32u) { __builtin_amdgcn_s_sleep(2); if (++spins > (1u << 20)) break; }
            __builtin_amdgcn_fence(__ATOMIC_ACQUIRE, "agent");
        }
        asm volatile("s_waitcnt vmcnt(0) lgkmcnt(0)" ::: "memory"); __builtin_amdgcn_s_barrier(); asm volatile("" ::: "memory");
        if (t < 256) { const float* pp = part_ + (size_t)(u.pm * BM + t) * 8; float sq = 0.f;
#pragma unroll
            for (int j = 0; j < 8; ++j) sq += __hip_atomic_load(pp + j, __ATOMIC_RELAXED, __HIP_MEMORY_SCOPE_AGENT);
            rsL[t] = __builtin_amdgcn_rsqf(sq * (1.0f / D) + EPS); }
        asm volatile("s_waitcnt vmcnt(0) lgkmcnt(0)" ::: "memory"); __builtin_amdgcn_s_barrier(); asm volatile("" ::: "memory");
        f32x4 g4[2][2];
#pragma unroll
        for (int bj = 0; bj < 2; ++bj)
#pragma unroll
            for (int n = 0; n < 2; ++n) g4[bj][n] = *(const f32x4*)(g_ + col0 + bj * HALF + n * 4);
#pragma unroll
        for (int ai = 0; ai < 2; ++ai)
#pragma unroll
            for (int m = 0; m < 4; ++m) { const int rowl = ai * HALF + m * 16; const float rs = rsL[rowl + wr * 64 + fr]; const size_t off = base + (size_t)rowl * D;
#pragma unroll
                for (int bj = 0; bj < 2; ++bj)
#pragma unroll
                    for (int n = 0; n < 2; ++n) *(f32x4*)(out_ + off + bj * HALF + n * 4) = acc[ai][bj][m][n] * rs * g4[bj][n]; }
    }
};
constexpr int LDS_RS2 = 131072 + 8192, LDS_RS2PM = 131072 + 8192 + 2048 + 64;
__device__ __forceinline__ void rs2_panel(LAS unsigned char* lds, const float* yp, int pm) {
    volatile LAS int* pmL = (volatile LAS int*)(lds + LDS_RS2PM); LAS f32x2* rsL = (LAS f32x2*)(lds + LDS_RS2);
    if (pmL[0] != pm) {
        asm volatile("s_waitcnt lgkmcnt(0)" ::: "memory"); __builtin_amdgcn_s_barrier();
        const int t = threadIdx.x;
        if (t < 256) { const f32x4* pp = (const f32x4*)(yp + (size_t)(pm * 256 + t) * 24);
            const f32x4 a0 = pp[0], a1 = pp[1], a2 = pp[2], a3 = pp[3], b0 = pp[4], b1 = pp[5];
            const float sl = (((a0.x + a0.y) + (a0.z + a0.w)) + ((a1.x + a1.y) + (a1.z + a1.w))) + (((a2.x + a2.y) + (a2.z + a2.w)) + ((a3.x + a3.y) + (a3.z + a3.w)));
            const float sa = ((b0.x + b0.y) + (b0.z + b0.w)) + ((b1.x + b1.y) + (b1.z + b1.w));
            const float va = sa * (1.0f / 1024.f) + EPS, vl = sl * (1.0f / 1024.f) + EPS;
            rsL[t] = (f32x2){__builtin_amdgcn_rsqf(va), __builtin_amdgcn_rsqf(vl) * sqrtf(va)}; }
        if (t == 0) pmL[0] = pm;
        asm volatile("s_waitcnt vmcnt(0) lgkmcnt(0)" ::: "memory"); __builtin_amdgcn_s_barrier();
    }
}
struct EpiResidY {
    static constexpr bool PERM = true, AFTER_DRAIN = false, MIDK = true;
    bf16_t* xb; float* ssq_part; const float* yp; LAS unsigned char* lds;
    __device__ __forceinline__ void prep(const Unit& u) const { rs2_panel(lds, yp, u.pm); }
    __device__ __forceinline__ void mid(f32x4 (&acc)[2][2][4][2], const Unit& u, int wr, int wc, int fr, int fq) const {
        const LAS f32x2* rsL = (const LAS f32x2*)(lds + LDS_RS2) + wr * 64 + fr;
#pragma unroll
        for (int ai = 0; ai < 2; ++ai)
#pragma unroll
            for (int m = 0; m < 4; ++m) { const float q = rsL[ai * HALF + m * 16].y;
#pragma unroll
                for (int bj = 0; bj < 2; ++bj)
#pragma unroll
                    for (int n = 0; n < 2; ++n) acc[ai][bj][m][n] = acc[ai][bj][m][n] * q; }
    }
    __device__ __forceinline__ void operator()(const f32x4 (&acc)[2][2][4][2], const Unit& u, int wr, int wc, int fr, int fq) const {
        bf16_t* const xb_ = xb; float* const ssq_ = ssq_part;
        LAS float* pl = (LAS float*)(lds + LDS_SSP);
        const LAS f32x2* rsL = (const LAS f32x2*)(lds + LDS_RS2) + wr * 64 + fr;
        const int col0 = u.pn * BM + wc * 32 + 8 * fq;
        const size_t base = (size_t)(u.pm * BM + wr * 64 + fr) * D + col0;
        u32x4 r[2][2][2];
#define ER_LOAD(buf, bb) do { _Pragma("unroll") for (int mm = 0; mm < 2; ++mm) _Pragma("unroll") for (int bj = 0; bj < 2; ++bj) \
            r[buf][mm][bj] = *(const u32x4*)(xb_ + base + (size_t)(((bb) >> 1) * HALF + (((bb) & 1) * 2 + mm) * 16) * D + bj * HALF); } while (0)
        ER_LOAD(0, 0);
#pragma unroll
        for (int bb = 0; bb < 4; ++bb) {
            if (bb < 3) ER_LOAD((bb + 1) & 1, bb + 1);
            const int ai = bb >> 1;
#pragma unroll
            for (int mm = 0; mm < 2; ++mm) { const int m = (bb & 1) * 2 + mm; const int rowl = ai * HALF + m * 16; const size_t off = base + (size_t)rowl * D; float ssum = 0.f;
                const float scale_ = rsL[rowl].x;
#pragma unroll
                for (int bj = 0; bj < 2; ++bj) { const u32x4 rr = r[bb & 1][mm][bj]; const f32x4 a = acc[ai][bj][m][0], c = acc[ai][bj][m][1];
                        const float o0 = bf_lo(rr.x) + a.x * scale_, o1 = bf_hi(rr.x) + a.y * scale_, o2 = bf_lo(rr.y) + a.z * scale_, o3 = bf_hi(rr.y) + a.w * scale_;
                        const float o4 = bf_lo(rr.z) + c.x * scale_, o5 = bf_hi(rr.z) + c.y * scale_, o6 = bf_lo(rr.w) + c.z * scale_, o7 = bf_hi(rr.w) + c.w * scale_;
                        u32x4 w; w.x = cvt_pk_bf16(o0, o1); w.y = cvt_pk_bf16(o2, o3); w.z = cvt_pk_bf16(o4, o5); w.w = cvt_pk_bf16(o6, o7); *(u32x4*)(xb_ + off + bj * HALF) = w;
                        ssum += ((o0 * o0 + o1 * o1) + (o2 * o2 + o3 * o3)) + ((o4 * o4 + o5 * o5) + (o6 * o6 + o7 * o7)); }
                ssum += __shfl_xor(ssum, 16); ssum += __shfl_xor(ssum, 32);
                if (fq == 0) pl[(rowl + wr * 64 + fr) * 4 + wc] = ssum;
            }
        }
#undef ER_LOAD
        asm volatile("s_waitcnt lgkmcnt(0)" ::: "memory"); __builtin_amdgcn_s_barrier();
        const int t = threadIdx.x;
        if (t < 256) { const f32x4 p = *(const LAS f32x4*)(pl + t * 4); ssq_[(size_t)(u.pm * BM + t) * 8 + u.pn] = (p.x + p.y) + (p.z + p.w); }
    }
};
struct EpiZ {
    static constexpr bool PERM = true, AFTER_DRAIN = false, MIDK = false;
    bf16_t* Z; bf16_t* Vt; bf16_t* Kh; const float* ssq; LAS unsigned char* lds;
    __device__ __forceinline__ void operator()(const f32x4 (&acc)[2][2][4][2], const Unit& u, int wr, int wc, int fr, int fq) const {
        rs_panel(lds, ssq, u.pm);
        float rs[2][4];
        { const LAS float* rsL = (const LAS float*)(lds + LDS_RS) + wr * 64 + fr;
#pragma unroll
          for (int ai = 0; ai < 2; ++ai)
#pragma unroll
            for (int m = 0; m < 4; ++m) rs[ai][m] = rsL[ai * HALF + m * 16]; }
        if (u.pn >= 12 && u.pn < 16) {
            const int b = (u.pm * BM) / SEQ; const int s0 = (u.pm * BM) % SEQ + wr * 64 + fr;
#pragma unroll
            for (int bj = 0; bj < 2; ++bj) {
                const int head = (u.pn - 12) * 2 + bj;
                bf16_t* hb = Kh + ((size_t)(b * NH + head) * SEQ + s0) * HD + wc * 32 + 8 * fq;
#pragma unroll
                for (int ai = 0; ai < 2; ++ai)
#pragma unroll
                    for (int m = 0; m < 4; ++m) { const f32x4 v0 = acc[ai][bj][m][0] * rs[ai][m], v1 = acc[ai][bj][m][1] * rs[ai][m];
                        u32x4 w; w.x = cvt_pk_bf16(v0[0], v0[1]); w.y = cvt_pk_bf16(v0[2], v0[3]); w.z = cvt_pk_bf16(v1[0], v1[1]); w.w = cvt_pk_bf16(v1[2], v1[3]);
                        *(u32x4*)(hb + (size_t)(ai * HALF + m * 16) * HD) = w; }
            }
        } else if (u.pn < 12) {
            const int row0 = u.pm * BM + wr * 64 + fr; const int col0 = u.pn * BM + wc * 32 + 8 * fq;
#pragma unroll
            for (int ai = 0; ai < 2; ++ai)
#pragma unroll
                for (int m = 0; m < 4; ++m) {
                    bf16_t* rowp = Z + (size_t)(row0 + ai * HALF + m * 16) * ZLD + col0;
#pragma unroll
                    for (int bj = 0; bj < 2; ++bj) { const f32x4 v0 = acc[ai][bj][m][0] * rs[ai][m], v1 = acc[ai][bj][m][1] * rs[ai][m];
                        u32x4 w; w.x = cvt_pk_bf16(v0[0], v0[1]); w.y = cvt_pk_bf16(v0[2], v0[3]); w.z = cvt_pk_bf16(v1[0], v1[1]); w.w = cvt_pk_bf16(v1[2], v1[3]);
                        *(u32x4*)(rowp + bj * HALF) = w; }
                }
        } else {
            const int b = (u.pm * BM) / SEQ; const int s0 = (u.pm * BM) % SEQ + wr * 64 + fr;
#pragma unroll
            for (int bj = 0; bj < 2; ++bj) {
                const int head = (u.pn - 16) * 2 + bj;
                bf16_t* hb = Vt + ((size_t)(b * NH + head) * HD + wc * 32 + 8 * fq) * SEQ + s0;
#pragma unroll
                for (int ai = 0; ai < 2; ++ai)
#pragma unroll
                    for (int m = 0; m < 4; ++m)
#pragma unroll
                        for (int n = 0; n < 2; ++n)
#pragma unroll
                            for (int i = 0; i < 4; ++i) {
                                const unsigned w = cvt_pk_bf16(acc[ai][bj][m][n][i] * rs[ai][m], 0.f);
                                hb[(size_t)(4 * n + i) * SEQ + ai * HALF + m * 16] = (bf16_t)(w & 0xffffu);
                            }
            }
        }
    }
};

template <class Epi, class Sched, bool ALIGN_EPI = false, bool SP2 = false>
__device__ __forceinline__ void gemm_phase(LAS unsigned char* lds, const Gemm g, const Sched& S, const Epi& E) {
    int tid_l = threadIdx.x; LAUNDER(tid_l);
    const int tid = tid_l, wid = __builtin_amdgcn_readfirstlane(tid >> 6), lane = tid & 63, wr = wid >> 2, wc = wid & 3, fr = lane & 15, fq = lane >> 4;
    const int K = g.K, nt = K / BK;
    unsigned voffA[2], voffB[2];
#pragma unroll
    for (int i = 0; i < 2; ++i) { int R, C; stage_rc(tid * 16 + i * 8192, R, C); const int Rb = Epi::PERM ? ((R & ~31) + perm32(R & 31)) : R;
        voffA[i] = (unsigned)(R * K + C) * 2u; voffB[i] = (unsigned)(Rb * K + C) * 2u; }
    const size_t kstep = (size_t)(BK * 2);
    const size_t hstep = (size_t)HALF * K * 2;
    const size_t tstep = 2 * hstep;
    const unsigned ldsw = (unsigned)wid * 1024u;
    const int aoff = lds_byte(wr * 64 + fr, fq * 8), boff = lds_byte(wc * 32 + fr, fq * 8);
#define PG8_SA(b, h) (((b) * 2 + (h)) * HTB)
#define PG8_SB(b, h) ((4 + (b) * 2 + (h)) * HTB)
#define PG8_STAGE(bufoff, gbase, voff) do { _Pragma("unroll") for (int _i = 0; _i < 2; ++_i) \
        __builtin_amdgcn_global_load_lds((const unsigned*)((const char*)(gbase) + (voff)[_i]), (LAS unsigned*)(lds + (bufoff) + ldsw + _i * 8192), 16, 0, 0); } while (0)
#define PG8_LDA(dst, b, h) do { _Pragma("unroll") for (int m = 0; m < 4; ++m) _Pragma("unroll") for (int k = 0; k < 2; ++k) dst[m][k] = *(const LAS bf16x8*)(lds + PG8_SA(b, h) + aoff + m * 2048 + k * 1024); } while (0)
#define PG8_LDB(dst, b, h) do { _Pragma("unroll") for (int n = 0; n < 2; ++n) _Pragma("unroll") for (int k = 0; k < 2; ++k) dst[n][k] = *(const LAS bf16x8*)(lds + PG8_SB(b, h) + boff + n * 2048 + k * 1024); } while (0)
#define PG8_MMA(ai, bj, At, Bt) do { __builtin_amdgcn_s_setprio(1); _Pragma("unroll") for (int m = 0; m < 4; ++m) _Pragma("unroll") for (int n = 0; n < 2; ++n) _Pragma("unroll") for (int k = 0; k < 2; ++k) \
        acc[ai][bj][m][n] = __builtin_amdgcn_mfma_f32_16x16x32_bf16(Bt[n][k], At[m][k], acc[ai][bj][m][n], 0, 0, 0); __builtin_amdgcn_s_setprio(0); } while (0)
#define PG8_MMA_NP(ai, bj, At, Bt) do { _Pragma("unroll") for (int m = 0; m < 4; ++m) _Pragma("unroll") for (int n = 0; n < 2; ++n) _Pragma("unroll") for (int k = 0; k < 2; ++k) \
        acc[ai][bj][m][n] = __builtin_amdgcn_mfma_f32_16x16x32_bf16(Bt[n][k], At[m][k], acc[ai][bj][m][n], 0, 0, 0); } while (0)
#define PG8_MMA2(ai, At, Ba, Bb) do { __builtin_amdgcn_s_setprio(1); PG8_MMA_NP(ai, 0, At, Ba); PG8_MMA_NP(ai, 1, At, Bb); __builtin_amdgcn_s_setprio(0); } while (0)
#define PG8_WAIT_V(n) asm volatile("s_waitcnt vmcnt(" #n ")" ::: "memory")
#define PG8_WAIT_L(n) asm volatile("s_waitcnt lgkmcnt(" #n ")" ::: "memory")
#define PG8_BAR __builtin_amdgcn_s_barrier()
#define PG8_SCHED __builtin_amdgcn_sched_barrier(0)
    Unit cur, nxt; int ui = 0;
    if (!S.next(0, cur)) return;
    f32x4 acc[2][2][4][2];
#pragma unroll
    for (int a = 0; a < 2; ++a)
#pragma unroll
        for (int b = 0; b < 2; ++b)
#pragma unroll
            for (int m = 0; m < 4; ++m)
#pragma unroll
                for (int n = 0; n < 2; ++n) acc[a][b][m][n] = (f32x4){0.f, 0.f, 0.f, 0.f};
    bf16x8 At[4][2], B0[2][2], B1[2][2];
    const char* cA = (const char*)g.A + (size_t)cur.pm * tstep; const char* cB = (const char*)g.Bt + (size_t)cur.pn * tstep;
    S.a_ready(cur);
    if constexpr (SP2) {
        PG8_STAGE(PG8_SB(0, 0), cB, voffB); PG8_STAGE(PG8_SB(0, 1), cB + hstep, voffB); PG8_STAGE(PG8_SA(0, 0), cA, voffA); PG8_STAGE(PG8_SA(0, 1), cA + hstep, voffA);
        if (wr == 1) PG8_BAR;
        PG8_WAIT_V(2); PG8_BAR;
        PG8_STAGE(PG8_SB(1, 0), cB + kstep, voffB); PG8_STAGE(PG8_SA(1, 0), cA + kstep, voffA); PG8_STAGE(PG8_SB(1, 1), cB + hstep + kstep, voffB);
        PG8_WAIT_V(6); PG8_BAR;
    } else {
        PG8_STAGE(PG8_SB(0, 0), cB, voffB); PG8_STAGE(PG8_SA(0, 0), cA, voffA); PG8_STAGE(PG8_SB(0, 1), cB + hstep, voffB); PG8_STAGE(PG8_SA(0, 1), cA + hstep, voffA);
        if (wr == 1) PG8_BAR;
        PG8_WAIT_V(4); PG8_BAR;
        PG8_STAGE(PG8_SB(1, 0), cB + kstep, voffB); PG8_STAGE(PG8_SA(1, 0), cA + kstep, voffA); PG8_STAGE(PG8_SB(1, 1), cB + hstep + kstep, voffB);
        PG8_WAIT_V(6); PG8_BAR;
    }
    for (;;) {
        const bool has_next = S.next(ui + 1, nxt);
        const char* nA = has_next ? (const char*)g.A + (size_t)nxt.pm * tstep : cA; const char* nB = has_next ? (const char*)g.Bt + (size_t)nxt.pn * tstep : cB;
        for (int t = 0; t < nt; t += 2) {
            if constexpr (Epi::MIDK) { if (t == (nt >> 1)) E.mid(acc, cur, wr, wc, fr, fq); }
            const bool last = (t == nt - 2);
            const char* a1 = cA + (size_t)(t + 1) * kstep;
            const char* a2 = last ? nA : cA + (size_t)(t + 2) * kstep; const char* b2 = last ? nB : cB + (size_t)(t + 2) * kstep;
            const char* a3 = a2 + kstep; const char* b3 = b2 + kstep;
            if (last && has_next) S.a_ready(nxt);
            if constexpr (SP2) {
            PG8_LDB(B0, 0, 0); PG8_LDB(B1, 0, 1); PG8_SCHED; PG8_LDA(At, 0, 0); PG8_STAGE(PG8_SA(1, 1), a1 + hstep, voffA);
            PG8_WAIT_V(8); PG8_WAIT_L(0); PG8_BAR; PG8_MMA2(0, At, B0, B1); PG8_BAR; PG8_SCHED;
            PG8_LDA(At, 0, 1); PG8_STAGE(PG8_SB(0, 0), b2, voffB); PG8_STAGE(PG8_SB(0, 1), b2 + hstep, voffB); PG8_STAGE(PG8_SA(0, 0), a2, voffA);
            PG8_WAIT_V(8); PG8_WAIT_L(0); PG8_BAR; PG8_MMA2(1, At, B0, B1); PG8_BAR; PG8_SCHED;
            PG8_LDB(B0, 1, 0); PG8_LDB(B1, 1, 1); PG8_SCHED; PG8_LDA(At, 1, 0); PG8_STAGE(PG8_SA(0, 1), a2 + hstep, voffA);
            PG8_WAIT_V(8); PG8_WAIT_L(0); PG8_BAR; PG8_MMA2(0, At, B0, B1); PG8_BAR; PG8_SCHED;
            PG8_LDA(At, 1, 1); PG8_STAGE(PG8_SB(1, 0), b3, voffB); PG8_STAGE(PG8_SB(1, 1), b3 + hstep, voffB); PG8_STAGE(PG8_SA(1, 0), a3, voffA);
            PG8_WAIT_V(8); PG8_WAIT_L(0); PG8_BAR; PG8_MMA2(1, At, B0, B1); PG8_BAR; PG8_SCHED;
            } else {
            PG8_LDB(B0, 0, 0); PG8_SCHED; PG8_LDA(At, 0, 0); PG8_STAGE(PG8_SA(1, 1), a1 + hstep, voffA);
            PG8_WAIT_L(8); PG8_BAR; PG8_WAIT_L(0); PG8_MMA(0, 0, At, B0); PG8_BAR; PG8_SCHED;
            PG8_LDB(B1, 0, 1); PG8_STAGE(PG8_SB(0, 0), b2, voffB);
            PG8_BAR; PG8_WAIT_L(0); PG8_MMA(0, 1, At, B1); PG8_BAR;
            PG8_LDA(At, 0, 1); PG8_STAGE(PG8_SA(0, 0), a2, voffA);
            PG8_BAR; PG8_WAIT_L(0); PG8_MMA(1, 0, At, B0); PG8_BAR; PG8_SCHED;
            PG8_STAGE(PG8_SB(0, 1), b2 + hstep, voffB);
            PG8_WAIT_V(6); PG8_BAR; PG8_MMA(1, 1, At, B1); PG8_BAR;
            PG8_LDB(B0, 1, 0); PG8_SCHED; PG8_LDA(At, 1, 0); PG8_STAGE(PG8_SA(0, 1), a2 + hstep, voffA);
            PG8_WAIT_L(8); PG8_BAR; PG8_WAIT_L(0); PG8_MMA(0, 0, At, B0); PG8_BAR; PG8_SCHED;
            PG8_LDB(B1, 1, 1); PG8_STAGE(PG8_SB(1, 0), b3, voffB);
            PG8_BAR; PG8_WAIT_L(0); PG8_MMA(0, 1, At, B1); PG8_BAR;
            PG8_LDA(At, 1, 1); PG8_STAGE(PG8_SA(1, 0), a3, voffA);
            PG8_BAR; PG8_WAIT_L(0); PG8_MMA(1, 0, At, B0); PG8_BAR; PG8_SCHED;
            PG8_STAGE(PG8_SB(1, 1), b3 + hstep, voffB);
            PG8_WAIT_V(6); PG8_BAR; PG8_MMA(1, 1, At, B1); PG8_BAR;
            }
        }
        if constexpr (ALIGN_EPI) { if (wr == 0) PG8_BAR; }
        if constexpr (!Epi::AFTER_DRAIN) { E(acc, cur, wr, wc, fr, fq); S.done(cur); }
        if constexpr (Epi::MIDK) { if (has_next) E.prep(nxt); }
        if (!has_next) break;
#pragma unroll
        for (int a = 0; a < 2; ++a)
#pragma unroll
            for (int b = 0; b < 2; ++b)
#pragma unroll
                for (int m = 0; m < 4; ++m)
#pragma unroll
                    for (int n = 0; n < 2; ++n) acc[a][b][m][n] = (f32x4){0.f, 0.f, 0.f, 0.f};
        cur = nxt; cA = nA; cB = nB; ++ui;
        if constexpr (ALIGN_EPI) { if (wr == 1) PG8_BAR; }
    }
    PG8_WAIT_V(0);
    if constexpr (!ALIGN_EPI) { if (wr == 0) PG8_BAR; }
    PG8_BAR;
#undef PG8_SA
#undef PG8_SB
#undef PG8_STAGE
#undef PG8_LDA
#undef PG8_LDB
#undef PG8_MMA
#undef PG8_MMA_NP
#undef PG8_MMA2
#undef PG8_WAIT_V
#undef PG8_WAIT_L
#undef PG8_BAR
#undef PG8_SCHED
}
}

#define LDS_WAIT() asm volatile("s_waitcnt lgkmcnt(0)" ::: "memory")

__device__ __forceinline__ float wave_sum(float v) {
#pragma unroll
    for (int o = 1; o < 64; o <<= 1) v += __shfl_xor(v, o);
    return v;
}

__device__ __forceinline__ void p0_transpose_item(const float* W, const float* gain, int K, int N, bf16_t* WT, int ilv, LAS float* scr, int item, int lane, const float* gain2 = nullptr) {
    const int nblk = N / 32, kb = item / nblk, nb = item % nblk, k0 = 64 * kb, n0 = 32 * nb;
#pragma unroll 8
    for (int i = 0; i < 32; ++i) { const int kk = 2 * i + (lane >> 5); scr[kk * 33 + (lane & 31)] = W[(size_t)(k0 + kk) * N + n0 + (lane & 31)]; }
    LDS_WAIT(); asm volatile("" ::: "memory");
    const int c = lane & 7;
    f32x4 g0 = (f32x4){1.f, 1.f, 1.f, 1.f}, g1 = g0;
    if (gain) { const float* gp = (gain2 && k0 >= 1024) ? gain2 + (k0 - 1024) : gain + k0; g0 = *(const f32x4*)(gp + 8 * c); g1 = *(const f32x4*)(gp + 8 * c + 4); }
#pragma unroll
    for (int j = 0; j < 4; ++j) { const int n = (lane >> 3) + 8 * j; const LAS float* s = scr + (8 * c) * 33 + n;
        u32x4 o; o.x = cvt_pk_bf16(s[0 * 33] * g0.x, s[1 * 33] * g0.y); o.y = cvt_pk_bf16(s[2 * 33] * g0.z, s[3 * 33] * g0.w); o.z = cvt_pk_bf16(s[4 * 33] * g1.x, s[5 * 33] * g1.y); o.w = cvt_pk_bf16(s[6 * 33] * g1.z, s[7 * 33] * g1.w);
        const int nn = n0 + n; const int row = ilv < 0 ? nn : ((nn >> 7) * 256 + (nn & 127) + ilv);
        *(u32x4*)(WT + (size_t)row * K + k0 + 8 * c) = o; }
    LDS_WAIT(); asm volatile("" ::: "memory");
}

__device__ __forceinline__ void rms_rows_bf16(const float* x, const float* g, bf16_t* out, int gw, int NGW, int lane) {
    LAUNDER(lane);
    f32x4 gv[8];
#pragma unroll
    for (int j = 0; j < 8; ++j) gv[j] = *(const f32x4*)(g + 4 * lane + 256 * j);
    for (int m = gw; m < M; m += NGW) {
        const f32x4* xr = (const f32x4*)(x + (size_t)m * D) + lane; f32x4 v[8]; float s = 0.f;
#pragma unroll
        for (int j = 0; j < 8; ++j) { v[j] = xr[64 * j]; s += (v[j].x * v[j].x + v[j].y * v[j].y) + (v[j].z * v[j].z + v[j].w * v[j].w); }
        const float rstd = 1.0f / sqrtf(wave_sum(s) * (1.0f / D) + EPS);
        u32x2* o8 = (u32x2*)(out + (size_t)m * D) + lane;
#pragma unroll
        for (int j = 0; j < 8; ++j) { const f32x4 o = v[j] * rstd * gv[j]; u32x2 w; w.x = cvt_pk_bf16(o.x, o.y); w.y = cvt_pk_bf16(o.z, o.w); o8[64 * j] = w; }
    }
}
__device__ __forceinline__ void cast_rows_bf16(const float* x, bf16_t* out, float* ssq, int gw, int NGW, int lane) {
    LAUNDER(lane);
    for (int m = gw; m < M; m += NGW) {
        const f32x4* xr = (const f32x4*)(x + (size_t)m * D) + lane; f32x4 v[8]; float s = 0.f;
#pragma unroll
        for (int j = 0; j < 8; ++j) { v[j] = xr[64 * j]; s += (v[j].x * v[j].x + v[j].y * v[j].y) + (v[j].z * v[j].z + v[j].w * v[j].w); }
        s = wave_sum(s);
        if (lane == 0) { f32x4* pp = (f32x4*)(ssq + (size_t)m * 8); pp[0] = (f32x4){s, 0.f, 0.f, 0.f}; pp[1] = (f32x4){0.f, 0.f, 0.f, 0.f}; }
        u32x2* o8 = (u32x2*)(out + (size_t)m * D) + lane;
#pragma unroll
        for (int j = 0; j < 8; ++j) { u32x2 w; w.x = cvt_pk_bf16(v[j].x, v[j].y); w.y = cvt_pk_bf16(v[j].z, v[j].w); o8[64 * j] = w; }
    }
}
__device__ __forceinline__ void rms_rows_f32_inplace(float* x, const float* g, int gw, int NGW, int lane) {
    LAUNDER(lane);
    f32x4 gv[8];
#pragma unroll
    for (int j = 0; j < 8; ++j) gv[j] = *(const f32x4*)(g + 4 * lane + 256 * j);
    for (int m = gw; m < M; m += NGW) {
        f32x4* xr = (f32x4*)(x + (size_t)m * D) + lane; f32x4 v[8]; float s = 0.f;
#pragma unroll
        for (int j = 0; j < 8; ++j) { v[j] = xr[64 * j]; s += (v[j].x * v[j].x + v[j].y * v[j].y) + (v[j].z * v[j].z + v[j].w * v[j].w); }
        const float rstd = 1.0f / sqrtf(wave_sum(s) * (1.0f / D) + EPS);
#pragma unroll
        for (int j = 0; j < 8; ++j) xr[64 * j] = v[j] * rstd * gv[j];
    }
}
__device__ __forceinline__ void rms_rows_bf16_to_f32(const bf16_t* x, const float* g, float* out, int gw, int NGW, int lane) {
    LAUNDER(lane);
    f32x4 gv[4][2];
#pragma unroll
    for (int j = 0; j < 4; ++j) { const float* gp = g + 512 * j + 8 * lane; gv[j][0] = *(const f32x4*)gp; gv[j][1] = *(const f32x4*)(gp + 4); }
    for (int m = gw; m < M; m += NGW) {
        const u32x4* xr = (const u32x4*)(x + (size_t)m * D) + lane; u32x4 raw[4]; float s = 0.f;
#pragma unroll
        for (int j = 0; j < 4; ++j) raw[j] = xr[64 * j];
        float v[4][8];
#pragma unroll
        for (int j = 0; j < 4; ++j) {
            v[j][0] = bf_lo(raw[j].x); v[j][1] = bf_hi(raw[j].x); v[j][2] = bf_lo(raw[j].y); v[j][3] = bf_hi(raw[j].y);
            v[j][4] = bf_lo(raw[j].z); v[j][5] = bf_hi(raw[j].z); v[j][6] = bf_lo(raw[j].w); v[j][7] = bf_hi(raw[j].w);
#pragma unroll
            for (int e = 0; e < 8; ++e) s += v[j][e] * v[j][e];
        }
        const float rstd = 1.0f / sqrtf(wave_sum(s) * (1.0f / D) + EPS);
        f32x4* orow = (f32x4*)(out + (size_t)m * D + 8 * lane);
#pragma unroll
        for (int j = 0; j < 4; ++j) {
            orow[128 * j] = (f32x4){v[j][0] * rstd * gv[j][0].x, v[j][1] * rstd * gv[j][0].y, v[j][2] * rstd * gv[j][0].z, v[j][3] * rstd * gv[j][0].w};
            orow[128 * j + 1] = (f32x4){v[j][4] * rstd * gv[j][1].x, v[j][5] * rstd * gv[j][1].y, v[j][6] * rstd * gv[j][1].z, v[j][7] * rstd * gv[j][1].w};
        }
    }
}
__device__ __forceinline__ void ynorm_rows(bf16_t* y, const float* g_lru, const float* g_att, int gw, int NGW, int lane) {
    LAUNDER(lane);
    f32x4 gv[4][2];
#pragma unroll
    for (int j = 0; j < 4; ++j) { const float* gp = (j < 2 ? g_lru + 512 * j : g_att + 512 * (j - 2)) + 8 * lane; gv[j][0] = *(const f32x4*)gp; gv[j][1] = *(const f32x4*)(gp + 4); }
    for (int m = gw; m < M; m += NGW) {
        u32x4* yr = (u32x4*)(y + (size_t)m * D) + lane; u32x4 raw[4]; float s0 = 0.f, s1 = 0.f;
#pragma unroll
        for (int j = 0; j < 4; ++j) raw[j] = yr[64 * j];
        float v[4][8];
#pragma unroll
        for (int j = 0; j < 4; ++j) {
            v[j][0] = bf_lo(raw[j].x); v[j][1] = bf_hi(raw[j].x); v[j][2] = bf_lo(raw[j].y); v[j][3] = bf_hi(raw[j].y);
            v[j][4] = bf_lo(raw[j].z); v[j][5] = bf_hi(raw[j].z); v[j][6] = bf_lo(raw[j].w); v[j][7] = bf_hi(raw[j].w);
            float s = 0.f;
#pragma unroll
            for (int e = 0; e < 8; ++e) s += v[j][e] * v[j][e];
            if (j < 2) s0 += s; else s1 += s;
        }
        const float r0 = 1.0f / sqrtf(wave_sum(s0) * (1.0f / 1024.f) + EPS), r1 = 1.0f / sqrtf(wave_sum(s1) * (1.0f / 1024.f) + EPS);
#pragma unroll
        for (int j = 0; j < 4; ++j) { const float r = j < 2 ? r0 : r1; u32x4 w;
            w.x = cvt_pk_bf16(v[j][0] * r * gv[j][0].x, v[j][1] * r * gv[j][0].y); w.y = cvt_pk_bf16(v[j][2] * r * gv[j][0].z, v[j][3] * r * gv[j][0].w);
            w.z = cvt_pk_bf16(v[j][4] * r * gv[j][1].x, v[j][5] * r * gv[j][1].y); w.w = cvt_pk_bf16(v[j][6] * r * gv[j][1].z, v[j][7] * r * gv[j][1].w);
            yr[64 * j] = w; }
    }
}

constexpr int LM_BIAS = 0;
constexpr int LM_CW = 8448;
constexpr int LM_CB = 9472;
constexpr int LM_P = 10240;
constexpr int LM_H = 18432;
__device__ __forceinline__ void lru_unit(LAS unsigned char* lds, const bf16_t* zm, bf16_t* yraw, float* yp, const float* conv_w, const float* conv_b, const float* wa, const float* ba,
                                         const float* wx, const float* bx, const float* lam, int b, int hb, int tid) {
    LAUNDER(tid);
    const int lane = tid & 63, w = tid >> 6, fr = lane & 15, fq = lane >> 4;
    LAS float* cwL = (LAS float*)(lds + LM_CW); LAS float* cbL = (LAS float*)(lds + LM_CB);
    if (tid < 256) cwL[tid] = conv_w[(tid >> 6) * DL + hb * 64 + (tid & 63)];
    else if (tid < 320) cbL[tid - 256] = conv_b[hb * 64 + tid - 256];
    bf16x8 WA[4][2], WX[4][2];
#pragma unroll
    for (int nt = 0; nt < 4; ++nt)
#pragma unroll
        for (int ks = 0; ks < 2; ++ks) {
            const float* pa = wa + ((size_t)hb * 64 + ks * 32 + 8 * fq) * 64 + nt * 16 + fr; const float* px = wx + ((size_t)hb * 64 + ks * 32 + 8 * fq) * 64 + nt * 16 + fr;
            u32x4 ua, ux;
            ua.x = cvt_pk_bf16(pa[0 * 64], pa[1 * 64]); ua.y = cvt_pk_bf16(pa[2 * 64], pa[3 * 64]); ua.z = cvt_pk_bf16(pa[4 * 64], pa[5 * 64]); ua.w = cvt_pk_bf16(pa[6 * 64], pa[7 * 64]);
            ux.x = cvt_pk_bf16(px[0 * 64], px[1 * 64]); ux.y = cvt_pk_bf16(px[2 * 64], px[3 * 64]); ux.z = cvt_pk_bf16(px[4 * 64], px[5 * 64]); ux.w = cvt_pk_bf16(px[6 * 64], px[7 * 64]);
            WA[nt][ks] = __builtin_bit_cast(bf16x8, ua); WX[nt][ks] = __builtin_bit_cast(bf16x8, ux);
        }
    bf16x8 ID[2];
#pragma unroll
    for (int p = 0; p < 2; ++p)
#pragma unroll
        for (int e = 0; e < 8; ++e) ID[p][e] = (8 * fq + e == 16 * p + fr) ? (short)0x3F80 : (short)0;
    float pba[4], pbx[4], pcl[4];
#pragma unroll
    for (int nt = 0; nt < 4; ++nt) { const int c = hb * 64 + nt * 16 + fr; pba[nt] = ba[c]; pbx[nt] = bx[c]; pcl[nt] = -8.0f * log1pf(expf(-lam[c])); }
    __syncthreads();
    float hin[4] = {0.f, 0.f, 0.f, 0.f};
    const bf16_t* zb = zm + (size_t)b * SEQ * ZLD + hb * 64;
    LAS f32x2* TOT = (LAS f32x2*)(lds + LM_P);
    u32x4 XR[2][4], GR[2];
    {
        const int tA = 16 * w + fr;
#pragma unroll
        for (int ks = 0; ks < 2; ++ks) {
            const int ch0 = ks * 32 + 8 * fq;
#pragma unroll
            for (int tap = 0; tap < 4; ++tap) { const int t = tA - 3 + tap; const int tt = t >= 0 ? t : 0; XR[ks][tap] = *(const u32x4*)(zb + (size_t)tt * ZLD + ch0); }
            GR[ks] = *(const u32x4*)(zb + (size_t)tA * ZLD + 1024 + ch0);
        }
    }
#pragma unroll 1
    for (int sc = 0; sc < 16; ++sc) {
        const int tA = sc * 128 + 16 * w + fr;
        const int tN = sc < 15 ? tA + 128 : tA;
        u32x4 XN[2][4], GN[2];
#pragma unroll
        for (int ks = 0; ks < 2; ++ks) {
            const int ch0 = ks * 32 + 8 * fq;
#pragma unroll
            for (int tap = 0; tap < 4; ++tap) XN[ks][tap] = *(const u32x4*)(zb + (size_t)(tN - 3 + tap) * ZLD + ch0);
            GN[ks] = *(const u32x4*)(zb + (size_t)tN * ZLD + 1024 + ch0);
        }
        bf16x8 XC[2], GL[2];
#pragma unroll
        for (int ks = 0; ks < 2; ++ks) {
            const int ch0 = ks * 32 + 8 * fq;
            const f32x4 c0 = *(const LAS f32x4*)(cbL + ch0), c1 = *(const LAS f32x4*)(cbL + ch0 + 4);
            float a8[8] = {c0.x, c0.y, c0.z, c0.w, c1.x, c1.y, c1.z, c1.w};
#pragma unroll
            for (int tap = 0; tap < 4; ++tap) {
                const bool ok = (tA - 3 + tap) >= 0;
                u32x4 xr = XR[ks][tap];
                if (!ok) xr = (u32x4){0u, 0u, 0u, 0u};
                const f32x4 w0 = *(const LAS f32x4*)(cwL + tap * 64 + ch0), w1 = *(const LAS f32x4*)(cwL + tap * 64 + ch0 + 4);
                a8[0] += w0.x * bf_lo(xr.x); a8[1] += w0.y * bf_hi(xr.x); a8[2] += w0.z * bf_lo(xr.y); a8[3] += w0.w * bf_hi(xr.y);
                a8[4] += w1.x * bf_lo(xr.z); a8[5] += w1.y * bf_hi(xr.z); a8[6] += w1.z * bf_lo(xr.w); a8[7] += w1.w * bf_hi(xr.w);
            }
            u32x4 pk; pk.x = cvt_pk_bf16(a8[0], a8[1]); pk.y = cvt_pk_bf16(a8[2], a8[3]); pk.z = cvt_pk_bf16(a8[4], a8[5]); pk.w = cvt_pk_bf16(a8[6], a8[7]);
            XC[ks] = __builtin_bit_cast(bf16x8, pk);
            GL[ks] = __builtin_bit_cast(bf16x8, GR[ks]);
        }
        float hl[4][4], pc[4][4], gel[4][4], PE[4], HE[4];
        LAS f32x2* totw = TOT + ((sc & 1) * 8 + w) * 64;
#pragma unroll
        for (int nt = 0; nt < 4; ++nt) {
            f32x4 ga = (f32x4){0.f, 0.f, 0.f, 0.f}, gx = ga, xo = ga, go = ga;
#pragma unroll
            for (int ks = 0; ks < 2; ++ks) { ga = __builtin_amdgcn_mfma_f32_16x16x32_bf16(XC[ks], WA[nt][ks], ga, 0, 0, 0); gx = __builtin_amdgcn_mfma_f32_16x16x32_bf16(XC[ks], WX[nt][ks], gx, 0, 0, 0); }
            xo = __builtin_amdgcn_mfma_f32_16x16x32_bf16(XC[nt >> 1], ID[nt & 1], xo, 0, 0, 0);
            go = __builtin_amdgcn_mfma_f32_16x16x32_bf16(GL[nt >> 1], ID[nt & 1], go, 0, 0, 0);
#pragma unroll
            for (int hh = 0; hh < 2; ++hh) {
                const f32x2 ga2 = (f32x2){ga[2 * hh], ga[2 * hh + 1]}, gx2 = (f32x2){gx[2 * hh], gx[2 * hh + 1]}, xo2 = (f32x2){xo[2 * hh], xo[2 * hh + 1]}, go2 = (f32x2){go[2 * hh], go[2 * hh + 1]};
                const f32x2 ta = (ga2 + pba[nt]) * (-LOG2E), tx = (gx2 + pbx[nt]) * (-LOG2E);
                f32x2 da, dx; da.x = fast_exp2(ta.x); da.y = fast_exp2(ta.y); dx.x = fast_exp2(tx.x); dx.y = fast_exp2(tx.y);
                da = da + 1.0f; dx = dx + 1.0f;
                f32x2 r, ig; r.x = fast_rcp(da.x); r.y = fast_rcp(da.y); ig.x = fast_rcp(dx.x); ig.y = fast_rcp(dx.y);
                const f32x2 la2 = r * (pcl[nt] * LOG2E), x2 = r * (2.0f * pcl[nt]);
                f32x2 av; av.x = fast_exp2(la2.x); av.y = fast_exp2(la2.y);
                const f32x2 omp = -x2 * (x2 * 0.5f * (x2 * (1.0f / 3.0f) + 1.0f) + 1.0f), omd = 1.0f - av * av;
                f32x2 uv; uv.x = __builtin_amdgcn_sqrtf(x2.x < -0.03f ? omd.x : omp.x); uv.y = __builtin_amdgcn_sqrtf(x2.y < -0.03f ? omd.y : omp.y);
                uv = uv * ig * xo2;
                const f32x2 tg = go2 * (go2 * go2 * (-LOG2E * 1.5957691216057308f * 0.044715f) + (-LOG2E * 1.5957691216057308f));
                f32x2 dg; dg.x = fast_exp2(tg.x); dg.y = fast_exp2(tg.y); dg = dg + 1.0f;
                gel[nt][2 * hh] = go2.x * fast_rcp(dg.x); gel[nt][2 * hh + 1] = go2.y * fast_rcp(dg.y);
                if (hh == 0) { hl[nt][0] = uv.x; pc[nt][0] = av.x; }
                else { hl[nt][2] = av.x * hl[nt][1] + uv.x; pc[nt][2] = pc[nt][1] * av.x; }
                hl[nt][2 * hh + 1] = av.y * hl[nt][2 * hh] + uv.y; pc[nt][2 * hh + 1] = pc[nt][2 * hh] * av.y;
            }
            float P = pc[nt][3], H = hl[nt][3];
            { const float Pp = __shfl_up(P, 16), Hp = __shfl_up(H, 16); if (fq >= 1) { H = P * Hp + H; P = P * Pp; } }
            { const float Pp = __shfl_up(P, 32), Hp = __shfl_up(H, 32); if (fq >= 2) { H = P * Hp + H; P = P * Pp; } }
            { float Pe = __shfl_up(P, 16), He = __shfl_up(H, 16); if (fq == 0) { Pe = 1.0f; He = 0.0f; } PE[nt] = Pe; HE[nt] = He; }
            if (fq == 3) totw[nt * 16 + fr] = (f32x2){P, H};
        }
        asm volatile("s_waitcnt lgkmcnt(0)" ::: "memory"); __builtin_amdgcn_s_barrier(); asm volatile("" ::: "memory");
        float psq[4] = {0.f, 0.f, 0.f, 0.f};
#pragma unroll
        for (int nt = 0; nt < 4; ++nt) {
            float hrun = hin[nt], hws = hin[nt];
#pragma unroll
            for (int w2 = 0; w2 < 8; ++w2) { const f32x2 t2 = TOT[((sc & 1) * 8 + w2) * 64 + nt * 16 + fr]; hrun = t2.x * hrun + t2.y; if (w2 + 1 == w) hws = hrun; }
            hin[nt] = hrun;
            const float hs = PE[nt] * hws + HE[nt];
#pragma unroll
            for (int j = 0; j < 4; ++j) {
                const float ov = (hl[nt][j] + pc[nt][j] * hs) * gel[nt][j]; psq[j] += ov * ov;
                const unsigned o = cvt_pk_bf16(ov, 0.f);
                yraw[(size_t)(b * SEQ + sc * 128 + 16 * w + 4 * fq + j) * D + hb * 64 + nt * 16 + fr] = (bf16_t)(o & 0xffffu);
            }
        }
#pragma unroll
        for (int j = 0; j < 4; ++j) { float q = psq[j]; q += __shfl_xor(q, 1); q += __shfl_xor(q, 2); q += __shfl_xor(q, 4); q += __shfl_xor(q, 8);
            if (fr == 0) yp[(size_t)(b * SEQ + sc * 128 + 16 * w + 4 * fq + j) * 24 + hb] = q; }
#pragma unroll
        for (int ks = 0; ks < 2; ++ks) {
#pragma unroll
            for (int tap = 0; tap < 4; ++tap) XR[ks][tap] = XN[ks][tap];
            GR[ks] = GN[ks];
        }
    }
    __syncthreads();
}

constexpr int LM_ATT = 32768;
#define ATT_COMPUTE(FAR) do { \
        bf16x8 Kf[2][4], Vf[8]; \
        _Pragma("unroll") for (int t = 0; t < 2; ++t) _Pragma("unroll") for (int ks = 0; ks < 4; ++ks) Kf[t][ks] = *(const LAS bf16x8*)(sb + (t * 4 + ks) * 1024 + foff); \
        _Pragma("unroll") for (int dt = 0; dt < 8; ++dt) Vf[dt] = *(const LAS bf16x8*)(sb + 8192 + dt * 1024 + foff); \
        f32x4 St[2][2]; \
        _Pragma("unroll") for (int t = 0; t < 2; ++t) _Pragma("unroll") for (int qt = 0; qt < 2; ++qt) { f32x4 s_ = (f32x4){0.f, 0.f, 0.f, 0.f}; \
            _Pragma("unroll") for (int ks = 0; ks < 4; ++ks) s_ = __builtin_amdgcn_mfma_f32_16x16x32_bf16(Kf[t][ks], Q[qt][ks], s_, 0, 0, 0); \
            St[t][qt] = s_; } \
        bf16x8 Pf[2]; \
        _Pragma("unroll") for (int qt = 0; qt < 2; ++qt) { \
            const int qpos = c * 64 + qh * 32 + qt * 16 + fr; \
            float sv[8]; float bm = -1e30f; \
            _Pragma("unroll") for (int t = 0; t < 2; ++t) _Pragma("unroll") for (int j = 0; j < 4; ++j) { float bv_; \
                if (FAR) bv_ = bias0; else { int rel = k0 + 8 * fq + 4 * t + j - qpos; rel = rel < -128 ? -128 : (rel > 128 ? 128 : rel); bv_ = bias[rel + 128]; } \
                const float s_ = St[t][qt][j] * SC + bv_; sv[t * 4 + j] = s_; bm = fmaxf(bm, s_); } \
            bm = fmaxf(bm, __shfl_xor(bm, 16)); bm = fmaxf(bm, __shfl_xor(bm, 32)); \
            const float mn = (bm > mrun[qt] + 8.0f) ? bm : mrun[qt];     \
            if (__builtin_amdgcn_ballot_w64(mn != mrun[qt]) != 0ull) { const float alpha = fast_exp2(mrun[qt] - mn); mrun[qt] = mn; lrun[qt] = lrun[qt] * alpha; \
                _Pragma("unroll") for (int dt = 0; dt < 8; ++dt) O[dt][qt] = O[dt][qt] * alpha; } \
            float ps = 0.f; \
            _Pragma("unroll") for (int e = 0; e < 8; ++e) { sv[e] = fast_exp2(sv[e] - mn); ps += sv[e]; } \
            lrun[qt] = lrun[qt] + ps; \
            u32x4 pk; pk.x = cvt_pk_bf16(sv[0], sv[1]); pk.y = cvt_pk_bf16(sv[2], sv[3]); pk.z = cvt_pk_bf16(sv[4], sv[5]); pk.w = cvt_pk_bf16(sv[6], sv[7]); \
            Pf[qt] = __builtin_bit_cast(bf16x8, pk); } \
        _Pragma("unroll") for (int dt = 0; dt < 8; ++dt) _Pragma("unroll") for (int qt = 0; qt < 2; ++qt) O[dt][qt] = __builtin_amdgcn_mfma_f32_16x16x32_bf16(Vf[dt], Pf[qt], O[dt][qt], 0, 0, 0); \
    } while (0)
__device__ __forceinline__ void attn_block(LAS unsigned char* lds, const bf16_t* zm, const bf16_t* Kh, const bf16_t* Vt, bf16_t* yraw, float* yp, const LAS float* biasAll, int b, int h, int g, int tid) {
    LAUNDER(tid);
    const int lane = tid & 63, wave = tid >> 6, fr = lane & 15, fq = lane >> 4;
    const int c = 4 * g + (wave >> 1), qh = wave & 1;
    const LAS float* bias = biasAll + h * NREL;
    const float bias0 = bias[0];
    const float SC = 0.08838834764831845f * LOG2E;
    bf16x8 Q[2][4];
#pragma unroll
    for (int qt = 0; qt < 2; ++qt) { const size_t tok = (size_t)b * SEQ + c * 64 + qh * 32 + qt * 16 + fr;
#pragma unroll
        for (int ks = 0; ks < 4; ++ks) Q[qt][ks] = *(const bf16x8*)(zm + tok * ZLD + 2048 + h * HD + ks * 32 + 8 * fq); }
    f32x4 O[8][2];
#pragma unroll
    for (int dt = 0; dt < 8; ++dt)
#pragma unroll
        for (int qt = 0; qt < 2; ++qt) O[dt][qt] = (f32x4){0.f, 0.f, 0.f, 0.f};
    float mrun[2] = {-1e30f, -1e30f}, lrun[2] = {0.f, 0.f};
    const int lo = g >= 2 ? 4 * g - 8 : 0, nch = 4 * g + 4 - lo;
    const int kr = tid >> 4, c16 = tid & 15;
    const int krho = ((kr >> 3) << 2) | (kr & 3);
    const int kst = ((((kr >> 2) & 1) * 4 + (c16 >> 2)) * 1024) + ((krho * 64 + (c16 & 3) * 16) ^ (krho >= 8 ? 32 : 0));
    const bf16_t* kg = Kh + ((size_t)(b * NH + h) * SEQ + kr) * HD + 8 * c16;
    const int vd = tid >> 2, vq = tid & 3;
    const int vst = 8192 + (vd >> 4) * 1024 + (((vd & 15) * 64 + vq * 16) ^ ((vd & 15) >= 8 ? 32 : 0));
    const bf16_t* vg = Vt + ((size_t)(b * NH + h) * HD + vd) * SEQ + 8 * vq;
    const int foff = (fr * 64 + fq * 16) ^ (fr >= 8 ? 32 : 0);
    LAS unsigned char* st = lds + LM_ATT;
    { const int k0 = lo * 64;
      const u32x4 kv0 = *(const u32x4*)(kg + (size_t)k0 * HD), kv1 = *(const u32x4*)(kg + (size_t)(k0 + 32) * HD); const u32x4 vv0 = *(const u32x4*)(vg + k0), vv1 = *(const u32x4*)(vg + k0 + 32);
      *(LAS u32x4*)(st + kst) = kv0; *(LAS u32x4*)(st + vst) = vv0; *(LAS u32x4*)(st + 16384 + kst) = kv1; *(LAS u32x4*)(st + 16384 + vst) = vv1; }
    __syncthreads();
#pragma unroll 1
    for (int ci = 0; ci < nch; ++ci) {
        const int kc = lo + ci;
        const int k0n = (lo + (ci + 1 < nch ? ci + 1 : ci)) * 64;
        const u32x4 kv0 = *(const u32x4*)(kg + (size_t)k0n * HD), kv1 = *(const u32x4*)(kg + (size_t)(k0n + 32) * HD); const u32x4 vv0 = *(const u32x4*)(vg + k0n), vv1 = *(const u32x4*)(vg + k0n + 32);
        if (kc >= c - 8 && kc <= c) {
            const bool farc = kc <= c - 3;
#pragma unroll 1
            for (int hf = 0; hf < 2; ++hf) {
                const LAS unsigned char* sb = st + (ci & 1) * 32768 + hf * 16384; const int k0 = kc * 64 + hf * 32;
                if (farc) ATT_COMPUTE(true); else ATT_COMPUTE(false);
            }
        }
        LAS unsigned char* nb = st + ((ci + 1) & 1) * 32768;
        *(LAS u32x4*)(nb + kst) = kv0; *(LAS u32x4*)(nb + vst) = vv0; *(LAS u32x4*)(nb + 16384 + kst) = kv1; *(LAS u32x4*)(nb + 16384 + vst) = vv1;
        __syncthreads();
    }
#pragma unroll
    for (int qt = 0; qt < 2; ++qt) {
        float l = lrun[qt]; l += __shfl_xor(l, 16); l += __shfl_xor(l, 32);
        const float inv = 1.0f / l;
        bf16_t* op = yraw + ((size_t)b * SEQ + c * 64 + qh * 32 + qt * 16 + fr) * D + 1024 + h * HD + 4 * fq;
        float q = 0.f;
#pragma unroll
        for (int dt = 0; dt < 8; ++dt) { const f32x4 o = O[dt][qt] * inv; u32x2 w; w.x = cvt_pk_bf16(o.x, o.y); w.y = cvt_pk_bf16(o.z, o.w); *(u32x2*)(op + dt * 16) = w; q += (o.x * o.x + o.y * o.y) + (o.z * o.z + o.w * o.w); }
        q += __shfl_xor(q, 16); q += __shfl_xor(q, 32);
        if (fq == 0) yp[((size_t)b * SEQ + c * 64 + qh * 32 + qt * 16 + fr) * 24 + 16 + h] = q;
    }
}
#undef ATT_COMPUTE

#define XB_TMO      128
#define XB_XCNT(j)  (256  + 64 * (j))
#define XB_XSUB(j)  (1280 + 64 * (j))
#define XB_XGEN(j)  (2304 + 64 * (j))
#define XB_TOP      3328
#define XB_TOPGEN   3392
#define XCD_BAR_WORDS 3456
#define XB_SPIN_CAP (1u << 18)
__device__ __forceinline__ unsigned xb_ld(unsigned* p)              { return __hip_atomic_load(p, __ATOMIC_RELAXED, __HIP_MEMORY_SCOPE_AGENT); }
__device__ __forceinline__ unsigned xb_add(unsigned* p, unsigned v) { return __hip_atomic_fetch_add(p, v, __ATOMIC_RELAXED, __HIP_MEMORY_SCOPE_AGENT); }
__device__ __forceinline__ unsigned xb_xcc_id() { return (unsigned)__builtin_amdgcn_s_getreg((3 << 11) | 20) & 0xFu; }
#define XB_SPIN(cond, bar) do { unsigned _sp = 0; while (cond) { __builtin_amdgcn_s_sleep(1); \
    if ((++_sp & 255u) == 0u) { if (xb_ld(&(bar)[XB_TMO])) break; if (_sp > XB_SPIN_CAP) { atomicAdd(&(bar)[XB_TMO], 1u); break; } } } } while (0)
struct XcdBarrier { unsigned* bar; unsigned x; volatile LAS unsigned* st; };
__device__ __forceinline__ XcdBarrier xcd_barrier_post(unsigned* bar, volatile LAS unsigned* st) {
    XcdBarrier b; b.bar = bar; b.x = xb_xcc_id(); b.st = st;
    if (threadIdx.x == 0) (void)xb_add(&bar[XB_XCNT(b.x)], 1u);
    return b;
}
__device__ __forceinline__ void xcd_barrier_complete(unsigned* bar, unsigned x, unsigned& nloc, unsigned& nx) {
    const unsigned G = gridDim.x * gridDim.y * gridDim.z;
    unsigned sum, cnt, mine, sp = 0u;
    for (;;) {
        sum = 0u; cnt = 0u; mine = 0u;
#pragma unroll
        for (unsigned j = 0; j < 16; ++j) { const unsigned c = xb_ld(&bar[XB_XCNT(j)]); sum += c; cnt += (c > 0u) ? 1u : 0u; mine = (j == x) ? c : mine; }
        if (sum == G) break;
        __builtin_amdgcn_s_sleep(1);
        if ((++sp & 255u) == 0u) { if (xb_ld(&bar[XB_TMO])) break; if (sp > XB_SPIN_CAP) { atomicAdd(&bar[XB_TMO], 1u); break; } }
    }
    nloc = mine > 0u ? mine : 1u; nx = cnt > 0u ? cnt : 1u;
}
__device__ __forceinline__ void xcd_barrier(const XcdBarrier& b) {
    asm volatile("s_waitcnt vmcnt(0)" ::: "memory");
    __syncthreads();
    if (threadIdx.x == 0) {
        unsigned* bar = b.bar;
        __builtin_amdgcn_s_waitcnt(0);
        unsigned nloc = b.st[0], nx = b.st[1];
        if (nloc == 0u) { xcd_barrier_complete(bar, b.x, nloc, nx); b.st[0] = nloc; b.st[1] = nx; }
        const unsigned old = xb_add(&bar[XB_XSUB(b.x)], 1u);
        const unsigned gen = old / nloc;
        if (old + 1u == (gen + 1u) * nloc) {
            __builtin_amdgcn_fence(__ATOMIC_RELEASE, "agent");
            asm volatile("s_waitcnt vmcnt(0)" ::: "memory");
            const unsigned og = xb_add(&bar[XB_TOP], 1u);
            const unsigned tg = og / nx;
            if (og + 1u == (tg + 1u) * nx) xb_add(&bar[XB_TOPGEN], 1u);
            else XB_SPIN(xb_ld(&bar[XB_TOPGEN]) == tg, bar);
            __builtin_amdgcn_fence(__ATOMIC_ACQUIRE, "agent");
            xb_add(&bar[XB_XGEN(b.x)], 1u);
            asm volatile("s_waitcnt vmcnt(0)" ::: "memory");
        } else {
            XB_SPIN(xb_ld(&bar[XB_XGEN(b.x)]) == gen, bar);
            __builtin_amdgcn_fence(__ATOMIC_ACQUIRE, "agent");
            asm volatile("s_waitcnt vmcnt(0)" ::: "memory");
        }
    }
    __syncthreads();
}

struct Args { const float* in[23]; float* out; unsigned char* ws; int pad0, pad1; };

__global__ void __launch_bounds__(NTHREADS, 2) mk_fwd(Args args) {
    extern __shared__ __attribute__((aligned(16))) unsigned char lds_raw[];
    LAS unsigned char* lds = (LAS unsigned char*)lds_raw;
    cg::grid_group grid = cg::this_grid();
    const int tid = threadIdx.x, lane = tid & 63, wave = __builtin_amdgcn_readfirstlane(tid >> 6);
    const int G = gridDim.x, bx = blockIdx.x;
    const int gw = bx * NWAVES + wave, NGW = G * NWAVES;
    typedef const float* cfp;
    const __attribute__((address_space(4))) cfp* inp = (const __attribute__((address_space(4))) cfp*)__builtin_amdgcn_kernarg_segment_ptr();
#define INP(k) (inp[k])
#define LAUNDER_S(v) asm volatile("" : "+s"(v))
    unsigned char* ws = args.ws;
    float* out = args.out;
    volatile LAS unsigned* bst = (volatile LAS unsigned*)(lds + 131072 + 64);
    if (tid < 2) bst[tid] = 0u;
    __syncthreads();
    if (bx == 0) for (int i = tid; i < 12288; i += NTHREADS) ((unsigned*)(ws + WS_CTL))[i] = 0u;
#define GRID_BAR() do { XcdBarrier xb_; xb_.bar = (unsigned*)(args.ws + WS_CTL); xb_.x = xb_xcc_id(); xb_.st = (volatile LAS unsigned*)(lds + 131072 + 64); xcd_barrier(xb_); } while (0)
    bf16_t* HID = (bf16_t*)(ws + WS_BIG); bf16_t* ZM = (bf16_t*)(ws + WS_BIG); bf16_t* VT = (bf16_t*)(ws + WS_VT); bf16_t* KH = (bf16_t*)(ws + WS_KH); bf16_t* HB = (bf16_t*)(ws + WS_H); bf16_t* HB2 = (bf16_t*)(ws + WS_H2); float* SSQ = (float*)(ws + WS_SSQ); float* YP = (float*)(ws + WS_YP);

    {
        LAS float* scr = (LAS float*)(lds + wave * 16384);
        constexpr int I_G = (D / 64) * (FF / 32), I_D = (FF / 64) * (D / 32), I_IN = (D / 64) * (DIN / 32), I_O = (D / 64) * (D / 32);
        constexpr int PER_LAYER = 4 * I_G + 2 * I_D + I_IN + I_O;
        for (int it = gw; it < DEPTH * PER_LAYER; it += NGW) {
            const int l = it / PER_LAYER; int r = it % PER_LAYER;
            unsigned char* wl = ws + (size_t)l * LAYER_W;
            if (r < I_G) { p0_transpose_item(INP(2) + (size_t)l * D * FF, INP(1) + (size_t)l * D, D, FF, (bf16_t*)(wl + OFF_WGU1), 0, scr, r, lane); continue; } r -= I_G;
            if (r < I_G) { p0_transpose_item(INP(3) + (size_t)l * D * FF, INP(1) + (size_t)l * D, D, FF, (bf16_t*)(wl + OFF_WGU1), 128, scr, r, lane); continue; } r -= I_G;
            if (r < I_D) { p0_transpose_item(INP(4) + (size_t)l * FF * D, nullptr, FF, D, (bf16_t*)(wl + OFF_WD1), -1, scr, r, lane); continue; } r -= I_D;
            if (r < I_IN) { p0_transpose_item(INP(6) + (size_t)l * D * DIN, INP(5) + (size_t)l * D, D, DIN, (bf16_t*)(wl + OFF_WIN), -1, scr, r, lane); continue; } r -= I_IN;
            if (r < I_O) { p0_transpose_item(INP(17) + (size_t)l * D * D, INP(15) + (size_t)l * DL, D, D, (bf16_t*)(wl + OFF_WOUT), -1, scr, r, lane, INP(16) + (size_t)l * DL); continue; } r -= I_O;
            if (r < I_G) { p0_transpose_item(INP(19) + (size_t)l * D * FF, INP(18) + (size_t)l * D, D, FF, (bf16_t*)(wl + OFF_WGU2), 0, scr, r, lane); continue; } r -= I_G;
            if (r < I_G) { p0_transpose_item(INP(20) + (size_t)l * D * FF, INP(18) + (size_t)l * D, D, FF, (bf16_t*)(wl + OFF_WGU2), 128, scr, r, lane); continue; } r -= I_G;
            p0_transpose_item(INP(21) + (size_t)l * FF * D, nullptr, FF, D, (bf16_t*)(wl + OFF_WD2), -1, scr, r, lane);
        }
        cast_rows_bf16(INP(0), HB, SSQ, gw, NGW, lane);
    }
    grid.sync();
    (void)xcd_barrier_post((unsigned*)(ws + WS_CTL), bst);

#pragma unroll 1
    for (int l = 0; l < DEPTH; ++l) {
        unsigned char* wl = ws + (size_t)l * LAYER_W;
#pragma unroll 1
        for (int f = 0; f < 2; ++f) {
            LAUNDER_S(inp);
            {
                pg8::Gemm g{HB, (const bf16_t*)(wl + (f ? OFF_WGU2 : OFF_WGU1)), M, 2 * FF, D}; pg8::StaticOrder S; S.init(M, 2 * FF, G, bx);
                { if (tid == 0) *(volatile LAS int*)(lds + pg8::LDS_RSPM) = -1; __syncthreads(); }
                pg8::EpiSwiGLU E{HID, FF, SSQ + (size_t)(3 * l + (f ? 2 : 0)) * M * 8, lds};
                pg8::gemm_phase<pg8::EpiSwiGLU, pg8::StaticOrder, true, true>(lds, g, S, E);
            }
            GRID_BAR();
            {
                pg8::Gemm g{HID, (const bf16_t*)(wl + (f ? OFF_WD2 : OFF_WD1)), M, D, FF}; pg8::StaticOrder S; S.init(M, D, G, bx);
                if (l + 1 == DEPTH && f == 1) {
                    pg8::EpiResidFinal E{HB, out, INP(22), SSQ + (size_t)6 * M * 8, (unsigned*)(ws + WS_CTL) + 4096, lds};
                    pg8::gemm_phase<pg8::EpiResidFinal, pg8::StaticOrder, true, true>(lds, g, S, E);
                } else {
                    pg8::EpiResid<true> E{HB, SSQ + (size_t)(3 * l + (f ? 3 : 1)) * M * 8, lds};
                    pg8::gemm_phase<pg8::EpiResid<true>, pg8::StaticOrder, true, true>(lds, g, S, E);
                }
            }
            if (!(l + 1 == DEPTH && f == 1)) GRID_BAR();
            if (f == 0) {
                {
                    pg8::Gemm g{HB, (const bf16_t*)(wl + OFF_WIN), M, DIN, D}; pg8::StaticOrder S; S.init(M, DIN, G, bx);
                    { if (tid == 0) *(volatile LAS int*)(lds + pg8::LDS_RSPM) = -1; __syncthreads(); }
                    pg8::EpiZ E{ZM, VT, KH, SSQ + (size_t)(3 * l + 1) * M * 8, lds};
                    pg8::gemm_phase<pg8::EpiZ, pg8::StaticOrder, true, true>(lds, g, S, E);
                }
                GRID_BAR();
                {
                    LAS float* biasL = (LAS float*)(lds + LM_BIAS);
                    const float* rb = INP(14) + (size_t)l * NH * NREL;
                    int tid_m = tid; LAUNDER(tid_m);
                    for (int i = tid_m; i < NH * NREL; i += NTHREADS) biasL[i] = rb[i] * LOG2E;
                    __syncthreads();
                    for (int u = bx; u < NB * 16; u += G)
                        lru_unit(lds, ZM, HB2, YP, INP(7) + (size_t)l * 4 * DL, INP(8) + (size_t)l * DL, INP(9) + (size_t)l * 16 * 64 * 64, INP(10) + (size_t)l * DL,
                                 INP(11) + (size_t)l * 16 * 64 * 64, INP(12) + (size_t)l * DL, INP(13) + (size_t)l * DL, u >> 4, u & 15, tid);
                    for (int bu = bx; bu < 1024; bu += G) {
                        const int kk = bu >> 8, bxv = bu & 255;
                        const int ag = ((bxv & 7) + 2 * kk) & 7, ap = (bxv >> 3) + 32 * kk;
                        attn_block(lds, ZM, KH, VT, HB2, YP, biasL, ap >> 3, ap & 7, ag, tid);
                    }
                }
                GRID_BAR();
                {
                    pg8::Gemm g{HB2, (const bf16_t*)(wl + OFF_WOUT), M, D, D}; pg8::StaticOrder S; S.init(M, D, G, bx);
                    { if (tid == 0) *(volatile LAS int*)(lds + pg8::LDS_RS2PM) = -1; __syncthreads(); }
                    pg8::EpiResidY E{HB, SSQ + (size_t)(3 * l + 2) * M * 8, YP, lds};
                    { pg8::Unit u0; if (S.next(0, u0)) E.prep(u0); }
                    pg8::gemm_phase<pg8::EpiResidY, pg8::StaticOrder, true, true>(lds, g, S, E);
                }
                GRID_BAR();
            } else {
            }
        }
    }
}

extern "C" void kernel_launch(void* const* d_in, const int* in_sizes, int n_in, void* d_out, int out_size, void* d_ws, size_t ws_size, hipStream_t stream) {
    static int grid = 0;
    if (grid == 0) {
        if (n_in != 23 || in_sizes[0] != M * D || out_size != M * D || ws_size < WS_END) {
            fprintf(stderr, "kernel_launch: unexpected shapes: n_in %d in0 %d out %d ws %zu (need %zu)\n", n_in, n_in > 0 ? in_sizes[0] : -1, out_size, ws_size, (size_t)WS_END); grid = -1; return; }
        int dev = 0, cus = 0, per_cu = 0;
        hipGetDevice(&dev); hipDeviceGetAttribute(&cus, hipDeviceAttributeMultiprocessorCount, dev);
        if (hipFuncSetAttribute((const void*)mk_fwd, hipFuncAttributeMaxDynamicSharedMemorySize, LDS_BYTES) != hipSuccess) fprintf(stderr, "kernel_launch: hipFuncSetAttribute failed\n");
        if (hipOccupancyMaxActiveBlocksPerMultiprocessor(&per_cu, (const void*)mk_fwd, NTHREADS, LDS_BYTES) != hipSuccess || per_cu < 1) { fprintf(stderr, "kernel_launch: occupancy query gave %d\n", per_cu); per_cu = 1; }
        (void)hipGetLastError();
        grid = cus * per_cu;
        if (grid > 256) grid = 256;
    }
    if (grid < 0) return;
    Args a{};
    for (int i = 0; i < 23; ++i) a.in[i] = (const float*)d_in[i];
    a.out = (float*)d_out; a.ws = (unsigned char*)d_ws;
    void* kargs[] = {&a};
    hipError_t e = hipLaunchCooperativeKernel((const void*)mk_fwd, dim3(grid), dim3(NTHREADS), kargs, LDS_BYTES, stream);
    if (e != hipSuccess) fprintf(stderr, "kernel_launch: cooperative launch failed: %s (grid %d)\n", hipGetErrorString(e), grid);
}
```
